# Optimizing an MI355X kernel written in HIP

```python
import math
import jax, jax.numpy as jnp
from jax import lax
import numpy as np

D_MODEL = 2048
BATCH = 1
SEQ = 8192
DEPTH = 1

HEAD_DIM = 128
A_HEADS = 8
A_KV_HEADS = 2
B_HEADS = 8
B_KV_HEADS = 2
WINDOW = 128
BLOCK = 128
N_BUCKETS = 32
MAX_DISTANCE = 128
GRID_W = 64
ROPE_THETA = 10000.0
N_EXPERTS = 64
TOP_K = 8
N_GROUPS = 8
TOPK_GROUPS = 4
EXPERT_HIDDEN = 512
SHARED_HIDDEN = 512
ROUTED_SCALE = 2.5
MOE_BLOCK = 128
LN_EPS = 1e-5
RMS_EPS = 1e-6
DEEPNORM_ALPHA = (2 * DEPTH) ** 0.25
DEEPNORM_BETA = (8 * DEPTH) ** -0.25

A_Q = A_HEADS * HEAD_DIM
A_KV = A_KV_HEADS * HEAD_DIM
B_Q = B_HEADS * HEAD_DIM
B_KV = B_KV_HEADS * HEAD_DIM
IN_COLS = A_Q + 2 * A_KV + B_Q + 2 * B_KV + 2 * D_MODEL

kernel_name = "hybrid_window_axial_moe_encoder"


def layer_norm(x, g, b):
    xf = x.astype(jnp.float32)
    mu = jnp.mean(xf, -1, keepdims=True)
    var = jnp.mean(jnp.square(xf - mu), -1, keepdims=True)
    return ((xf - mu) * lax.rsqrt(var + LN_EPS) * g.astype(jnp.float32) + b.astype(jnp.float32)).astype(x.dtype)


def rms_norm(x, g):
    xf = x.astype(jnp.float32)
    y = xf * lax.rsqrt(jnp.mean(jnp.square(xf), -1, keepdims=True) + RMS_EPS)
    return (y * g.astype(jnp.float32)).astype(x.dtype)


def t5_bucket(rel):
    nb = N_BUCKETS // 2
    ret = jnp.where(rel > 0, nb, 0)
    n = jnp.abs(rel)
    max_exact = nb // 2
    nf = jnp.maximum(n, 1).astype(jnp.float32)
    large = max_exact + (jnp.log(nf / max_exact) / math.log(MAX_DISTANCE / max_exact) * (nb - max_exact)).astype(jnp.int32)
    large = jnp.minimum(large, nb - 1)
    return ret + jnp.where(n < max_exact, n, large)


def windowed_sink_attention(q, k, v, sink, rel_table):
    Bsz, S = q.shape[0], q.shape[1]
    nblk = S // BLOCK
    G = A_HEADS // A_KV_HEADS
    qb = q.reshape(Bsz, nblk, BLOCK, A_KV_HEADS, G, HEAD_DIM)
    pad = ((0, 0), (BLOCK, BLOCK), (0, 0))

    def band(t):
        tp = jnp.pad(t, pad)
        return jnp.concatenate(
            [tp[:, j * BLOCK:(j + nblk) * BLOCK].reshape(Bsz, nblk, BLOCK, A_KV_HEADS, HEAD_DIM) for j in range(3)],
            axis=2)

    kb, vb = band(k), band(v)
    s = jnp.einsum('bnqkgd,bnckd->bnkgqc', qb, kb, preferred_element_type=jnp.float32) * (HEAD_DIM ** -0.5)
    qi = jnp.arange(BLOCK)[:, None]
    c = jnp.arange(3 * BLOCK)[None, :]
    rel = c - BLOCK - qi
    bias = rel_table.astype(jnp.float32)[t5_bucket(rel)]
    bias = jnp.moveaxis(bias, -1, 0).reshape(A_KV_HEADS, G, BLOCK, 3 * BLOCK)
    kpos = (jnp.arange(nblk)[:, None] - 1) * BLOCK + jnp.arange(3 * BLOCK)[None, :]
    valid = (jnp.abs(rel) <= WINDOW)[None] & ((kpos >= 0) & (kpos < S))[:, None, :]
    s = jnp.where(valid[None, :, None, None], s + bias, -jnp.inf)
    sk = sink.astype(jnp.float32).reshape(A_KV_HEADS, G)[:, :, None, None]
    m = jnp.maximum(jnp.max(s, -1, keepdims=True), sk)
    p = jnp.exp(s - m)
    p = p / (jnp.sum(p, -1, keepdims=True) + jnp.exp(sk - m))
    o = jnp.einsum('bnkgqc,bnckd->bnqkgd', p.astype(v.dtype), vb)
    return o.reshape(Bsz, S, A_Q)


def axial_rope(x, cos_r, sin_r, cos_c, sin_c):
    half = HEAD_DIM // 2
    qd = half // 2

    def rot(xs, cs, sn):
        x1, x2 = xs[..., :qd], xs[..., qd:]
        return jnp.concatenate([x1 * cs - x2 * sn, x2 * cs + x1 * sn], -1)

    return jnp.concatenate([rot(x[..., :half], cos_r, sin_r), rot(x[..., half:], cos_c, sin_c)], -1)


def axial_dense_attention(q, k, v, qn_g, kn_g):
    Bsz, S = q.shape[0], q.shape[1]
    ROWS = S // GRID_W
    nblk = S // BLOCK
    G = B_HEADS // B_KV_HEADS
    row = jnp.broadcast_to(jnp.arange(ROWS)[:, None], (ROWS, GRID_W)).reshape(S).astype(jnp.float32)
    col = jnp.broadcast_to(jnp.arange(GRID_W)[None, :], (ROWS, GRID_W)).reshape(S).astype(jnp.float32)
    half = HEAD_DIM // 2
    inv = ROPE_THETA ** (-jnp.arange(0, half, 2, dtype=jnp.float32) / half)
    ang_r = (row[:, None] * inv)[:, None, :]
    ang_c = (col[:, None] * inv)[:, None, :]
    dt = q.dtype
    tabs = (jnp.cos(ang_r).astype(dt), jnp.sin(ang_r).astype(dt), jnp.cos(ang_c).astype(dt), jnp.sin(ang_c).astype(dt))
    qh = axial_rope(rms_norm(q.reshape(Bsz, S, B_HEADS, HEAD_DIM), qn_g), *tabs)
    kh = axial_rope(rms_norm(k.reshape(Bsz, S, B_KV_HEADS, HEAD_DIM), kn_g), *tabs)
    vh = v.reshape(Bsz, S, B_KV_HEADS, HEAD_DIM)
    qb = qh.reshape(Bsz, nblk, BLOCK, B_KV_HEADS, G, HEAD_DIM).transpose(1, 0, 2, 3, 4, 5)
    scale = HEAD_DIM ** -0.5

    def one_block(qblk):
        s = jnp.einsum('bqkgd,bskd->bkgqs', qblk, kh, preferred_element_type=jnp.float32) * scale
        p = jax.nn.softmax(s, axis=-1)
        return jnp.einsum('bkgqs,bskd->bqkgd', p.astype(vh.dtype), vh)

    o = lax.map(one_block, qb)
    return o.transpose(1, 0, 2, 3, 4, 5).reshape(Bsz, S, B_Q)


def token_mixer(h, w_in, b_gate, sink, rel_table, qn_g, kn_g, w_branch_a, w_branch_b, w_out):
    proj = jnp.einsum('bsd,dc->bsc', h, w_in)
    bounds = [int(i) for i in np.cumsum([A_Q, A_KV, A_KV, B_Q, B_KV, B_KV, D_MODEL])]
    qa, ka, va, qb, kb, vb, ga, gb = jnp.split(proj, bounds, axis=-1)
    oa = windowed_sink_attention(qa, ka, va, sink, rel_table)
    ob = axial_dense_attention(qb, kb, vb, qn_g, kn_g)
    gate_a = jax.nn.sigmoid(ga + b_gate[0])
    gate_b = jax.nn.sigmoid(gb + b_gate[1])
    merged = gate_a * jnp.einsum('bsc,cd->bsd', oa, w_branch_a) + gate_b * jnp.einsum('bsc,cd->bsd', ob, w_branch_b)
    return jnp.einsum('bsd,de->bse', merged, w_out)


def moe_ffn(h, w_router, e_bias, w_gate, w_up, w_down, ws_gate, ws_up, ws_down):
    Bsz, S, D = h.shape
    N = Bsz * S
    xt = h.reshape(N, D)
    scores = jax.nn.sigmoid(jnp.einsum('nd,de->ne', xt, w_router, preferred_element_type=jnp.float32))
    biased = scores + e_bias.astype(jnp.float32)
    group_score = lax.top_k(biased.reshape(N, N_GROUPS, N_EXPERTS // N_GROUPS), 2)[0].sum(-1)
    _, gidx = lax.top_k(group_score, TOPK_GROUPS)
    gmask = jnp.sum(jax.nn.one_hot(gidx, N_GROUPS, dtype=jnp.float32), axis=1) > 0
    masked = jnp.where(jnp.repeat(gmask, N_EXPERTS // N_GROUPS, axis=1), biased, -jnp.inf)
    _, eidx = lax.top_k(masked, TOP_K)
    wsel = jnp.take_along_axis(scores, eidx, axis=1)
    wsel = wsel / jnp.sum(wsel, -1, keepdims=True) * ROUTED_SCALE

    A = N * TOP_K
    e_flat = eidx.reshape(A)
    tok_flat = jnp.arange(A, dtype=jnp.int32) // TOP_K
    w_flat = wsel.reshape(A)
    order = jnp.argsort(e_flat)
    e_sorted = e_flat[order]
    counts = jnp.bincount(e_flat, length=N_EXPERTS)
    starts = jnp.cumsum(counts) - counts
    padded = (counts + MOE_BLOCK - 1) // MOE_BLOCK * MOE_BLOCK
    pends = jnp.cumsum(padded)
    pstarts = pends - padded
    dest = pstarts[e_sorted] + jnp.arange(A, dtype=jnp.int32) - starts[e_sorted]
    nb = -(-A // MOE_BLOCK) + N_EXPERTS
    P = nb * MOE_BLOCK
    tok_buf = jnp.full((P,), N, jnp.int32).at[dest].set(tok_flat[order])
    w_buf = jnp.zeros((P,), jnp.float32).at[dest].set(w_flat[order])
    block_e = jnp.minimum(jnp.searchsorted(pends, jnp.arange(nb) * MOE_BLOCK, side='right'), N_EXPERTS - 1)
    x_pad = jnp.concatenate([xt, jnp.zeros((1, D), xt.dtype)], axis=0)

    def run_block(args):
        e, toks, wts = args
        xb = x_pad[toks]
        hid = jax.nn.silu(xb @ w_gate[e]) * (xb @ w_up[e])
        return (hid @ w_down[e]) * wts[:, None].astype(xb.dtype)

    yb = lax.map(run_block, (block_e, tok_buf.reshape(nb, MOE_BLOCK), w_buf.reshape(nb, MOE_BLOCK)))
    routed = jnp.zeros((N + 1, D), jnp.float32).at[tok_buf].add(yb.reshape(P, D).astype(jnp.float32))[:N]
    shared = (jax.nn.silu(xt @ ws_gate) * (xt @ ws_up)) @ ws_down
    return (routed.astype(h.dtype) + shared).reshape(Bsz, S, D)


def setup_inputs(seed: int = 0) -> dict:
    key = jax.random.key(seed)
    ks = jax.random.split(key, 24)
    f32 = jnp.float32
    L, D, E, F, Fs = DEPTH, D_MODEL, N_EXPERTS, EXPERT_HIDDEN, SHARED_HIDDEN

    def nrm(k, shape, scale):
        return jax.random.normal(k, shape, f32) * scale

    colscale = np.concatenate([np.ones(A_Q), np.ones(A_KV), np.full(A_KV, DEEPNORM_BETA), np.ones(B_Q), np.ones(B_KV),
                               np.full(B_KV, DEEPNORM_BETA), np.ones(2 * D)]).astype(np.float32)
    return {
        "x": nrm(ks[0], (BATCH, SEQ, D), 1.0),
        "w_in": nrm(ks[1], (L, D, IN_COLS), D ** -0.5) * jnp.asarray(colscale),
        "b_gate": nrm(ks[2], (L, 2, D), 0.02),
        "attn_sink": nrm(ks[3], (L, A_HEADS), 0.5),
        "rel_bias_table": nrm(ks[4], (N_BUCKETS, A_HEADS), 0.5),
        "q_norm_g": 1.0 + nrm(ks[5], (L, HEAD_DIM), 0.02),
        "k_norm_g": 1.0 + nrm(ks[6], (L, HEAD_DIM), 0.02),
        "w_branch_a": nrm(ks[7], (L, A_Q, D), A_Q ** -0.5),
        "w_branch_b": nrm(ks[8], (L, B_Q, D), B_Q ** -0.5),
        "w_out": nrm(ks[9], (L, D, D), D ** -0.5 * DEEPNORM_BETA),
        "ln1_g": 1.0 + nrm(ks[10], (L, D), 0.02),
        "ln1_b": nrm(ks[11], (L, D), 0.02),
        "w_router": nrm(ks[12], (L, D, E), D ** -0.5),
        "router_bias": nrm(ks[13], (L, E), 0.01),
        "w_exp_gate": nrm(ks[14], (L, E, D, F), D ** -0.5),
        "w_exp_up": nrm(ks[15], (L, E, D, F), D ** -0.5),
        "w_exp_down": nrm(ks[16], (L, E, F, D), F ** -0.5 * DEEPNORM_BETA),
        "w_sh_gate": nrm(ks[17], (L, D, Fs), D ** -0.5),
        "w_sh_up": nrm(ks[18], (L, D, Fs), D ** -0.5),
        "w_sh_down": nrm(ks[19], (L, Fs, D), Fs ** -0.5 * DEEPNORM_BETA),
        "ln2_g": 1.0 + nrm(ks[20], (L, D), 0.02),
        "ln2_b": nrm(ks[21], (L, D), 0.02),
    }


def reference(x, w_in, b_gate, attn_sink, rel_bias_table, q_norm_g, k_norm_g, w_branch_a, w_branch_b, w_out,
              ln1_g, ln1_b, w_router, router_bias, w_exp_gate, w_exp_up, w_exp_down, w_sh_gate, w_sh_up, w_sh_down,
              ln2_g, ln2_b):
    h = x
    for l in range(DEPTH):
        mix = token_mixer(h, w_in[l], b_gate[l], attn_sink[l], rel_bias_table, q_norm_g[l], k_norm_g[l],
                          w_branch_a[l], w_branch_b[l], w_out[l])
        h = layer_norm(DEEPNORM_ALPHA * h + mix, ln1_g[l], ln1_b[l])
        ffn = moe_ffn(h, w_router[l], router_bias[l], w_exp_gate[l], w_exp_up[l], w_exp_down[l],
                      w_sh_gate[l], w_sh_up[l], w_sh_down[l])
        h = layer_norm(DEEPNORM_ALPHA * h + ffn, ln2_g[l], ln2_b[l])
    return h
```

```cpp
#define P1_NCG 13
#define CONV_Q 59
#define P1_QE2 28
#define CONV_G1 0
#include <hip/hip_runtime.h>
#include <hip/hip_bf16.h>
#include <cstdio>
#include <cstdint>
#include <cmath>
namespace pg8 {
#define PG8_LAS __attribute__((address_space(3)))
typedef unsigned short bf16_t;
typedef short bf16x8 __attribute__((ext_vector_type(8)));
typedef float f32x4 __attribute__((ext_vector_type(4)));
typedef unsigned u32x4 __attribute__((ext_vector_type(4)));
typedef int v4i_t __attribute__((ext_vector_type(4)));
typedef int v8i_t __attribute__((ext_vector_type(8)));
constexpr int BM = 256, BK = 64, HALF = 128, HTB = HALF * BK * 2  , STAGE_BYTES = 8 * HTB;

__host__ __device__ __forceinline__ int lds_byte(int r, int c) { const int st = (r >> 4) * 2 + (c >> 5), rr = r & 15, cc = c & 31, ob = rr * 64 + cc * 2; return st * 1024 + (ob ^ (((ob >> 9) & 1) << 5)); }
__host__ __device__ __forceinline__ void stage_rc(int b, int& R, int& C) { const int st = b / 1024, sb = b % 1024, swz = sb ^ (((sb >> 9) & 1) << 5); R = (st >> 1) * 16 + swz / 64; C = (st & 1) * 32 + (swz % 64) / 2; }
__host__ __device__ __forceinline__ int perm32(int rho) { const int n = rho >> 4, i = rho & 15; return 8 * (i >> 2) + 4 * n + (i & 3); }

struct Unit { const char* A; const char* B; const int* idx; const float* wts; int r0, c0, aux, kind; };

typedef float f32x2_t __attribute__((ext_vector_type(2))); typedef __bf16 bf16x2_t __attribute__((ext_vector_type(2)));
__device__ __forceinline__ unsigned cvt_pk_bf16(float lo, float hi) { f32x2_t v = {lo, hi}; bf16x2_t b = __builtin_convertvector(v, bf16x2_t); return __builtin_bit_cast(unsigned, b); }
__device__ __forceinline__ float bf_lo(unsigned w) { return __uint_as_float(w << 16); }
__device__ __forceinline__ float bf_hi(unsigned w) { return __uint_as_float(w & 0xffff0000u); }

template <class Epi, class Sched, bool ALIGN_EPI, bool GATHER, bool FP8 = false>
__device__ __forceinline__ void gemm_phase(PG8_LAS unsigned char* lds, PG8_LAS int* idxl, const int K, const Sched& S, const Epi& E) {
    PG8_LAS float* wl = (PG8_LAS float*)(idxl + 256);
    const int tid = threadIdx.x, wid = __builtin_amdgcn_readfirstlane(tid >> 6), lane = tid & 63, wr = wid >> 2, wc = wid & 3, fr = lane & 15, fq = lane >> 4;
    const int KB = FP8 ? K : 2 * K;
    const int nt = KB / 128;
    const size_t kstep = (size_t)(BK * 2);
    const size_t hstep = (size_t)HALF * KB;
    unsigned voffA0[2], voffA1[2], voffB[2];
#pragma unroll
    for (int i = 0; i < 2; ++i) { int R, C; stage_rc(tid * 16 + i * 8192, R, C); const int Rb = Epi::PERM ? ((R & ~31) + perm32(R & 31)) : R;
        voffA0[i] = (unsigned)(R * KB + C * 2); voffA1[i] = voffA0[i] + (unsigned)hstep; voffB[i] = (unsigned)(Rb * KB + C * 2); }
    const unsigned ldsw = (unsigned)wid * 1024u;
    const int aoff = FP8 ? lds_byte(wr * 64 + fr, (fq >> 1) * 32 + (fq & 1) * 16) : lds_byte(wr * 64 + fr, fq * 8), boff = FP8 ? lds_byte(wc * 32 + fr, (fq >> 1) * 32 + (fq & 1) * 16) : lds_byte(wc * 32 + fr, fq * 8);
#define PG8_SA(b, h) (((b) * 2 + (h)) * HTB)
#define PG8_SB(b, h) ((4 + (b) * 2 + (h)) * HTB)
#define PG8_STAGE(bufoff, gbase, voff) do { _Pragma("unroll") for (int _i = 0; _i < 2; ++_i) \
        __builtin_amdgcn_global_load_lds((const unsigned*)((const char*)(gbase) + (voff)[_i]), (PG8_LAS unsigned*)(lds + (bufoff) + ldsw + _i * 8192), 16, 0, 0); } while (0)
#define PG8_LD8(addr) __builtin_shufflevector(*(const PG8_LAS v4i_t*)(addr), *(const PG8_LAS v4i_t*)((addr) + 16), 0, 1, 2, 3, 4, 5, 6, 7)
#define PG8_LDA(dst, b, h) do { if constexpr (FP8) { _Pragma("unroll") for (int m = 0; m < 4; ++m) dst##8[m] = PG8_LD8(lds + PG8_SA(b, h) + aoff + m * 2048); } \
        else { _Pragma("unroll") for (int m = 0; m < 4; ++m) _Pragma("unroll") for (int k = 0; k < 2; ++k) dst[m][k] = *(const PG8_LAS bf16x8*)(lds + PG8_SA(b, h) + aoff + m * 2048 + k * 1024); } } while (0)
#define PG8_LDB(dst, b, h) do { if constexpr (FP8) { _Pragma("unroll") for (int n = 0; n < 2; ++n) dst##8[n] = PG8_LD8(lds + PG8_SB(b, h) + boff + n * 2048); } \
        else { _Pragma("unroll") for (int n = 0; n < 2; ++n) _Pragma("unroll") for (int k = 0; k < 2; ++k) dst[n][k] = *(const PG8_LAS bf16x8*)(lds + PG8_SB(b, h) + boff + n * 2048 + k * 1024); } } while (0)
#define PG8_MMA(ai, bj, At, Bt) do { __builtin_amdgcn_s_setprio(1); _Pragma("unroll") for (int m = 0; m < 4; ++m) _Pragma("unroll") for (int n = 0; n < 2; ++n) { \
        if constexpr (FP8) asm volatile("v_mfma_scale_f32_16x16x128_f8f6f4 %0, %1, %2, %0, %3, %3 op_sel_hi:[0,0,0]" : "+v"(acc[ai][bj][m][n]) : "v"(Bt##8[n]), "v"(At##8[m]), "v"(one_scale)); \
        else { _Pragma("unroll") for (int k = 0; k < 2; ++k) acc[ai][bj][m][n] = __builtin_amdgcn_mfma_f32_16x16x32_bf16(Bt[n][k], At[m][k], acc[ai][bj][m][n], 0, 0, 0); } } __builtin_amdgcn_s_setprio(0); } while (0)
#define PG8_WAIT_V(n) asm volatile("s_waitcnt vmcnt(" #n ")" ::: "memory")
#define PG8_WAIT_L(n) asm volatile("s_waitcnt lgkmcnt(" #n ")" ::: "memory")
#define PG8_WAIT_VN(n) asm volatile("s_waitcnt vmcnt(%0)" :: "n"(n) : "memory")
#define PG8_WAIT_VR(sel) do { if constexpr (Epi::NST > 0) { int _sg; asm volatile("v_readfirstlane_b32 %0, %1\n\ts_nop 0\n\ts_cmp_lg_u32 %0, 0\n\ts_cbranch_scc1 1f\n\ts_waitcnt vmcnt(8)\n\ts_branch 2f\n1:\n\ts_waitcnt vmcnt(%2)\n2:" \
            : "=&s"(_sg) : "v"(sel), "n"(8 + Epi::NST) : "memory", "scc"); } \
        else asm volatile("s_waitcnt vmcnt(8)" ::: "memory"); } while (0)
#define PG8_BAR __builtin_amdgcn_s_barrier()
#define PG8_SCHED __builtin_amdgcn_sched_barrier(0)
#define PG8_GOFF(src) do { _Pragma("unroll") for (int _i = 0; _i < 2; ++_i) { int R_, C_; stage_rc(tid * 16 + _i * 8192, R_, C_); \
        voffA0[_i] = (unsigned)((src)[R_] * KB + C_ * 2); voffA1[_i] = (unsigned)((src)[R_ + HALF] * KB + C_ * 2); } } while (0)
    Unit cur, nxt; int ui = 0;
    if (!S.next(0, cur)) return;
    f32x4 acc[2][2][4][2];
#pragma unroll
    for (int a = 0; a < 2; ++a)
#pragma unroll
        for (int b = 0; b < 2; ++b)
#pragma unroll
            for (int m = 0; m < 4; ++m)
#pragma unroll
                for (int n = 0; n < 2; ++n) acc[a][b][m][n] = (f32x4){0.f, 0.f, 0.f, 0.f};
    bf16x8 At[4][2], B0[2][2], B1[2][2];
    v8i_t At8[4], B08[2], B18[2];
    int one_scale = 0x7f7f7f7f; asm volatile("" : "+v"(one_scale));
    const char* cA = cur.A; const char* cB = cur.B;
    if constexpr (GATHER) { PG8_GOFF(cur.idx); if (tid >= 256) wl[tid - 256] = cur.wts[tid - 256]; }
    PG8_STAGE(PG8_SB(0, 0), cB, voffB); PG8_STAGE(PG8_SB(0, 1), cB + hstep, voffB); PG8_STAGE(PG8_SA(0, 0), cA, voffA0); PG8_STAGE(PG8_SA(0, 1), cA, voffA1);
    if (wr == 1) PG8_BAR;
    PG8_WAIT_V(2); PG8_BAR;
    PG8_STAGE(PG8_SB(1, 0), cB + kstep, voffB); PG8_STAGE(PG8_SA(1, 0), cA + kstep, voffA0); PG8_STAGE(PG8_SB(1, 1), cB + hstep + kstep, voffB);
    PG8_WAIT_V(6); PG8_BAR;
    for (;;) {
        const bool has_next = S.next(ui + 1, nxt);
        const char* nA = has_next ? nxt.A : cA; const char* nB = has_next ? nxt.B : cB;
        if constexpr (GATHER) { if (has_next && tid < 256) {
            __builtin_amdgcn_global_load_lds((const unsigned*)(nxt.idx + tid), (PG8_LAS unsigned*)((PG8_LAS unsigned char*)idxl + wid * 256), 4, 0, 0); }
          if (has_next && tid >= 256) {
            __builtin_amdgcn_global_load_lds((const unsigned*)(nxt.wts + (tid - 256)), (PG8_LAS unsigned*)((PG8_LAS unsigned char*)(wl + ((ui + 1) & 1) * 256) + (wid - 4) * 256), 4, 0, 0); } }
#pragma unroll 1
        for (int t = 0; t < nt; t += 2) {
            const bool last = (t == nt - 2);
            const char* a1 = cA + (size_t)(t + 1) * kstep;
            const char* a2 = last ? nA : cA + (size_t)(t + 2) * kstep; const char* b2 = last ? nB : cB + (size_t)(t + 2) * kstep;
            const char* a3 = a2 + kstep; const char* b3 = b2 + kstep;
            const int rlx = (t == 0 && ui > 0) ? 1 : 0;
            PG8_LDB(B0, 0, 0); PG8_LDB(B1, 0, 1); PG8_SCHED; PG8_LDA(At, 0, 0); PG8_STAGE(PG8_SA(1, 1), a1, voffA1);
            if constexpr (GATHER) { if (last && has_next) { PG8_GOFF(idxl); } }
            PG8_WAIT_VR(rlx); PG8_WAIT_L(0); PG8_BAR; PG8_MMA(0, 0, At, B0); PG8_MMA(0, 1, At, B1); PG8_BAR; PG8_SCHED;
            PG8_LDA(At, 0, 1); PG8_STAGE(PG8_SB(0, 0), b2, voffB); PG8_STAGE(PG8_SB(0, 1), b2 + hstep, voffB); PG8_STAGE(PG8_SA(0, 0), a2, voffA0);
            PG8_WAIT_VR(rlx); PG8_WAIT_L(0); PG8_BAR; PG8_MMA(1, 0, At, B0); PG8_MMA(1, 1, At, B1); PG8_BAR; PG8_SCHED;
            PG8_LDB(B0, 1, 0); PG8_LDB(B1, 1, 1); PG8_SCHED; PG8_LDA(At, 1, 0); PG8_STAGE(PG8_SA(0, 1), a2, voffA1);
            PG8_WAIT_V(8); PG8_WAIT_L(0); PG8_BAR; PG8_MMA(0, 0, At, B0); PG8_MMA(0, 1, At, B1); PG8_BAR; PG8_SCHED;
            PG8_LDA(At, 1, 1); PG8_STAGE(PG8_SB(1, 0), b3, voffB); PG8_STAGE(PG8_SB(1, 1), b3 + hstep, voffB); PG8_STAGE(PG8_SA(1, 0), a3, voffA0);
            PG8_WAIT_V(8); PG8_WAIT_L(0); PG8_BAR; PG8_MMA(1, 0, At, B0); PG8_MMA(1, 1, At, B1); PG8_BAR; PG8_SCHED;
        }
        if constexpr (ALIGN_EPI) { if (wr == 0) PG8_BAR; }
        if constexpr (FP8) asm volatile("s_nop 15\n\ts_nop 15" ::: "memory");
        const bool keep = E(acc, cur, wr, wc, fr, fq, wl + (ui & 1) * 256);
        if (!has_next) break;
        if (!keep) {
#pragma unroll
        for (int a = 0; a < 2; ++a)
#pragma unroll
            for (int b = 0; b < 2; ++b)
#pragma unroll
                for (int m = 0; m < 4; ++m)
#pragma unroll
                    for (int n = 0; n < 2; ++n) acc[a][b][m][n] = (f32x4){0.f, 0.f, 0.f, 0.f};
        }
        cur = nxt; cA = nA; cB = nB; ++ui;
        if constexpr (ALIGN_EPI) { if (wr == 1) PG8_BAR; }
    }
    PG8_WAIT_V(0);
    if constexpr (!ALIGN_EPI) { if (wr == 0) PG8_BAR; }
    PG8_BAR;
#undef PG8_SA
#undef PG8_SB
#undef PG8_STAGE
#undef PG8_LDA
#undef PG8_LDB
#undef PG8_MMA
#undef PG8_LD8
#undef PG8_WAIT_V
#undef PG8_WAIT_L
#undef PG8_WAIT_VN
#undef PG8_WAIT_VR
#undef PG8_BAR
#undef PG8_SCHED
#undef PG8_GOFF
}
}
namespace attn {
using bf16 = __hip_bfloat16;
constexpr int   D = 128, NW = 8, QBLK = 32, KVBLK = 64;
constexpr float SCALE = 0.088388347648318440f;
constexpr float THR = 8.f;
constexpr float LOG2E = 1.4426950408889634f;
#ifndef PROJ_PAD
#define PROJ_PAD 64
#endif
constexpr int LDQ = 7168 + PROJ_PAD, LDK = 7168 + PROJ_PAD, LDO = 1024;
constexpr size_t SHM_V = KVBLK * D * 2, SHM_K = KVBLK * D * 2, SHM_ATTN = 2 * SHM_V + 2 * SHM_K + NW * 64 * 4;
constexpr int WIN_TAB = (int)SHM_ATTN;

using bf16x8 = __attribute__((ext_vector_type(8))) short;
using s16x4  = __attribute__((ext_vector_type(4))) short;
using f32x16 = __attribute__((ext_vector_type(16))) float;
using u32x4  = __attribute__((ext_vector_type(4))) unsigned;
using f32x4_a = __attribute__((ext_vector_type(4))) float;
#define KSWZ(row, colB) ((row) * 256 + ((colB) ^ (((row) & 7) << 4)))
#define SBAR() __builtin_amdgcn_sched_barrier(0)
__device__ __forceinline__ int crow(int r, int hi) { return (r & 3) + 8 * (r >> 2) + 4 * hi; }
__device__ __forceinline__ unsigned cvtpk(float lo, float hi) { return pg8::cvt_pk_bf16(lo, hi); }
template <bool FIXM>
__device__ __forceinline__ void partialSM(f32x16& p0, f32x16& p1, float& m_reg, float& mn, float& alpha) {
  constexpr float C = SCALE * LOG2E;
  if constexpr (FIXM) {
    mn = m_reg; alpha = 1.f; const float mnC = -m_reg * C;
    for (int r = 0; r < 16; ++r) p0[r] = fmaf(p0[r], C, mnC); for (int r = 0; r < 16; ++r) p1[r] = fmaf(p1[r], C, mnC);
    for (int r = 0; r < 16; ++r) p0[r] = __builtin_amdgcn_exp2f(p0[r]);
    return;
  }
  float pmax = p0[0]; for (int r = 1; r < 16; ++r) pmax = fmaxf(pmax, p0[r]); for (int r = 0; r < 16; ++r) pmax = fmaxf(pmax, p1[r]);
  { auto rr = __builtin_amdgcn_permlane32_swap(__float_as_uint(pmax), __float_as_uint(pmax), false, false);
    pmax = fmaxf(__uint_as_float(rr[0]), __uint_as_float(rr[1])); }
  if (__builtin_expect(__all(pmax - m_reg <= THR / SCALE), 1)) { mn = m_reg; alpha = 1.f; }
  else { mn = fmaxf(m_reg, pmax); alpha = __builtin_amdgcn_exp2f((m_reg - mn) * C); m_reg = mn; }
  float mnC = -mn * C;
  for (int r = 0; r < 16; ++r) p0[r] = fmaf(p0[r], C, mnC); for (int r = 0; r < 16; ++r) p1[r] = fmaf(p1[r], C, mnC);
  for (int r = 0; r < 16; ++r) p0[r] = __builtin_amdgcn_exp2f(p0[r]);
}
__device__ __forceinline__ void finishSM(f32x16& p0, f32x16& p1, float alpha, float& l_reg, bf16x8& pa0, bf16x8& pa1, bf16x8& pa2, bf16x8& pa3) {
  for (int r = 0; r < 16; ++r) p1[r] = __builtin_amdgcn_exp2f(p1[r]);
  float ps = 0; for (int r = 0; r < 16; ++r) ps += p0[r]; for (int r = 0; r < 16; ++r) ps += p1[r];
  { auto rr = __builtin_amdgcn_permlane32_swap(__float_as_uint(ps), __float_as_uint(ps), false, false);
    ps = __uint_as_float(rr[0]) + __uint_as_float(rr[1]); }
  l_reg = l_reg * alpha + ps;
#define PK4(P, BASE, OUT) do { unsigned a0 = cvtpk(P[BASE + 0], P[BASE + 1]), a1 = cvtpk(P[BASE + 2], P[BASE + 3]);   \
    unsigned b0 = cvtpk(P[BASE + 4], P[BASE + 5]), b1 = cvtpk(P[BASE + 6], P[BASE + 7]);                              \
    auto r0 = __builtin_amdgcn_permlane32_swap(a0, b0, false, false); auto r1 = __builtin_amdgcn_permlane32_swap(a1, b1, false, false); \
    u32x4 w = {r0[0], r1[0], r0[1], r1[1]}; OUT = *reinterpret_cast<bf16x8*>(&w); } while (0)
  PK4(p0, 0, pa0); PK4(p0, 8, pa1); PK4(p1, 0, pa2); PK4(p1, 8, pa3);
#undef PK4
}
#define KSWZ8(row, colB) ((row) * 128 + ((colB) ^ (((row) & 7) << 4)))
typedef int v8i_a __attribute__((ext_vector_type(8))); typedef int v4i_a __attribute__((ext_vector_type(4)));
template <bool WIN, bool F8>
__device__ __forceinline__ void qkt(f32x16& p0, f32x16& p1, const bf16* Ks, const bf16x8* qr, const v8i_a* q8, int r32, int hi, const __attribute__((address_space(3))) float* tb) {
  if constexpr (F8) {
    p0 = f32x16{}; p1 = f32x16{}; int one = 0x7f7f7f7f; asm volatile("" : "+v"(one));
#pragma unroll
    for (int s = 0; s < 2; ++s) { const int cb = 64 * s + 32 * hi;
      const char* ka = (const char*)Ks + KSWZ8(r32, cb); const char* kb = (const char*)Ks + KSWZ8(32 + r32, cb);
      const v8i_a k0 = __builtin_shufflevector(*reinterpret_cast<const v4i_a*>(ka), *reinterpret_cast<const v4i_a*>((const char*)Ks + KSWZ8(r32, cb + 16)), 0, 1, 2, 3, 4, 5, 6, 7);
      const v8i_a k1 = __builtin_shufflevector(*reinterpret_cast<const v4i_a*>(kb), *reinterpret_cast<const v4i_a*>((const char*)Ks + KSWZ8(32 + r32, cb + 16)), 0, 1, 2, 3, 4, 5, 6, 7);
      asm volatile("s_nop 1\n\tv_mfma_scale_f32_32x32x64_f8f6f4 %0, %1, %2, %0, %3, %3 op_sel_hi:[0,0,0]" : "+v"(p0) : "v"(k0), "v"(q8[s]), "v"(one));
      asm volatile("v_mfma_scale_f32_32x32x64_f8f6f4 %0, %1, %2, %0, %3, %3 op_sel_hi:[0,0,0]" : "+v"(p1) : "v"(k1), "v"(q8[s]), "v"(one)); }
    asm volatile("s_nop 15\n\ts_nop 15" : "+v"(p0), "+v"(p1));
    return;
  }
  if constexpr (WIN) {
#pragma unroll
    for (int r = 0; r < 16; ++r) { p0[r] = tb[(r & 3) + 8 * (r >> 2)]; p1[r] = tb[32 + (r & 3) + 8 * (r >> 2)]; }
  } else { p0 = f32x16{}; p1 = f32x16{}; }
  for (int d0 = 0; d0 < 8; ++d0) { int cb = (d0 * 16 + hi * 8) * 2;
    bf16x8 b0 = *reinterpret_cast<const bf16x8*>((const char*)Ks + KSWZ(r32, cb));
    bf16x8 b1 = *reinterpret_cast<const bf16x8*>((const char*)Ks + KSWZ(32 + r32, cb));
    p0 = __builtin_amdgcn_mfma_f32_32x32x16_bf16(b0, qr[d0], p0, 0, 0, 0);
    p1 = __builtin_amdgcn_mfma_f32_32x32x16_bf16(b1, qr[d0], p1, 0, 0, 0); }
}
__device__ __forceinline__ int v_st(int k, int c) { const int kk = (k & ~0xC) | ((k & 4) << 1) | ((k & 8) >> 1); return ((kk >> 3) * 4 + (c >> 5)) * 512 + ((kk & 7) * 32 + (c & 31)) * 2; }
__device__ __forceinline__ int v_rd_base(int lane) { return ((lane & 3) << 3) | (((lane >> 2) & 3) << 6) | (((lane >> 4) & 1) << 5) | (((lane >> 5) & 1) << 8); }
constexpr int v_rd_off(int d0, int ks, int half) { return d0 * 512 + ks * 4096 + half * 2048; }
template <int OFF> __device__ __forceinline__ s16x4 tr_read(int vb) {
  s16x4 r; asm volatile("ds_read_b64_tr_b16 %0, %1 offset:%2" : "=&v"(r) : "v"(vb), "i"(OFF) : "memory"); return r;
}
template <int D0> __device__ __forceinline__ void pv_one(f32x16& od, int vb, bf16x8 pa0, bf16x8 pa1, bf16x8 pa2, bf16x8 pa3) {
  const s16x4 l0 = tr_read<v_rd_off(D0, 0, 0)>(vb), h0 = tr_read<v_rd_off(D0, 0, 1)>(vb), l1 = tr_read<v_rd_off(D0, 1, 0)>(vb), h1 = tr_read<v_rd_off(D0, 1, 1)>(vb);
  const s16x4 l2 = tr_read<v_rd_off(D0, 2, 0)>(vb), h2 = tr_read<v_rd_off(D0, 2, 1)>(vb), l3 = tr_read<v_rd_off(D0, 3, 0)>(vb), h3 = tr_read<v_rd_off(D0, 3, 1)>(vb);
  asm volatile("s_waitcnt lgkmcnt(0)" ::: "memory"); SBAR();
#define PK(L, H) (bf16x8){L[0], L[1], L[2], L[3], H[0], H[1], H[2], H[3]}
  od = __builtin_amdgcn_mfma_f32_32x32x16_bf16(pa0, PK(l0, h0), od, 0, 0, 0);
  od = __builtin_amdgcn_mfma_f32_32x32x16_bf16(pa1, PK(l1, h1), od, 0, 0, 0);
  od = __builtin_amdgcn_mfma_f32_32x32x16_bf16(pa2, PK(l2, h2), od, 0, 0, 0);
  od = __builtin_amdgcn_mfma_f32_32x32x16_bf16(pa3, PK(l3, h3), od, 0, 0, 0);
#undef PK
}
__device__ __forceinline__ void pv_d0(f32x16* o, int vb, bf16x8 pa0, bf16x8 pa1, bf16x8 pa2, bf16x8 pa3) {
  pv_one<0>(o[0], vb, pa0, pa1, pa2, pa3); pv_one<1>(o[1], vb, pa0, pa1, pa2, pa3); pv_one<2>(o[2], vb, pa0, pa1, pa2, pa3); pv_one<3>(o[3], vb, pa0, pa1, pa2, pa3);
}

template <bool WIN, int SDEPTH, bool F8, bool FIXM, bool QN = false>
__device__ __forceinline__ void attn_body(const bf16* __restrict__ Qb, const bf16* __restrict__ Kh, const unsigned char* __restrict__ Kh8, const bf16* __restrict__ Vh,
                                          unsigned char* __restrict__ Ob, float oscale, int seq, char* lds, const __attribute__((address_space(3))) float* tab, int relbase, float m0, float l0,
                                          const float* __restrict__ gq = nullptr, int qpos0 = 0) {
  int tid_ = threadIdx.x; asm volatile("" : "+v"(tid_));
  const int tid = tid_, wid = tid >> 6, lane = tid & 63, r32 = lane & 31, hi = lane >> 5;
  bf16* V_lds = (bf16*)lds; bf16* K_lds = (bf16*)(lds + 2 * SHM_V);
  float* ws = (float*)(lds + 2 * SHM_V + 2 * SHM_K) + wid * 64; float* li_l = ws; float* al_l = ws + 32;
  float m_reg = m0, l_reg = l0; f32x16 o[4] = {}; bf16x8 qr[8];
  const bf16* Qw = Qb + (long)(wid * QBLK + r32) * LDQ + hi * 8;
  v8i_a q8[2];
  if constexpr (F8 && QN) {
    const bf16* Qr = Qb + (long)(wid * QBLK + r32) * LDQ + hi * 16;
    float x[2][2][16];
#pragma unroll
    for (int s = 0; s < 2; ++s)
#pragma unroll
      for (int pt = 0; pt < 2; ++pt)
#pragma unroll
        for (int c = 0; c < 2; ++c) { const u32x4 v = *reinterpret_cast<const u32x4*>(Qr + 64 * s + 32 * pt + 8 * c);
          x[s][pt][8 * c + 0] = __uint_as_float(v.x << 16); x[s][pt][8 * c + 1] = __uint_as_float(v.x & 0xffff0000u); x[s][pt][8 * c + 2] = __uint_as_float(v.y << 16); x[s][pt][8 * c + 3] = __uint_as_float(v.y & 0xffff0000u);
          x[s][pt][8 * c + 4] = __uint_as_float(v.z << 16); x[s][pt][8 * c + 5] = __uint_as_float(v.z & 0xffff0000u); x[s][pt][8 * c + 6] = __uint_as_float(v.w << 16); x[s][pt][8 * c + 7] = __uint_as_float(v.w & 0xffff0000u); }
    float ss = 0.f;
#pragma unroll
    for (int s = 0; s < 2; ++s)
#pragma unroll
      for (int pt = 0; pt < 2; ++pt)
#pragma unroll
        for (int t = 0; t < 16; ++t) ss = fmaf(x[s][pt][t], x[s][pt][t], ss);
    { auto rr = __builtin_amdgcn_permlane32_swap(__float_as_uint(ss), __float_as_uint(ss), false, false); ss = __uint_as_float(rr[0]) + __uint_as_float(rr[1]); }
    const float rs = 1.0f / sqrtf(ss * (1.0f / D) + 1e-6f);
    const int tok = qpos0 + wid * QBLK + r32;
#pragma unroll
    for (int s = 0; s < 2; ++s) { int w[8]; const float pos = (float)(s == 0 ? (tok >> 6) : (tok & 63)); float o1[16], o2[16];
#pragma unroll
      for (int t4 = 0; t4 < 4; ++t4) { const f32x4_a g1 = *reinterpret_cast<const f32x4_a*>(gq + 64 * s + 16 * hi + 4 * t4), g2 = *reinterpret_cast<const f32x4_a*>(gq + 64 * s + 32 + 16 * hi + 4 * t4);
#pragma unroll
        for (int u = 0; u < 4; ++u) { const int t = 4 * t4 + u; const float inv = __builtin_amdgcn_exp2f(-(float)(2 * (16 * hi + t)) * (1.0f / 64.0f) * 13.287712379549449f);
          const float rev = pos * inv * 0.15915494309189535f, fr = rev - floorf(rev); const float sn = __builtin_amdgcn_sinf(fr), cs = __builtin_amdgcn_cosf(fr);
          const float a = x[s][0][t] * rs * g1[u], b = x[s][1][t] * rs * g2[u]; o1[t] = a * cs - b * sn; o2[t] = b * cs + a * sn; } }
#pragma unroll
      for (int c = 0; c < 4; ++c) { int t = __builtin_amdgcn_cvt_pk_fp8_f32(o1[4 * c], o1[4 * c + 1], 0, false); t = __builtin_amdgcn_cvt_pk_fp8_f32(o1[4 * c + 2], o1[4 * c + 3], t, true); w[c] = t;
        t = __builtin_amdgcn_cvt_pk_fp8_f32(o2[4 * c], o2[4 * c + 1], 0, false); t = __builtin_amdgcn_cvt_pk_fp8_f32(o2[4 * c + 2], o2[4 * c + 3], t, true); w[4 + c] = t; }
      q8[s] = (v8i_a){w[0], w[1], w[2], w[3], w[4], w[5], w[6], w[7]}; }
  } else if constexpr (F8) {
    const bf16* Qr = Qb + (long)(wid * QBLK + r32) * LDQ + hi * 32;
#pragma unroll
    for (int s = 0; s < 2; ++s) { int w[8];
#pragma unroll
      for (int c = 0; c < 4; ++c) { const u32x4 v = *reinterpret_cast<const u32x4*>(Qr + 64 * s + 8 * c);
        int t = __builtin_amdgcn_cvt_pk_fp8_f32(__uint_as_float(v.x << 16), __uint_as_float(v.x & 0xffff0000u), 0, false); t = __builtin_amdgcn_cvt_pk_fp8_f32(__uint_as_float(v.y << 16), __uint_as_float(v.y & 0xffff0000u), t, true); w[2 * c] = t;
        t = __builtin_amdgcn_cvt_pk_fp8_f32(__uint_as_float(v.z << 16), __uint_as_float(v.z & 0xffff0000u), 0, false); t = __builtin_amdgcn_cvt_pk_fp8_f32(__uint_as_float(v.w << 16), __uint_as_float(v.w & 0xffff0000u), t, true); w[2 * c + 1] = t; }
      q8[s] = (v8i_a){w[0], w[1], w[2], w[3], w[4], w[5], w[6], w[7]}; }
  } else {
#pragma unroll
    for (int d0 = 0; d0 < 8; ++d0) qr[d0] = *reinterpret_cast<const bf16x8*>(Qw + d0 * 16);
  }
  const int sr = tid >> 4, sc = (tid & 15) * 8, vst0 = v_st(sr, sc), vst1 = v_st(32 + sr, sc);
  const int vb0 = (int)(uintptr_t)V_lds + v_rd_base(lane);
  const __attribute__((address_space(3))) float* tb0 = tab + (relbase - (wid * QBLK + r32) + 512 + 4 * hi);
  struct { bf16x8 vs0, vs1, ks0, ks1; } sr_[SDEPTH];
#define SLOAD(i, k0) do { sr_[i].vs0 = *reinterpret_cast<const bf16x8*>(&Vh[(long)((k0) + sr) * LDK + sc]); sr_[i].vs1 = *reinterpret_cast<const bf16x8*>(&Vh[(long)((k0) + 32 + sr) * LDK + sc]); \
    if constexpr (F8) { sr_[i].ks0 = *reinterpret_cast<const bf16x8*>(&Kh8[(long)((k0) + (tid >> 3)) * 256 + (tid & 7) * 16]); } \
    else { sr_[i].ks0 = *reinterpret_cast<const bf16x8*>(&Kh[(long)((k0) + sr) * LDK + sc]); sr_[i].ks1 = *reinterpret_cast<const bf16x8*>(&Kh[(long)((k0) + 32 + sr) * LDK + sc]); } } while (0)
#define SWRITE(b, i) do { *(bf16x8*)((char*)V_lds + (b) * SHM_V + vst0) = sr_[i].vs0;          \
    *(bf16x8*)((char*)V_lds + (b) * SHM_V + vst1) = sr_[i].vs1; int kc = sc * 2;               \
    if constexpr (F8) { *(bf16x8*)((char*)K_lds + (b) * SHM_K + KSWZ8(tid >> 3, (tid & 7) * 16)) = sr_[i].ks0; } \
    else { *(bf16x8*)((char*)K_lds + (b) * SHM_K + KSWZ(sr, kc)) = sr_[i].ks0;                       \
    *(bf16x8*)((char*)K_lds + (b) * SHM_K + KSWZ(32 + sr, kc)) = sr_[i].ks1; } } while (0)
#define SWAIT() do { if constexpr (SDEPTH == 2) asm volatile("s_waitcnt vmcnt(4)" ::: "memory"); else asm volatile("s_waitcnt vmcnt(0)" ::: "memory"); } while (0)
#define RESC(a) do { if (!FIXM && __any((a) < 1.f)) { if (hi == 0) al_l[r32] = (a); asm volatile("s_waitcnt lgkmcnt(0)" ::: "memory"); \
    for (int d = 0; d < 4; ++d) for (int r = 0; r < 16; ++r) o[d][r] *= al_l[crow(r, hi)]; } } while (0)
  f32x16 pA0, pA1, pB0, pB1; float mnA, mnB, alA, alB; bf16x8 pa0, pa1, pa2, pa3; const int NT = seq / KVBLK;
  constexpr int SE = 0, SO = SDEPTH - 1;
  SLOAD(SE, 0); asm volatile("s_waitcnt vmcnt(0)" ::: "memory"); SWRITE(0, SE); __syncthreads();
  qkt<WIN, F8>(pA0, pA1, K_lds, qr, q8, r32, hi, tb0); partialSM<FIXM>(pA0, pA1, m_reg, mnA, alA);
  SLOAD(SO, KVBLK); if constexpr (SDEPTH == 2) { if (2 < NT) SLOAD(SE, 2 * KVBLK); }
  SWAIT(); SWRITE(1, SO); __syncthreads();
  for (int j = 1; j + 1 < NT; j += 2) {
    SBAR(); qkt<WIN, F8>(pB0, pB1, (bf16*)((char*)K_lds + SHM_K), qr, q8, r32, hi, tb0 + 64 * j);
    finishSM(pA0, pA1, alA, l_reg, pa0, pa1, pa2, pa3); SBAR();
    SLOAD(SO, (j + SDEPTH) * KVBLK); SBAR();
    pv_d0(o, vb0, pa0, pa1, pa2, pa3); partialSM<FIXM>(pB0, pB1, m_reg, mnB, alB);
    __syncthreads(); SWAIT(); SWRITE(0, SE);
    RESC(alB); __syncthreads();
    SBAR(); qkt<WIN, F8>(pA0, pA1, K_lds, qr, q8, r32, hi, tb0 + 64 * (j + 1));
    finishSM(pB0, pB1, alB, l_reg, pa0, pa1, pa2, pa3); SBAR();
    if (SDEPTH == 1 || j + 3 < NT) SLOAD(SE, (j + 1 + SDEPTH) * KVBLK); SBAR();
    pv_d0(o, vb0 + (int)SHM_V, pa0, pa1, pa2, pa3); partialSM<FIXM>(pA0, pA1, m_reg, mnA, alA);
    __syncthreads(); SWAIT(); SWRITE(1, SO);
    RESC(alA); __syncthreads();
  }
  SBAR(); qkt<WIN, F8>(pB0, pB1, (bf16*)((char*)K_lds + SHM_K), qr, q8, r32, hi, tb0 + 64 * (NT - 1));
  finishSM(pA0, pA1, alA, l_reg, pa0, pa1, pa2, pa3); SBAR();
  pv_d0(o, vb0, pa0, pa1, pa2, pa3); partialSM<FIXM>(pB0, pB1, m_reg, mnB, alB);
  __syncthreads(); RESC(alB);
  finishSM(pB0, pB1, alB, l_reg, pa0, pa1, pa2, pa3); SBAR();
  pv_d0(o, vb0 + (int)SHM_V, pa0, pa1, pa2, pa3);
  if (hi == 0) li_l[r32] = l_reg; asm volatile("s_waitcnt lgkmcnt(0)" ::: "memory");
  float rli[16];
#pragma unroll
  for (int r = 0; r < 16; ++r) rli[r] = __builtin_amdgcn_rcpf(li_l[crow(r, hi)]);
  unsigned char* Ow = Ob + (long)(wid * QBLK) * LDO;
#pragma unroll
  for (int r = 0; r < 16; ++r) { int orow = crow(r, hi); const float sc = rli[r] * oscale;
    for (int d0 = 0; d0 < 4; ++d0) Ow[(long)orow * LDO + d0 * 32 + r32] = (unsigned char)(__builtin_amdgcn_cvt_pk_fp8_f32(o[d0][r] * sc, 0.f, 0, false) & 0xff); }
  __syncthreads();
#undef SLOAD
#undef SWRITE
#undef SWAIT
#undef RESC
}
#undef KSWZ
#undef KSWZ8
#undef SBAR
}
constexpr int NWAVES = 8;
constexpr int SEQ = 8192, DM = 2048, HD = 128, NEXP = 64, TOPK = 8, FE = 512;
constexpr int INC = 7168;
constexpr int PLD = INC + PROJ_PAD;
constexpr int C_QA = 0, C_KA = 1024, C_VA = 1280, C_QB = 1536, C_KB = 2560, C_VB = 2816, C_GA = 3072, C_GB = 5120;
constexpr float LN_EPS = 1e-5f, RMS_EPS = 1e-6f;
constexpr float ALPHA = 1.189207115002721f;
constexpr float ROUTED_SCALE = 2.5f;
constexpr int LCAP = 8192;
constexpr int NEXP1 = NEXP + 1;

constexpr size_t MiB = 1u << 20;
constexpr size_t WS_CTL = 0, CTL_ZERO_BYTES = 1 * MiB;
constexpr size_t WS_WGU = 1 * MiB;
constexpr size_t WS_WINT = WS_WGU + 260 * MiB;
constexpr size_t WS_XBF = WS_WINT + 28 * MiB;
constexpr size_t WS_PROJ = WS_XBF + 32 * MiB;
constexpr size_t WS_OA = WS_PROJ + 116 * MiB;
constexpr size_t WS_OB = WS_OA + 16 * MiB;
constexpr size_t WS_MRG = WS_OB + 16 * MiB;
constexpr size_t WS_WAT = WS_MRG + 32 * MiB;
constexpr size_t WS_WBT = WS_WAT + 4 * MiB;
constexpr size_t WS_WOT = WS_WBT + 4 * MiB;
constexpr size_t WS_DEAD_END = WS_WOT + 8 * MiB;
constexpr size_t WS_Y = WS_WGU;
constexpr size_t WS_WD = WS_DEAD_END;
constexpr size_t WS_WR = WS_WD + 130 * MiB;
constexpr size_t WS_H32 = WS_WR + 1 * MiB;
constexpr size_t WS_HBF = WS_H32 + 64 * MiB;
constexpr size_t WS_HID = WS_HBF + 32 * MiB;
constexpr size_t WS_PRE = WS_HID + 88 * MiB;
constexpr size_t WS_LTOK = WS_PRE + 64 * MiB;
constexpr size_t WS_LW = WS_LTOK + 3 * MiB;
constexpr size_t WS_ROUTE = WS_LW + 3 * MiB;
constexpr size_t WS_HF8 = WS_H32;
constexpr size_t WS_KF8 = WS_H32 + 16 * MiB;
constexpr size_t WS_END = WS_ROUTE + 1 * MiB;
static_assert(WS_Y + 352 * MiB <= WS_WD, "Y overlay");
static_assert((size_t)SEQ * PLD * 2 <= 116 * MiB, "proj slot");
static_assert(WS_END <= 1024 * MiB, "d_ws map must fit 1 GiB");
constexpr int CW_TMO = 0;
constexpr int CW_CNT = 64;
constexpr int CW_BAR = 4096;

constexpr int RING_OFF = 0, RING_BYTES = 131072;
constexpr int LDSCTL_OFF = RING_BYTES;
constexpr int MISC_OFF = LDSCTL_OFF;
constexpr int IDXL_OFF = LDSCTL_OFF + 256;
constexpr int TST_OFF = IDXL_OFF + 1024 + 2048;
constexpr int LDS_BYTES = 147456;
static_assert(TST_OFF + 512 <= LDS_BYTES, "LDS map");

#define GAS __attribute__((address_space(1)))
#define LAS __attribute__((address_space(3)))
typedef unsigned short bf16;
typedef unsigned v4u __attribute__((ext_vector_type(4)));
typedef unsigned v2u __attribute__((ext_vector_type(2)));
typedef float f32x4 __attribute__((ext_vector_type(4)));
typedef short bf16x8 __attribute__((ext_vector_type(8)));
#define RLX_AGENT __ATOMIC_RELAXED, __HIP_MEMORY_SCOPE_AGENT
#define LDS_WAIT() asm volatile("s_waitcnt lgkmcnt(0)" ::: "memory")
#define VM_WAIT() asm volatile("s_waitcnt vmcnt(0)" ::: "memory")
__device__ __forceinline__ unsigned f2bf(float f) { unsigned u = __builtin_bit_cast(unsigned, f); return (u + 0x7fffu + ((u >> 16) & 1u)) >> 16; }
__device__ __forceinline__ unsigned pk2(float lo, float hi) { return f2bf(lo) | (f2bf(hi) << 16); }
__device__ __forceinline__ float bf2f(unsigned short h) { return __uint_as_float((unsigned)h << 16); }

#define XB_TMO      128
#define XB_XCNT(j)  (256  + 64 * (j))
#define XB_XSUB(j)  (1280 + 64 * (j))
#define XB_XGEN(j)  (2304 + 64 * (j))
#define XB_TOP      3328
#define XB_TOPGEN   3392
#define XCD_BAR_WORDS 3456
#define XB_SPIN_CAP (1u << 20)
__device__ __forceinline__ unsigned xb_ld(unsigned* p)              { return __hip_atomic_load(p, __ATOMIC_RELAXED, __HIP_MEMORY_SCOPE_AGENT); }
__device__ __forceinline__ unsigned xb_add(unsigned* p, unsigned v) { return __hip_atomic_fetch_add(p, v, __ATOMIC_RELAXED, __HIP_MEMORY_SCOPE_AGENT); }
__device__ __forceinline__ unsigned xb_xcc_id() { return (unsigned)__builtin_amdgcn_s_getreg((3 << 11) | 20) & 0xFu; }
#define XB_SPIN(cond, bar) do { unsigned _sp = 0; while (cond) { __builtin_amdgcn_s_sleep(1); \
    if ((++_sp & 255u) == 0u) { if (xb_ld(&(bar)[XB_TMO])) break; if (_sp > XB_SPIN_CAP) { atomicAdd(&(bar)[XB_TMO], 1u); break; } } } } while (0)
struct XcdBarrier { unsigned* bar; unsigned x; volatile LAS unsigned* st; unsigned total; };
__device__ __forceinline__ XcdBarrier xcd_barrier_post(unsigned* bar, volatile LAS unsigned* st, unsigned total) {
    XcdBarrier b; b.bar = bar; b.x = xb_xcc_id(); b.st = st; b.total = total;
    if (threadIdx.x == 0) (void)xb_add(&bar[XB_XCNT(b.x)], 1u);
    return b;
}
__device__ __forceinline__ void xcd_barrier_complete(unsigned* bar, unsigned x, unsigned G, unsigned& nloc, unsigned& nx) {
    unsigned sum, cnt, mine, sp = 0u;
    for (;;) {
        sum = 0u; cnt = 0u; mine = 0u;
#pragma unroll
        for (unsigned j = 0; j < 16; ++j) { const unsigned c = xb_ld(&bar[XB_XCNT(j)]); sum += c; cnt += (c > 0u) ? 1u : 0u; mine = (j == x) ? c : mine; }
        if (sum == G) break;
        __builtin_amdgcn_s_sleep(1);
        if ((++sp & 255u) == 0u) { if (xb_ld(&bar[XB_TMO])) break; if (sp > XB_SPIN_CAP) { atomicAdd(&bar[XB_TMO], 1u); break; } }
    }
    nloc = mine > 0u ? mine : 1u; nx = cnt > 0u ? cnt : 1u;
}
__device__ __forceinline__ void xcd_barrier(const XcdBarrier& b) {
    asm volatile("s_waitcnt vmcnt(0)" ::: "memory");
    __syncthreads();
    if (threadIdx.x == 0) {
        unsigned* bar = b.bar;
        __builtin_amdgcn_s_waitcnt(0);
        unsigned nloc = b.st[0], nx = b.st[1];
        if (nloc == 0u) { xcd_barrier_complete(bar, b.x, b.total, nloc, nx); b.st[0] = nloc; b.st[1] = nx; }
        const unsigned old = xb_add(&bar[XB_XSUB(b.x)], 1u);
        const unsigned gen = old / nloc;
        if (old + 1u == (gen + 1u) * nloc) {
            __builtin_amdgcn_fence(__ATOMIC_RELEASE, "agent");
            asm volatile("s_waitcnt vmcnt(0)" ::: "memory");
            const unsigned og = xb_add(&bar[XB_TOP], 1u);
            const unsigned tg = og / nx;
            if (og + 1u == (tg + 1u) * nx) xb_add(&bar[XB_TOPGEN], 1u);
            else XB_SPIN(xb_ld(&bar[XB_TOPGEN]) == tg, bar);
            __builtin_amdgcn_fence(__ATOMIC_ACQUIRE, "agent");
            xb_add(&bar[XB_XGEN(b.x)], 1u);
            asm volatile("s_waitcnt vmcnt(0)" ::: "memory");
        } else {
            XB_SPIN(xb_ld(&bar[XB_XGEN(b.x)]) == gen, bar);
            __builtin_amdgcn_fence(__ATOMIC_ACQUIRE, "agent");
            asm volatile("s_waitcnt vmcnt(0)" ::: "memory");
        }
    }
    __syncthreads();
}

__device__ __forceinline__ float wave_sum(float v) {
#pragma unroll
    for (int o = 1; o < 64; o <<= 1) v += __shfl_xor(v, o);
    return v;
}
__device__ __forceinline__ float sigmoidf_(float x) { return __builtin_amdgcn_rcpf(1.0f + __builtin_amdgcn_exp2f(-x * 1.4426950408889634f)); }

struct Args { const float* in[22]; float* out; unsigned char* ws; int ph_lo, ph_hi; };
struct Frame {
    LAS unsigned char* lds;
    volatile LAS unsigned* MISC;
    unsigned* ctl;
    int tid, lane, wave;
    int vcu, G;
    const float* in[22]; float* out; unsigned char* ws;
};

#ifndef G1_FP8
#define G1_FP8 1
#endif
#ifndef ATT_F8
#define ATT_F8 1
#endif
#ifndef P1_FP8
#define P1_FP8 1
#endif
struct TItem { const float* W; unsigned char* WT; int K, N, k0, n0, drow0, f8; };
constexpr float W8SCALE = 32.0f, H8SCALE = 8.0f, OA_SCALE = 16.0f, OB_SCALE = 64.0f, MG_SCALE = 32.0f;
__device__ __forceinline__ void titem_issue(const TItem& it, LAS unsigned char* buf, int lane) {
#pragma unroll
    for (int g = 0; g < 8; ++g) { const int k = 8 * g + (lane >> 3), pos = lane & 7;
        __builtin_amdgcn_global_load_lds((const unsigned*)(it.W + (size_t)(it.k0 + k) * it.N + it.n0 + 4 * (pos ^ g)), (LAS unsigned*)(buf + g * 1024), 16, 0, 0); }
}
__device__ __forceinline__ void titem_finish(const TItem& it, const LAS float* buf, int lane) {
    const int c = lane & 7;
#pragma unroll
    for (int j = 0; j < 4; ++j) { const int nn = (lane >> 3) + 8 * j; const LAS float* s = buf + (8 * c) * 32 + (((nn >> 2) ^ c) << 2) + (nn & 3);
        const size_t eo = (size_t)(it.drow0 + nn) * it.K + it.k0 + 8 * c;
        if (it.f8) { v2u o; int t = __builtin_amdgcn_cvt_pk_fp8_f32(s[0 * 32] * W8SCALE, s[1 * 32] * W8SCALE, 0, false); t = __builtin_amdgcn_cvt_pk_fp8_f32(s[2 * 32] * W8SCALE, s[3 * 32] * W8SCALE, t, true); o.x = (unsigned)t;
            t = __builtin_amdgcn_cvt_pk_fp8_f32(s[4 * 32] * W8SCALE, s[5 * 32] * W8SCALE, 0, false); t = __builtin_amdgcn_cvt_pk_fp8_f32(s[6 * 32] * W8SCALE, s[7 * 32] * W8SCALE, t, true); o.y = (unsigned)t;
            __builtin_nontemporal_store(o, (GAS v2u*)(it.WT + eo)); }
        else { v4u o; o.x = pg8::cvt_pk_bf16(s[0 * 32], s[1 * 32]); o.y = pg8::cvt_pk_bf16(s[2 * 32], s[3 * 32]); o.z = pg8::cvt_pk_bf16(s[4 * 32], s[5 * 32]); o.w = pg8::cvt_pk_bf16(s[6 * 32], s[7 * 32]);
            __builtin_nontemporal_store(o, (GAS v4u*)(it.WT + 2 * eo)); } }
}
constexpr int I_IN = (DM / 64) * (INC / 32);
constexpr int I_BR = (1024 / 64) * (DM / 32);
constexpr int I_WO = (DM / 64) * (DM / 32);
constexpr int I_GU = (DM / 64) * (FE / 32);
constexpr int I_DN = (FE / 64) * (DM / 32);
constexpr int NITEMS_E1 = 2 * I_BR + I_WO + NEXP1 * 2 * I_GU;
constexpr int NITEMS_E2 = NEXP1 * I_DN;
__device__ __forceinline__ void titem_plain(TItem& it, const float* W, int K, int N, void* WT, int item, int f8 = 0) {
    const int nblk = N / 32, kb = item / nblk, nb = item % nblk; it.W = W; it.WT = (unsigned char*)WT; it.K = K; it.N = N; it.k0 = 64 * kb; it.n0 = 32 * nb; it.drow0 = 32 * nb; it.f8 = f8;
}
template <int LIST>
__device__ __forceinline__ void titem_get(Frame& F, int r, TItem& it) {
    if constexpr (LIST == 0) { titem_plain(it, F.in[1], DM, INC, F.ws + WS_WINT, r, P1_FP8); }
    else if constexpr (LIST == 2) { const int e = r / I_DN; r -= e * I_DN;
        titem_plain(it, e < NEXP ? F.in[16] + (size_t)e * FE * DM : F.in[19], FE, DM, F.ws + WS_WD + (size_t)e * DM * FE, r, 1); }
    else {
        if (r < I_BR) { titem_plain(it, F.in[7], 1024, DM, F.ws + WS_WAT, r, 1); return; } r -= I_BR;
        if (r < I_BR) { titem_plain(it, F.in[8], 1024, DM, F.ws + WS_WBT, r, 1); return; } r -= I_BR;
        if (r < I_WO) { titem_plain(it, F.in[9], DM, DM, F.ws + WS_WOT, r, 1); return; } r -= I_WO;
        const int e = r / (2 * I_GU); r -= e * (2 * I_GU);
        const int half = r >= I_GU ? 1 : 0; r -= half * I_GU;
        const float* w = e < NEXP ? (half ? F.in[15] : F.in[14]) + (size_t)e * DM * FE : (half ? F.in[18] : F.in[17]);
        const int nblk = FE / 32, kb = r / nblk, nb = r % nblk, n0 = 32 * nb;
        it.W = w; it.WT = F.ws + WS_WGU + (size_t)e * 1024 * DM * (G1_FP8 ? 1 : 2); it.f8 = G1_FP8; it.K = DM; it.N = FE; it.k0 = 64 * kb; it.n0 = n0; it.drow0 = 256 * (n0 >> 7) + 128 * half + (n0 & 127);
    }
}
#ifndef CONV_D
#define CONV_D 4
#endif
__device__ __forceinline__ void titem_load(const TItem& it, f32x4 (&r)[8], int lane) {
#pragma unroll
    for (int g = 0; g < 8; ++g) r[g] = __builtin_nontemporal_load((const GAS f32x4*)(it.W + (size_t)(it.k0 + 8 * g + (lane >> 3)) * it.N + it.n0 + 4 * (lane & 7)));
}
__device__ __forceinline__ void titem_store(const TItem& it, const f32x4 (&r)[8], LAS float* buf, int lane) {
#pragma unroll
    for (int g = 0; g < 8; ++g) *(LAS f32x4*)(buf + (8 * g + (lane >> 3)) * 32 + (((lane & 7) ^ g) << 2)) = r[g];
    titem_finish(it, buf, lane);
}
template <int LISTE>
__device__ __forceinline__ void convert_items(Frame& F, int first, int step, int last) {
    LAS float* buf = (LAS float*)(F.lds + RING_OFF + F.wave * 8192);
    if (first >= last) return;
    const int n_my = (last - first + step - 1) / step;
    f32x4 r[CONV_D][8]; TItem it;
#pragma unroll
    for (int d = 0; d < CONV_D; ++d) if (d < n_my) { titem_get<LISTE>(F, first + d * step, it); titem_load(it, r[d], F.lane); }
    for (int base = 0; base < n_my; base += CONV_D) {
#pragma unroll
        for (int d = 0; d < CONV_D; ++d) { const int idx = base + d;
            if (idx < n_my) { titem_get<LISTE>(F, first + idx * step, it); titem_store(it, r[d], buf, F.lane);
                if (idx + CONV_D < n_my) { titem_get<LISTE>(F, first + (idx + CONV_D) * step, it); titem_load(it, r[d], F.lane); } } }
    }
}
#ifndef CONV_Q
#define CONV_Q 200
#endif
#ifndef P1_NCG
#define P1_NCG 23
#endif
constexpr int NCONV = 32, NCOMP = 256 - NCONV, NCONV1 = 8 * (32 - P1_NCG), NCOMP1 = 8 * P1_NCG, E_SPLIT = (NCONV1 * NWAVES * CONV_Q < NITEMS_E1) ? NCONV1 * NWAVES * CONV_Q : NITEMS_E1;
#ifndef CONV_Q2
#define CONV_Q2 100
#endif
#ifndef P1_QE2
#define P1_QE2 0
#endif
constexpr int E2_A = (NCONV1 * NWAVES * P1_QE2 < NITEMS_E2) ? NCONV1 * NWAVES * P1_QE2 : NITEMS_E2;
constexpr int E2_SPLIT = (E2_A + 32 * NWAVES * CONV_Q2 < NITEMS_E2) ? E2_A + 32 * NWAVES * CONV_Q2 : NITEMS_E2;
#ifndef CONV_G1
#define CONV_G1 1
#endif
__device__ __forceinline__ void p0_prologue(Frame& F, bool compute_only) {
    const int gw = (compute_only ? (F.vcu >> 5) * P1_NCG + (F.vcu & 31) : F.vcu) * NWAVES + F.wave, NGW = (compute_only ? NCOMP1 : F.G) * NWAVES;
    convert_items<0>(F, gw, NGW, I_IN);
    { const int gt = gw * 64 + F.lane, NT = NGW * 64; const GAS f32x4* xs = (const GAS f32x4*)F.in[0]; GAS v4u* xo = (GAS v4u*)(F.ws + WS_XBF);
      for (int i = gt; i < SEQ * DM / 8; i += 4 * NT) {
          f32x4 a[4], b[4];
#pragma unroll
          for (int u = 0; u < 4; ++u) if (i + u * NT < SEQ * DM / 8) { a[u] = __builtin_nontemporal_load(xs + 2 * (i + u * NT)); b[u] = __builtin_nontemporal_load(xs + 2 * (i + u * NT) + 1); }
#pragma unroll
          for (int u = 0; u < 4; ++u) if (i + u * NT < SEQ * DM / 8) {
              if (P1_FP8) { v2u o; int t = __builtin_amdgcn_cvt_pk_fp8_f32(a[u].x, a[u].y, 0, false); t = __builtin_amdgcn_cvt_pk_fp8_f32(a[u].z, a[u].w, t, true); o.x = (unsigned)t;
                  t = __builtin_amdgcn_cvt_pk_fp8_f32(b[u].x, b[u].y, 0, false); t = __builtin_amdgcn_cvt_pk_fp8_f32(b[u].z, b[u].w, t, true); o.y = (unsigned)t; ((GAS v2u*)xo)[i + u * NT] = o; }
              else { v4u o; o.x = pg8::cvt_pk_bf16(a[u].x, a[u].y); o.y = pg8::cvt_pk_bf16(a[u].z, a[u].w); o.z = pg8::cvt_pk_bf16(b[u].x, b[u].y); o.w = pg8::cvt_pk_bf16(b[u].z, b[u].w); xo[i + u * NT] = o; } } } }
    { const int gt = gw * 64 + F.lane, NT = NGW * 64; bf16* wr = (bf16*)(F.ws + WS_WR);
      for (int i = gt; i < NEXP * DM; i += NT) {
          const int j_ = i & 7, ln = (i >> 3) & 63, nt_ = (i >> 9) & 3, ks = i >> 11, q_ = ln >> 4, t_ = ln & 15;
          const int k = ks * 32 + (j_ < 4 ? 4 * q_ + j_ : 16 + 4 * q_ + j_ - 4), e = 16 * nt_ + t_;
          const float w = F.in[12][(size_t)k * NEXP + e]; const unsigned h = f2bf(w); const float lo = w - __uint_as_float(h << 16);
          wr[i] = (bf16)h; wr[NEXP * DM + i] = (bf16)f2bf(lo); } }
    { const int gt = gw * 64 + F.lane, NT = NGW * 64; int* lt = (int*)(F.ws + WS_LTOK); float* lw = (float*)(F.ws + WS_LW);
      for (int i = gt; i < NEXP1 * LCAP; i += NT) { const bool sh = i >= NEXP * LCAP; lt[i] = sh ? i - NEXP * LCAP : 0; lw[i] = sh ? 1.0f : 0.0f; } }
}

#ifndef WT_STORES
#define WT_STORES 0
#endif
__device__ __forceinline__ void st_wt8(void* p, v2u w) {
    if (WT_STORES) __hip_atomic_store((unsigned long long*)p, ((unsigned long long)w.y << 32) | w.x, __ATOMIC_RELAXED, __HIP_MEMORY_SCOPE_AGENT);
    else *(v2u*)p = w;
}
__device__ __forceinline__ v4u pair16(v2u a, v2u b) {
    auto sx = __builtin_amdgcn_permlane16_swap(a.x, b.x, false, false);
    auto sy = __builtin_amdgcn_permlane16_swap(a.y, b.y, false, false);
    return (v4u){sx[0], sy[0], sx[1], sy[1]};
}
struct DenseOrder {
    const char* A; const char* B; int nM, nN, nwg, G, c; size_t tstep;
    __device__ __forceinline__ void init(const void* A_, const void* B_, int M, int N, int K, int G_, int c_) { A = (const char*)A_; B = (const char*)B_; nM = M / 256; nN = N / 256; nwg = nM * nN; G = G_; c = c_; tstep = (size_t)256 * K * (P1_FP8 ? 1 : 2); }
    __device__ __forceinline__ bool next(int i, pg8::Unit& u) const {
#ifdef P1_DOUBLE
        const long L = (long)(i >> 1) * G + c; if (L >= nwg) return false;
#else
        const long L = (long)i * G + c; if (L >= nwg) return false;
#endif
        int wgid = (int)L; { const int q = nwg / 8, r = nwg % 8, xcd = wgid % 8, off = wgid / 8; wgid = (xcd < r ? xcd * (q + 1) : r * (q + 1) + (xcd - r) * q) + off; }
        const int nig = 8 * nN, gid = wgid / nig, fm = gid * 8, gsz = (nM - fm) < 8 ? (nM - fm) : 8;
        const int pm = fm + ((wgid % nig) % gsz), pn = (wgid % nig) / gsz;
        u.A = A + (size_t)pm * tstep; u.B = B + (size_t)pn * tstep; u.idx = nullptr; u.wts = nullptr; u.r0 = pm * 256; u.c0 = pn * 256; u.aux = 0; u.kind = 0; return true;
    }
};
struct BranchOrder {
    const char *OA, *OB, *WA, *WB; int vcu;
    __device__ __forceinline__ bool next(int i, pg8::Unit& u) const {
#ifdef P3_DOUBLE
        if (i >= 4) return false; i &= 1;
#else
        if (i >= 2) return false;
#endif
        const int pm = vcu >> 3, pn = vcu & 7; const size_t ts = (size_t)256 * 1024;
        u.A = (i ? OB : OA) + (size_t)pm * ts; u.B = (i ? WB : WA) + (size_t)pn * ts; u.idx = nullptr; u.wts = nullptr; u.r0 = pm * 256; u.c0 = pn * 256; u.aux = 0; u.kind = i; return true;
    }
};
struct OneTileOrder {
    const char *A, *B; int vcu; size_t ts;
    __device__ __forceinline__ bool next(int i, pg8::Unit& u) const {
#ifdef P4_DOUBLE
        if (i >= 2) return false;
#else
        if (i >= 1) return false;
#endif
        const int pm = vcu >> 3, pn = vcu & 7;
        u.A = A + (size_t)pm * ts; u.B = B + (size_t)pn * ts; u.idx = nullptr; u.wts = nullptr; u.r0 = pm * 256; u.c0 = pn * 256; u.aux = 0; u.kind = 0; return true;
    }
};
template <int NPN>
struct MoeOrder {
    const LAS int* tst; const char* A; const char* B; const int* ltok; const float* lwt; int vcu, G; size_t arow, bexp, bpn;
    bool gather;
    int l0, lend, nheavy;
    const unsigned* flag; int wait_gmt, need;
    mutable int ec = 0;
    __device__ __forceinline__ bool next(int i, pg8::Unit& u) const {
        const int T = tst[NEXP1]; const int end = lend < 0 ? T * NPN : lend;
        int L;
#ifdef G2_DOUBLE
        if (NPN == 8) i >>= 1;
#endif
        if (nheavy > 0) { const int NL = G - nheavy; if (vcu >= NL) L = 2 * NL + i * G + vcu; else L = i < 2 ? i * NL + vcu : 2 * NL + (i - 2) * G + vcu; }
        else L = l0 + i * G + vcu;
        if (L >= end) return false;
        const int gmt = L / NPN, pn = L % NPN; int e = ec; if (tst[e] > gmt) e = 0;
        while (e < NEXP && tst[e + 1] <= gmt) ++e;
        ec = e;
        const int mt = gmt - tst[e];
        if (need > 0 && gmt >= wait_gmt) {
            unsigned spins = 0; while (__hip_atomic_load(flag, __ATOMIC_RELAXED, __HIP_MEMORY_SCOPE_AGENT) < (unsigned)need && ++spins < (1u << 22)) __builtin_amdgcn_s_sleep(2);
            __builtin_amdgcn_fence(__ATOMIC_ACQUIRE, "agent"); asm volatile("s_waitcnt vmcnt(0)" ::: "memory"); }
        u.A = gather ? A : A + (size_t)gmt * 256 * arow; u.B = B + (size_t)e * bexp + (size_t)pn * bpn; u.idx = ltok + e * LCAP + mt * 256; u.wts = lwt + e * LCAP + mt * 256;
        u.r0 = gmt * 256; u.c0 = pn * 256; u.aux = e * LCAP + mt * 256; u.kind = 0; return true;
    }
};

constexpr float GSCALE = 256.0f;
typedef float f32x2v __attribute__((ext_vector_type(2)));
struct EpiProj {
    static constexpr bool PERM = true; static constexpr int NST = 8;
    bf16* O; const float* bgate;
    __device__ __forceinline__ bool operator()(const pg8::f32x4 (&acc)[2][2][4][2], const pg8::Unit& u, int wr, int wc, int fr, int fq, const LAS float* wl) const {
        const int row0 = u.r0 + wr * 64 + fr, col0 = u.c0 + wc * 32 + 8 * fq;
        constexpr float PS = P1_FP8 ? 1.0f / W8SCALE : 1.0f;
        if (u.c0 >= C_GA) {
            f32x4 bb[2][2];
#pragma unroll
            for (int bj = 0; bj < 2; ++bj) { bb[bj][0] = *(const f32x4*)(bgate + col0 + bj * 128 - C_GA); bb[bj][1] = *(const f32x4*)(bgate + col0 + bj * 128 - C_GA + 4); }
            const int odd = fq & 1; unsigned char* G = (unsigned char*)O + (size_t)C_GA * 2 + (col0 - 8 * odd - C_GA);
#pragma unroll
            for (int ai = 0; ai < 2; ++ai)
#pragma unroll
                for (int mp = 0; mp < 2; ++mp)
#pragma unroll
                    for (int bj = 0; bj < 2; ++bj) { v2u w[2];
#pragma unroll
                        for (int mm = 0; mm < 2; ++mm) { const int m = 2 * mp + mm; const f32x4 v0 = acc[ai][bj][m][0] * PS + bb[bj][0], v1 = acc[ai][bj][m][1] * PS + bb[bj][1];
                            int t = __builtin_amdgcn_cvt_pk_fp8_f32(GSCALE * sigmoidf_(v0[0]), GSCALE * sigmoidf_(v0[1]), 0, false); t = __builtin_amdgcn_cvt_pk_fp8_f32(GSCALE * sigmoidf_(v0[2]), GSCALE * sigmoidf_(v0[3]), t, true); w[mm].x = (unsigned)t;
                            t = __builtin_amdgcn_cvt_pk_fp8_f32(GSCALE * sigmoidf_(v1[0]), GSCALE * sigmoidf_(v1[1]), 0, false); t = __builtin_amdgcn_cvt_pk_fp8_f32(GSCALE * sigmoidf_(v1[2]), GSCALE * sigmoidf_(v1[3]), t, true); w[mm].y = (unsigned)t; }
                        *(v4u*)(G + (size_t)(row0 + ai * 128 + (2 * mp + odd) * 16) * (PLD * 2) + bj * 128) = pair16(w[0], w[1]); }
        } else {
#pragma unroll
            for (int ai = 0; ai < 2; ++ai)
#pragma unroll
                for (int m = 0; m < 4; ++m)
#pragma unroll
                    for (int bj = 0; bj < 2; ++bj) { const f32x4 v0 = acc[ai][bj][m][0] * PS, v1 = acc[ai][bj][m][1] * PS;
                        v4u w; w.x = pg8::cvt_pk_bf16(v0[0], v0[1]); w.y = pg8::cvt_pk_bf16(v0[2], v0[3]); w.z = pg8::cvt_pk_bf16(v1[0], v1[1]); w.w = pg8::cvt_pk_bf16(v1[2], v1[3]);
                        *(v4u*)(O + (size_t)(row0 + ai * 128 + m * 16) * PLD + col0 + bj * 128) = w; }
        }
        return false;
    }
};
struct EpiBranch {
    static constexpr bool PERM = true; static constexpr int NST = 0;
    const bf16* proj; unsigned char* O;
    __device__ __forceinline__ bool operator()(pg8::f32x4 (&acc)[2][2][4][2], const pg8::Unit& u, int wr, int wc, int fr, int fq, const LAS float* wl) const {
        const int row0 = u.r0 + wr * 64 + fr, col0 = u.c0 + wc * 32 + 8 * fq;
        const bool seg0 = u.kind == 0;
#pragma unroll
        for (int ai = 0; ai < 2; ++ai) {
            v2u gb[4][2], ga[4][2];
#pragma unroll
            for (int m = 0; m < 4; ++m)
#pragma unroll
                for (int bj = 0; bj < 2; ++bj) { const size_t r = (size_t)(row0 + ai * 128 + m * 16); const int c = col0 + bj * 128;
                    const unsigned char* gp = (const unsigned char*)proj + r * (PLD * 2) + (size_t)C_GA * 2 + c;
                    gb[m][bj] = *(const v2u*)(gp + (C_GB - C_GA)); ga[m][bj] = seg0 ? *(const v2u*)gp : (v2u){0u, 0u}; }
            __builtin_amdgcn_sched_barrier(0);
#pragma unroll
            for (int mp = 0; mp < 2; ++mp) {
                v2u wq[2][2];
#pragma unroll
                for (int mm = 0; mm < 2; ++mm)
#pragma unroll
                    for (int bj = 0; bj < 2; ++bj) { const int m = 2 * mp + mm;
                        const v2u gbv = gb[m][bj], gav = ga[m][bj];
                        const f32x2v g01 = __builtin_amdgcn_cvt_pk_f32_fp8((int)gbv.x, false), g23 = __builtin_amdgcn_cvt_pk_f32_fp8((int)gbv.x, true), g45 = __builtin_amdgcn_cvt_pk_f32_fp8((int)gbv.y, false), g67 = __builtin_amdgcn_cvt_pk_f32_fp8((int)gbv.y, true);
                        float g[8] = {g01[0], g01[1], g23[0], g23[1], g45[0], g45[1], g67[0], g67[1]};
                        if (seg0) {
                            const f32x2v a01 = __builtin_amdgcn_cvt_pk_f32_fp8((int)gav.x, false), a23 = __builtin_amdgcn_cvt_pk_f32_fp8((int)gav.x, true), a45 = __builtin_amdgcn_cvt_pk_f32_fp8((int)gav.y, false), a67 = __builtin_amdgcn_cvt_pk_f32_fp8((int)gav.y, true);
                            float a[8] = {a01[0], a01[1], a23[0], a23[1], a45[0], a45[1], a67[0], a67[1]};
#pragma unroll
                            for (int j = 0; j < 4; ++j) { acc[ai][bj][m][0][j] *= (OB_SCALE / OA_SCALE) * a[j] * __builtin_amdgcn_rcpf(fmaxf(g[j], 1e-30f)); acc[ai][bj][m][1][j] *= (OB_SCALE / OA_SCALE) * a[4 + j] * __builtin_amdgcn_rcpf(fmaxf(g[4 + j], 1e-30f)); }
                        } else {
                            const pg8::f32x4 v0 = acc[ai][bj][m][0], v1 = acc[ai][bj][m][1];
                            constexpr float S1 = MG_SCALE / (OB_SCALE * W8SCALE * GSCALE);
                            v2u w; int t = __builtin_amdgcn_cvt_pk_fp8_f32(v0[0] * g[0] * S1, v0[1] * g[1] * S1, 0, false); t = __builtin_amdgcn_cvt_pk_fp8_f32(v0[2] * g[2] * S1, v0[3] * g[3] * S1, t, true); w.x = (unsigned)t;
                            t = __builtin_amdgcn_cvt_pk_fp8_f32(v1[0] * g[4] * S1, v1[1] * g[5] * S1, 0, false); t = __builtin_amdgcn_cvt_pk_fp8_f32(v1[2] * g[6] * S1, v1[3] * g[7] * S1, t, true); w.y = (unsigned)t;
                            wq[mm][bj] = w;
                        }
                    }
                if (!seg0) { const int odd = fq & 1;
#pragma unroll
                    for (int bj = 0; bj < 2; ++bj) *(v4u*)(O + (size_t)(row0 + ai * 128 + (2 * mp + odd) * 16) * DM + col0 - 8 * odd + bj * 128) = pair16(wq[0][bj], wq[1][bj]); }
            }
            __builtin_amdgcn_sched_barrier(0);
        }
        return seg0;
    }
};
struct EpiMix {
    static constexpr bool PERM = true; static constexpr int NST = 16;
    bf16* O;
    __device__ __forceinline__ bool operator()(const pg8::f32x4 (&acc)[2][2][4][2], const pg8::Unit& u, int wr, int wc, int fr, int fq, const LAS float* wl) const {
        const int row0 = u.r0 + wr * 64 + fr, col0 = u.c0 + wc * 32 + 8 * fq;
#pragma unroll
        for (int ai = 0; ai < 2; ++ai)
#pragma unroll
            for (int m = 0; m < 4; ++m)
#pragma unroll
                for (int bj = 0; bj < 2; ++bj) { const pg8::f32x4 v0 = acc[ai][bj][m][0] * (1.0f / (MG_SCALE * W8SCALE)), v1 = acc[ai][bj][m][1] * (1.0f / (MG_SCALE * W8SCALE));
                    v4u w; w.x = pg8::cvt_pk_bf16(v0[0], v0[1]); w.y = pg8::cvt_pk_bf16(v0[2], v0[3]); w.z = pg8::cvt_pk_bf16(v1[0], v1[1]); w.w = pg8::cvt_pk_bf16(v1[2], v1[3]);
                    *(v4u*)(O + (size_t)(row0 + ai * 128 + m * 16) * DM + col0 + bj * 128) = w; }
        return false;
    }
};
struct EpiMoe1 {
    static constexpr bool PERM = true; static constexpr int NST = 4;
    unsigned char* H;
    __device__ __forceinline__ bool operator()(const pg8::f32x4 (&acc)[2][2][4][2], const pg8::Unit& u, int wr, int wc, int fr, int fq, const LAS float* wl) const {
        const int odd = fq & 1; const int row0 = u.r0 + wr * 64 + fr + odd * 16, col0 = (u.c0 >> 1) + wc * 32 + 8 * (fq - odd);
#pragma unroll
        for (int ai = 0; ai < 2; ++ai)
#pragma unroll
            for (int mp = 0; mp < 2; ++mp) { v2u w[2];
#pragma unroll
                for (int mm = 0; mm < 2; ++mm) { const int m = 2 * mp + mm; float h[8]; const float wt = wl[wr * 64 + fr + ai * 128 + m * 16] * H8SCALE;
#pragma unroll
                    for (int n = 0; n < 2; ++n)
#pragma unroll
                        for (int j = 0; j < 4; ++j) { const float g = acc[ai][0][m][n][j] * (G1_FP8 ? 1.0f / W8SCALE : 1.0f), up = acc[ai][1][m][n][j] * (G1_FP8 ? 1.0f / W8SCALE : 1.0f); h[4 * n + j] = __builtin_amdgcn_fmed3f(g * sigmoidf_(g) * up * wt, -448.0f, 448.0f); }
                    int t = __builtin_amdgcn_cvt_pk_fp8_f32(h[0], h[1], 0, false); t = __builtin_amdgcn_cvt_pk_fp8_f32(h[2], h[3], t, true); w[mm].x = (unsigned)t;
                    t = __builtin_amdgcn_cvt_pk_fp8_f32(h[4], h[5], 0, false); t = __builtin_amdgcn_cvt_pk_fp8_f32(h[6], h[7], t, true); w[mm].y = (unsigned)t; }
                *(v4u*)(H + (size_t)(row0 + ai * 128 + mp * 32) * FE + col0) = pair16(w[0], w[1]); }
        return false;
    }
};
constexpr float YSCALE = 16.0f;
struct EpiMoe2 {
    static constexpr bool PERM = true; static constexpr int NST = 8;
    unsigned char* Y;
    __device__ __forceinline__ bool operator()(const pg8::f32x4 (&acc)[2][2][4][2], const pg8::Unit& u, int wr, int wc, int fr, int fq, const LAS float* wl) const {
        const int odd = fq & 1; const int lr0 = wr * 64 + fr + odd * 16, col0 = u.c0 + wc * 32 + 8 * (fq - odd);
#pragma unroll
        for (int ai = 0; ai < 2; ++ai)
#pragma unroll
            for (int mp = 0; mp < 2; ++mp) { const int lr = lr0 + ai * 128 + mp * 32;
#pragma unroll
                for (int bj = 0; bj < 2; ++bj) { v2u w[2];
#pragma unroll
                    for (int mm = 0; mm < 2; ++mm) { pg8::f32x4 v0 = acc[ai][bj][2 * mp + mm][0] * (YSCALE / (W8SCALE * H8SCALE)), v1 = acc[ai][bj][2 * mp + mm][1] * (YSCALE / (W8SCALE * H8SCALE));
#pragma unroll
                        for (int j = 0; j < 4; ++j) { v0[j] = __builtin_amdgcn_fmed3f(v0[j], -448.0f, 448.0f); v1[j] = __builtin_amdgcn_fmed3f(v1[j], -448.0f, 448.0f); }
                        int t = __builtin_amdgcn_cvt_pk_fp8_f32(v0[0], v0[1], 0, false); t = __builtin_amdgcn_cvt_pk_fp8_f32(v0[2], v0[3], t, true); w[mm].x = (unsigned)t;
                        t = __builtin_amdgcn_cvt_pk_fp8_f32(v1[0], v1[1], 0, false); t = __builtin_amdgcn_cvt_pk_fp8_f32(v1[2], v1[3], t, true); w[mm].y = (unsigned)t; }
                    *(v4u*)(Y + (size_t)(u.r0 + lr) * DM + col0 + bj * 128) = pair16(w[0], w[1]); } }
        return false;
    }
};

__device__ __forceinline__ void p1b_qknorm(Frame& F) {
    const int gw = F.vcu * NWAVES + F.wave, NGW = F.G * NWAVES; const bf16* proj = (const bf16*)(F.ws + WS_PROJ);
    const int hf = F.lane >> 5, i = F.lane & 31;
    const float inv = __builtin_amdgcn_exp2f(-(float)(2 * i) * (1.0f / 64.0f) * 13.287712379549449f);
    const float gk0 = F.in[6][64 * hf + i], gk1 = F.in[6][64 * hf + 32 + i];
    for (int tok0 = gw; tok0 < SEQ; tok0 += 4 * NGW) {
        float x1[4][2], x2[4][2];
#pragma unroll
        for (int b = 0; b < 4; ++b) { const int tok = tok0 + b * NGW; const bf16* pq = proj + (size_t)(tok < SEQ ? tok : 0) * PLD + C_KB + 64 * hf + i;
#pragma unroll
            for (int hh = 0; hh < 2; ++hh) { x1[b][hh] = bf2f(pq[hh * HD]); x2[b][hh] = bf2f(pq[hh * HD + 32]); } }
        __builtin_amdgcn_sched_barrier(0);
#pragma unroll
        for (int b = 0; b < 4; ++b) { const int tok = tok0 + b * NGW;
            const float pos = (float)(hf == 0 ? (tok >> 6) : (tok & 63));
            const float rev = pos * inv * 0.15915494309189535f, fr = rev - floorf(rev);
            const float sn = __builtin_amdgcn_sinf(fr), cs = __builtin_amdgcn_cosf(fr);
#pragma unroll
            for (int hh = 0; hh < 2; ++hh) {
                const float ss = wave_sum(x1[b][hh] * x1[b][hh] + x2[b][hh] * x2[b][hh]);
                const float rs = 1.0f / sqrtf(ss * (1.0f / HD) + RMS_EPS);
                const float a = x1[b][hh] * rs * gk0, c = x2[b][hh] * rs * gk1;
                const float o1 = a * cs - c * sn, o2 = c * cs + a * sn;
                if (tok < SEQ) { unsigned char* kf = F.ws + WS_KF8 + (size_t)tok * 256 + hh * HD + 64 * hf + 32 * ((i >> 4) & 1) + (i & 15);
                    kf[0] = (unsigned char)(__builtin_amdgcn_cvt_pk_fp8_f32(o1, 0.f, 0, false) & 0xff); kf[16] = (unsigned char)(__builtin_amdgcn_cvt_pk_fp8_f32(o2, 0.f, 0, false) & 0xff); } } }
    }
}

__device__ __forceinline__ int t5_bucket(int rel) {
    const int n = rel < 0 ? -rel : rel; int b;
    if (n < 8) b = n; else if (n < 12) b = 8; else if (n < 16) b = 9; else if (n < 23) b = 10; else if (n < 32) b = 11; else if (n < 46) b = 12; else if (n < 64) b = 13; else if (n < 91) b = 14; else b = 15;
    return (rel > 0 ? 16 : 0) + b;
}
__device__ __forceinline__ void p3_dense_attention(Frame& F) {
    using abf = attn::bf16;
    char* lds = (char*)F.lds;
    const abf* proj = (const abf*)(F.ws + WS_PROJ);
    float gqm = fmaxf(fabsf(F.in[5][F.lane]), fabsf(F.in[5][F.lane + 64])), gkm = fmaxf(fabsf(F.in[6][F.lane]), fabsf(F.in[6][F.lane + 64]));
#pragma unroll
    for (int o = 1; o < 64; o <<= 1) { gqm = fmaxf(gqm, __shfl_xor(gqm, o)); gkm = fmaxf(gkm, __shfl_xor(gkm, o)); }
    const float sbound = 1.15f * 128.0f * gqm * gkm;
    for (int un = F.vcu; un < 256; un += F.G) {
        const int h = un >> 5, ub = un & 31, kvh = h >> 2;
        attn::attn_body<false, 1, true, true, true>(proj + (size_t)(ub * 256) * PLD + C_QB + h * HD, proj + C_KB + kvh * HD, F.ws + WS_KF8 + kvh * HD, proj + C_VB + kvh * HD,
                               F.ws + WS_OB + (size_t)(ub * 256) * 1024 + h * HD, OB_SCALE, SEQ, lds, nullptr, 0, sbound, 0.f, F.in[5], ub * 256);
    }
}
__device__ __forceinline__ void win_attention(Frame& F, int first, int step) {
    using abf = attn::bf16;
    char* lds = (char*)F.lds;
    const abf* proj = (const abf*)(F.ws + WS_PROJ);
    for (int un = first; un < 256; un += step) {
        const int h = un >> 5, ub = un & 31, kvh = h >> 2;
        LAS float* tab = (LAS float*)(F.lds + attn::WIN_TAB);
        for (int e = F.tid; e < 1024; e += NWAVES * 64) { const int rel = e - 512; const int ar = rel < 0 ? -rel : rel;
            tab[e] = ar <= 128 ? F.in[4][t5_bucket(rel) * 8 + h] * (1.0f / attn::SCALE) : -1e30f; }
        __syncthreads();
        const int q0 = ub * 256; int kf = q0 - 128, ke = q0 + 384; if (kf < 0) kf = 0; if (ke > SEQ) ke = SEQ;
        const float sinkl = F.in[3][h] * (1.0f / attn::SCALE);
        attn::attn_body<true, 1, false, false>(proj + (size_t)q0 * PLD + C_QA + h * HD, proj + (size_t)kf * PLD + C_KA + kvh * HD, nullptr, proj + (size_t)kf * PLD + C_VA + kvh * HD,
                              F.ws + WS_OA + (size_t)q0 * 1024 + h * HD, OA_SCALE, ke - kf, lds, tab, kf - q0, sinkl, 1.0f);
    }
}

__device__ __forceinline__ void p5_ln_router(Frame& F, bool probe_rep = false) {
    typedef float f32x4v __attribute__((ext_vector_type(4)));
    const bf16* mixb = (const bf16*)(F.ws + WS_PRE); bf16* hbf = (bf16*)(F.ws + WS_HBF);
    const bf16* wrh = (const bf16*)(F.ws + WS_WR); const bf16* wrl = wrh + NEXP * DM;
    LAS float* red = (LAS float*)(F.lds);
    LAS float* part = (LAS float*)(F.lds + 4096);
    LAS int* cntl = (LAS int*)(F.lds + 4096 + 32768);
    LAS int* basel = cntl + 64;
    LAS int* rec_e = basel + 64;
    LAS int* rec_p = rec_e + 256;
    LAS float* rec_w = (LAS float*)(rec_p + 256);
    const int lane = F.lane, w = F.wave, gi = w >> 2, kq = w & 3, t = lane & 15, q = lane >> 4;
    for (int blk = F.vcu; blk < SEQ / 32; blk += F.G) {
        const int tok = blk * 32 + gi * 16 + t;
        if (F.tid < 64) cntl[F.tid] = 0;
        float s1 = 0.f, s2 = 0.f;
        const float* prow = F.in[0] + (size_t)tok * DM + kq * 512 + 4 * q; const bf16* mrow = mixb + (size_t)tok * DM + kq * 512 + 4 * q;
#pragma unroll 8
        for (int s = 0; s < 16; ++s) { const v2u m0 = *(const v2u*)(mrow + 32 * s), m1 = *(const v2u*)(mrow + 32 * s + 16);
            const f32x4v v0 = *(const f32x4v*)(prow + 32 * s) * ALPHA + (f32x4v){pg8::bf_lo(m0.x), pg8::bf_hi(m0.x), pg8::bf_lo(m0.y), pg8::bf_hi(m0.y)}, v1 = *(const f32x4v*)(prow + 32 * s + 16) * ALPHA + (f32x4v){pg8::bf_lo(m1.x), pg8::bf_hi(m1.x), pg8::bf_lo(m1.y), pg8::bf_hi(m1.y)};
#pragma unroll
            for (int j = 0; j < 4; ++j) { s1 += v0[j] + v1[j]; s2 += v0[j] * v0[j] + v1[j] * v1[j]; } }
        s1 += __shfl_xor(s1, 16); s1 += __shfl_xor(s1, 32); s2 += __shfl_xor(s2, 16); s2 += __shfl_xor(s2, 32);
        if (q == 0) { red[(w * 16 + t) * 2] = s1; red[(w * 16 + t) * 2 + 1] = s2; }
        __syncthreads();
        float m1 = 0.f, m2 = 0.f;
#pragma unroll
        for (int k = 0; k < 4; ++k) { m1 += red[((gi * 4 + k) * 16 + t) * 2]; m2 += red[((gi * 4 + k) * 16 + t) * 2 + 1]; }
        const float mean = m1 * (1.0f / DM); const float var = m2 * (1.0f / DM) - mean * mean; const float rstd = 1.0f / sqrtf(var + LN_EPS);
        f32x4v acc[4] = {};
        const float* gp = F.in[10] + kq * 512 + 4 * q; const float* bp = F.in[11] + kq * 512 + 4 * q;
        bf16* brow = hbf + (size_t)tok * DM + kq * 512 + 4 * q; unsigned char* frow = F.ws + WS_HF8 + (size_t)tok * DM + kq * 512 + 4 * q;
        struct P5Set { f32x4v g0, g1, b0, b1, v0, v1; v2u m0, m1; bf16x8 Bh[4], Bl[4]; };
        P5Set A_;
#define P5_LOAD(S, X) do { X.g0 = *(const f32x4v*)(gp + 32 * (S)); X.g1 = *(const f32x4v*)(gp + 32 * (S) + 16); X.b0 = *(const f32x4v*)(bp + 32 * (S)); X.b1 = *(const f32x4v*)(bp + 32 * (S) + 16); \
            X.v0 = *(const f32x4v*)(prow + 32 * (S)); X.v1 = *(const f32x4v*)(prow + 32 * (S) + 16); X.m0 = *(const v2u*)(mrow + 32 * (S)); X.m1 = *(const v2u*)(mrow + 32 * (S) + 16); \
            _Pragma("unroll") for (int nt = 0; nt < 4; ++nt) { const size_t wo = (size_t)((((kq * 16 + (S)) * 4 + nt) * 64 + lane) * 8); X.Bh[nt] = *(const bf16x8*)(wrh + wo); X.Bl[nt] = *(const bf16x8*)(wrl + wo); } } while (0)
#define P5_COMP(S, X) do { const f32x4v p0_ = X.v0 * ALPHA + (f32x4v){pg8::bf_lo(X.m0.x), pg8::bf_hi(X.m0.x), pg8::bf_lo(X.m0.y), pg8::bf_hi(X.m0.y)}, p1_ = X.v1 * ALPHA + (f32x4v){pg8::bf_lo(X.m1.x), pg8::bf_hi(X.m1.x), pg8::bf_lo(X.m1.y), pg8::bf_hi(X.m1.y)}; \
            const f32x4v y0 = (p0_ - mean) * rstd * X.g0 + X.b0, y1 = (p1_ - mean) * rstd * X.g1 + X.b1; \
            v4u ah, al; ah.x = pg8::cvt_pk_bf16(y0[0], y0[1]); ah.y = pg8::cvt_pk_bf16(y0[2], y0[3]); ah.z = pg8::cvt_pk_bf16(y1[0], y1[1]); ah.w = pg8::cvt_pk_bf16(y1[2], y1[3]); \
            al.x = pg8::cvt_pk_bf16(y0[0] - pg8::bf_lo(ah.x), y0[1] - pg8::bf_hi(ah.x)); al.y = pg8::cvt_pk_bf16(y0[2] - pg8::bf_lo(ah.y), y0[3] - pg8::bf_hi(ah.y)); \
            al.z = pg8::cvt_pk_bf16(y1[0] - pg8::bf_lo(ah.z), y1[1] - pg8::bf_hi(ah.z)); al.w = pg8::cvt_pk_bf16(y1[2] - pg8::bf_lo(ah.w), y1[3] - pg8::bf_hi(ah.w)); \
            *(v2u*)(brow + 32 * (S)) = (v2u){ah.x, ah.y}; *(v2u*)(brow + 32 * (S) + 16) = (v2u){ah.z, ah.w}; \
            { int t0_ = __builtin_amdgcn_cvt_pk_fp8_f32(y0[0], y0[1], 0, false); t0_ = __builtin_amdgcn_cvt_pk_fp8_f32(y0[2], y0[3], t0_, true); \
              int t1_ = __builtin_amdgcn_cvt_pk_fp8_f32(y1[0], y1[1], 0, false); t1_ = __builtin_amdgcn_cvt_pk_fp8_f32(y1[2], y1[3], t1_, true); \
              *(int*)(frow + 32 * (S)) = t0_; *(int*)(frow + 32 * (S) + 16) = t1_; } \
            const bf16x8 Ah = __builtin_bit_cast(bf16x8, ah), Al = __builtin_bit_cast(bf16x8, al); \
            _Pragma("unroll") for (int nt = 0; nt < 4; ++nt) { acc[nt] = __builtin_amdgcn_mfma_f32_16x16x32_bf16(Ah, X.Bh[nt], acc[nt], 0, 0, 0); \
                acc[nt] = __builtin_amdgcn_mfma_f32_16x16x32_bf16(Al, X.Bh[nt], acc[nt], 0, 0, 0); acc[nt] = __builtin_amdgcn_mfma_f32_16x16x32_bf16(Ah, X.Bl[nt], acc[nt], 0, 0, 0); } } while (0)
#pragma unroll 1
        for (int s = 0; s < 16; ++s) {
            P5_LOAD(s, A_); __builtin_amdgcn_sched_barrier(0);
            P5_COMP(s, A_); __builtin_amdgcn_sched_barrier(0);
        }
#undef P5_LOAD
#undef P5_COMP
#pragma unroll
        for (int nt = 0; nt < 4; ++nt)
#pragma unroll
            for (int r = 0; r < 4; ++r) part[(w * 16 + 4 * q + r) * 64 + 16 * nt + t] = acc[nt][r];
        __syncthreads();
#ifdef PROBE_P5
        if (PROBE_P5 >= 2 && probe_rep) { __syncthreads(); continue; }
#endif
        const float rb = F.in[13][lane];
#pragma unroll 1
        for (int i = 0; i < 4; ++i) {
            const int tl = w * 4 + i, g2 = tl >> 4, tt = tl & 15;
            float logit = 0.f;
#pragma unroll
            for (int k = 0; k < 4; ++k) logit += part[((g2 * 4 + k) * 16 + tt) * 64 + lane];
            const float sc = 1.0f / (1.0f + expf(-logit));
            const float b = sc + rb;
            float mx = b; mx = fmaxf(mx, __shfl_xor(mx, 1)); mx = fmaxf(mx, __shfl_xor(mx, 2)); mx = fmaxf(mx, __shfl_xor(mx, 4));
            const unsigned long long bal = __ballot(b == mx); const unsigned gm = (unsigned)(bal >> (lane & ~7)) & 0xffu; const int first = __builtin_ctz(gm);
            float b2 = ((lane & 7) == first) ? -INFINITY : b; b2 = fmaxf(b2, __shfl_xor(b2, 1)); b2 = fmaxf(b2, __shfl_xor(b2, 2)); b2 = fmaxf(b2, __shfl_xor(b2, 4));
            const float gs = mx + b2; const int grp = lane >> 3; int gc = 0;
#pragma unroll
            for (int g3 = 0; g3 < 8; ++g3) { const float o = __uint_as_float(__builtin_amdgcn_readlane(__float_as_uint(gs), g3 * 8)); gc += (o > gs || (o == gs && g3 < grp)) ? 1 : 0; }
            const float mk = gc < 4 ? b : -INFINITY; int rank = 0;
#pragma unroll
            for (int j = 0; j < 64; ++j) { const float o = __uint_as_float(__builtin_amdgcn_readlane(__float_as_uint(mk), j)); rank += (o > mk || (o == mk && j < lane)) ? 1 : 0; }
            const bool sel = (gc < 4) && rank < 8;
            const float wsum = wave_sum(sel ? sc : 0.f);
            if (sel) { const int lp = atomicAdd((int*)(cntl + lane), 1); rec_e[tl * 8 + rank] = lane; rec_p[tl * 8 + rank] = lp; rec_w[tl * 8 + rank] = sc / wsum * ROUTED_SCALE; }
        }
        __syncthreads();
#ifdef PROBE_P5
        if (PROBE_P5 == 1 && probe_rep) { __syncthreads(); continue; }
#endif
        if (F.tid < 64) basel[F.tid] = (int)atomicAdd(F.ctl + CW_CNT + F.tid, (unsigned)cntl[F.tid]);
        __syncthreads();
        if (F.tid < 256) { const int tl = F.tid >> 3, e = rec_e[F.tid], pos = basel[e] + rec_p[F.tid]; const int token = blk * 32 + tl;
            ((int*)(F.ws + WS_LTOK))[e * LCAP + pos] = token; ((float*)(F.ws + WS_LW))[e * LCAP + pos] = rec_w[F.tid];
            int* rt = (int*)(F.ws + WS_ROUTE); rt[(token * 8 + (F.tid & 7)) * 2] = e; rt[(token * 8 + (F.tid & 7)) * 2 + 1] = pos; }
        __syncthreads();
    }
}

__device__ __forceinline__ void moe_build_tst(Frame& F) {
    LAS int* tst = (LAS int*)(F.lds + TST_OFF);
    if (F.tid == 0) { int acc = 0; for (int e = 0; e < NEXP1; ++e) { tst[e] = acc; const unsigned c = e < NEXP ? __hip_atomic_load(F.ctl + CW_CNT + e, RLX_AGENT) : (unsigned)SEQ; acc += (int)((c + 255u) >> 8); } tst[NEXP1] = acc; }
    __syncthreads();
}

__device__ __forceinline__ void p9_combine(Frame& F) {
    const LAS int* tst = (const LAS int*)(F.lds + TST_OFF);
    const int gw = F.vcu * NWAVES + F.wave, NGW = F.G * NWAVES; const int lane = F.lane;
    const unsigned char* Y = (const unsigned char*)(F.ws + WS_Y); const bf16* hbf = (const bf16*)(F.ws + WS_HBF); const int* rt = (const int*)(F.ws + WS_ROUTE);
    unsigned rows[9];
#define P9_ROWS(dst, tok_) do { _Pragma("unroll") for (int k = 0; k < 8; ++k) { const int e = rt[((tok_) * 8 + k) * 2], pos = rt[((tok_) * 8 + k) * 2 + 1]; dst[k] = (unsigned)(tst[e] * 256 + pos) * (DM / 8); } \
        dst[8] = (unsigned)(tst[NEXP] * 256 + (tok_)) * (DM / 8); } while (0)
    for (int tok = gw; tok < SEQ; tok += NGW) {
        P9_ROWS(rows, tok);
        float v[4][8]; float s1 = 0.f;
#pragma unroll
        for (int c = 0; c < 4; ++c) { const int col = 512 * c + 8 * lane;
            const v4u hv = __builtin_nontemporal_load((const v4u*)(hbf + (size_t)tok * DM + col));
            const f32x4 a = {pg8::bf_lo(hv.x), pg8::bf_hi(hv.x), pg8::bf_lo(hv.y), pg8::bf_hi(hv.y)}, b = {pg8::bf_lo(hv.z), pg8::bf_hi(hv.z), pg8::bf_lo(hv.w), pg8::bf_hi(hv.w)};
            float r[8] = {0.f, 0.f, 0.f, 0.f, 0.f, 0.f, 0.f, 0.f};
#pragma unroll
            for (int k = 0; k < 9; ++k) { const v2u y = __builtin_nontemporal_load((const v2u*)Y + (size_t)rows[k] + (col >> 3));
                const auto q0 = __builtin_amdgcn_cvt_pk_f32_fp8((int)y.x, false), q1 = __builtin_amdgcn_cvt_pk_f32_fp8((int)y.x, true), q2 = __builtin_amdgcn_cvt_pk_f32_fp8((int)y.y, false), q3 = __builtin_amdgcn_cvt_pk_f32_fp8((int)y.y, true);
                r[0] += q0[0]; r[1] += q0[1]; r[2] += q1[0]; r[3] += q1[1]; r[4] += q2[0]; r[5] += q2[1]; r[6] += q3[0]; r[7] += q3[1]; }
#pragma unroll
            for (int j = 0; j < 4; ++j) { v[c][j] = ALPHA * a[j] + r[j] * (1.0f / YSCALE); v[c][4 + j] = ALPHA * b[j] + r[4 + j] * (1.0f / YSCALE); }
#pragma unroll
            for (int j = 0; j < 8; ++j) s1 += v[c][j]; }
        const float mean = wave_sum(s1) * (1.0f / DM); float s2 = 0.f;
#pragma unroll
        for (int c = 0; c < 4; ++c)
#pragma unroll
            for (int j = 0; j < 8; ++j) { v[c][j] -= mean; s2 += v[c][j] * v[c][j]; }
        const float rstd = 1.0f / sqrtf(wave_sum(s2) * (1.0f / DM) + LN_EPS);
#pragma unroll
        for (int c = 0; c < 4; ++c) { const int col = 512 * c + 8 * lane;
            const f32x4 g0 = *(const f32x4*)(F.in[20] + col), g1 = *(const f32x4*)(F.in[20] + col + 4), b0 = *(const f32x4*)(F.in[21] + col), b1 = *(const f32x4*)(F.in[21] + col + 4);
            f32x4 o0, o1;
#pragma unroll
            for (int j = 0; j < 4; ++j) { o0[j] = v[c][j] * rstd * g0[j] + b0[j]; o1[j] = v[c][4 + j] * rstd * g1[j] + b1[j]; }
            __builtin_nontemporal_store(o0, (f32x4*)(F.out + (size_t)tok * DM + col)); __builtin_nontemporal_store(o1, (f32x4*)(F.out + (size_t)tok * DM + col + 4)); }
    }
#undef P9_ROWS
}

constexpr int NPHASES = 10;
#ifndef MK_ONE_LAUNCH
#define MK_ONE_LAUNCH 1
#endif
__global__ void __launch_bounds__(NWAVES * 64, 2) mega_fwd(Args args) {
    extern __shared__ __attribute__((aligned(16))) unsigned char lds[];
    Frame F;
    F.lds = (LAS unsigned char*)lds;
    F.MISC = (volatile LAS unsigned*)(F.lds + MISC_OFF);
    F.tid = threadIdx.x; F.lane = F.tid & 63; F.wave = __builtin_amdgcn_readfirstlane(F.tid >> 6);
    F.G = gridDim.x; { const int bx = blockIdx.x; F.vcu = (F.G % 8 == 0) ? (bx % 8) * (F.G / 8) + bx / 8 : bx; }
#pragma unroll
    for (int i = 0; i < 22; ++i) F.in[i] = args.in[i];
    F.out = args.out; F.ws = args.ws; F.ctl = (unsigned*)(args.ws + WS_CTL);
    for (int u = F.tid; u < (LDS_BYTES - LDSCTL_OFF) / 4; u += NWAVES * 64) ((LAS unsigned*)(F.lds + LDSCTL_OFF))[u] = 0u;
    __syncthreads();
    XcdBarrier bar; bar.bar = F.ctl + CW_BAR; bar.x = 0; bar.st = nullptr; bar.total = 0; XcdBarrier barB = bar;
    const bool conv1 = (F.G == 256) && (F.vcu & 31) >= P1_NCG;
    if (MK_ONE_LAUNCH) { bar = xcd_barrier_post(F.ctl + CW_BAR, F.MISC + 8, (unsigned)F.G); }
    const int lo = args.ph_lo, hi = args.ph_hi;
#ifndef PH_MASK
#define PH_MASK 0x3ff
#endif
#define IN(k) (((PH_MASK >> (k)) & 1) && lo <= (k) && (k) < hi)
#ifndef REP_MASK
#define REP_MASK 0
#endif
#define REP(k) for (int rep_ = 0; rep_ < 1 + ((REP_MASK >> (k)) & 1); ++rep_)
#ifndef BAR_REP
#define BAR_REP 1
#endif
#define SEAM(k) do { if (IN(k) && IN((k) + 1)) for (int br_ = 0; br_ < BAR_REP; ++br_) xcd_barrier(bar); } while (0)
    LAS int* idxl = (LAS int*)(F.lds + IDXL_OFF);
    const bool tst_needed = true;

    if (IN(0)) REP(0) { p0_prologue(F, false); } SEAM(0);
    if (IN(1)) REP(1) {
        const int grp = F.vcu >> 5, cin = F.vcu & 31;
        const bool conv = (F.G == 256) && cin >= P1_NCG;
        if (conv) { const int cw = (grp * (32 - P1_NCG) + (cin - P1_NCG)) * NWAVES + F.wave; convert_items<1>(F, cw, NCONV1 * NWAVES, E_SPLIT); convert_items<2>(F, cw, NCONV1 * NWAVES, E2_A); }
        else {
            DenseOrder S; if (F.G == 256) S.init(F.ws + WS_XBF, F.ws + WS_WINT, SEQ, INC, DM, NCOMP1, cin * 8 + grp); else S.init(F.ws + WS_XBF, F.ws + WS_WINT, SEQ, INC, DM, F.G, (int)blockIdx.x);
            EpiProj E{(bf16*)(F.ws + WS_PROJ), F.in[2]};
            pg8::gemm_phase<EpiProj, DenseOrder, true, false, P1_FP8 != 0>(F.lds + RING_OFF, idxl, DM, S, E);
        }
    } SEAM(1);
    if (IN(2)) {
        p1b_qknorm(F);
        if (F.G == 256) {
            if (E_SPLIT >= NITEMS_E1 && (CONV_G1 ? E2_SPLIT : E2_A) >= NITEMS_E2) win_attention(F, F.vcu, 256);
            else if (F.vcu & 1) win_attention(F, F.vcu >> 1, 128);
            else { const int cw = (F.vcu >> 1) * NWAVES + F.wave;
                convert_items<1>(F, E_SPLIT + cw, 128 * NWAVES, NITEMS_E1); convert_items<2>(F, (CONV_G1 ? E2_SPLIT : E2_A) + cw, 128 * NWAVES, NITEMS_E2); }
        } else { win_attention(F, F.vcu, F.G); convert_items<1>(F, F.vcu * NWAVES + F.wave, F.G * NWAVES, NITEMS_E1); convert_items<2>(F, F.vcu * NWAVES + F.wave, F.G * NWAVES, NITEMS_E2); }
    } SEAM(2);
    if (IN(3)) REP(3) { p3_dense_attention(F); } SEAM(3);
    if (IN(4)) REP(4) {
        BranchOrder S{(const char*)(F.ws + WS_OA), (const char*)(F.ws + WS_OB), (const char*)(F.ws + WS_WAT), (const char*)(F.ws + WS_WBT), F.vcu};
        EpiBranch E{(const bf16*)(F.ws + WS_PROJ), F.ws + WS_MRG};
        if (F.vcu < 256) pg8::gemm_phase<EpiBranch, BranchOrder, false, false, true>(F.lds + RING_OFF, idxl, 1024, S, E);
    } SEAM(4);
    if (IN(5)) REP(5) {
        OneTileOrder S{(const char*)(F.ws + WS_MRG), (const char*)(F.ws + WS_WOT), F.vcu, (size_t)256 * DM};
        EpiMix E{(bf16*)(F.ws + WS_PRE)};
        if (F.vcu < 256) pg8::gemm_phase<EpiMix, OneTileOrder, false, false, true>(F.lds + RING_OFF, idxl, DM, S, E);
    } SEAM(5);
    if (IN(6)) REP(6) { if (rep_) { xcd_barrier(bar);
#ifndef PROBE_P5
            if (blockIdx.x == 0 && F.tid < 64) __hip_atomic_store(F.ctl + CW_CNT + F.tid, 0u, RLX_AGENT);
#endif
            xcd_barrier(bar); } p5_ln_router(F, rep_ != 0); } SEAM(6);
    if (IN(7) || IN(8) || IN(9)) { if (tst_needed) moe_build_tst(F); }
#ifndef DEFER_MAX
#define DEFER_MAX 64
#endif
    int n_defer = 0, u1_end = -1;
    if (IN(7) || IN(8)) { const int T_ = ((const LAS int*)(F.lds + TST_OFF))[NEXP1]; const int r_ = (4 * T_) % 256;
        if (F.G == 256 && !CONV_G1 && 4 * T_ > 256 && r_ > 0 && r_ <= DEFER_MAX && (lo <= 7 && 8 < hi)) { n_defer = r_; u1_end = 4 * T_ - r_; } }
    if (IN(7)) REP(7) {
        const bool split = CONV_G1 && F.G == 256, conv = split && ((F.vcu & 7) == 7);
        if (conv) { convert_items<2>(F, E2_A + (F.vcu >> 3) * NWAVES + F.wave, NCONV * NWAVES, E2_SPLIT); }
        else {
        MoeOrder<4> S{(const LAS int*)(F.lds + TST_OFF), (const char*)(F.ws + (G1_FP8 ? WS_HF8 : WS_HBF)), (const char*)(F.ws + WS_WGU), (const int*)(F.ws + WS_LTOK), (const float*)(F.ws + WS_LW), split ? F.vcu - (F.vcu >> 3) : F.vcu, split ? NCOMP : F.G, 0, (size_t)1024 * DM * (G1_FP8 ? 1 : 2), (size_t)256 * DM * (G1_FP8 ? 1 : 2), true,
                      0, u1_end, 0, nullptr, 0, 0};
        EpiMoe1 E{F.ws + WS_HID};
        pg8::gemm_phase<EpiMoe1, MoeOrder<4>, true, true, G1_FP8 != 0>(F.lds + RING_OFF, idxl, DM, S, E);
        }
    } SEAM(7);
    if (IN(8)) REP(8) {
        unsigned* dflag = F.ctl + CW_CNT + 128;
        if (n_defer > 0 && F.vcu >= 256 - n_defer) {
            MoeOrder<4> S1{(const LAS int*)(F.lds + TST_OFF), (const char*)(F.ws + (G1_FP8 ? WS_HF8 : WS_HBF)), (const char*)(F.ws + WS_WGU), (const int*)(F.ws + WS_LTOK), (const float*)(F.ws + WS_LW), F.vcu - (256 - n_defer), 256, 0, (size_t)1024 * DM * (G1_FP8 ? 1 : 2), (size_t)256 * DM * (G1_FP8 ? 1 : 2), true,
                           u1_end, u1_end + n_defer, 0, nullptr, 0, 0};
            EpiMoe1 E1{F.ws + WS_HID};
            pg8::gemm_phase<EpiMoe1, MoeOrder<4>, true, true, G1_FP8 != 0>(F.lds + RING_OFF, idxl, DM, S1, E1);
            if (F.tid == 0) { __builtin_amdgcn_fence(__ATOMIC_RELEASE, "agent"); asm volatile("s_waitcnt vmcnt(0)" ::: "memory"); __hip_atomic_fetch_add(dflag, 1u, __ATOMIC_RELAXED, __HIP_MEMORY_SCOPE_AGENT); }
        }
        MoeOrder<8> S{(const LAS int*)(F.lds + TST_OFF), (const char*)(F.ws + WS_HID), (const char*)(F.ws + WS_WD), (const int*)(F.ws + WS_LTOK), (const float*)(F.ws + WS_LW), F.vcu, F.G, (size_t)FE, (size_t)DM * FE, (size_t)256 * FE, false,
                      0, -1, n_defer, dflag, n_defer > 0 ? u1_end / 4 : 0, n_defer};
#ifndef G2_ALIGN
#define G2_ALIGN true
#endif
        EpiMoe2 E{(unsigned char*)(F.ws + WS_Y)};
        pg8::gemm_phase<EpiMoe2, MoeOrder<8>, G2_ALIGN, false, true>(F.lds + RING_OFF, idxl, FE, S, E);
    } SEAM(8);
    if (IN(9)) REP(9) { p9_combine(F); }
#ifdef PROBE_T
    { const LAS int* tst_ = (const LAS int*)(F.lds + TST_OFF); if (tst_[NEXP1] > PROBE_T && blockIdx.x == 0 && F.tid == 0) F.out[0] = __builtin_nanf(""); }
#endif
#undef IN
#undef SEAM
}

extern "C" void kernel_launch(void* const* d_in, const int* in_sizes, int n_in, void* d_out, int out_size, void* d_ws, size_t ws_size, hipStream_t stream) {
    static int grid = 0;
    if (grid == 0) {
        if (n_in != 22 || out_size != SEQ * DM || ws_size < WS_END) { fprintf(stderr, "kernel_launch: unexpected shapes (n_in %d, out %d, ws %zu < %zu); nothing launched\n", n_in, out_size, ws_size, (size_t)WS_END); grid = -1; return; }
        int dev = 0, cus = 0, per_cu = 0;
        if (hipGetDevice(&dev) != hipSuccess || hipDeviceGetAttribute(&cus, hipDeviceAttributeMultiprocessorCount, dev) != hipSuccess) { grid = -1; return; }
        if (hipFuncSetAttribute((const void*)mega_fwd, hipFuncAttributeMaxDynamicSharedMemorySize, LDS_BYTES) != hipSuccess) { fprintf(stderr, "kernel_launch: hipFuncSetAttribute failed\n"); grid = -1; return; }
        if (hipOccupancyMaxActiveBlocksPerMultiprocessor(&per_cu, (const void*)mega_fwd, NWAVES * 64, LDS_BYTES) != hipSuccess || per_cu < 1) { fprintf(stderr, "kernel_launch: occupancy query says %d blocks per CU; nothing launched\n", per_cu); (void)hipGetLastError(); grid = -1; return; }
        grid = cus;
        if (grid > 256) grid = 256;
    }
    if (grid < 0) return;
    (void)hipMemsetAsync((char*)d_ws + WS_CTL, 0, CTL_ZERO_BYTES, stream);
    Args a{};
    for (int i = 0; i < 22; ++i) a.in[i] = (const float*)d_in[i];
    a.out = (float*)d_out; a.ws = (unsigned char*)d_ws;
#if MK_ONE_LAUNCH
    a.ph_lo = 0; a.ph_hi = NPHASES;
    hipLaunchKernelGGL(mega_fwd, dim3(grid), dim3(NWAVES * 64), LDS_BYTES, stream, a);
#else
    for (int p = 0; p < NPHASES; ++p) { a.ph_lo = p; a.ph_hi = p + 1; hipLaunchKernelGGL(mega_fwd, dim3(grid), dim3(NWAVES * 64), LDS_BYTES, stream, a); }
#endif
    const hipError_t le = hipPeekAtLastError();
    if (le != hipSuccess) fprintf(stderr, "kernel_launch: launch failed: %s\n", hipGetErrorName(le));
}
```

```cpp
#define P1_NCG 13
#define CONV_Q 59
#define P1_QE2 28
#define CONV_G1 0
#include <hip/hip_runtime.h>
#include <hip/hip_bf16.h>
#include <cstdio>
#include <cstdint>
#include <cmath>
namespace pg8 {
#define PG8_LAS __attribute__((address_space(3)))
typedef unsigned short bf16_t;
typedef short bf16x8 __attribute__((ext_vector_type(8)));
typedef float f32x4 __attribute__((ext_vector_type(4)));
typedef unsigned u32x4 __attribute__((ext_vector_type(4)));
typedef int v4i_t __attribute__((ext_vector_type(4)));
typedef int v8i_t __attribute__((ext_vector_type(8)));
constexpr int BM = 256, BK = 64, HALF = 128, HTB = HALF * BK * 2  , STAGE_BYTES = 8 * HTB;

__host__ __device__ __forceinline__ int lds_byte(int r, int c) { const int st = (r >> 4) * 2 + (c >> 5), rr = r & 15, cc = c & 31, ob = rr * 64 + cc * 2; return st * 1024 + (ob ^ (((ob >> 9) & 1) << 5)); }
__host__ __device__ __forceinline__ void stage_rc(int b, int& R, int& C) { const int st = b / 1024, sb = b % 1024, swz = sb ^ (((sb >> 9) & 1) << 5); R = (st >> 1) * 16 + swz / 64; C = (st & 1) * 32 + (swz % 64) / 2; }
__host__ __device__ __forceinline__ int perm32(int rho) { const int n = rho >> 4, i = rho & 15; return 8 * (i >> 2) + 4 * n + (i & 3); }

struct Unit { const char* A; const char* B; const int* idx; const float* wts; int r0, c0, aux, kind; };

typedef float f32x2_t __attribute__((ext_vector_type(2))); typedef __bf16 bf16x2_t __attribute__((ext_vector_type(2)));
__device__ __forceinline__ unsigned cvt_pk_bf16(float lo, float hi) { f32x2_t v = {lo, hi}; bf16x2_t b = __builtin_convertvector(v, bf16x2_t); return __builtin_bit_cast(unsigned, b); }
__device__ __forceinline__ float bf_lo(unsigned w) { return __uint_as_float(w << 16); }
__device__ __forceinline__ float bf_hi(unsigned w) { return __uint_as_float(w & 0xffff0000u); }

template <class Epi, class Sched, bool ALIGN_EPI, bool GATHER, bool FP8 = false>
__device__ __forceinline__ void gemm_phase(PG8_LAS unsigned char* lds, PG8_LAS int* idxl, const int K, const Sched& S, const Epi& E) {
    PG8_LAS float* wl = (PG8_LAS float*)(idxl + 256);
    const int tid = threadIdx.x, wid = __builtin_amdgcn_readfirstlane(tid >> 6), lane = tid & 63, wr = wid >> 2, wc = wid & 3, fr = lane & 15, fq = lane >> 4;
    const int KB = FP8 ? K : 2 * K;
    const int nt = KB / 128;
    const size_t kstep = (size_t)(BK * 2);
    const size_t hstep = (size_t)HALF * KB;
    unsigned voffA0[2], voffA1[2], voffB[2];
#pragma unroll
    for (int i = 0; i < 2; ++i) { int R, C; stage_rc(tid * 16 + i * 8192, R, C); const int Rb = Epi::PERM ? ((R & ~31) + perm32(R & 31)) : R;
        voffA0[i] = (unsigned)(R * KB + C * 2); voffA1[i] = voffA0[i] + (unsigned)hstep; voffB[i] = (unsigned)(Rb * KB + C * 2); }
    const unsigned ldsw = (unsigned)wid * 1024u;
    const int aoff = FP8 ? lds_byte(wr * 64 + fr, (fq >> 1) * 32 + (fq & 1) * 16) : lds_byte(wr * 64 + fr, fq * 8), boff = FP8 ? lds_byte(wc * 32 + fr, (fq >> 1) * 32 + (fq & 1) * 16) : lds_byte(wc * 32 + fr, fq * 8);
#define PG8_SA(b, h) (((b) * 2 + (h)) * HTB)
#define PG8_SB(b, h) ((4 + (b) * 2 + (h)) * HTB)
#define PG8_STAGE(bufoff, gbase, voff) do { _Pragma("unroll") for (int _i = 0; _i < 2; ++_i) \
        __builtin_amdgcn_global_load_lds((const unsigned*)((const char*)(gbase) + (voff)[_i]), (PG8_LAS unsigned*)(lds + (bufoff) + ldsw + _i * 8192), 16, 0, 0); } while (0)
#define PG8_LD8(addr) __builtin_shufflevector(*(const PG8_LAS v4i_t*)(addr), *(const PG8_LAS v4i_t*)((addr) + 16), 0, 1, 2, 3, 4, 5, 6, 7)
#define PG8_LDA(dst, b, h) do { if constexpr (FP8) { _Pragma("unroll") for (int m = 0; m < 4; ++m) dst##8[m] = PG8_LD8(lds + PG8_SA(b, h) + aoff + m * 2048); } \
        else { _Pragma("unroll") for (int m = 0; m < 4; ++m) _Pragma("unroll") for (int k = 0; k < 2; ++k) dst[m][k] = *(const PG8_LAS bf16x8*)(lds + PG8_SA(b, h) + aoff + m * 2048 + k * 1024); } } while (0)
#define PG8_LDB(dst, b, h) do { if constexpr (FP8) { _Pragma("unroll") for (int n = 0; n < 2; ++n) dst##8[n] = PG8_LD8(lds + PG8_SB(b, h) + boff + n * 2048); } \
        else { _Pragma("unroll") for (int n = 0; n < 2; ++n) _Pragma("unroll") for (int k = 0; k < 2; ++k) dst[n][k] = *(const PG8_LAS bf16x8*)(lds + PG8_SB(b, h) + boff + n * 2048 + k * 1024); } } while (0)
#define PG8_MMA(ai, bj, At, Bt) do { __builtin_amdgcn_s_setprio(1); _Pragma("unroll") for (int m = 0; m < 4; ++m) _Pragma("unroll") for (int n = 0; n < 2; ++n) { \
        if constexpr (FP8) asm volatile("v_mfma_scale_f32_16x16x128_f8f6f4 %0, %1, %2, %0, %3, %3 op_sel_hi:[0,0,0]" : "+v"(acc[ai][bj][m][n]) : "v"(Bt##8[n]), "v"(At##8[m]), "v"(one_scale)); \
        else { _Pragma("unroll") for (int k = 0; k < 2; ++k) acc[ai][bj][m][n] = __builtin_amdgcn_mfma_f32_16x16x32_bf16(Bt[n][k], At[m][k], acc[ai][bj][m][n], 0, 0, 0); } } __builtin_amdgcn_s_setprio(0); } while (0)
#define PG8_WAIT_V(n) asm volatile("s_waitcnt vmcnt(" #n ")" ::: "memory")
#define PG8_WAIT_L(n) asm volatile("s_waitcnt lgkmcnt(" #n ")" ::: "memory")
#define PG8_WAIT_VN(n) asm volatile("s_waitcnt vmcnt(%0)" :: "n"(n) : "memory")
#define PG8_WAIT_VR(sel) do { if constexpr (Epi::NST > 0) { int _sg; asm volatile("v_readfirstlane_b32 %0, %1\n\ts_nop 0\n\ts_cmp_lg_u32 %0, 0\n\ts_cbranch_scc1 1f\n\ts_waitcnt vmcnt(8)\n\ts_branch 2f\n1:\n\ts_waitcnt vmcnt(%2)\n2:" \
            : "=&s"(_sg) : "v"(sel), "n"(8 + Epi::NST) : "memory", "scc"); } \
        else asm volatile("s_waitcnt vmcnt(8)" ::: "memory"); } while (0)
#define PG8_BAR __builtin_amdgcn_s_barrier()
#define PG8_SCHED __builtin_amdgcn_sched_barrier(0)
#define PG8_GOFF(src) do { _Pragma("unroll") for (int _i = 0; _i < 2; ++_i) { int R_, C_; stage_rc(tid * 16 + _i * 8192, R_, C_); \
        voffA0[_i] = (unsigned)((src)[R_] * KB + C_ * 2); voffA1[_i] = (unsigned)((src)[R_ + HALF] * KB + C_ * 2); } } while (0)
    Unit cur, nxt; int ui = 0;
    if (!S.next(0, cur)) return;
    f32x4 acc[2][2][4][2];
#pragma unroll
    for (int a = 0; a < 2; ++a)
#pragma unroll
        for (int b = 0; b < 2; ++b)
#pragma unroll
            for (int m = 0; m < 4; ++m)
#pragma unroll
                for (int n = 0; n < 2; ++n) acc[a][b][m][n] = (f32x4){0.f, 0.f, 0.f, 0.f};
    bf16x8 At[4][2], B0[2][2], B1[2][2];
    v8i_t At8[4], B08[2], B18[2];
    int one_scale = 0x7f7f7f7f; asm volatile("" : "+v"(one_scale));
    const char* cA = cur.A; const char* cB = cur.B;
    if constexpr (GATHER) { PG8_GOFF(cur.idx); if (tid >= 256) wl[tid - 256] = cur.wts[tid - 256]; }
    PG8_STAGE(PG8_SB(0, 0), cB, voffB); PG8_STAGE(PG8_SB(0, 1), cB + hstep, voffB); PG8_STAGE(PG8_SA(0, 0), cA, voffA0); PG8_STAGE(PG8_SA(0, 1), cA, voffA1);
    if (wr == 1) PG8_BAR;
    PG8_WAIT_V(2); PG8_BAR;
    PG8_STAGE(PG8_SB(1, 0), cB + kstep, voffB); PG8_STAGE(PG8_SA(1, 0), cA + kstep, voffA0); PG8_STAGE(PG8_SB(1, 1), cB + hstep + kstep, voffB);
    PG8_WAIT_V(6); PG8_BAR;
    for (;;) {
        const bool has_next = S.next(ui + 1, nxt);
        const char* nA = has_next ? nxt.A : cA; const char* nB = has_next ? nxt.B : cB;
        if constexpr (GATHER) { if (has_next && tid < 256) {
            __builtin_amdgcn_global_load_lds((const unsigned*)(nxt.idx + tid), (PG8_LAS unsigned*)((PG8_LAS unsigned char*)idxl + wid * 256), 4, 0, 0); }
          if (has_next && tid >= 256) {
            __builtin_amdgcn_global_load_lds((const unsigned*)(nxt.wts + (tid - 256)), (PG8_LAS unsigned*)((PG8_LAS unsigned char*)(wl + ((ui + 1) & 1) * 256) + (wid - 4) * 256), 4, 0, 0); } }
#pragma unroll 1
        for (int t = 0; t < nt; t += 2) {
            const bool last = (t == nt - 2);
            const char* a1 = cA + (size_t)(t + 1) * kstep;
            const char* a2 = last ? nA : cA + (size_t)(t + 2) * kstep; const char* b2 = last ? nB : cB + (size_t)(t + 2) * kstep;
            const char* a3 = a2 + kstep; const char* b3 = b2 + kstep;
            const int rlx = (t == 0 && ui > 0) ? 1 : 0;
            PG8_LDB(B0, 0, 0); PG8_LDB(B1, 0, 1); PG8_SCHED; PG8_LDA(At, 0, 0); PG8_STAGE(PG8_SA(1, 1), a1, voffA1);
            if constexpr (GATHER) { if (last && has_next) { PG8_GOFF(idxl); } }
            PG8_WAIT_VR(rlx); PG8_WAIT_L(0); PG8_BAR; PG8_MMA(0, 0, At, B0); PG8_MMA(0, 1, At, B1); PG8_BAR; PG8_SCHED;
            PG8_LDA(At, 0, 1); PG8_STAGE(PG8_SB(0, 0), b2, voffB); PG8_STAGE(PG8_SB(0, 1), b2 + hstep, voffB); PG8_STAGE(PG8_SA(0, 0), a2, voffA0);
            PG8_WAIT_VR(rlx); PG8_WAIT_L(0); PG8_BAR; PG8_MMA(1, 0, At, B0); PG8_MMA(1, 1, At, B1); PG8_BAR; PG8_SCHED;
            PG8_LDB(B0, 1, 0); PG8_LDB(B1, 1, 1); PG8_SCHED; PG8_LDA(At, 1, 0); PG8_STAGE(PG8_SA(0, 1), a2, voffA1);
            PG8_WAIT_V(8); PG8_WAIT_L(0); PG8_BAR; PG8_MMA(0, 0, At, B0); PG8_MMA(0, 1, At, B1); PG8_BAR; PG8_SCHED;
            PG8_LDA(At, 1, 1); PG8_STAGE(PG8_SB(1, 0), b3, voffB); PG8_STAGE(PG8_SB(1, 1), b3 + hstep, voffB); PG8_STAGE(PG8_SA(1, 0), a3, voffA0);
            PG8_WAIT_V(8); PG8_WAIT_L(0); PG8_BAR; PG8_MMA(1, 0, At, B0); PG8_MMA(1, 1, At, B1); PG8_BAR; PG8_SCHED;
        }
        if constexpr (ALIGN_EPI) { if (wr == 0) PG8_BAR; }
        if constexpr (FP8) asm volatile("s_nop 15\n\ts_nop 15" ::: "memory");
        const bool keep = E(acc, cur, wr, wc, fr, fq, wl + (ui & 1) * 256);
        if (!has_next) break;
        if (!keep) {
#pragma unroll
        for (int a = 0; a < 2; ++a)
#pragma unroll
            for (int b = 0; b < 2; ++b)
#pragma unroll
                for (int m = 0; m < 4; ++m)
#pragma unroll
                    for (int n = 0; n < 2; ++n) acc[a][b][m][n] = (f32x4){0.f, 0.f, 0.f, 0.f};
        }
        cur = nxt; cA = nA; cB = nB; ++ui;
        if constexpr (ALIGN_EPI) { if (wr == 1) PG8_BAR; }
    }
    PG8_WAIT_V(0);
    if constexpr (!ALIGN_EPI) { if (wr == 0) PG8_BAR; }
    PG8_BAR;
#undef PG8_SA
#undef PG8_SB
#undef PG8_STAGE
#undef PG8_LDA
#undef PG8_LDB
#undef PG8_MMA
#undef PG8_LD8
#undef PG8_WAIT_V
#undef PG8_WAIT_L
#undef PG8_WAIT_VN
#undef PG8_WAIT_VR
#undef PG8_BAR
#undef PG8_SCHED
#undef PG8_GOFF
}
}
namespace attn {
using bf16 = __hip_bfloat16;
constexpr int   D = 128, NW = 8, QBLK = 32, KVBLK = 64;
constexpr float SCALE = 0.088388347648318440f;
constexpr float THR = 8.f;
constexpr float LOG2E = 1.4426950408889634f;
#ifndef PROJ_PAD
#define PROJ_PAD 64
#endif
constexpr int LDQ = 7168 + PROJ_PAD, LDK = 7168 + PROJ_PAD, LDO = 1024;
constexpr size_t SHM_V = KVBLK * D * 2, SHM_K = KVBLK * D * 2, SHM_ATTN = 2 * SHM_V + 2 * SHM_K + NW * 64 * 4;
constexpr int WIN_TAB = (int)SHM_ATTN;

using bf16x8 = __attribute__((ext_vector_type(8))) short;
using s16x4  = __attribute__((ext_vector_type(4))) short;
using f32x16 = __attribute__((ext_vector_type(16))) float;
using u32x4  = __attribute__((ext_vector_type(4))) unsigned;
using f32x4_a = __attribute__((ext_vector_type(4))) float;
#define KSWZ(row, colB) ((row) * 256 + ((colB) ^ (((row) & 7) << 4)))
#define SBAR() __builtin_amdgcn_sched_barrier(0)
__device__ __forceinline__ int crow(int r, int hi) { return (r & 3) + 8 * (r >> 2) + 4 * hi; }
__device__ __forceinline__ unsigned cvtpk(float lo, float hi) { return pg8::cvt_pk_bf16(lo, hi); }
template <bool FIXM>
__device__ __forceinline__ void partialSM(f32x16& p0, f32x16& p1, float& m_reg, float& mn, float& alpha) {
  constexpr float C = SCALE * LOG2E;
  if constexpr (FIXM) {
    mn = m_reg; alpha = 1.f; const float mnC = -m_reg * C;
    for (int r = 0; r < 16; ++r) p0[r] = fmaf(p0[r], C, mnC); for (int r = 0; r < 16; ++r) p1[r] = fmaf(p1[r], C, mnC);
    for (int r = 0; r < 16; ++r) p0[r] = __builtin_amdgcn_exp2f(p0[r]);
    return;
  }
  float pmax = p0[0]; for (int r = 1; r < 16; ++r) pmax = fmaxf(pmax, p0[r]); for (int r = 0; r < 16; ++r) pmax = fmaxf(pmax, p1[r]);
  { auto rr = __builtin_amdgcn_permlane32_swap(__float_as_uint(pmax), __float_as_uint(pmax), false, false);
    pmax = fmaxf(__uint_as_float(rr[0]), __uint_as_float(rr[1])); }
  if (__builtin_expect(__all(pmax - m_reg <= THR / SCALE), 1)) { mn = m_reg; alpha = 1.f; }
  else { mn = fmaxf(m_reg, pmax); alpha = __builtin_amdgcn_exp2f((m_reg - mn) * C); m_reg = mn; }
  float mnC = -mn * C;
  for (int r = 0; r < 16; ++r) p0[r] = fmaf(p0[r], C, mnC); for (int r = 0; r < 16; ++r) p1[r] = fmaf(p1[r], C, mnC);
  for (int r = 0; r < 16; ++r) p0[r] = __builtin_amdgcn_exp2f(p0[r]);
}
__device__ __forceinline__ void finishSM(f32x16& p0, f32x16& p1, float alpha, float& l_reg, bf16x8& pa0, bf16x8& pa1, bf16x8& pa2, bf16x8& pa3) {
  for (int r = 0; r < 16; ++r) p1[r] = __builtin_amdgcn_exp2f(p1[r]);
  float ps = 0; for (int r = 0; r < 16; ++r) ps += p0[r]; for (int r = 0; r < 16; ++r) ps += p1[r];
  { auto rr = __builtin_amdgcn_permlane32_swap(__float_as_uint(ps), __float_as_uint(ps), false, false);
    ps = __uint_as_float(rr[0]) + __uint_as_float(rr[1]); }
  l_reg = l_reg * alpha + ps;
#define PK4(P, BASE, OUT) do { unsigned a0 = cvtpk(P[BASE + 0], P[BASE + 1]), a1 = cvtpk(P[BASE + 2], P[BASE + 3]);   \
    unsigned b0 = cvtpk(P[BASE + 4], P[BASE + 5]), b1 = cvtpk(P[BASE + 6], P[BASE + 7]);                              \
    auto r0 = __builtin_amdgcn_permlane32_swap(a0, b0, false, false); auto r1 = __builtin_amdgcn_permlane32_swap(a1, b1, false, false); \
    u32x4 w = {r0[0], r1[0], r0[1], r1[1]}; OUT = *reinterpret_cast<bf16x8*>(&w); } while (0)
  PK4(p0, 0, pa0); PK4(p0, 8, pa1); PK4(p1, 0, pa2); PK4(p1, 8, pa3);
#undef PK4
}
#define KSWZ8(row, colB) ((row) * 128 + ((colB) ^ (((row) & 7) << 4)))
typedef int v8i_a __attribute__((ext_vector_type(8))); typedef int v4i_a __attribute__((ext_vector_type(4)));
template <bool WIN, bool F8>
__device__ __forceinline__ void qkt(f32x16& p0, f32x16& p1, const bf16* Ks, const bf16x8* qr, const v8i_a* q8, int r32, int hi, const __attribute__((address_space(3))) float* tb) {
  if constexpr (F8) {
    p0 = f32x16{}; p1 = f32x16{}; int one = 0x7f7f7f7f; asm volatile("" : "+v"(one));
#pragma unroll
    for (int s = 0; s < 2; ++s) { const int cb = 64 * s + 32 * hi;
      const char* ka = (const char*)Ks + KSWZ8(r32, cb); const char* kb = (const char*)Ks + KSWZ8(32 + r32, cb);
      const v8i_a k0 = __builtin_shufflevector(*reinterpret_cast<const v4i_a*>(ka), *reinterpret_cast<const v4i_a*>((const char*)Ks + KSWZ8(r32, cb + 16)), 0, 1, 2, 3, 4, 5, 6, 7);
      const v8i_a k1 = __builtin_shufflevector(*reinterpret_cast<const v4i_a*>(kb), *reinterpret_cast<const v4i_a*>((const char*)Ks + KSWZ8(32 + r32, cb + 16)), 0, 1, 2, 3, 4, 5, 6, 7);
      asm volatile("s_nop 1\n\tv_mfma_scale_f32_32x32x64_f8f6f4 %0, %1, %2, %0, %3, %3 op_sel_hi:[0,0,0]" : "+v"(p0) : "v"(k0), "v"(q8[s]), "v"(one));
      asm volatile("v_mfma_scale_f32_32x32x64_f8f6f4 %0, %1, %2, %0, %3, %3 op_sel_hi:[0,0,0]" : "+v"(p1) : "v"(k1), "v"(q8[s]), "v"(one)); }
    asm volatile("s_nop 15\n\ts_nop 15" : "+v"(p0), "+v"(p1));
    return;
  }
  if constexpr (WIN) {
#pragma unroll
    for (int r = 0; r < 16; ++r) { p0[r] = tb[(r & 3) + 8 * (r >> 2)]; p1[r] = tb[32 + (r & 3) + 8 * (r >> 2)]; }
  } else { p0 = f32x16{}; p1 = f32x16{}; }
  for (int d0 = 0; d0 < 8; ++d0) { int cb = (d0 * 16 + hi * 8) * 2;
    bf16x8 b0 = *reinterpret_cast<const bf16x8*>((const char*)Ks + KSWZ(r32, cb));
    bf16x8 b1 = *reinterpret_cast<const bf16x8*>((const char*)Ks + KSWZ(32 + r32, cb));
    p0 = __builtin_amdgcn_mfma_f32_32x32x16_bf16(b0, qr[d0], p0, 0, 0, 0);
    p1 = __builtin_amdgcn_mfma_f32_32x32x16_bf16(b1, qr[d0], p1, 0, 0, 0); }
}
__device__ __forceinline__ int v_st(int k, int c) { const int kk = (k & ~0xC) | ((k & 4) << 1) | ((k & 8) >> 1); return ((kk >> 3) * 4 + (c >> 5)) * 512 + ((kk & 7) * 32 + (c & 31)) * 2; }
__device__ __forceinline__ int v_rd_base(int lane) { return ((lane & 3) << 3) | (((lane >> 2) & 3) << 6) | (((lane >> 4) & 1) << 5) | (((lane >> 5) & 1) << 8); }
constexpr int v_rd_off(int d0, int ks, int half) { return d0 * 512 + ks * 4096 + half * 2048; }
template <int OFF> __device__ __forceinline__ s16x4 tr_read(int vb) {
  s16x4 r; asm volatile("ds_read_b64_tr_b16 %0, %1 offset:%2" : "=&v"(r) : "v"(vb), "i"(OFF) : "memory"); return r;
}
template <int D0> __device__ __forceinline__ void pv_one(f32x16& od, int vb, bf16x8 pa0, bf16x8 pa1, bf16x8 pa2, bf16x8 pa3) {
  const s16x4 l0 = tr_read<v_rd_off(D0, 0, 0)>(vb), h0 = tr_read<v_rd_off(D0, 0, 1)>(vb), l1 = tr_read<v_rd_off(D0, 1, 0)>(vb), h1 = tr_read<v_rd_off(D0, 1, 1)>(vb);
  const s16x4 l2 = tr_read<v_rd_off(D0, 2, 0)>(vb), h2 = tr_read<v_rd_off(D0, 2, 1)>(vb), l3 = tr_read<v_rd_off(D0, 3, 0)>(vb), h3 = tr_read<v_rd_off(D0, 3, 1)>(vb);
  asm volatile("s_waitcnt lgkmcnt(0)" ::: "memory"); SBAR();
#define PK(L, H) (bf16x8){L[0], L[1], L[2], L[3], H[0], H[1], H[2], H[3]}
  od = __builtin_amdgcn_mfma_f32_32x32x16_bf16(pa0, PK(l0, h0), od, 0, 0, 0);
  od = __builtin_amdgcn_mfma_f32_32x32x16_bf16(pa1, PK(l1, h1), od, 0, 0, 0);
  od = __builtin_amdgcn_mfma_f32_32x32x16_bf16(pa2, PK(l2, h2), od, 0, 0, 0);
  od = __builtin_amdgcn_mfma_f32_32x32x16_bf16(pa3, PK(l3, h3), od, 0, 0, 0);
#undef PK
}
__device__ __forceinline__ void pv_d0(f32x16* o, int vb, bf16x8 pa0, bf16x8 pa1, bf16x8 pa2, bf16x8 pa3) {
  pv_one<0>(o[0], vb, pa0, pa1, pa2, pa3); pv_one<1>(o[1], vb, pa0, pa1, pa2, pa3); pv_one<2>(o[2], vb, pa0, pa1, pa2, pa3); pv_one<3>(o[3], vb, pa0, pa1, pa2, pa3);
}

template <bool WIN, int SDEPTH, bool F8, bool FIXM, bool QN = false>
__device__ __forceinline__ void attn_body(const bf16* __restrict__ Qb, const bf16* __restrict__ Kh, const unsigned char* __restrict__ Kh8, const bf16* __restrict__ Vh,
                                          unsigned char* __restrict__ Ob, float oscale, int seq, char* lds, const __attribute__((address_space(3))) float* tab, int relbase, float m0, float l0,
                                          const float* __restrict__ gq = nullptr, int qpos0 = 0) {
  int tid_ = threadIdx.x; asm volatile("" : "+v"(tid_));
  const int tid = tid_, wid = tid >> 6, lane = tid & 63, r32 = lane & 31, hi = lane >> 5;
  bf16* V_lds = (bf16*)lds; bf16* K_lds = (bf16*)(lds + 2 * SHM_V);
  float* ws = (float*)(lds + 2 * SHM_V + 2 * SHM_K) + wid * 64; float* li_l = ws; float* al_l = ws + 32;
  float m_reg = m0, l_reg = l0; f32x16 o[4] = {}; bf16x8 qr[8];
  const bf16* Qw = Qb + (long)(wid * QBLK + r32) * LDQ + hi * 8;
  v8i_a q8[2];
  if constexpr (F8 && QN) {
    const bf16* Qr = Qb + (long)(wid * QBLK + r32) * LDQ + hi * 16;
    float x[2][2][16];
#pragma unroll
    for (int s = 0; s < 2; ++s)
#pragma unroll
      for (int pt = 0; pt < 2; ++pt)
#pragma unroll
        for (int c = 0; c < 2; ++c) { const u32x4 v = *reinterpret_cast<const u32x4*>(Qr + 64 * s + 32 * pt + 8 * c);
          x[s][pt][8 * c + 0] = __uint_as_float(v.x << 16); x[s][pt][8 * c + 1] = __uint_as_float(v.x & 0xffff0000u); x[s][pt][8 * c + 2] = __uint_as_float(v.y << 16); x[s][pt][8 * c + 3] = __uint_as_float(v.y & 0xffff0000u);
          x[s][pt][8 * c + 4] = __uint_as_float(v.z << 16); x[s][pt][8 * c + 5] = __uint_as_float(v.z & 0xffff0000u); x[s][pt][8 * c + 6] = __uint_as_float(v.w << 16); x[s][pt][8 * c + 7] = __uint_as_float(v.w & 0xffff0000u); }
    float ss = 0.f;
#pragma unroll
    for (int s = 0; s < 2; ++s)
#pragma unroll
      for (int pt = 0; pt < 2; ++pt)
#pragma unroll
        for (int t = 0; t < 16; ++t) ss = fmaf(x[s][pt][t], x[s][pt][t], ss);
    { auto rr = __builtin_amdgcn_permlane32_swap(__float_as_uint(ss), __float_as_uint(ss), false, false); ss = __uint_as_float(rr[0]) + __uint_as_float(rr[1]); }
    const float rs = 1.0f / sqrtf(ss * (1.0f / D) + 1e-6f);
    const int tok = qpos0 + wid * QBLK + r32;
#pragma unroll
    for (int s = 0; s < 2; ++s) { int w[8]; const float pos = (float)(s == 0 ? (tok >> 6) : (tok & 63)); float o1[16], o2[16];
#pragma unroll
      for (int t4 = 0; t4 < 4; ++t4) { const f32x4_a g1 = *reinterpret_cast<const f32x4_a*>(gq + 64 * s + 16 * hi + 4 * t4), g2 = *reinterpret_cast<const f32x4_a*>(gq + 64 * s + 32 + 16 * hi + 4 * t4);
#pragma unroll
        for (int u = 0; u < 4; ++u) { const int t = 4 * t4 + u; const float inv = __builtin_amdgcn_exp2f(-(float)(2 * (16 * hi + t)) * (1.0f / 64.0f) * 13.287712379549449f);
          const float rev = pos * inv * 0.15915494309189535f, fr = rev - floorf(rev); const float sn = __builtin_amdgcn_sinf(fr), cs = __builtin_amdgcn_cosf(fr);
          const float a = x[s][0][t] * rs * g1[u], b = x[s][1][t] * rs * g2[u]; o1[t] = a * cs - b * sn; o2[t] = b * cs + a * sn; } }
#pragma unroll
      for (int c = 0; c < 4; ++c) { int t = __builtin_amdgcn_cvt_pk_fp8_f32(o1[4 * c], o1[4 * c + 1], 0, false); t = __builtin_amdgcn_cvt_pk_fp8_f32(o1[4 * c + 2], o1[4 * c + 3], t, true); w[c] = t;
        t = __builtin_amdgcn_cvt_pk_fp8_f32(o2[4 * c], o2[4 * c + 1], 0, false); t = __builtin_amdgcn_cvt_pk_fp8_f32(o2[4 * c + 2], o2[4 * c + 3], t, true); w[4 + c] = t; }
      q8[s] = (v8i_a){w[0], w[1], w[2], w[3], w[4], w[5], w[6], w[7]}; }
  } else if constexpr (F8) {
    const bf16* Qr = Qb + (long)(wid * QBLK + r32) * LDQ + hi * 32;
#pragma unroll
    for (int s = 0; s < 2; ++s) { int w[8];
#pragma unroll
      for (int c = 0; c < 4; ++c) { const u32x4 v = *reinterpret_cast<const u32x4*>(Qr + 64 * s + 8 * c);
        int t = __builtin_amdgcn_cvt_pk_fp8_f32(__uint_as_float(v.x << 16), __uint_as_float(v.x & 0xffff0000u), 0, false); t = __builtin_amdgcn_cvt_pk_fp8_f32(__uint_as_float(v.y << 16), __uint_as_float(v.y & 0xffff0000u), t, true); w[2 * c] = t;
        t = __builtin_amdgcn_cvt_pk_fp8_f32(__uint_as_float(v.z << 16), __uint_as_float(v.z & 0xffff0000u), 0, false); t = __builtin_amdgcn_cvt_pk_fp8_f32(__uint_as_float(v.w << 16), __uint_as_float(v.w & 0xffff0000u), t, true); w[2 * c + 1] = t; }
      q8[s] = (v8i_a){w[0], w[1], w[2], w[3], w[4], w[5], w[6], w[7]}; }
  } else {
#pragma unroll
    for (int d0 = 0; d0 < 8; ++d0) qr[d0] = *reinterpret_cast<const bf16x8*>(Qw + d0 * 16);
  }
  const int sr = tid >> 4, sc = (tid & 15) * 8, vst0 = v_st(sr, sc), vst1 = v_st(32 + sr, sc);
  const int vb0 = (int)(uintptr_t)V_lds + v_rd_base(lane);
  const __attribute__((address_space(3))) float* tb0 = tab + (relbase - (wid * QBLK + r32) + 512 + 4 * hi);
  struct { bf16x8 vs0, vs1, ks0, ks1; } sr_[SDEPTH];
#define SLOAD(i, k0) do { sr_[i].vs0 = *reinterpret_cast<const bf16x8*>(&Vh[(long)((k0) + sr) * LDK + sc]); sr_[i].vs1 = *reinterpret_cast<const bf16x8*>(&Vh[(long)((k0) + 32 + sr) * LDK + sc]); \
    if constexpr (F8) { sr_[i].ks0 = *reinterpret_cast<const bf16x8*>(&Kh8[(long)((k0) + (tid >> 3)) * 256 + (tid & 7) * 16]); } \
    else { sr_[i].ks0 = *reinterpret_cast<const bf16x8*>(&Kh[(long)((k0) + sr) * LDK + sc]); sr_[i].ks1 = *reinterpret_cast<const bf16x8*>(&Kh[(long)((k0) + 32 + sr) * LDK + sc]); } } while (0)
#define SWRITE(b, i) do { *(bf16x8*)((char*)V_lds + (b) * SHM_V + vst0) = sr_[i].vs0;          \
    *(bf16x8*)((char*)V_lds + (b) * SHM_V + vst1) = sr_[i].vs1; int kc = sc * 2;               \
    if constexpr (F8) { *(bf16x8*)((char*)K_lds + (b) * SHM_K + KSWZ8(tid >> 3, (tid & 7) * 16)) = sr_[i].ks0; } \
    else { *(bf16x8*)((char*)K_lds + (b) * SHM_K + KSWZ(sr, kc)) = sr_[i].ks0;                       \
    *(bf16x8*)((char*)K_lds + (b) * SHM_K + KSWZ(32 + sr, kc)) = sr_[i].ks1; } } while (0)
#define SWAIT() do { if constexpr (SDEPTH == 2) asm volatile("s_waitcnt vmcnt(4)" ::: "memory"); else asm volatile("s_waitcnt vmcnt(0)" ::: "memory"); } while (0)
#define RESC(a) do { if (!FIXM && __any((a) < 1.f)) { if (hi == 0) al_l[r32] = (a); asm volatile("s_waitcnt lgkmcnt(0)" ::: "memory"); \
    for (int d = 0; d < 4; ++d) for (int r = 0; r < 16; ++r) o[d][r] *= al_l[crow(r, hi)]; } } while (0)
  f32x16 pA0, pA1, pB0, pB1; float mnA, mnB, alA, alB; bf16x8 pa0, pa1, pa2, pa3; const int NT = seq / KVBLK;
  constexpr int SE = 0, SO = SDEPTH - 1;
  SLOAD(SE, 0); asm volatile("s_waitcnt vmcnt(0)" ::: "memory"); SWRITE(0, SE); __syncthreads();
  qkt<WIN, F8>(pA0, pA1, K_lds, qr, q8, r32, hi, tb0); partialSM<FIXM>(pA0, pA1, m_reg, mnA, alA);
  SLOAD(SO, KVBLK); if constexpr (SDEPTH == 2) { if (2 < NT) SLOAD(SE, 2 * KVBLK); }
  SWAIT(); SWRITE(1, SO); __syncthreads();
  for (int j = 1; j + 1 < NT; j += 2) {
    SBAR(); qkt<WIN, F8>(pB0, pB1, (bf16*)((char*)K_lds + SHM_K), qr, q8, r32, hi, tb0 + 64 * j);
    finishSM(pA0, pA1, alA, l_reg, pa0, pa1, pa2, pa3); SBAR();
    SLOAD(SO, (j + SDEPTH) * KVBLK); SBAR();
    pv_d0(o, vb0, pa0, pa1, pa2, pa3); partialSM<FIXM>(pB0, pB1, m_reg, mnB, alB);
    __syncthreads(); SWAIT(); SWRITE(0, SE);
    RESC(alB); __syncthreads();
    SBAR(); qkt<WIN, F8>(pA0, pA1, K_lds, qr, q8, r32, hi, tb0 + 64 * (j + 1));
    finishSM(pB0, pB1, alB, l_reg, pa0, pa1, pa2, pa3); SBAR();
    if (SDEPTH == 1 || j + 3 < NT) SLOAD(SE, (j + 1 + SDEPTH) * KVBLK); SBAR();
    pv_d0(o, vb0 + (int)SHM_V, pa0, pa1, pa2, pa3); partialSM<FIXM>(pA0, pA1, m_reg, mnA, alA);
    __syncthreads(); SWAIT(); SWRITE(1, SO);
    RESC(alA); __syncthreads();
  }
  SBAR(); qkt<WIN, F8>(pB0, pB1, (bf16*)((char*)K_lds + SHM_K), qr, q8, r32, hi, tb0 + 64 * (NT - 1));
  finishSM(pA0, pA1, alA, l_reg, pa0, pa1, pa2, pa3); SBAR();
  pv_d0(o, vb0, pa0, pa1, pa2, pa3); partialSM<FIXM>(pB0, pB1, m_reg, mnB, alB);
  __syncthreads(); RESC(alB);
  finishSM(pB0, pB1, alB, l_reg, pa0, pa1, pa2, pa3); SBAR();
  pv_d0(o, vb0 + (int)SHM_V, pa0, pa1, pa2, pa3);
  if (hi == 0) li_l[r32] = l_reg; asm volatile("s_waitcnt lgkmcnt(0)" ::: "memory");
  float rli[16];
#pragma unroll
  for (int r = 0; r < 16; ++r) rli[r] = __builtin_amdgcn_rcpf(li_l[crow(r, hi)]);
  unsigned char* Ow = Ob + (long)(wid * QBLK) * LDO;
#pragma unroll
  for (int r = 0; r < 16; ++r) { int orow = crow(r, hi); const float sc = rli[r] * oscale;
    for (int d0 = 0; d0 < 4; ++d0) Ow[(long)orow * LDO + d0 * 32 + r32] = (unsigned char)(__builtin_amdgcn_cvt_pk_fp8_f32(o[d0][r] * sc, 0.f, 0, false) & 0xff); }
  __syncthreads();
#undef SLOAD
#undef SWRITE
#undef SWAIT
#undef RESC
}
#undef KSWZ
#undef KSWZ8
#undef SBAR
}
constexpr int NWAVES = 8;
constexpr int SEQ = 8192, DM = 2048, HD = 128, NEXP = 64, TOPK = 8, FE = 512;
constexpr int INC = 7168;
constexpr int PLD = INC + PROJ_PAD;
constexpr int C_QA = 0, C_KA = 1024, C_VA = 1280, C_QB = 1536, C_KB = 2560, C_VB = 2816, C_GA = 3072, C_GB = 5120;
constexpr float LN_EPS = 1e-5f, RMS_EPS = 1e-6f;
constexpr float ALPHA = 1.189207115002721f;
constexpr float ROUTED_SCALE = 2.5f;
constexpr int LCAP = 8192;
constexpr int NEXP1 = NEXP + 1;

constexpr size_t MiB = 1u << 20;
constexpr size_t WS_CTL = 0, CTL_ZERO_BYTES = 1 * MiB;
constexpr size_t WS_WGU = 1 * MiB;
constexpr size_t WS_WINT = WS_WGU + 260 * MiB;
constexpr size_t WS_XBF = WS_WINT + 28 * MiB;
constexpr size_t WS_PROJ = WS_XBF + 32 * MiB;
constexpr size_t WS_OA = WS_PROJ + 116 * MiB;
constexpr size_t WS_OB = WS_OA + 16 * MiB;
constexpr size_t WS_MRG = WS_OB + 16 * MiB;
constexpr size_t WS_WAT = WS_MRG + 32 * MiB;
constexpr size_t WS_WBT = WS_WAT + 4 * MiB;
constexpr size_t WS_WOT = WS_WBT + 4 * MiB;
constexpr size_t WS_DEAD_END = WS_WOT + 8 * MiB;
constexpr size_t WS_Y = WS_WGU;
constexpr size_t WS_WD = WS_DEAD_END;
constexpr size_t WS_WR = WS_WD + 130 * MiB;
constexpr size_t WS_H32 = WS_WR + 1 * MiB;
constexpr size_t WS_HBF = WS_H32 + 64 * MiB;
constexpr size_t WS_HID = WS_HBF + 32 * MiB;
constexpr size_t WS_PRE = WS_HID + 88 * MiB;
constexpr size_t WS_LTOK = WS_PRE + 64 * MiB;
constexpr size_t WS_LW = WS_LTOK + 3 * MiB;
constexpr size_t WS_ROUTE = WS_LW + 3 * MiB;
constexpr size_t WS_HF8 = WS_H32;
constexpr size_t WS_KF8 = WS_H32 + 16 * MiB;
constexpr size_t WS_END = WS_ROUTE + 1 * MiB;
static_assert(WS_Y + 352 * MiB <= WS_WD, "Y overlay");
static_assert((size_t)SEQ * PLD * 2 <= 116 * MiB, "proj slot");
static_assert(WS_END <= 1024 * MiB, "d_ws map must fit 1 GiB");
constexpr int CW_TMO = 0;
constexpr int CW_CNT = 64;
constexpr int CW_BAR = 4096;

constexpr int RING_OFF = 0, RING_BYTES = 131072;
constexpr int LDSCTL_OFF = RING_BYTES;
constexpr int MISC_OFF = LDSCTL_OFF;
constexpr int IDXL_OFF = LDSCTL_OFF + 256;
constexpr int TST_OFF = IDXL_OFF + 1024 + 2048;
constexpr int LDS_BYTES = 147456;
static_assert(TST_OFF + 512 <= LDS_BYTES, "LDS map");

#define GAS __attribute__((address_space(1)))
#define LAS __attribute__((address_space(3)))
typedef unsigned short bf16;
typedef unsigned v4u __attribute__((ext_vector_type(4)));
typedef unsigned v2u __attribute__((ext_vector_type(2)));
typedef float f32x4 __attribute__((ext_vector_type(4)));
typedef short bf16x8 __attribute__((ext_vector_type(8)));
#define RLX_AGENT __ATOMIC_RELAXED, __HIP_MEMORY_SCOPE_AGENT
#define LDS_WAIT() asm volatile("s_waitcnt lgkmcnt(0)" ::: "memory")
#define VM_WAIT() asm volatile("s_waitcnt vmcnt(0)" ::: "memory")
__device__ __forceinline__ unsigned f2bf(float f) { unsigned u = __builtin_bit_cast(unsigned, f); return (u + 0x7fffu + ((u >> 16) & 1u)) >> 16; }
__device__ __forceinline__ unsigned pk2(float lo, float hi) { return f2bf(lo) | (f2bf(hi) << 16); }
__device__ __forceinline__ float bf2f(unsigned short h) { return __uint_as_float((unsigned)h << 16); }

#define XB_TMO      128
#define XB_XCNT(j)  (256  + 64 * (j))
#define XB_XSUB(j)  (1280 + 64 * (j))
#define XB_XGEN(j)  (2304 + 64 * (j))
#define XB_TOP      3328
#define XB_TOPGEN   3392
#define XCD_BAR_WORDS 3456
#define XB_SPIN_CAP (1u << 20)
__device__ __forceinline__ unsigned xb_ld(unsigned* p)              { return __hip_atomic_load(p, __ATOMIC_RELAXED, __HIP_MEMORY_SCOPE_AGENT); }
__device__ __forceinline__ unsigned xb_add(unsigned* p, unsigned v) { return __hip_atomic_fetch_add(p, v, __ATOMIC_RELAXED, __HIP_MEMORY_SCOPE_AGENT); }
__device__ __forceinline__ unsigned xb_xcc_id() { return (unsigned)__builtin_amdgcn_s_getreg((3 << 11) | 20) & 0xFu; }
#define XB_SPIN(cond, bar) do { unsigned _sp = 0; while (cond) { __builtin_amdgcn_s_sleep(1); \
    if ((++_sp & 255u) == 0u) { if (xb_ld(&(bar)[XB_TMO])) break; if (_sp > XB_SPIN_CAP) { atomicAdd(&(bar)[XB_TMO], 1u); break; } } } } while (0)
struct XcdBarrier { unsigned* bar; unsigned x; volatile LAS unsigned* st; unsigned total; };
__device__ __forceinline__ XcdBarrier xcd_barrier_post(unsigned* bar, volatile LAS unsigned* st, unsigned total) {
    XcdBarrier b; b.bar = bar; b.x = xb_xcc_id(); b.st = st; b.total = total;
    if (threadIdx.x == 0) (void)xb_add(&bar[XB_XCNT(b.x)], 1u);
    return b;
}
__device__ __forceinline__ void xcd_barrier_complete(unsigned* bar, unsigned x, unsigned G, unsigned& nloc, unsigned& nx) {
    unsigned sum, cnt, mine, sp = 0u;
    for (;;) {
        sum = 0u; cnt = 0u; mine = 0u;
#pragma unroll
        for (unsigned j = 0; j < 16; ++j) { const unsigned c = xb_ld(&bar[XB_XCNT(j)]); sum += c; cnt += (c > 0u) ? 1u : 0u; mine = (j == x) ? c : mine; }
        if (sum == G) break;
        __builtin_amdgcn_s_sleep(1);
        if ((++sp & 255u) == 0u) { if (xb_ld(&bar[XB_TMO])) break; if (sp > XB_SPIN_CAP) { atomicAdd(&bar[XB_TMO], 1u); break; } }
    }
    nloc = mine > 0u ? mine : 1u; nx = cnt > 0u ? cnt : 1u;
}
__device__ __forceinline__ void xcd_barrier(const XcdBarrier& b) {
    asm volatile("s_waitcnt vmcnt(0)" ::: "memory");
    __syncthreads();
    if (threadIdx.x == 0) {
        unsigned* bar = b.bar;
        __builtin_amdgcn_s_waitcnt(0);
        unsigned nloc = b.st[0], nx = b.st[1];
        if (nloc == 0u) { xcd_barrier_complete(bar, b.x, b.total, nloc, nx); b.st[0] = nloc; b.st[1] = nx; }
        const unsigned old = xb_add(&bar[XB_XSUB(b.x)], 1u);
        const unsigned gen = old / nloc;
        if (old + 1u == (gen + 1u) * nloc) {
            __builtin_amdgcn_fence(__ATOMIC_RELEASE, "agent");
            asm volatile("s_waitcnt vmcnt(0)" ::: "memory");
            const unsigned og = xb_add(&bar[XB_TOP], 1u);
            const unsigned tg = og / nx;
            if (og + 1u == (tg + 1u) * nx) xb_add(&bar[XB_TOPGEN], 1u);
            else XB_SPIN(xb_ld(&bar[XB_TOPGEN]) == tg, bar);
            __builtin_amdgcn_fence(__ATOMIC_ACQUIRE, "agent");
            xb_add(&bar[XB_XGEN(b.x)], 1u);
            asm volatile("s_waitcnt vmcnt(0)" ::: "memory");
        } else {
            XB_SPIN(xb_ld(&bar[XB_XGEN(b.x)]) == gen, bar);
            __builtin_amdgcn_fence(__ATOMIC_ACQUIRE, "agent");
            asm volatile("s_waitcnt vmcnt(0)" ::: "memory");
        }
    }
    __syncthreads();
}

__device__ __forceinline__ float wave_sum(float v) {
#pragma unroll
    for (int o = 1; o < 64; o <<= 1) v += __shfl_xor(v, o);
    return v;
}
__device__ __forceinline__ float sigmoidf_(float x) { return __builtin_amdgcn_rcpf(1.0f + __builtin_amdgcn_exp2f(-x * 1.4426950408889634f)); }

struct Args { const float* in[22]; float* out; unsigned char* ws; int ph_lo, ph_hi; };
struct Frame {
    LAS unsigned char* lds;
    volatile LAS unsigned* MISC;
    unsigned* ctl;
    int tid, lane, wave;
    int vcu, G;
    const float* in[22]; float* out; unsigned char* ws;
};

#ifndef G1_FP8
#define G1_FP8 1
#endif
#ifndef ATT_F8
#define ATT_F8 1
#endif
#ifndef P1_FP8
#define P1_FP8 1
#endif
struct TItem { const float* W; unsigned char* WT; int K, N, k0, n0, drow0, f8; };
constexpr float W8SCALE = 32.0f, H8SCALE = 8.0f, OA_SCALE = 16.0f, OB_SCALE = 64.0f, MG_SCALE = 32.0f;
__device__ __forceinline__ void titem_issue(const TItem& it, LAS unsigned char* buf, int lane) {
#pragma unroll
    for (int g = 0; g < 8; ++g) { const int k = 8 * g + (lane >> 3), pos = lane & 7;
        __builtin_amdgcn_global_load_lds((const unsigned*)(it.W + (size_t)(it.k0 + k) * it.N + it.n0 + 4 * (pos ^ g)), (LAS unsigned*)(buf + g * 1024), 16, 0, 0); }
}
__device__ __forceinline__ void titem_finish(const TItem& it, const LAS float* buf, int lane) {
    const int c = lane & 7;
#pragma unroll
    for (int j = 0; j < 4; ++j) { const int nn = (lane >> 3) + 8 * j; const LAS float* s = buf + (8 * c) * 32 + (((nn >> 2) ^ c) << 2) + (nn & 3);
        const size_t eo = (size_t)(it.drow0 + nn) * it.K + it.k0 + 8 * c;
        if (it.f8) { v2u o; int t = __builtin_amdgcn_cvt_pk_fp8_f32(s[0 * 32] * W8SCALE, s[1 * 32] * W8SCALE, 0, false); t = __builtin_amdgcn_cvt_pk_fp8_f32(s[2 * 32] * W8SCALE, s[3 * 32] * W8SCALE, t, true); o.x = (unsigned)t;
            t = __builtin_amdgcn_cvt_pk_fp8_f32(s[4 * 32] * W8SCALE, s[5 * 32] * W8SCALE, 0, false); t = __builtin_amdgcn_cvt_pk_fp8_f32(s[6 * 32] * W8SCALE, s[7 * 32] * W8SCALE, t, true); o.y = (unsigned)t;
            __builtin_nontemporal_store(o, (GAS v2u*)(it.WT + eo)); }
        else { v4u o; o.x = pg8::cvt_pk_bf16(s[0 * 32], s[1 * 32]); o.y = pg8::cvt_pk_bf16(s[2 * 32], s[3 * 32]); o.z = pg8::cvt_pk_bf16(s[4 * 32], s[5 * 32]); o.w = pg8::cvt_pk_bf16(s[6 * 32], s[7 * 32]);
            __builtin_nontemporal_store(o, (GAS v4u*)(it.WT + 2 * eo)); } }
}
constexpr int I_IN = (DM / 64) * (INC / 32);
constexpr int I_BR = (1024 / 64) * (DM / 32);
constexpr int I_WO = (DM / 64) * (DM / 32);
constexpr int I_GU = (DM / 64) * (FE / 32);
constexpr int I_DN = (FE / 64) * (DM / 32);
constexpr int NITEMS_E1 = 2 * I_BR + I_WO + NEXP1 * 2 * I_GU;
constexpr int NITEMS_E2 = NEXP1 * I_DN;
__device__ __forceinline__ void titem_plain(TItem& it, const float* W, int K, int N, void* WT, int item, int f8 = 0) {
    const int nblk = N / 32, kb = item / nblk, nb = item % nblk; it.W = W; it.WT = (unsigned char*)WT; it.K = K; it.N = N; it.k0 = 64 * kb; it.n0 = 32 * nb; it.drow0 = 32 * nb; it.f8 = f8;
}
template <int LIST>
__device__ __forceinline__ void titem_get(Frame& F, int r, TItem& it) {
    if constexpr (LIST == 0) { titem_plain(it, F.in[1], DM, INC, F.ws + WS_WINT, r, P1_FP8); }
    else if constexpr (LIST == 2) { const int e = r / I_DN; r -= e * I_DN;
        titem_plain(it, e < NEXP ? F.in[16] + (size_t)e * FE * DM : F.in[19], FE, DM, F.ws + WS_WD + (size_t)e * DM * FE, r, 1); }
    else {
        if (r < I_BR) { titem_plain(it, F.in[7], 1024, DM, F.ws + WS_WAT, r, 1); return; } r -= I_BR;
        if (r < I_BR) { titem_plain(it, F.in[8], 1024, DM, F.ws + WS_WBT, r, 1); return; } r -= I_BR;
        if (r < I_WO) { titem_plain(it, F.in[9], DM, DM, F.ws + WS_WOT, r, 1); return; } r -= I_WO;
        const int e = r / (2 * I_GU); r -= e * (2 * I_GU);
        const int half = r >= I_GU ? 1 : 0; r -= half * I_GU;
        const float* w = e < NEXP ? (half ? F.in[15] : F.in[14]) + (size_t)e * DM * FE : (half ? F.in[18] : F.in[17]);
        const int nblk = FE / 32, kb = r / nblk, nb = r % nblk, n0 = 32 * nb;
        it.W = w; it.WT = F.ws + WS_WGU + (size_t)e * 1024 * DM * (G1_FP8 ? 1 : 2); it.f8 = G1_FP8; it.K = DM; it.N = FE; it.k0 = 64 * kb; it.n0 = n0; it.drow0 = 256 * (n0 >> 7) + 128 * half + (n0 & 127);
    }
}
#ifndef CONV_D
#define CONV_D 4
#endif
__device__ __forceinline__ void titem_load(const TItem& it, f32x4 (&r)[8], int lane) {
#pragma unroll
    for (int g = 0; g < 8; ++g) r[g] = __builtin_nontemporal_load((const GAS f32x4*)(it.W + (size_t)(it.k0 + 8 * g + (lane >> 3)) * it.N + it.n0 + 4 * (lane & 7)));
}
__device__ __forceinline__ void titem_store(const TItem& it, const f32x4 (&r)[8], LAS float* buf, int lane) {
#pragma unroll
    for (int g = 0; g < 8; ++g) *(LAS f32x4*)(buf + (8 * g + (lane >> 3)) * 32 + (((lane & 7) ^ g) << 2)) = r[g];
    titem_finish(it, buf, lane);
}
template <int LISTE>
__device__ __forceinline__ void convert_items(Frame& F, int first, int step, int last) {
    LAS float* buf = (LAS float*)(F.lds + RING_OFF + F.wave * 8192);
    if (first >= last) return;
    const int n_my = (last - first + step - 1) / step;
    f32x4 r[CONV_D][8]; TItem it;
#pragma unroll
    for (int d = 0; d < CONV_D; ++d) if (d < n_my) { titem_get<LISTE>(F, first + d * step, it); titem_load(it, r[d], F.lane); }
    for (int base = 0; base < n_my; base += CONV_D) {
#pragma unroll
        for (int d = 0; d < CONV_D; ++d) { const int idx = base + d;
            if (idx < n_my) { titem_get<LISTE>(F, first + idx * step, it); titem_store(it, r[d], buf, F.lane);
                if (idx + CONV_D < n_my) { titem_get<LISTE>(F, first + (idx + CONV_D) * step, it); titem_load(it, r[d], F.lane); } } }
    }
}
#ifndef CONV_Q
#define CONV_Q 200
#endif
#ifndef P1_NCG
#define P1_NCG 23
#endif
constexpr int NCONV = 32, NCOMP = 256 - NCONV, NCONV1 = 8 * (32 - P1_NCG), NCOMP1 = 8 * P1_NCG, E_SPLIT = (NCONV1 * NWAVES * CONV_Q < NITEMS_E1) ? NCONV1 * NWAVES * CONV_Q : NITEMS_E1;
#ifndef CONV_Q2
#define CONV_Q2 100
#endif
#ifndef P1_QE2
#define P1_QE2 0
#endif
constexpr int E2_A = (NCONV1 * NWAVES * P1_QE2 < NITEMS_E2) ? NCONV1 * NWAVES * P1_QE2 : NITEMS_E2;
constexpr int E2_SPLIT = (E2_A + 32 * NWAVES * CONV_Q2 < NITEMS_E2) ? E2_A + 32 * NWAVES * CONV_Q2 : NITEMS_E2;
#ifndef CONV_G1
#define CONV_G1 1
#endif
__device__ __forceinline__ void p0_prologue(Frame& F, bool compute_only) {
    const int gw = (compute_only ? (F.vcu >> 5) * P1_NCG + (F.vcu & 31) : F.vcu) * NWAVES + F.wave, NGW = (compute_only ? NCOMP1 : F.G) * NWAVES;
    convert_items<0>(F, gw, NGW, I_IN);
    { const int gt = gw * 64 + F.lane, NT = NGW * 64; const GAS f32x4* xs = (const GAS f32x4*)F.in[0]; GAS v4u* xo = (GAS v4u*)(F.ws + WS_XBF);
      for (int i = gt; i < SEQ * DM / 8; i += 4 * NT) {
          f32x4 a[4], b[4];
#pragma unroll
          for (int u = 0; u < 4; ++u) if (i + u * NT < SEQ * DM / 8) { a[u] = __builtin_nontemporal_load(xs + 2 * (i + u * NT)); b[u] = __builtin_nontemporal_load(xs + 2 * (i + u * NT) + 1); }
#pragma unroll
          for (int u = 0; u < 4; ++u) if (i + u * NT < SEQ * DM / 8) {
              if (P1_FP8) { v2u o; int t = __builtin_amdgcn_cvt_pk_fp8_f32(a[u].x, a[u].y, 0, false); t = __builtin_amdgcn_cvt_pk_fp8_f32(a[u].z, a[u].w, t, true); o.x = (unsigned)t;
                  t = __builtin_amdgcn_cvt_pk_fp8_f32(b[u].x, b[u].y, 0, false); t = __builtin_amdgcn_cvt_pk_fp8_f32(b[u].z, b[u].w, t, true); o.y = (unsigned)t; ((GAS v2u*)xo)[i + u * NT] = o; }
              else { v4u o; o.x = pg8::cvt_pk_bf16(a[u].x, a[u].y); o.y = pg8::cvt_pk_bf16(a[u].z, a[u].w); o.z = pg8::cvt_pk_bf16(b[u].x, b[u].y); o.w = pg8::cvt_pk_bf16(b[u].z, b[u].w); xo[i + u * NT] = o; } } } }
    { const int gt = gw * 64 + F.lane, NT = NGW * 64; bf16* wr = (bf16*)(F.ws + WS_WR);
      for (int i = gt; i < NEXP * DM; i += NT) {
          const int j_ = i & 7, ln = (i >> 3) & 63, nt_ = (i >> 9) & 3, ks = i >> 11, q_ = ln >> 4, t_ = ln & 15;
          const int k = ks * 32 + (j_ < 4 ? 4 * q_ + j_ : 16 + 4 * q_ + j_ - 4), e = 16 * nt_ + t_;
          const float w = F.in[12][(size_t)k * NEXP + e]; const unsigned h = f2bf(w); const float lo = w - __uint_as_float(h << 16);
          wr[i] = (bf16)h; wr[NEXP * DM + i] = (bf16)f2bf(lo); } }
    { const int gt = gw * 64 + F.lane, NT = NGW * 64; int* lt = (int*)(F.ws + WS_LTOK); float* lw = (float*)(F.ws + WS_LW);
      for (int i = gt; i < NEXP1 * LCAP; i += NT) { const bool sh = i >= NEXP * LCAP; lt[i] = sh ? i - NEXP * LCAP : 0; lw[i] = sh ? 1.0f : 0.0f; } }
}

#ifndef WT_STORES
#define WT_STORES 0
#endif
__device__ __forceinline__ void st_wt8(void* p, v2u w) {
    if (WT_STORES) __hip_atomic_store((unsigned long long*)p, ((unsigned long long)w.y << 32) | w.x, __ATOMIC_RELAXED, __HIP_MEMORY_SCOPE_AGENT);
    else *(v2u*)p = w;
}
__device__ __forceinline__ v4u pair16(v2u a, v2u b) {
    auto sx = __builtin_amdgcn_permlane16_swap(a.x, b.x, false, false);
    auto sy = __builtin_amdgcn_permlane16_swap(a.y, b.y, false, false);
    return (v4u){sx[0], sy[0], sx[1], sy[1]};
}
struct DenseOrder {
    const char* A; const char* B; int nM, nN, nwg, G, c; size_t tstep;
    __device__ __forceinline__ void init(const void* A_, const void* B_, int M, int N, int K, int G_, int c_) { A = (const char*)A_; B = (const char*)B_; nM = M / 256; nN = N / 256; nwg = nM * nN; G = G_; c = c_; tstep = (size_t)256 * K * (P1_FP8 ? 1 : 2); }
    __device__ __forceinline__ bool next(int i, pg8::Unit& u) const {
#ifdef P1_DOUBLE
        const long L = (long)(i >> 1) * G + c; if (L >= nwg) return false;
#else
        const long L = (long)i * G + c; if (L >= nwg) return false;
#endif
        int wgid = (int)L; { const int q = nwg / 8, r = nwg % 8, xcd = wgid % 8, off = wgid / 8; wgid = (xcd < r ? xcd * (q + 1) : r * (q + 1) + (xcd - r) * q) + off; }
        const int nig = 8 * nN, gid = wgid / nig, fm = gid * 8, gsz = (nM - fm) < 8 ? (nM - fm) : 8;
        const int pm = fm + ((wgid % nig) % gsz), pn = (wgid % nig) / gsz;
        u.A = A + (size_t)pm * tstep; u.B = B + (size_t)pn * tstep; u.idx = nullptr; u.wts = nullptr; u.r0 = pm * 256; u.c0 = pn * 256; u.aux = 0; u.kind = 0; return true;
    }
};
struct BranchOrder {
    const char *OA, *OB, *WA, *WB; int vcu;
    __device__ __forceinline__ bool next(int i, pg8::Unit& u) const {
#ifdef P3_DOUBLE
        if (i >= 4) return false; i &= 1;
#else
        if (i >= 2) return false;
#endif
        const int pm = vcu >> 3, pn = vcu & 7; const size_t ts = (size_t)256 * 1024;
        u.A = (i ? OB : OA) + (size_t)pm * ts; u.B = (i ? WB : WA) + (size_t)pn * ts; u.idx = nullptr; u.wts = nullptr; u.r0 = pm * 256; u.c0 = pn * 256; u.aux = 0; u.kind = i; return true;
    }
};
struct OneTileOrder {
    const char *A, *B; int vcu; size_t ts;
    __device__ __forceinline__ bool next(int i, pg8::Unit& u) const {
#ifdef P4_DOUBLE
        if (i >= 2) return false;
#else
        if (i >= 1) return false;
#endif
        const int pm = vcu >> 3, pn = vcu & 7;
        u.A = A + (size_t)pm * ts; u.B = B + (size_t)pn * ts; u.idx = nullptr; u.wts = nullptr; u.r0 = pm * 256; u.c0 = pn * 256; u.aux = 0; u.kind = 0; return true;
    }
};
template <int NPN>
struct MoeOrder {
    const LAS int* tst; const char* A; const char* B; const int* ltok; const float* lwt; int vcu, G; size_t arow, bexp, bpn;
    bool gather;
    int l0, lend, nheavy;
    const unsigned* flag; int wait_gmt, need;
    mutable int ec = 0;
    __device__ __forceinline__ bool next(int i, pg8::Unit& u) const {
        const int T = tst[NEXP1]; const int end = lend < 0 ? T * NPN : lend;
        int L;
#ifdef G2_DOUBLE
        if (NPN == 8) i >>= 1;
#endif
        if (nheavy > 0) { const int NL = G - nheavy; if (vcu >= NL) L = 2 * NL + i * G + vcu; else L = i < 2 ? i * NL + vcu : 2 * NL + (i - 2) * G + vcu; }
        else L = l0 + i * G + vcu;
        if (L >= end) return false;
        const int gmt = L / NPN, pn = L % NPN; int e = ec; if (tst[e] > gmt) e = 0;
        while (e < NEXP && tst[e + 1] <= gmt) ++e;
        ec = e;
        const int mt = gmt - tst[e];
        if (need > 0 && gmt >= wait_gmt) {
            unsigned spins = 0; while (__hip_atomic_load(flag, __ATOMIC_RELAXED, __HIP_MEMORY_SCOPE_AGENT) < (unsigned)need && ++spins < (1u << 22)) __builtin_amdgcn_s_sleep(2);
            __builtin_amdgcn_fence(__ATOMIC_ACQUIRE, "agent"); asm volatile("s_waitcnt vmcnt(0)" ::: "memory"); }
        u.A = gather ? A : A + (size_t)gmt * 256 * arow; u.B = B + (size_t)e * bexp + (size_t)pn * bpn; u.idx = ltok + e * LCAP + mt * 256; u.wts = lwt + e * LCAP + mt * 256;
        u.r0 = gmt * 256; u.c0 = pn * 256; u.aux = e * LCAP + mt * 256; u.kind = 0; return true;
    }
};

constexpr float GSCALE = 256.0f;
typedef float f32x2v __attribute__((ext_vector_type(2)));
struct EpiProj {
    static constexpr bool PERM = true; static constexpr int NST = 8;
    bf16* O; const float* bgate;
    __device__ __forceinline__ bool operator()(const pg8::f32x4 (&acc)[2][2][4][2], const pg8::Unit& u, int wr, int wc, int fr, int fq, const LAS float* wl) const {
        const int row0 = u.r0 + wr * 64 + fr, col0 = u.c0 + wc * 32 + 8 * fq;
        constexpr float PS = P1_FP8 ? 1.0f / W8SCALE : 1.0f;
        if (u.c0 >= C_GA) {
            f32x4 bb[2][2];
#pragma unroll
            for (int bj = 0; bj < 2; ++bj) { bb[bj][0] = *(const f32x4*)(bgate + col0 + bj * 128 - C_GA); bb[bj][1] = *(const f32x4*)(bgate + col0 + bj * 128 - C_GA + 4); }
            const int odd = fq & 1; unsigned char* G = (unsigned char*)O + (size_t)C_GA * 2 + (col0 - 8 * odd - C_GA);
#pragma unroll
            for (int ai = 0; ai < 2; ++ai)
#pragma unroll
                for (int mp = 0; mp < 2; ++mp)
#pragma unroll
                    for (int bj = 0; bj < 2; ++bj) { v2u w[2];
#pragma unroll
                        for (int mm = 0; mm < 2; ++mm) { const int m = 2 * mp + mm; const f32x4 v0 = acc[ai][bj][m][0] * PS + bb[bj][0], v1 = acc[ai][bj][m][1] * PS + bb[bj][1];
                            int t = __builtin_amdgcn_cvt_pk_fp8_f32(GSCALE * sigmoidf_(v0[0]), GSCALE * sigmoidf_(v0[1]), 0, false); t = __builtin_amdgcn_cvt_pk_fp8_f32(GSCALE * sigmoidf_(v0[2]), GSCALE * sigmoidf_(v0[3]), t, true); w[mm].x = (unsigned)t;
                            t = __builtin_amdgcn_cvt_pk_fp8_f32(GSCALE * sigmoidf_(v1[0]), GSCALE * sigmoidf_(v1[1]), 0, false); t = __builtin_amdgcn_cvt_pk_fp8_f32(GSCALE * sigmoidf_(v1[2]), GSCALE * sigmoidf_(v1[3]), t, true); w[mm].y = (unsigned)t; }
                        *(v4u*)(G + (size_t)(row0 + ai * 128 + (2 * mp + odd) * 16) * (PLD * 2) + bj * 128) = pair16(w[0], w[1]); }
        } else {
#pragma unroll
            for (int ai = 0; ai < 2; ++ai)
#pragma unroll
                for (int m = 0; m < 4; ++m)
#pragma unroll
                    for (int bj = 0; bj < 2; ++bj) { const f32x4 v0 = acc[ai][bj][m][0] * PS, v1 = acc[ai][bj][m][1] * PS;
                        v4u w; w.x = pg8::cvt_pk_bf16(v0[0], v0[1]); w.y = pg8::cvt_pk_bf16(v0[2], v0[3]); w.z = pg8::cvt_pk_bf16(v1[0], v1[1]); w.w = pg8::cvt_pk_bf16(v1[2], v1[3]);
                        *(v4u*)(O + (size_t)(row0 + ai * 128 + m * 16) * PLD + col0 + bj * 128) = w; }
        }
        return false;
    }
};
struct EpiBranch {
    static constexpr bool PERM = true; static constexpr int NST = 0;
    const bf16* proj; unsigned char* O;
    __device__ __forceinline__ bool operator()(pg8::f32x4 (&acc)[2][2][4][2], const pg8::Unit& u, int wr, int wc, int fr, int fq, const LAS float* wl) const {
        const int row0 = u.r0 + wr * 64 + fr, col0 = u.c0 + wc * 32 + 8 * fq;
        const bool seg0 = u.kind == 0;
#pragma unroll
        for (int ai = 0; ai < 2; ++ai) {
            v2u gb[4][2], ga[4][2];
#pragma unroll
            for (int m = 0; m < 4; ++m)
#pragma unroll
                for (int bj = 0; bj < 2; ++bj) { const size_t r = (size_t)(row0 + ai * 128 + m * 16); const int c = col0 + bj * 128;
                    const unsigned char* gp = (const unsigned char*)proj + r * (PLD * 2) + (size_t)C_GA * 2 + c;
                    gb[m][bj] = *(const v2u*)(gp + (C_GB - C_GA)); ga[m][bj] = seg0 ? *(const v2u*)gp : (v2u){0u, 0u}; }
            __builtin_amdgcn_sched_barrier(0);
#pragma unroll
            for (int mp = 0; mp < 2; ++mp) {
                v2u wq[2][2];
#pragma unroll
                for (int mm = 0; mm < 2; ++mm)
#pragma unroll
                    for (int bj = 0; bj < 2; ++bj) { const int m = 2 * mp + mm;
                        const v2u gbv = gb[m][bj], gav = ga[m][bj];
                        const f32x2v g01 = __builtin_amdgcn_cvt_pk_f32_fp8((int)gbv.x, false), g23 = __builtin_amdgcn_cvt_pk_f32_fp8((int)gbv.x, true), g45 = __builtin_amdgcn_cvt_pk_f32_fp8((int)gbv.y, false), g67 = __builtin_amdgcn_cvt_pk_f32_fp8((int)gbv.y, true);
                        float g[8] = {g01[0], g01[1], g23[0], g23[1], g45[0], g45[1], g67[0], g67[1]};
                        if (seg0) {
                            const f32x2v a01 = __builtin_amdgcn_cvt_pk_f32_fp8((int)gav.x, false), a23 = __builtin_amdgcn_cvt_pk_f32_fp8((int)gav.x, true), a45 = __builtin_amdgcn_cvt_pk_f32_fp8((int)gav.y, false), a67 = __builtin_amdgcn_cvt_pk_f32_fp8((int)gav.y, true);
                            float a[8] = {a01[0], a01[1], a23[0], a23[1], a45[0], a45[1], a67[0], a67[1]};
#pragma unroll
                            for (int j = 0; j < 4; ++j) { acc[ai][bj][m][0][j] *= (OB_SCALE / OA_SCALE) * a[j] * __builtin_amdgcn_rcpf(fmaxf(g[j], 1e-30f)); acc[ai][bj][m][1][j] *= (OB_SCALE / OA_SCALE) * a[4 + j] * __builtin_amdgcn_rcpf(fmaxf(g[4 + j], 1e-30f)); }
                        } else {
                            const pg8::f32x4 v0 = acc[ai][bj][m][0], v1 = acc[ai][bj][m][1];
                            constexpr float S1 = MG_SCALE / (OB_SCALE * W8SCALE * GSCALE);
                            v2u w; int t = __builtin_amdgcn_cvt_pk_fp8_f32(v0[0] * g[0] * S1, v0[1] * g[1] * S1, 0, false); t = __builtin_amdgcn_cvt_pk_fp8_f32(v0[2] * g[2] * S1, v0[3] * g[3] * S1, t, true); w.x = (unsigned)t;
                            t = __builtin_amdgcn_cvt_pk_fp8_f32(v1[0] * g[4] * S1, v1[1] * g[5] * S1, 0, false); t = __builtin_amdgcn_cvt_pk_fp8_f32(v1[2] * g[6] * S1, v1[3] * g[7] * S1, t, true); w.y = (unsigned)t;
                            wq[mm][bj] = w;
                        }
                    }
                if (!seg0) { const int odd = fq & 1;
#pragma unroll
                    for (int bj = 0; bj < 2; ++bj) *(v4u*)(O + (size_t)(row0 + ai * 128 + (2 * mp + odd) * 16) * DM + col0 - 8 * odd + bj * 128) = pair16(wq[0][bj], wq[1][bj]); }
            }
            __builtin_amdgcn_sched_barrier(0);
        }
        return seg0;
    }
};
struct EpiMix {
    static constexpr bool PERM = true; static constexpr int NST = 16;
    bf16* O;
    __device__ __forceinline__ bool operator()(const pg8::f32x4 (&acc)[2][2][4][2], const pg8::Unit& u, int wr, int wc, int fr, int fq, const LAS float* wl) const {
        const int row0 = u.r0 + wr * 64 + fr, col0 = u.c0 + wc * 32 + 8 * fq;
#pragma unroll
        for (int ai = 0; ai < 2; ++ai)
#pragma unroll
            for (int m = 0; m < 4; ++m)
#pragma unroll
                for (int bj = 0; bj < 2; ++bj) { const pg8::f32x4 v0 = acc[ai][bj][m][0] * (1.0f / (MG_SCALE * W8SCALE)), v1 = acc[ai][bj][m][1] * (1.0f / (MG_SCALE * W8SCALE));
                    v4u w; w.x = pg8::cvt_pk_bf16(v0[0], v0[1]); w.y = pg8::cvt_pk_bf16(v0[2], v0[3]); w.z = pg8::cvt_pk_bf16(v1[0], v1[1]); w.w = pg8::cvt_pk_bf16(v1[2], v1[3]);
                    *(v4u*)(O + (size_t)(row0 + ai * 128 + m * 16) * DM + col0 + bj * 128) = w; }
        return false;
    }
};
struct EpiMoe1 {
    static constexpr bool PERM = true; static constexpr int NST = 4;
    unsigned char* H;
    __device__ __forceinline__ bool operator()(const pg8::f32x4 (&acc)[2][2][4][2], const pg8::Unit& u, int wr, int wc, int fr, int fq, const LAS float* wl) const {
        const int odd = fq & 1; const int row0 = u.r0 + wr * 64 + fr + odd * 16, col0 = (u.c0 >> 1) + wc * 32 + 8 * (fq - odd);
#pragma unroll
        for (int ai = 0; ai < 2; ++ai)
#pragma unroll
            for (int mp = 0; mp < 2; ++mp) { v2u w[2];
#pragma unroll
                for (int mm = 0; mm < 2; ++mm) { const int m = 2 * mp + mm; float h[8]; const float wt = wl[wr * 64 + fr + ai * 128 + m * 16] * H8SCALE;
#pragma unroll
                    for (int n = 0; n < 2; ++n)
#pragma unroll
                        for (int j = 0; j < 4; ++j) { const float g = acc[ai][0][m][n][j] * (G1_FP8 ? 1.0f / W8SCALE : 1.0f), up = acc[ai][1][m][n][j] * (G1_FP8 ? 1.0f / W8SCALE : 1.0f); h[4 * n + j] = __builtin_amdgcn_fmed3f(g * sigmoidf_(g) * up * wt, -448.0f, 448.0f); }
                    int t = __builtin_amdgcn_cvt_pk_fp8_f32(h[0], h[1], 0, false); t = __builtin_amdgcn_cvt_pk_fp8_f32(h[2], h[3], t, true); w[mm].x = (unsigned)t;
                    t = __builtin_amdgcn_cvt_pk_fp8_f32(h[4], h[5], 0, false); t = __builtin_amdgcn_cvt_pk_fp8_f32(h[6], h[7], t, true); w[mm].y = (unsigned)t; }
                *(v4u*)(H + (size_t)(row0 + ai * 128 + mp * 32) * FE + col0) = pair16(w[0], w[1]); }
        return false;
    }
};
constexpr float YSCALE = 16.0f;
struct EpiMoe2 {
    static constexpr bool PERM = true; static constexpr int NST = 8;
    unsigned char* Y;
    __device__ __forceinline__ bool operator()(const pg8::f32x4 (&acc)[2][2][4][2], const pg8::Unit& u, int wr, int wc, int fr, int fq, const LAS float* wl) const {
        const int odd = fq & 1; const int lr0 = wr * 64 + fr + odd * 16, col0 = u.c0 + wc * 32 + 8 * (fq - odd);
#pragma unroll
        for (int ai = 0; ai < 2; ++ai)
#pragma unroll
            for (int mp = 0; mp < 2; ++mp) { const int lr = lr0 + ai * 128 + mp * 32;
#pragma unroll
                for (int bj = 0; bj < 2; ++bj) { v2u w[2];
#pragma unroll
                    for (int mm = 0; mm < 2; ++mm) { pg8::f32x4 v0 = acc[ai][bj][2 * mp + mm][0] * (YSCALE / (W8SCALE * H8SCALE)), v1 = acc[ai][bj][2 * mp + mm][1] * (YSCALE / (W8SCALE * H8SCALE));
#pragma unroll
                        for (int j = 0; j < 4; ++j) { v0[j] = __builtin_amdgcn_fmed3f(v0[j], -448.0f, 448.0f); v1[j] = __builtin_amdgcn_fmed3f(v1[j], -448.0f, 448.0f); }
                        int t = __builtin_amdgcn_cvt_pk_fp8_f32(v0[0], v0[1], 0, false); t = __builtin_amdgcn_cvt_pk_fp8_f32(v0[2], v0[3], t, true); w[mm].x = (unsigned)t;
                        t = __builtin_amdgcn_cvt_pk_fp8_f32(v1[0], v1[1], 0, false); t = __builtin_amdgcn_cvt_pk_fp8_f32(v1[2], v1[3], t, true); w[mm].y = (unsigned)t; }
                    *(v4u*)(Y + (size_t)(u.r0 + lr) * DM + col0 + bj * 128) = pair16(w[0], w[1]); } }
        return false;
    }
};

__device__ __forceinline__ void p1b_qknorm(Frame& F) {
    const int gw = F.vcu * NWAVES + F.wave, NGW = F.G * NWAVES; const bf16* proj = (const bf16*)(F.ws + WS_PROJ);
    const int hf = F.lane >> 5, i = F.lane & 31;
    const float inv = __builtin_amdgcn_exp2f(-(float)(2 * i) * (1.0f / 64.0f) * 13.287712379549449f);
    const float gk0 = F.in[6][64 * hf + i], gk1 = F.in[6][64 * hf + 32 + i];
    for (int tok0 = gw; tok0 < SEQ; tok0 += 4 * NGW) {
        float x1[4][2], x2[4][2];
#pragma unroll
        for (int b = 0; b < 4; ++b) { const int tok = tok0 + b * NGW; const bf16* pq = proj + (size_t)(tok < SEQ ? tok : 0) * PLD + C_KB + 64 * hf + i;
#pragma unroll
            for (int hh = 0; hh < 2; ++hh) { x1[b][hh] = bf2f(pq[hh * HD]); x2[b][hh] = bf2f(pq[hh * HD + 32]); } }
        __builtin_amdgcn_sched_barrier(0);
#pragma unroll
        for (int b = 0; b < 4; ++b) { const int tok = tok0 + b * NGW;
            const float pos = (float)(hf == 0 ? (tok >> 6) : (tok & 63));
            const float rev = pos * inv * 0.15915494309189535f, fr = rev - floorf(rev);
            const float sn = __builtin_amdgcn_sinf(fr), cs = __builtin_amdgcn_cosf(fr);
#pragma unroll
            for (int hh = 0; hh < 2; ++hh) {
                const float ss = wave_sum(x1[b][hh] * x1[b][hh] + x2[b][hh] * x2[b][hh]);
                const float rs = 1.0f / sqrtf(ss * (1.0f / HD) + RMS_EPS);
                const float a = x1[b][hh] * rs * gk0, c = x2[b][hh] * rs * gk1;
                const float o1 = a * cs - c * sn, o2 = c * cs + a * sn;
                if (tok < SEQ) { unsigned char* kf = F.ws + WS_KF8 + (size_t)tok * 256 + hh * HD + 64 * hf + 32 * ((i >> 4) & 1) + (i & 15);
                    kf[0] = (unsigned char)(__builtin_amdgcn_cvt_pk_fp8_f32(o1, 0.f, 0, false) & 0xff); kf[16] = (unsigned char)(__builtin_amdgcn_cvt_pk_fp8_f32(o2, 0.f, 0, false) & 0xff); } } }
    }
}

__device__ __forceinline__ int t5_bucket(int rel) {
    const int n = rel < 0 ? -rel : rel; int b;
    if (n < 8) b = n; else if (n < 12) b = 8; else if (n < 16) b = 9; else if (n < 23) b = 10; else if (n < 32) b = 11; else if (n < 46) b = 12; else if (n < 64) b = 13; else if (n < 91) b = 14; else b = 15;
    return (rel > 0 ? 16 : 0) + b;
}
__device__ __forceinline__ void p3_dense_attention(Frame& F) {
    using abf = attn::bf16;
    char* lds = (char*)F.lds;
    const abf* proj = (const abf*)(F.ws + WS_PROJ);
    float gqm = fmaxf(fabsf(F.in[5][F.lane]), fabsf(F.in[5][F.lane + 64])), gkm = fmaxf(fabsf(F.in[6][F.lane]), fabsf(F.in[6][F.lane + 64]));
#pragma unroll
    for (int o = 1; o < 64; o <<= 1) { gqm = fmaxf(gqm, __shfl_xor(gqm, o)); gkm = fmaxf(gkm, __shfl_xor(gkm, o)); }
    const float sbound = 1.15f * 128.0f * gqm * gkm;
    for (int un = F.vcu; un < 256; un += F.G) {
        const int h = un >> 5, ub = un & 31, kvh = h >> 2;
        attn::attn_body<false, 1, true, true, true>(proj + (size_t)(ub * 256) * PLD + C_QB + h * HD, proj + C_KB + kvh * HD, F.ws + WS_KF8 + kvh * HD, proj + C_VB + kvh * HD,
                               F.ws + WS_OB + (size_t)(ub * 256) * 1024 + h * HD, OB_SCALE, SEQ, lds, nullptr, 0, sbound, 0.f, F.in[5], ub * 256);
    }
}
__device__ __forceinline__ void win_attention(Frame& F, int first, int step) {
    using abf = attn::bf16;
    char* lds = (char*)F.lds;
    const abf* proj = (const abf*)(F.ws + WS_PROJ);
    for (int un = first; un < 256; un += step) {
        const int h = un >> 5, ub = un & 31, kvh = h >> 2;
        LAS float* tab = (LAS float*)(F.lds + attn::WIN_TAB);
        for (int e = F.tid; e < 1024; e += NWAVES * 64) { const int rel = e - 512; const int ar = rel < 0 ? -rel : rel;
            tab[e] = ar <= 128 ? F.in[4][t5_bucket(rel) * 8 + h] * (1.0f / attn::SCALE) : -1e30f; }
        __syncthreads();
        const int q0 = ub * 256; int kf = q0 - 128, ke = q0 + 384; if (kf < 0) kf = 0; if (ke > SEQ) ke = SEQ;
        const float sinkl = F.in[3][h] * (1.0f / attn::SCALE);
        attn::attn_body<true, 1, false, false>(proj + (size_t)q0 * PLD + C_QA + h * HD, proj + (size_t)kf * PLD + C_KA + kvh * HD, nullptr, proj + (size_t)kf * PLD + C_VA + kvh * HD,
                              F.ws + WS_OA + (size_t)q0 * 1024 + h * HD, OA_SCALE, ke - kf, lds, tab, kf - q0, sinkl, 1.0f);
    }
}

__device__ __forceinline__ void p5_ln_router(Frame& F, bool probe_rep = false) {
    typedef float f32x4v __attribute__((ext_vector_type(4)));
    const bf16* mixb = (const bf16*)(F.ws + WS_PRE); bf16* hbf = (bf16*)(F.ws + WS_HBF);
    const bf16* wrh = (const bf16*)(F.ws + WS_WR); const bf16* wrl = wrh + NEXP * DM;
    LAS float* red = (LAS float*)(F.lds);
    LAS float* part = (LAS float*)(F.lds + 4096);
    LAS int* cntl = (LAS int*)(F.lds + 4096 + 32768);
    LAS int* basel = cntl + 64;
    LAS int* rec_e = basel + 64;
    LAS int* rec_p = rec_e + 256;
    LAS float* rec_w = (LAS float*)(rec_p + 256);
    const int lane = F.lane, w = F.wave, gi = w >> 2, kq = w & 3, t = lane & 15, q = lane >> 4;
    for (int blk = F.vcu; blk < SEQ / 32; blk += F.G) {
        const int tok = blk * 32 + gi * 16 + t;
        if (F.tid < 64) cntl[F.tid] = 0;
        float s1 = 0.f, s2 = 0.f;
        const float* prow = F.in[0] + (size_t)tok * DM + kq * 512 + 4 * q; const bf16* mrow = mixb + (size_t)tok * DM + kq * 512 + 4 * q;
        f32x4v hv[16][2];
#pragma unroll
        for (int sg = 0; sg < 4; ++sg) {
            f32x4v xa[4][2]; v2u ma[4][2];
#pragma unroll
            for (int u = 0; u < 4; ++u) { const int s = 4 * sg + u; xa[u][0] = *(const f32x4v*)(prow + 32 * s); xa[u][1] = *(const f32x4v*)(prow + 32 * s + 16); ma[u][0] = *(const v2u*)(mrow + 32 * s); ma[u][1] = *(const v2u*)(mrow + 32 * s + 16); }
            __builtin_amdgcn_sched_barrier(0);
#pragma unroll
            for (int u = 0; u < 4; ++u) { const int s = 4 * sg + u; const v2u m0 = ma[u][0], m1 = ma[u][1];
                const f32x4v v0 = xa[u][0] * ALPHA + (f32x4v){pg8::bf_lo(m0.x), pg8::bf_hi(m0.x), pg8::bf_lo(m0.y), pg8::bf_hi(m0.y)}, v1 = xa[u][1] * ALPHA + (f32x4v){pg8::bf_lo(m1.x), pg8::bf_hi(m1.x), pg8::bf_lo(m1.y), pg8::bf_hi(m1.y)};
                hv[s][0] = v0; hv[s][1] = v1;
#pragma unroll
                for (int j = 0; j < 4; ++j) { s1 += v0[j] + v1[j]; s2 += v0[j] * v0[j] + v1[j] * v1[j]; } }
            __builtin_amdgcn_sched_barrier(0);
        }
        s1 += __shfl_xor(s1, 16); s1 += __shfl_xor(s1, 32); s2 += __shfl_xor(s2, 16); s2 += __shfl_xor(s2, 32);
        if (q == 0) { red[(w * 16 + t) * 2] = s1; red[(w * 16 + t) * 2 + 1] = s2; }
        __syncthreads();
        float m1 = 0.f, m2 = 0.f;
#pragma unroll
        for (int k = 0; k < 4; ++k) { m1 += red[((gi * 4 + k) * 16 + t) * 2]; m2 += red[((gi * 4 + k) * 16 + t) * 2 + 1]; }
        const float mean = m1 * (1.0f / DM); const float var = m2 * (1.0f / DM) - mean * mean; const float rstd = 1.0f / sqrtf(var + LN_EPS);
        f32x4v acc[4] = {};
        const float* gp = F.in[10] + kq * 512 + 4 * q; const float* bp = F.in[11] + kq * 512 + 4 * q;
        bf16* brow = hbf + (size_t)tok * DM + kq * 512 + 4 * q; unsigned char* frow = F.ws + WS_HF8 + (size_t)tok * DM + kq * 512 + 4 * q;
        struct P5Set { f32x4v g0, g1, b0, b1; bf16x8 Bh[4], Bl[4]; };
        P5Set A_; const unsigned lane8 = (unsigned)lane * 8u;
#define P5_LOAD(S, X) do { X.g0 = *(const f32x4v*)(gp + 32 * (S)); X.g1 = *(const f32x4v*)(gp + 32 * (S) + 16); X.b0 = *(const f32x4v*)(bp + 32 * (S)); X.b1 = *(const f32x4v*)(bp + 32 * (S) + 16); \
            { const bf16* wuh_ = wrh + (size_t)((kq * 16 + (S)) * 2048); const bf16* wul_ = wuh_ + NEXP * DM;     \
              asm volatile("" : "+s"(wuh_), "+s"(wul_));                                                         \
              _Pragma("unroll") for (int nt = 0; nt < 4; ++nt) { X.Bh[nt] = *(const bf16x8*)(wuh_ + nt * 512 + lane8); X.Bl[nt] = *(const bf16x8*)(wul_ + nt * 512 + lane8); } } } while (0)
#define P5_COMP(S, X) do { const f32x4v p0_ = hv[S][0], p1_ = hv[S][1]; \
            const f32x4v y0 = (p0_ - mean) * rstd * X.g0 + X.b0, y1 = (p1_ - mean) * rstd * X.g1 + X.b1; \
            v4u ah, al; ah.x = pg8::cvt_pk_bf16(y0[0], y0[1]); ah.y = pg8::cvt_pk_bf16(y0[2], y0[3]); ah.z = pg8::cvt_pk_bf16(y1[0], y1[1]); ah.w = pg8::cvt_pk_bf16(y1[2], y1[3]); \
            al.x = pg8::cvt_pk_bf16(y0[0] - pg8::bf_lo(ah.x), y0[1] - pg8::bf_hi(ah.x)); al.y = pg8::cvt_pk_bf16(y0[2] - pg8::bf_lo(ah.y), y0[3] - pg8::bf_hi(ah.y)); \
            al.z = pg8::cvt_pk_bf16(y1[0] - pg8::bf_lo(ah.z), y1[1] - pg8::bf_hi(ah.z)); al.w = pg8::cvt_pk_bf16(y1[2] - pg8::bf_lo(ah.w), y1[3] - pg8::bf_hi(ah.w)); \
            *(v2u*)(brow + 32 * (S)) = (v2u){ah.x, ah.y}; *(v2u*)(brow + 32 * (S) + 16) = (v2u){ah.z, ah.w}; \
            { int t0_ = __builtin_amdgcn_cvt_pk_fp8_f32(y0[0], y0[1], 0, false); t0_ = __builtin_amdgcn_cvt_pk_fp8_f32(y0[2], y0[3], t0_, true); \
              int t1_ = __builtin_amdgcn_cvt_pk_fp8_f32(y1[0], y1[1], 0, false); t1_ = __builtin_amdgcn_cvt_pk_fp8_f32(y1[2], y1[3], t1_, true); \
              *(int*)(frow + 32 * (S)) = t0_; *(int*)(frow + 32 * (S) + 16) = t1_; } \
            const bf16x8 Ah = __builtin_bit_cast(bf16x8, ah), Al = __builtin_bit_cast(bf16x8, al); \
            _Pragma("unroll") for (int nt = 0; nt < 4; ++nt) { acc[nt] = __builtin_amdgcn_mfma_f32_16x16x32_bf16(Ah, X.Bh[nt], acc[nt], 0, 0, 0); \
                acc[nt] = __builtin_amdgcn_mfma_f32_16x16x32_bf16(Al, X.Bh[nt], acc[nt], 0, 0, 0); acc[nt] = __builtin_amdgcn_mfma_f32_16x16x32_bf16(Ah, X.Bl[nt], acc[nt], 0, 0, 0); } } while (0)
#pragma unroll
        for (int s = 0; s < 16; ++s) {
            P5_LOAD(s, A_); __builtin_amdgcn_sched_barrier(0);
            P5_COMP(s, A_); __builtin_amdgcn_sched_barrier(0);
        }
#undef P5_LOAD
#undef P5_COMP
#pragma unroll
        for (int nt = 0; nt < 4; ++nt)
#pragma unroll
            for (int r = 0; r < 4; ++r) part[(w * 16 + 4 * q + r) * 64 + 16 * nt + t] = acc[nt][r];
        __syncthreads();
#ifdef PROBE_P5
        if (PROBE_P5 >= 2 && probe_rep) { __syncthreads(); continue; }
#endif
        const float rb = F.in[13][lane];
#pragma unroll 1
        for (int i = 0; i < 4; ++i) {
            const int tl = w * 4 + i, g2 = tl >> 4, tt = tl & 15;
            float logit = 0.f;
#pragma unroll
            for (int k = 0; k < 4; ++k) logit += part[((g2 * 4 + k) * 16 + tt) * 64 + lane];
            const float sc = 1.0f / (1.0f + expf(-logit));
            const float b = sc + rb;
            float mx = b; mx = fmaxf(mx, __shfl_xor(mx, 1)); mx = fmaxf(mx, __shfl_xor(mx, 2)); mx = fmaxf(mx, __shfl_xor(mx, 4));
            const unsigned long long bal = __ballot(b == mx); const unsigned gm = (unsigned)(bal >> (lane & ~7)) & 0xffu; const int first = __builtin_ctz(gm);
            float b2 = ((lane & 7) == first) ? -INFINITY : b; b2 = fmaxf(b2, __shfl_xor(b2, 1)); b2 = fmaxf(b2, __shfl_xor(b2, 2)); b2 = fmaxf(b2, __shfl_xor(b2, 4));
            const float gs = mx + b2; const int grp = lane >> 3; int gc = 0;
#pragma unroll
            for (int g3 = 0; g3 < 8; ++g3) { const float o = __uint_as_float(__builtin_amdgcn_readlane(__float_as_uint(gs), g3 * 8)); gc += (o > gs || (o == gs && g3 < grp)) ? 1 : 0; }
            const float mk = gc < 4 ? b : -INFINITY; int rank = 0;
#pragma unroll
            for (int j = 0; j < 64; ++j) { const float o = __uint_as_float(__builtin_amdgcn_readlane(__float_as_uint(mk), j)); rank += (o > mk || (o == mk && j < lane)) ? 1 : 0; }
            const bool sel = (gc < 4) && rank < 8;
            const float wsum = wave_sum(sel ? sc : 0.f);
            if (sel) { const int lp = atomicAdd((int*)(cntl + lane), 1); rec_e[tl * 8 + rank] = lane; rec_p[tl * 8 + rank] = lp; rec_w[tl * 8 + rank] = sc / wsum * ROUTED_SCALE; }
        }
        __syncthreads();
#ifdef PROBE_P5
        if (PROBE_P5 == 1 && probe_rep) { __syncthreads(); continue; }
#endif
        if (F.tid < 64) basel[F.tid] = (int)atomicAdd(F.ctl + CW_CNT + F.tid, (unsigned)cntl[F.tid]);
        __syncthreads();
        if (F.tid < 256) { const int tl = F.tid >> 3, e = rec_e[F.tid], pos = basel[e] + rec_p[F.tid]; const int token = blk * 32 + tl;
            ((int*)(F.ws + WS_LTOK))[e * LCAP + pos] = token; ((float*)(F.ws + WS_LW))[e * LCAP + pos] = rec_w[F.tid];
            int* rt = (int*)(F.ws + WS_ROUTE); rt[(token * 8 + (F.tid & 7)) * 2] = e; rt[(token * 8 + (F.tid & 7)) * 2 + 1] = pos; }
        __syncthreads();
    }
}

__device__ __forceinline__ void moe_build_tst(Frame& F) {
    LAS int* tst = (LAS int*)(F.lds + TST_OFF);
    if (F.tid == 0) { int acc = 0; for (int e = 0; e < NEXP1; ++e) { tst[e] = acc; const unsigned c = e < NEXP ? __hip_atomic_load(F.ctl + CW_CNT + e, RLX_AGENT) : (unsigned)SEQ; acc += (int)((c + 255u) >> 8); } tst[NEXP1] = acc; }
    __syncthreads();
}

__device__ __forceinline__ void p9_combine(Frame& F) {
    const LAS int* tst = (const LAS int*)(F.lds + TST_OFF);
    const int gw = F.vcu * NWAVES + F.wave, NGW = F.G * NWAVES; const int lane = F.lane;
    const unsigned char* Y = (const unsigned char*)(F.ws + WS_Y); const bf16* hbf = (const bf16*)(F.ws + WS_HBF); const int* rt = (const int*)(F.ws + WS_ROUTE);
    unsigned rows[9];
#define P9_ROWS(dst, tok_) do { _Pragma("unroll") for (int k = 0; k < 8; ++k) { const int e = rt[((tok_) * 8 + k) * 2], pos = rt[((tok_) * 8 + k) * 2 + 1]; dst[k] = (unsigned)(tst[e] * 256 + pos) * (DM / 8); } \
        dst[8] = (unsigned)(tst[NEXP] * 256 + (tok_)) * (DM / 8); } while (0)
    for (int tok = gw; tok < SEQ; tok += NGW) {
        P9_ROWS(rows, tok);
        float v[4][8]; float s1 = 0.f;
#pragma unroll
        for (int c = 0; c < 4; ++c) { const int col = 512 * c + 8 * lane;
            const v4u hv = __builtin_nontemporal_load((const v4u*)(hbf + (size_t)tok * DM + col));
            const f32x4 a = {pg8::bf_lo(hv.x), pg8::bf_hi(hv.x), pg8::bf_lo(hv.y), pg8::bf_hi(hv.y)}, b = {pg8::bf_lo(hv.z), pg8::bf_hi(hv.z), pg8::bf_lo(hv.w), pg8::bf_hi(hv.w)};
            float r[8] = {0.f, 0.f, 0.f, 0.f, 0.f, 0.f, 0.f, 0.f};
#pragma unroll
            for (int k = 0; k < 9; ++k) { const v2u y = __builtin_nontemporal_load((const v2u*)Y + (size_t)rows[k] + (col >> 3));
                const auto q0 = __builtin_amdgcn_cvt_pk_f32_fp8((int)y.x, false), q1 = __builtin_amdgcn_cvt_pk_f32_fp8((int)y.x, true), q2 = __builtin_amdgcn_cvt_pk_f32_fp8((int)y.y, false), q3 = __builtin_amdgcn_cvt_pk_f32_fp8((int)y.y, true);
                r[0] += q0[0]; r[1] += q0[1]; r[2] += q1[0]; r[3] += q1[1]; r[4] += q2[0]; r[5] += q2[1]; r[6] += q3[0]; r[7] += q3[1]; }
#pragma unroll
            for (int j = 0; j < 4; ++j) { v[c][j] = ALPHA * a[j] + r[j] * (1.0f / YSCALE); v[c][4 + j] = ALPHA * b[j] + r[4 + j] * (1.0f / YSCALE); }
#pragma unroll
            for (int j = 0; j < 8; ++j) s1 += v[c][j]; }
        const float mean = wave_sum(s1) * (1.0f / DM); float s2 = 0.f;
#pragma unroll
        for (int c = 0; c < 4; ++c)
#pragma unroll
            for (int j = 0; j < 8; ++j) { v[c][j] -= mean; s2 += v[c][j] * v[c][j]; }
        const float rstd = 1.0f / sqrtf(wave_sum(s2) * (1.0f / DM) + LN_EPS);
#pragma unroll
        for (int c = 0; c < 4; ++c) { const int col = 512 * c + 8 * lane;
            const f32x4 g0 = *(const f32x4*)(F.in[20] + col), g1 = *(const f32x4*)(F.in[20] + col + 4), b0 = *(const f32x4*)(F.in[21] + col), b1 = *(const f32x4*)(F.in[21] + col + 4);
            f32x4 o0, o1;
#pragma unroll
            for (int j = 0; j < 4; ++j) { o0[j] = v[c][j] * rstd * g0[j] + b0[j]; o1[j] = v[c][4 + j] * rstd * g1[j] + b1[j]; }
            __builtin_nontemporal_store(o0, (f32x4*)(F.out + (size_t)tok * DM + col)); __builtin_nontemporal_store(o1, (f32x4*)(F.out + (size_t)tok * DM + col + 4)); }
    }
#undef P9_ROWS
}

constexpr int NPHASES = 10;
#ifndef MK_ONE_LAUNCH
#define MK_ONE_LAUNCH 1
#endif
__global__ void __launch_bounds__(NWAVES * 64, 2) mega_fwd(Args args) {
    extern __shared__ __attribute__((aligned(16))) unsigned char lds[];
    Frame F;
    F.lds = (LAS unsigned char*)lds;
    F.MISC = (volatile LAS unsigned*)(F.lds + MISC_OFF);
    F.tid = threadIdx.x; F.lane = F.tid & 63; F.wave = __builtin_amdgcn_readfirstlane(F.tid >> 6);
    F.G = gridDim.x; { const int bx = blockIdx.x; F.vcu = (F.G % 8 == 0) ? (bx % 8) * (F.G / 8) + bx / 8 : bx; }
#pragma unroll
    for (int i = 0; i < 22; ++i) F.in[i] = args.in[i];
    F.out = args.out; F.ws = args.ws; F.ctl = (unsigned*)(args.ws + WS_CTL);
    for (int u = F.tid; u < (LDS_BYTES - LDSCTL_OFF) / 4; u += NWAVES * 64) ((LAS unsigned*)(F.lds + LDSCTL_OFF))[u] = 0u;
    __syncthreads();
    XcdBarrier bar; bar.bar = F.ctl + CW_BAR; bar.x = 0; bar.st = nullptr; bar.total = 0; XcdBarrier barB = bar;
    const bool conv1 = (F.G == 256) && (F.vcu & 31) >= P1_NCG;
    if (MK_ONE_LAUNCH) { bar = xcd_barrier_post(F.ctl + CW_BAR, F.MISC + 8, (unsigned)F.G); }
    const int lo = args.ph_lo, hi = args.ph_hi;
#ifndef PH_MASK
#define PH_MASK 0x3ff
#endif
#define IN(k) (((PH_MASK >> (k)) & 1) && lo <= (k) && (k) < hi)
#ifndef REP_MASK
#define REP_MASK 0
#endif
#define REP(k) for (int rep_ = 0; rep_ < 1 + ((REP_MASK >> (k)) & 1); ++rep_)
#ifndef BAR_REP
#define BAR_REP 1
#endif
#define SEAM(k) do { if (IN(k) && IN((k) + 1)) for (int br_ = 0; br_ < BAR_REP; ++br_) xcd_barrier(bar); } while (0)
    LAS int* idxl = (LAS int*)(F.lds + IDXL_OFF);
    const bool tst_needed = true;

    if (IN(0)) REP(0) { p0_prologue(F, false); } SEAM(0);
    if (IN(1)) REP(1) {
        const int grp = F.vcu >> 5, cin = F.vcu & 31;
        const bool conv = (F.G == 256) && cin >= P1_NCG;
        if (conv) { const int cw = (grp * (32 - P1_NCG) + (cin - P1_NCG)) * NWAVES + F.wave; convert_items<1>(F, cw, NCONV1 * NWAVES, E_SPLIT); convert_items<2>(F, cw, NCONV1 * NWAVES, E2_A); }
        else {
            DenseOrder S; if (F.G == 256) S.init(F.ws + WS_XBF, F.ws + WS_WINT, SEQ, INC, DM, NCOMP1, cin * 8 + grp); else S.init(F.ws + WS_XBF, F.ws + WS_WINT, SEQ, INC, DM, F.G, (int)blockIdx.x);
            EpiProj E{(bf16*)(F.ws + WS_PROJ), F.in[2]};
            pg8::gemm_phase<EpiProj, DenseOrder, true, false, P1_FP8 != 0>(F.lds + RING_OFF, idxl, DM, S, E);
        }
    } SEAM(1);
    if (IN(2)) {
        p1b_qknorm(F);
        if (F.G == 256) {
            if (E_SPLIT >= NITEMS_E1 && (CONV_G1 ? E2_SPLIT : E2_A) >= NITEMS_E2) win_attention(F, F.vcu, 256);
            else if (F.vcu & 1) win_attention(F, F.vcu >> 1, 128);
            else { const int cw = (F.vcu >> 1) * NWAVES + F.wave;
                convert_items<1>(F, E_SPLIT + cw, 128 * NWAVES, NITEMS_E1); convert_items<2>(F, (CONV_G1 ? E2_SPLIT : E2_A) + cw, 128 * NWAVES, NITEMS_E2); }
        } else { win_attention(F, F.vcu, F.G); convert_items<1>(F, F.vcu * NWAVES + F.wave, F.G * NWAVES, NITEMS_E1); convert_items<2>(F, F.vcu * NWAVES + F.wave, F.G * NWAVES, NITEMS_E2); }
    } SEAM(2);
    if (IN(3)) REP(3) { p3_dense_attention(F); } SEAM(3);
    if (IN(4)) REP(4) {
        BranchOrder S{(const char*)(F.ws + WS_OA), (const char*)(F.ws + WS_OB), (const char*)(F.ws + WS_WAT), (const char*)(F.ws + WS_WBT), F.vcu};
        EpiBranch E{(const bf16*)(F.ws + WS_PROJ), F.ws + WS_MRG};
        if (F.vcu < 256) pg8::gemm_phase<EpiBranch, BranchOrder, false, false, true>(F.lds + RING_OFF, idxl, 1024, S, E);
    } SEAM(4);
    if (IN(5)) REP(5) {
        OneTileOrder S{(const char*)(F.ws + WS_MRG), (const char*)(F.ws + WS_WOT), F.vcu, (size_t)256 * DM};
        EpiMix E{(bf16*)(F.ws + WS_PRE)};
        if (F.vcu < 256) pg8::gemm_phase<EpiMix, OneTileOrder, false, false, true>(F.lds + RING_OFF, idxl, DM, S, E);
    } SEAM(5);
    if (IN(6)) REP(6) { if (rep_) { xcd_barrier(bar);
#ifndef PROBE_P5
            if (blockIdx.x == 0 && F.tid < 64) __hip_atomic_store(F.ctl + CW_CNT + F.tid, 0u, RLX_AGENT);
#endif
            xcd_barrier(bar); } p5_ln_router(F, rep_ != 0); } SEAM(6);
    if (IN(7) || IN(8) || IN(9)) { if (tst_needed) moe_build_tst(F); }
#ifndef DEFER_MAX
#define DEFER_MAX 64
#endif
    int n_defer = 0, u1_end = -1;
    if (IN(7) || IN(8)) { const int T_ = ((const LAS int*)(F.lds + TST_OFF))[NEXP1]; const int r_ = (4 * T_) % 256;
        if (F.G == 256 && !CONV_G1 && 4 * T_ > 256 && r_ > 0 && r_ <= DEFER_MAX && (lo <= 7 && 8 < hi)) { n_defer = r_; u1_end = 4 * T_ - r_; } }
    if (IN(7)) REP(7) {
        const bool split = CONV_G1 && F.G == 256, conv = split && ((F.vcu & 7) == 7);
        if (conv) { convert_items<2>(F, E2_A + (F.vcu >> 3) * NWAVES + F.wave, NCONV * NWAVES, E2_SPLIT); }
        else {
        MoeOrder<4> S{(const LAS int*)(F.lds + TST_OFF), (const char*)(F.ws + (G1_FP8 ? WS_HF8 : WS_HBF)), (const char*)(F.ws + WS_WGU), (const int*)(F.ws + WS_LTOK), (const float*)(F.ws + WS_LW), split ? F.vcu - (F.vcu >> 3) : F.vcu, split ? NCOMP : F.G, 0, (size_t)1024 * DM * (G1_FP8 ? 1 : 2), (size_t)256 * DM * (G1_FP8 ? 1 : 2), true,
                      0, u1_end, 0, nullptr, 0, 0};
        EpiMoe1 E{F.ws + WS_HID};
        pg8::gemm_phase<EpiMoe1, MoeOrder<4>, true, true, G1_FP8 != 0>(F.lds + RING_OFF, idxl, DM, S, E);
        }
    } SEAM(7);
    if (IN(8)) REP(8) {
        unsigned* dflag = F.ctl + CW_CNT + 128;
        if (n_defer > 0 && F.vcu >= 256 - n_defer) {
            MoeOrder<4> S1{(const LAS int*)(F.lds + TST_OFF), (const char*)(F.ws + (G1_FP8 ? WS_HF8 : WS_HBF)), (const char*)(F.ws + WS_WGU), (const int*)(F.ws + WS_LTOK), (const float*)(F.ws + WS_LW), F.vcu - (256 - n_defer), 256, 0, (size_t)1024 * DM * (G1_FP8 ? 1 : 2), (size_t)256 * DM * (G1_FP8 ? 1 : 2), true,
                           u1_end, u1_end + n_defer, 0, nullptr, 0, 0};
            EpiMoe1 E1{F.ws + WS_HID};
            pg8::gemm_phase<EpiMoe1, MoeOrder<4>, true, true, G1_FP8 != 0>(F.lds + RING_OFF, idxl, DM, S1, E1);
            if (F.tid == 0) { __builtin_amdgcn_fence(__ATOMIC_RELEASE, "agent"); asm volatile("s_waitcnt vmcnt(0)" ::: "memory"); __hip_atomic_fetch_add(dflag, 1u, __ATOMIC_RELAXED, __HIP_MEMORY_SCOPE_AGENT); }
        }
        MoeOrder<8> S{(const LAS int*)(F.lds + TST_OFF), (const char*)(F.ws + WS_HID), (const char*)(F.ws + WS_WD), (const int*)(F.ws + WS_LTOK), (const float*)(F.ws + WS_LW), F.vcu, F.G, (size_t)FE, (size_t)DM * FE, (size_t)256 * FE, false,
                      0, -1, n_defer, dflag, n_defer > 0 ? u1_end / 4 : 0, n_defer};
#ifndef G2_ALIGN
#define G2_ALIGN true
#endif
        EpiMoe2 E{(unsigned char*)(F.ws + WS_Y)};
        pg8::gemm_phase<EpiMoe2, MoeOrder<8>, G2_ALIGN, false, true>(F.lds + RING_OFF, idxl, FE, S, E);
    } SEAM(8);
    if (IN(9)) REP(9) { p9_combine(F); }
#ifdef PROBE_T
    { const LAS int* tst_ = (const LAS int*)(F.lds + TST_OFF); if (tst_[NEXP1] > PROBE_T && blockIdx.x == 0 && F.tid == 0) F.out[0] = __builtin_nanf(""); }
#endif
#undef IN
#undef SEAM
}

extern "C" void kernel_launch(void* const* d_in, const int* in_sizes, int n_in, void* d_out, int out_size, void* d_ws, size_t ws_size, hipStream_t stream) {
    static int grid = 0;
    if (grid == 0) {
        if (n_in != 22 || out_size != SEQ * DM || ws_size < WS_END) { fprintf(stderr, "kernel_launch: unexpected shapes (n_in %d, out %d, ws %zu < %zu); nothing launched\n", n_in, out_size, ws_size, (size_t)WS_END); grid = -1; return; }
        int dev = 0, cus = 0, per_cu = 0;
        if (hipGetDevice(&dev) != hipSuccess || hipDeviceGetAttribute(&cus, hipDeviceAttributeMultiprocessorCount, dev) != hipSuccess) { grid = -1; return; }
        if (hipFuncSetAttribute((const void*)mega_fwd, hipFuncAttributeMaxDynamicSharedMemorySize, LDS_BYTES) != hipSuccess) { fprintf(stderr, "kernel_launch: hipFuncSetAttribute failed\n"); grid = -1; return; }
        if (hipOccupancyMaxActiveBlocksPerMultiprocessor(&per_cu, (const void*)mega_fwd, NWAVES * 64, LDS_BYTES) != hipSuccess || per_cu < 1) { fprintf(stderr, "kernel_launch: occupancy query says %d blocks per CU; nothing launched\n", per_cu); (void)hipGetLastError(); grid = -1; return; }
        grid = cus;
        if (grid > 256) grid = 256;
    }
    if (grid < 0) return;
    (void)hipMemsetAsync((char*)d_ws + WS_CTL, 0, CTL_ZERO_BYTES, stream);
    Args a{};
    for (int i = 0; i < 22; ++i) a.in[i] = (const float*)d_in[i];
    a.out = (float*)d_out; a.ws = (unsigned char*)d_ws;
#if MK_ONE_LAUNCH
    a.ph_lo = 0; a.ph_hi = NPHASES;
    hipLaunchKernelGGL(mega_fwd, dim3(grid), dim3(NWAVES * 64), LDS_BYTES, stream, a);
#else
    for (int p = 0; p < NPHASES; ++p) { a.ph_lo = p; a.ph_hi = p + 1; hipLaunchKernelGGL(mega_fwd, dim3(grid), dim3(NWAVES * 64), LDS_BYTES, stream, a); }
#endif
    const hipError_t le = hipPeekAtLastError();
    if (le != hipSuccess) fprintf(stderr, "kernel_launch: launch failed: %s\n", hipGetErrorName(le));
}
```

```cpp
#define P1_NCG 13
#define CONV_Q 59
#define P1_QE2 28
#define CONV_G1 0
#include <hip/hip_runtime.h>
#include <hip/hip_bf16.h>
#include <cstdio>
#include <cstdint>
#include <cmath>
namespace pg8 {
#define PG8_LAS __attribute__((address_space(3)))
typedef unsigned short bf16_t;
typedef short bf16x8 __attribute__((ext_vector_type(8)));
typedef float f32x4 __attribute__((ext_vector_type(4)));
typedef unsigned u32x4 __attribute__((ext_vector_type(4)));
typedef int v4i_t __attribute__((ext_vector_type(4)));
typedef int v8i_t __attribute__((ext_vector_type(8)));
constexpr int BM = 256, BK = 64, HALF = 128, HTB = HALF * BK * 2  , STAGE_BYTES = 8 * HTB;

__host__ __device__ __forceinline__ int lds_byte(int r, int c) { const int st = (r >> 4) * 2 + (c >> 5), rr = r & 15, cc = c & 31, ob = rr * 64 + cc * 2; return st * 1024 + (ob ^ (((ob >> 9) & 1) << 5)); }
__host__ __device__ __forceinline__ void stage_rc(int b, int& R, int& C) { const int st = b / 1024, sb = b % 1024, swz = sb ^ (((sb >> 9) & 1) << 5); R = (st >> 1) * 16 + swz / 64; C = (st & 1) * 32 + (swz % 64) / 2; }
__host__ __device__ __forceinline__ int perm32(int rho) { const int n = rho >> 4, i = rho & 15; return 8 * (i >> 2) + 4 * n + (i & 3); }

struct Unit { const char* A; const char* B; const int* idx; const float* wts; int r0, c0, aux, kind; };

typedef float f32x2_t __attribute__((ext_vector_type(2))); typedef __bf16 bf16x2_t __attribute__((ext_vector_type(2)));
__device__ __forceinline__ unsigned cvt_pk_bf16(float lo, float hi) { f32x2_t v = {lo, hi}; bf16x2_t b = __builtin_convertvector(v, bf16x2_t); return __builtin_bit_cast(unsigned, b); }
__device__ __forceinline__ float bf_lo(unsigned w) { return __uint_as_float(w << 16); }
__device__ __forceinline__ float bf_hi(unsigned w) { return __uint_as_float(w & 0xffff0000u); }

template <class Epi, class Sched, bool ALIGN_EPI, bool GATHER, bool FP8 = false>
__device__ __forceinline__ void gemm_phase(PG8_LAS unsigned char* lds, PG8_LAS int* idxl, const int K, const Sched& S, const Epi& E) {
    PG8_LAS float* wl = (PG8_LAS float*)(idxl + 256);
    const int tid = threadIdx.x, wid = __builtin_amdgcn_readfirstlane(tid >> 6), lane = tid & 63, wr = wid >> 2, wc = wid & 3, fr = lane & 15, fq = lane >> 4;
    const int KB = FP8 ? K : 2 * K;
    const int nt = KB / 128;
    const size_t kstep = (size_t)(BK * 2);
    const size_t hstep = (size_t)HALF * KB;
    unsigned voffA0[2], voffA1[2], voffB[2];
#pragma unroll
    for (int i = 0; i < 2; ++i) { int R, C; stage_rc(tid * 16 + i * 8192, R, C); const int Rb = Epi::PERM ? ((R & ~31) + perm32(R & 31)) : R;
        voffA0[i] = (unsigned)(R * KB + C * 2); voffA1[i] = voffA0[i] + (unsigned)hstep; voffB[i] = (unsigned)(Rb * KB + C * 2); }
    const unsigned ldsw = (unsigned)wid * 1024u;
    const int aoff = FP8 ? lds_byte(wr * 64 + fr, (fq >> 1) * 32 + (fq & 1) * 16) : lds_byte(wr * 64 + fr, fq * 8), boff = FP8 ? lds_byte(wc * 32 + fr, (fq >> 1) * 32 + (fq & 1) * 16) : lds_byte(wc * 32 + fr, fq * 8);
#define PG8_SA(b, h) (((b) * 2 + (h)) * HTB)
#define PG8_SB(b, h) ((4 + (b) * 2 + (h)) * HTB)
#define PG8_STAGE(bufoff, gbase, voff) do { _Pragma("unroll") for (int _i = 0; _i < 2; ++_i) \
        __builtin_amdgcn_global_load_lds((const unsigned*)((const char*)(gbase) + (voff)[_i]), (PG8_LAS unsigned*)(lds + (bufoff) + ldsw + _i * 8192), 16, 0, 0); } while (0)
#define PG8_LD8(addr) __builtin_shufflevector(*(const PG8_LAS v4i_t*)(addr), *(const PG8_LAS v4i_t*)((addr) + 16), 0, 1, 2, 3, 4, 5, 6, 7)
#define PG8_LDA(dst, b, h) do { if constexpr (FP8) { _Pragma("unroll") for (int m = 0; m < 4; ++m) dst##8[m] = PG8_LD8(lds + PG8_SA(b, h) + aoff + m * 2048); } \
        else { _Pragma("unroll") for (int m = 0; m < 4; ++m) _Pragma("unroll") for (int k = 0; k < 2; ++k) dst[m][k] = *(const PG8_LAS bf16x8*)(lds + PG8_SA(b, h) + aoff + m * 2048 + k * 1024); } } while (0)
#define PG8_LDB(dst, b, h) do { if constexpr (FP8) { _Pragma("unroll") for (int n = 0; n < 2; ++n) dst##8[n] = PG8_LD8(lds + PG8_SB(b, h) + boff + n * 2048); } \
        else { _Pragma("unroll") for (int n = 0; n < 2; ++n) _Pragma("unroll") for (int k = 0; k < 2; ++k) dst[n][k] = *(const PG8_LAS bf16x8*)(lds + PG8_SB(b, h) + boff + n * 2048 + k * 1024); } } while (0)
#define PG8_MMA(ai, bj, At, Bt) do { __builtin_amdgcn_s_setprio(1); _Pragma("unroll") for (int m = 0; m < 4; ++m) _Pragma("unroll") for (int n = 0; n < 2; ++n) { \
        if constexpr (FP8) asm volatile("v_mfma_scale_f32_16x16x128_f8f6f4 %0, %1, %2, %0, %3, %3 op_sel_hi:[0,0,0]" : "+v"(acc[ai][bj][m][n]) : "v"(Bt##8[n]), "v"(At##8[m]), "v"(one_scale)); \
        else { _Pragma("unroll") for (int k = 0; k < 2; ++k) acc[ai][bj][m][n] = __builtin_amdgcn_mfma_f32_16x16x32_bf16(Bt[n][k], At[m][k], acc[ai][bj][m][n], 0, 0, 0); } } __builtin_amdgcn_s_setprio(0); } while (0)
#define PG8_WAIT_V(n) asm volatile("s_waitcnt vmcnt(" #n ")" ::: "memory")
#define PG8_WAIT_L(n) asm volatile("s_waitcnt lgkmcnt(" #n ")" ::: "memory")
#define PG8_WAIT_VN(n) asm volatile("s_waitcnt vmcnt(%0)" :: "n"(n) : "memory")
#define PG8_WAIT_VR(sel) do { if constexpr (Epi::NST > 0) { int _sg; asm volatile("v_readfirstlane_b32 %0, %1\n\ts_nop 0\n\ts_cmp_lg_u32 %0, 0\n\ts_cbranch_scc1 1f\n\ts_waitcnt vmcnt(8)\n\ts_branch 2f\n1:\n\ts_waitcnt vmcnt(%2)\n2:" \
            : "=&s"(_sg) : "v"(sel), "n"(8 + Epi::NST) : "memory", "scc"); } \
        else asm volatile("s_waitcnt vmcnt(8)" ::: "memory"); } while (0)
#define PG8_BAR __builtin_amdgcn_s_barrier()
#define PG8_SCHED __builtin_amdgcn_sched_barrier(0)
#define PG8_GOFF(src) do { _Pragma("unroll") for (int _i = 0; _i < 2; ++_i) { int R_, C_; stage_rc(tid * 16 + _i * 8192, R_, C_); \
        voffA0[_i] = (unsigned)((src)[R_] * KB + C_ * 2); voffA1[_i] = (unsigned)((src)[R_ + HALF] * KB + C_ * 2); } } while (0)
    Unit cur, nxt; int ui = 0;
    if (!S.next(0, cur)) return;
    f32x4 acc[2][2][4][2];
#pragma unroll
    for (int a = 0; a < 2; ++a)
#pragma unroll
        for (int b = 0; b < 2; ++b)
#pragma unroll
            for (int m = 0; m < 4; ++m)
#pragma unroll
                for (int n = 0; n < 2; ++n) acc[a][b][m][n] = (f32x4){0.f, 0.f, 0.f, 0.f};
    bf16x8 At[4][2], B0[2][2], B1[2][2];
    v8i_t At8[4], B08[2], B18[2];
    int one_scale = 0x7f7f7f7f; asm volatile("" : "+v"(one_scale));
    const char* cA = cur.A; const char* cB = cur.B;
    if constexpr (GATHER) { PG8_GOFF(cur.idx); if (tid >= 256) wl[tid - 256] = cur.wts[tid - 256]; }
    PG8_STAGE(PG8_SB(0, 0), cB, voffB); PG8_STAGE(PG8_SB(0, 1), cB + hstep, voffB); PG8_STAGE(PG8_SA(0, 0), cA, voffA0); PG8_STAGE(PG8_SA(0, 1), cA, voffA1);
    if (wr == 1) PG8_BAR;
    PG8_WAIT_V(2); PG8_BAR;
    PG8_STAGE(PG8_SB(1, 0), cB + kstep, voffB); PG8_STAGE(PG8_SA(1, 0), cA + kstep, voffA0); PG8_STAGE(PG8_SB(1, 1), cB + hstep + kstep, voffB);
    PG8_WAIT_V(6); PG8_BAR;
    for (;;) {
        const bool has_next = S.next(ui + 1, nxt);
        const char* nA = has_next ? nxt.A : cA; const char* nB = has_next ? nxt.B : cB;
        if constexpr (GATHER) { if (has_next && tid < 256) {
            __builtin_amdgcn_global_load_lds((const unsigned*)(nxt.idx + tid), (PG8_LAS unsigned*)((PG8_LAS unsigned char*)idxl + wid * 256), 4, 0, 0); }
          if (has_next && tid >= 256) {
            __builtin_amdgcn_global_load_lds((const unsigned*)(nxt.wts + (tid - 256)), (PG8_LAS unsigned*)((PG8_LAS unsigned char*)(wl + ((ui + 1) & 1) * 256) + (wid - 4) * 256), 4, 0, 0); } }
#pragma unroll 1
        for (int t = 0; t < nt; t += 2) {
            const bool last = (t == nt - 2);
            const char* a1 = cA + (size_t)(t + 1) * kstep;
            const char* a2 = last ? nA : cA + (size_t)(t + 2) * kstep; const char* b2 = last ? nB : cB + (size_t)(t + 2) * kstep;
            const char* a3 = a2 + kstep; const char* b3 = b2 + kstep;
            const int rlx = (t == 0 && ui > 0) ? 1 : 0;
            PG8_LDB(B0, 0, 0); PG8_LDB(B1, 0, 1); PG8_SCHED; PG8_LDA(At, 0, 0); PG8_STAGE(PG8_SA(1, 1), a1, voffA1);
            if constexpr (GATHER) { if (last && has_next) { PG8_GOFF(idxl); } }
            PG8_WAIT_VR(rlx); PG8_WAIT_L(0); PG8_BAR; PG8_MMA(0, 0, At, B0); PG8_MMA(0, 1, At, B1); PG8_BAR; PG8_SCHED;
            PG8_LDA(At, 0, 1); PG8_STAGE(PG8_SB(0, 0), b2, voffB); PG8_STAGE(PG8_SB(0, 1), b2 + hstep, voffB); PG8_STAGE(PG8_SA(0, 0), a2, voffA0);
            PG8_WAIT_VR(rlx); PG8_WAIT_L(0); PG8_BAR; PG8_MMA(1, 0, At, B0); PG8_MMA(1, 1, At, B1); PG8_BAR; PG8_SCHED;
            PG8_LDB(B0, 1, 0); PG8_LDB(B1, 1, 1); PG8_SCHED; PG8_LDA(At, 1, 0); PG8_STAGE(PG8_SA(0, 1), a2, voffA1);
            PG8_WAIT_V(8); PG8_WAIT_L(0); PG8_BAR; PG8_MMA(0, 0, At, B0); PG8_MMA(0, 1, At, B1); PG8_BAR; PG8_SCHED;
            PG8_LDA(At, 1, 1); PG8_STAGE(PG8_SB(1, 0), b3, voffB); PG8_STAGE(PG8_SB(1, 1), b3 + hstep, voffB); PG8_STAGE(PG8_SA(1, 0), a3, voffA0);
            PG8_WAIT_V(8); PG8_WAIT_L(0); PG8_BAR; PG8_MMA(1, 0, At, B0); PG8_MMA(1, 1, At, B1); PG8_BAR; PG8_SCHED;
        }
        if constexpr (ALIGN_EPI) { if (wr == 0) PG8_BAR; }
        if constexpr (FP8) asm volatile("s_nop 15\n\ts_nop 15" ::: "memory");
        const bool keep = E(acc, cur, wr, wc, fr, fq, wl + (ui & 1) * 256);
        if (!has_next) break;
        if (!keep) {
#pragma unroll
        for (int a = 0; a < 2; ++a)
#pragma unroll
            for (int b = 0; b < 2; ++b)
#pragma unroll
                for (int m = 0; m < 4; ++m)
#pragma unroll
                    for (int n = 0; n < 2; ++n) acc[a][b][m][n] = (f32x4){0.f, 0.f, 0.f, 0.f};
        }
        cur = nxt; cA = nA; cB = nB; ++ui;
        if constexpr (ALIGN_EPI) { if (wr == 1) PG8_BAR; }
    }
    PG8_WAIT_V(0);
    if constexpr (!ALIGN_EPI) { if (wr == 0) PG8_BAR; }
    PG8_BAR;
#undef PG8_SA
#undef PG8_SB
#undef PG8_STAGE
#undef PG8_LDA
#undef PG8_LDB
#undef PG8_MMA
#undef PG8_LD8
#undef PG8_WAIT_V
#undef PG8_WAIT_L
#undef PG8_WAIT_VN
#undef PG8_WAIT_VR
#undef PG8_BAR
#undef PG8_SCHED
#undef PG8_GOFF
}
}
namespace attn {
using bf16 = __hip_bfloat16;
constexpr int   D = 128, NW = 8, QBLK = 32, KVBLK = 64;
constexpr float SCALE = 0.088388347648318440f;
constexpr float THR = 8.f;
constexpr float LOG2E = 1.4426950408889634f;
#ifndef PROJ_PAD
#define PROJ_PAD 64
#endif
constexpr int LDQ = 7168 + PROJ_PAD, LDK = 7168 + PROJ_PAD, LDO = 1024;
constexpr size_t SHM_V = KVBLK * D * 2, SHM_K = KVBLK * D * 2, SHM_ATTN = 2 * SHM_V + 2 * SHM_K + NW * 64 * 4;
constexpr int WIN_TAB = (int)SHM_ATTN;

using bf16x8 = __attribute__((ext_vector_type(8))) short;
using s16x4  = __attribute__((ext_vector_type(4))) short;
using f32x16 = __attribute__((ext_vector_type(16))) float;
using u32x4  = __attribute__((ext_vector_type(4))) unsigned;
using f32x4_a = __attribute__((ext_vector_type(4))) float;
#define KSWZ(row, colB) ((row) * 256 + ((colB) ^ (((row) & 7) << 4)))
#define SBAR() __builtin_amdgcn_sched_barrier(0)
__device__ __forceinline__ int crow(int r, int hi) { return (r & 3) + 8 * (r >> 2) + 4 * hi; }
__device__ __forceinline__ unsigned cvtpk(float lo, float hi) { return pg8::cvt_pk_bf16(lo, hi); }
template <bool FIXM>
__device__ __forceinline__ void partialSM(f32x16& p0, f32x16& p1, float& m_reg, float& mn, float& alpha) {
  constexpr float C = SCALE * LOG2E;
  if constexpr (FIXM) {
    mn = m_reg; alpha = 1.f; float mnC = -m_reg * C; asm volatile("" : "+v"(mnC));
    typedef float f32x2_p __attribute__((ext_vector_type(2))); const f32x2_p c2 = {C, C}, m2 = {mnC, mnC};
#pragma unroll
    for (int r = 0; r < 16; r += 2) { f32x2_p a = {p0[r], p0[r + 1]}, b = {p1[r], p1[r + 1]}; a = __builtin_elementwise_fma(a, c2, m2); b = __builtin_elementwise_fma(b, c2, m2); p0[r] = a[0]; p0[r + 1] = a[1]; p1[r] = b[0]; p1[r + 1] = b[1]; }
    for (int r = 0; r < 16; ++r) p0[r] = __builtin_amdgcn_exp2f(p0[r]);
    return;
  }
  float pmax = p0[0]; for (int r = 1; r < 16; ++r) pmax = fmaxf(pmax, p0[r]); for (int r = 0; r < 16; ++r) pmax = fmaxf(pmax, p1[r]);
  { auto rr = __builtin_amdgcn_permlane32_swap(__float_as_uint(pmax), __float_as_uint(pmax), false, false);
    pmax = fmaxf(__uint_as_float(rr[0]), __uint_as_float(rr[1])); }
  if (__builtin_expect(__all(pmax - m_reg <= THR / SCALE), 1)) { mn = m_reg; alpha = 1.f; }
  else { mn = fmaxf(m_reg, pmax); alpha = __builtin_amdgcn_exp2f((m_reg - mn) * C); m_reg = mn; }
  float mnC = -mn * C;
  for (int r = 0; r < 16; ++r) p0[r] = fmaf(p0[r], C, mnC); for (int r = 0; r < 16; ++r) p1[r] = fmaf(p1[r], C, mnC);
  for (int r = 0; r < 16; ++r) p0[r] = __builtin_amdgcn_exp2f(p0[r]);
}
__device__ __forceinline__ void finishSM(f32x16& p0, f32x16& p1, float alpha, float& l_reg, bf16x8& pa0, bf16x8& pa1, bf16x8& pa2, bf16x8& pa3) {
  for (int r = 0; r < 16; ++r) p1[r] = __builtin_amdgcn_exp2f(p1[r]);
  float ps = 0; for (int r = 0; r < 16; ++r) ps += p0[r]; for (int r = 0; r < 16; ++r) ps += p1[r];
  { auto rr = __builtin_amdgcn_permlane32_swap(__float_as_uint(ps), __float_as_uint(ps), false, false);
    ps = __uint_as_float(rr[0]) + __uint_as_float(rr[1]); }
  l_reg = l_reg * alpha + ps;
#define PK4(P, BASE, OUT) do { unsigned a0 = cvtpk(P[BASE + 0], P[BASE + 1]), a1 = cvtpk(P[BASE + 2], P[BASE + 3]);   \
    unsigned b0 = cvtpk(P[BASE + 4], P[BASE + 5]), b1 = cvtpk(P[BASE + 6], P[BASE + 7]);                              \
    auto r0 = __builtin_amdgcn_permlane32_swap(a0, b0, false, false); auto r1 = __builtin_amdgcn_permlane32_swap(a1, b1, false, false); \
    u32x4 w = {r0[0], r1[0], r0[1], r1[1]}; OUT = *reinterpret_cast<bf16x8*>(&w); } while (0)
  PK4(p0, 0, pa0); PK4(p0, 8, pa1); PK4(p1, 0, pa2); PK4(p1, 8, pa3);
#undef PK4
}
#define KSWZ8(row, colB) ((row) * 128 + ((colB) ^ (((row) & 7) << 4)))
typedef int v8i_a __attribute__((ext_vector_type(8))); typedef int v4i_a __attribute__((ext_vector_type(4)));
template <bool WIN, bool F8>
__device__ __forceinline__ void qkt(f32x16& p0, f32x16& p1, const bf16* Ks, const bf16x8* qr, const v8i_a* q8, int r32, int hi, const __attribute__((address_space(3))) float* tb) {
  if constexpr (F8) {
    int one = 0x7f7f7f7f; asm volatile("" : "+v"(one));
#pragma unroll
    for (int s = 0; s < 2; ++s) { const int cb = 64 * s + 32 * hi;
      const char* ka = (const char*)Ks + KSWZ8(r32, cb); const char* kb = (const char*)Ks + KSWZ8(32 + r32, cb);
      const v8i_a k0 = __builtin_shufflevector(*reinterpret_cast<const v4i_a*>(ka), *reinterpret_cast<const v4i_a*>((const char*)Ks + KSWZ8(r32, cb + 16)), 0, 1, 2, 3, 4, 5, 6, 7);
      const v8i_a k1 = __builtin_shufflevector(*reinterpret_cast<const v4i_a*>(kb), *reinterpret_cast<const v4i_a*>((const char*)Ks + KSWZ8(32 + r32, cb + 16)), 0, 1, 2, 3, 4, 5, 6, 7);
      if (s == 0) {
        asm volatile("s_nop 1\n\tv_mfma_scale_f32_32x32x64_f8f6f4 %0, %1, %2, 0, %3, %3 op_sel_hi:[0,0,0]" : "=&v"(p0) : "v"(k0), "v"(q8[s]), "v"(one));
        asm volatile("v_mfma_scale_f32_32x32x64_f8f6f4 %0, %1, %2, 0, %3, %3 op_sel_hi:[0,0,0]" : "=&v"(p1) : "v"(k1), "v"(q8[s]), "v"(one));
      } else {
        asm volatile("v_mfma_scale_f32_32x32x64_f8f6f4 %0, %1, %2, %0, %3, %3 op_sel_hi:[0,0,0]" : "+v"(p0) : "v"(k0), "v"(q8[s]), "v"(one));
        asm volatile("v_mfma_scale_f32_32x32x64_f8f6f4 %0, %1, %2, %0, %3, %3 op_sel_hi:[0,0,0]" : "+v"(p1) : "v"(k1), "v"(q8[s]), "v"(one)); } }
    asm volatile("s_nop 15\n\ts_nop 15" : "+v"(p0), "+v"(p1));
    return;
  }
  if constexpr (WIN) {
#pragma unroll
    for (int r = 0; r < 16; ++r) { p0[r] = tb[(r & 3) + 8 * (r >> 2)]; p1[r] = tb[32 + (r & 3) + 8 * (r >> 2)]; }
  } else { p0 = f32x16{}; p1 = f32x16{}; }
  for (int d0 = 0; d0 < 8; ++d0) { int cb = (d0 * 16 + hi * 8) * 2;
    bf16x8 b0 = *reinterpret_cast<const bf16x8*>((const char*)Ks + KSWZ(r32, cb));
    bf16x8 b1 = *reinterpret_cast<const bf16x8*>((const char*)Ks + KSWZ(32 + r32, cb));
    p0 = __builtin_amdgcn_mfma_f32_32x32x16_bf16(b0, qr[d0], p0, 0, 0, 0);
    p1 = __builtin_amdgcn_mfma_f32_32x32x16_bf16(b1, qr[d0], p1, 0, 0, 0); }
}
__device__ __forceinline__ int v_st(int k, int c) { const int kk = (k & ~0xC) | ((k & 4) << 1) | ((k & 8) >> 1); return ((kk >> 3) * 4 + (c >> 5)) * 512 + ((kk & 7) * 32 + (c & 31)) * 2; }
__device__ __forceinline__ int v_rd_base(int lane) { return ((lane & 3) << 3) | (((lane >> 2) & 3) << 6) | (((lane >> 4) & 1) << 5) | (((lane >> 5) & 1) << 8); }
constexpr int v_rd_off(int d0, int ks, int half) { return d0 * 512 + ks * 4096 + half * 2048; }
template <int OFF> __device__ __forceinline__ s16x4 tr_read(int vb) {
  s16x4 r; asm volatile("ds_read_b64_tr_b16 %0, %1 offset:%2" : "=&v"(r) : "v"(vb), "i"(OFF) : "memory"); return r;
}
template <int D0> __device__ __forceinline__ void pv_one(f32x16& od, int vb, bf16x8 pa0, bf16x8 pa1, bf16x8 pa2, bf16x8 pa3) {
  const s16x4 l0 = tr_read<v_rd_off(D0, 0, 0)>(vb), h0 = tr_read<v_rd_off(D0, 0, 1)>(vb), l1 = tr_read<v_rd_off(D0, 1, 0)>(vb), h1 = tr_read<v_rd_off(D0, 1, 1)>(vb);
  const s16x4 l2 = tr_read<v_rd_off(D0, 2, 0)>(vb), h2 = tr_read<v_rd_off(D0, 2, 1)>(vb), l3 = tr_read<v_rd_off(D0, 3, 0)>(vb), h3 = tr_read<v_rd_off(D0, 3, 1)>(vb);
  asm volatile("s_waitcnt lgkmcnt(0)" ::: "memory"); SBAR();
#define PK(L, H) (bf16x8){L[0], L[1], L[2], L[3], H[0], H[1], H[2], H[3]}
  od = __builtin_amdgcn_mfma_f32_32x32x16_bf16(pa0, PK(l0, h0), od, 0, 0, 0);
  od = __builtin_amdgcn_mfma_f32_32x32x16_bf16(pa1, PK(l1, h1), od, 0, 0, 0);
  od = __builtin_amdgcn_mfma_f32_32x32x16_bf16(pa2, PK(l2, h2), od, 0, 0, 0);
  od = __builtin_amdgcn_mfma_f32_32x32x16_bf16(pa3, PK(l3, h3), od, 0, 0, 0);
#undef PK
}
__device__ __forceinline__ void pv_d0(f32x16* o, int vb, bf16x8 pa0, bf16x8 pa1, bf16x8 pa2, bf16x8 pa3) {
  pv_one<0>(o[0], vb, pa0, pa1, pa2, pa3); pv_one<1>(o[1], vb, pa0, pa1, pa2, pa3); pv_one<2>(o[2], vb, pa0, pa1, pa2, pa3); pv_one<3>(o[3], vb, pa0, pa1, pa2, pa3);
}

template <bool WIN, int SDEPTH, bool F8, bool FIXM, bool QN = false, int kmask = -1, bool PP = false>
__device__ __forceinline__ void attn_body(const bf16* __restrict__ Qb, const bf16* __restrict__ Kh, const unsigned char* __restrict__ Kh8, const bf16* __restrict__ Vh,
                                          unsigned char* __restrict__ Ob, float oscale, int seq, char* lds, const __attribute__((address_space(3))) float* tab, int relbase, float m0, float l0,
                                          const float* __restrict__ gq = nullptr, int qpos0 = 0) {
  int tid_ = threadIdx.x; asm volatile("" : "+v"(tid_));
  const int tid = tid_, wid = tid >> 6, lane = tid & 63, r32 = lane & 31, hi = lane >> 5;
  bf16* V_lds = (bf16*)lds; bf16* K_lds = (bf16*)(lds + 2 * SHM_V);
  float* ws = (float*)(lds + 2 * SHM_V + 2 * SHM_K) + wid * 64; float* li_l = ws; float* al_l = ws + 32;
  float m_reg = m0, l_reg = l0; f32x16 o[4]; bf16x8 qr[8];
  const bf16* Qw = Qb + (long)(wid * QBLK + r32) * LDQ + hi * 8;
  v8i_a q8[2];
  if constexpr (F8 && QN) {
    const bf16* Qr = Qb + (long)(wid * QBLK + r32) * LDQ + hi * 16;
    u32x4 raw[2][2][2];
#pragma unroll
    for (int s = 0; s < 2; ++s)
#pragma unroll
      for (int pt = 0; pt < 2; ++pt)
#pragma unroll
        for (int c = 0; c < 2; ++c) raw[s][pt][c] = *reinterpret_cast<const u32x4*>(Qr + 64 * s + 32 * pt + 8 * c);
#define QLO(w_) __uint_as_float((w_) << 16)
#define QHI(w_) __uint_as_float((w_) & 0xffff0000u)
    float ss = 0.f;
#pragma unroll
    for (int s = 0; s < 2; ++s)
#pragma unroll
      for (int pt = 0; pt < 2; ++pt)
#pragma unroll
        for (int c = 0; c < 2; ++c) { const u32x4 v = raw[s][pt][c];
          ss = fmaf(QLO(v.x), QLO(v.x), ss); ss = fmaf(QHI(v.x), QHI(v.x), ss); ss = fmaf(QLO(v.y), QLO(v.y), ss); ss = fmaf(QHI(v.y), QHI(v.y), ss);
          ss = fmaf(QLO(v.z), QLO(v.z), ss); ss = fmaf(QHI(v.z), QHI(v.z), ss); ss = fmaf(QLO(v.w), QLO(v.w), ss); ss = fmaf(QHI(v.w), QHI(v.w), ss); }
    { auto rr = __builtin_amdgcn_permlane32_swap(__float_as_uint(ss), __float_as_uint(ss), false, false); ss = __uint_as_float(rr[0]) + __uint_as_float(rr[1]); }
    const float rs = 1.0f / sqrtf(ss * (1.0f / D) + 1e-6f);
    const int tok = qpos0 + wid * QBLK + r32;
#pragma unroll
    for (int s = 0; s < 2; ++s) { int w[8]; const float pos = (float)(s == 0 ? (tok >> 6) : (tok & 63));
#pragma unroll
      for (int c = 0; c < 2; ++c) {
        const u32x4 va = raw[s][0][c], vb = raw[s][1][c];
        const float xa[8] = {QLO(va.x), QHI(va.x), QLO(va.y), QHI(va.y), QLO(va.z), QHI(va.z), QLO(va.w), QHI(va.w)}, xb[8] = {QLO(vb.x), QHI(vb.x), QLO(vb.y), QHI(vb.y), QLO(vb.z), QHI(vb.z), QLO(vb.w), QHI(vb.w)};
        float o1[8], o2[8];
#pragma unroll
        for (int u4 = 0; u4 < 2; ++u4) { const f32x4_a g1 = *reinterpret_cast<const f32x4_a*>(gq + 64 * s + 16 * hi + 8 * c + 4 * u4), g2 = *reinterpret_cast<const f32x4_a*>(gq + 64 * s + 32 + 16 * hi + 8 * c + 4 * u4);
#pragma unroll
          for (int u = 0; u < 4; ++u) { const int t = 4 * u4 + u; const float inv = __builtin_amdgcn_exp2f(-(float)(2 * (16 * hi + 8 * c + t)) * (1.0f / 64.0f) * 13.287712379549449f);
            const float rev = pos * inv * 0.15915494309189535f, fr = rev - floorf(rev); const float sn = __builtin_amdgcn_sinf(fr), cs = __builtin_amdgcn_cosf(fr);
            const float a = xa[t] * rs * g1[u], b = xb[t] * rs * g2[u]; o1[t] = a * cs - b * sn; o2[t] = b * cs + a * sn; } }
        int t0 = __builtin_amdgcn_cvt_pk_fp8_f32(o1[0], o1[1], 0, false); t0 = __builtin_amdgcn_cvt_pk_fp8_f32(o1[2], o1[3], t0, true); w[2 * c] = t0;
        t0 = __builtin_amdgcn_cvt_pk_fp8_f32(o1[4], o1[5], 0, false); t0 = __builtin_amdgcn_cvt_pk_fp8_f32(o1[6], o1[7], t0, true); w[2 * c + 1] = t0;
        t0 = __builtin_amdgcn_cvt_pk_fp8_f32(o2[0], o2[1], 0, false); t0 = __builtin_amdgcn_cvt_pk_fp8_f32(o2[2], o2[3], t0, true); w[4 + 2 * c] = t0;
        t0 = __builtin_amdgcn_cvt_pk_fp8_f32(o2[4], o2[5], 0, false); t0 = __builtin_amdgcn_cvt_pk_fp8_f32(o2[6], o2[7], t0, true); w[4 + 2 * c + 1] = t0; }
      q8[s] = (v8i_a){w[0], w[1], w[2], w[3], w[4], w[5], w[6], w[7]}; }
#undef QLO
#undef QHI
  } else if constexpr (F8) {
    const bf16* Qr = Qb + (long)(wid * QBLK + r32) * LDQ + hi * 32;
#pragma unroll
    for (int s = 0; s < 2; ++s) { int w[8];
#pragma unroll
      for (int c = 0; c < 4; ++c) { const u32x4 v = *reinterpret_cast<const u32x4*>(Qr + 64 * s + 8 * c);
        int t = __builtin_amdgcn_cvt_pk_fp8_f32(__uint_as_float(v.x << 16), __uint_as_float(v.x & 0xffff0000u), 0, false); t = __builtin_amdgcn_cvt_pk_fp8_f32(__uint_as_float(v.y << 16), __uint_as_float(v.y & 0xffff0000u), t, true); w[2 * c] = t;
        t = __builtin_amdgcn_cvt_pk_fp8_f32(__uint_as_float(v.z << 16), __uint_as_float(v.z & 0xffff0000u), 0, false); t = __builtin_amdgcn_cvt_pk_fp8_f32(__uint_as_float(v.w << 16), __uint_as_float(v.w & 0xffff0000u), t, true); w[2 * c + 1] = t; }
      q8[s] = (v8i_a){w[0], w[1], w[2], w[3], w[4], w[5], w[6], w[7]}; }
  } else {
#pragma unroll
    for (int d0 = 0; d0 < 8; ++d0) qr[d0] = *reinterpret_cast<const bf16x8*>(Qw + d0 * 16);
  }
#pragma unroll
  for (int d = 0; d < 4; ++d) { float z_; asm volatile("v_mov_b32 %0, 0" : "=v"(z_));
#pragma unroll
    for (int r = 0; r < 16; ++r) o[d][r] = z_; }
  const int sr = tid >> 4, sc = (tid & 15) * 8, vst0 = v_st(sr, sc), vst1 = v_st(32 + sr, sc);
  const int vb0 = (int)(uintptr_t)V_lds + v_rd_base(lane);
  const __attribute__((address_space(3))) float* tb0 = tab + (relbase - (wid * QBLK + r32) + 512 + 4 * hi);
  struct { bf16x8 vs0, vs1, ks0, ks1; } sr_[SDEPTH];
#define SLOAD(i, k0) do { sr_[i].vs0 = *reinterpret_cast<const bf16x8*>(&Vh[(long)(((k0) & kmask) + sr) * LDK + sc]); sr_[i].vs1 = *reinterpret_cast<const bf16x8*>(&Vh[(long)(((k0) & kmask) + 32 + sr) * LDK + sc]); \
    if constexpr (F8) { sr_[i].ks0 = *reinterpret_cast<const bf16x8*>(&Kh8[(long)(((k0) & kmask) + (tid >> 3)) * 256 + (tid & 7) * 16]); } \
    else { sr_[i].ks0 = *reinterpret_cast<const bf16x8*>(&Kh[(long)(((k0) & kmask) + sr) * LDK + sc]); sr_[i].ks1 = *reinterpret_cast<const bf16x8*>(&Kh[(long)(((k0) & kmask) + 32 + sr) * LDK + sc]); } } while (0)
#define SWRITE(b, i) do { *(bf16x8*)((char*)V_lds + (b) * SHM_V + vst0) = sr_[i].vs0;          \
    *(bf16x8*)((char*)V_lds + (b) * SHM_V + vst1) = sr_[i].vs1; int kc = sc * 2;               \
    if constexpr (F8) { *(bf16x8*)((char*)K_lds + (b) * SHM_K + KSWZ8(tid >> 3, (tid & 7) * 16)) = sr_[i].ks0; } \
    else { *(bf16x8*)((char*)K_lds + (b) * SHM_K + KSWZ(sr, kc)) = sr_[i].ks0;                       \
    *(bf16x8*)((char*)K_lds + (b) * SHM_K + KSWZ(32 + sr, kc)) = sr_[i].ks1; } } while (0)
#define SWAIT() do { if constexpr (SDEPTH == 2) asm volatile("s_waitcnt vmcnt(4)" ::: "memory"); else asm volatile("s_waitcnt vmcnt(0)" ::: "memory"); } while (0)
#define RESC(a) do { if (!FIXM && __any((a) < 1.f)) { if (hi == 0) al_l[r32] = (a); asm volatile("s_waitcnt lgkmcnt(0)" ::: "memory"); \
    for (int d = 0; d < 4; ++d) for (int r = 0; r < 16; ++r) o[d][r] *= al_l[crow(r, hi)]; } } while (0)
  f32x16 pA0, pA1, pB0, pB1; float mnA, mnB, alA, alB; bf16x8 pa0, pa1, pa2, pa3; const int NT = seq / KVBLK;
  if constexpr (PP) {
    static_assert(!PP || (F8 && FIXM && !WIN), "ping-pong path: dense fp8 fixed-reference attention only");
    constexpr int NS = 4, KSLOT = KVBLK * D, VSLOT = KVBLK * D * 2, KRING = NS * VSLOT;
    typedef __attribute__((address_space(3))) unsigned lds_u32;
    const int widu = __builtin_amdgcn_readfirstlane(wid), grp = widu >> 2;
    li_l = (float*)(lds + KRING + NS * KSLOT) + widu * 64; al_l = li_l + 32;
    const __attribute__((address_space(3))) unsigned char* ldsb = (const __attribute__((address_space(3))) unsigned char*)(unsigned)(uintptr_t)lds;
    const int krow = widu * 8 + (lane >> 3);
    const unsigned kofs = (unsigned)(krow * 256 + (((lane & 7) ^ (krow & 7)) << 4));
    unsigned vofs[2];
#pragma unroll
    for (int i = 0; i < 2; ++i) { const int blk = (widu * 2 + i) * 2 + (lane >> 5), kk = (blk >> 2) * 8 + ((lane & 31) >> 2), k = (kk & ~0xC) | ((kk & 4) << 1) | ((kk & 8) >> 1);
      vofs[i] = (unsigned)((k * LDK + (blk & 3) * 32 + 8 * (lane & 3)) * 2); }
#define DMAK(t) do { const int t_ = (t) < NT ? (t) : NT - 1; const unsigned char* kb_ = Kh8 + (long)t_ * (KVBLK * 256); asm volatile("" : "+s"(kb_)); \
      __builtin_amdgcn_global_load_lds((const unsigned*)(kb_ + kofs), (lds_u32*)(ldsb + KRING + ((t) & (NS - 1)) * KSLOT + widu * 1024), 16, 0, 0); } while (0)
#define DMAV(t) do { const int t_ = (t) < NT ? (t) : NT - 1; const unsigned char* vb_ = (const unsigned char*)(Vh + (long)t_ * (KVBLK * LDK)); asm volatile("" : "+s"(vb_)); _Pragma("unroll") for (int i_ = 0; i_ < 2; ++i_) \
      __builtin_amdgcn_global_load_lds((const unsigned*)(vb_ + vofs[i_]), (lds_u32*)(ldsb + ((t) & (NS - 1)) * VSLOT + (widu * 2 + i_) * 1024), 16, 0, 0); } while (0)
#define PBAR() do { asm volatile("s_waitcnt lgkmcnt(0)" ::: "memory"); __builtin_amdgcn_s_barrier(); } while (0)
#define PEND() do { asm volatile("s_waitcnt vmcnt(6)" ::: "memory"); PBAR(); } while (0)
#define KSL(t) ((bf16*)(lds + KRING + ((t) & (NS - 1)) * KSLOT))
#define VSL(t) (vb0 + ((t) & (NS - 1)) * VSLOT)
    DMAK(0); DMAV(0); DMAK(1); DMAV(1); DMAK(2); DMAK(3); DMAV(2);
    asm volatile("s_waitcnt vmcnt(0)" ::: "memory"); PBAR();
    qkt<WIN, F8>(pA0, pA1, KSL(0), qr, q8, r32, hi, tb0); partialSM<FIXM>(pA0, pA1, m_reg, mnA, alA);
    if (grp == 1) PBAR();
#pragma unroll 1
    for (int t = 1; t < NT; ++t) {
      SBAR(); DMAK(t + 3); SBAR();
      finishSM(pA0, pA1, alA, l_reg, pa0, pa1, pa2, pa3); SBAR();
      qkt<WIN, F8>(pA0, pA1, KSL(t), qr, q8, r32, hi, tb0); SBAR();
      PEND();
      SBAR(); DMAV(t + 2); SBAR();
      pv_d0(o, VSL(t - 1), pa0, pa1, pa2, pa3); partialSM<FIXM>(pA0, pA1, m_reg, mnA, alA); SBAR();
      PEND();
    }
    if (grp == 0) PBAR();
    finishSM(pA0, pA1, alA, l_reg, pa0, pa1, pa2, pa3); SBAR();
    pv_d0(o, VSL(NT - 1), pa0, pa1, pa2, pa3);
    asm volatile("s_waitcnt vmcnt(0)" ::: "memory");
#undef DMAK
#undef DMAV
#undef PBAR
#undef PEND
#undef KSL
#undef VSL
  } else {
  constexpr int SE = 0, SO = SDEPTH - 1;
  SLOAD(SE, 0); asm volatile("s_waitcnt vmcnt(0)" ::: "memory"); SWRITE(0, SE); __syncthreads();
  qkt<WIN, F8>(pA0, pA1, K_lds, qr, q8, r32, hi, tb0); partialSM<FIXM>(pA0, pA1, m_reg, mnA, alA);
  SLOAD(SO, KVBLK); if constexpr (SDEPTH == 2) { if (2 < NT) SLOAD(SE, 2 * KVBLK); }
  SWAIT(); SWRITE(1, SO); __syncthreads();
  for (int j = 1; j + 1 < NT; j += 2) {
    SBAR(); qkt<WIN, F8>(pB0, pB1, (bf16*)((char*)K_lds + SHM_K), qr, q8, r32, hi, tb0 + 64 * j);
    finishSM(pA0, pA1, alA, l_reg, pa0, pa1, pa2, pa3); SBAR();
    SLOAD(SO, (j + SDEPTH) * KVBLK); SBAR();
    pv_d0(o, vb0, pa0, pa1, pa2, pa3); partialSM<FIXM>(pB0, pB1, m_reg, mnB, alB);
    __syncthreads(); SWAIT(); SWRITE(0, SE);
    RESC(alB); __syncthreads();
    SBAR(); qkt<WIN, F8>(pA0, pA1, K_lds, qr, q8, r32, hi, tb0 + 64 * (j + 1));
    finishSM(pB0, pB1, alB, l_reg, pa0, pa1, pa2, pa3); SBAR();
    if (SDEPTH == 1 || j + 3 < NT) SLOAD(SE, (j + 1 + SDEPTH) * KVBLK); SBAR();
    pv_d0(o, vb0 + (int)SHM_V, pa0, pa1, pa2, pa3); partialSM<FIXM>(pA0, pA1, m_reg, mnA, alA);
    __syncthreads(); SWAIT(); SWRITE(1, SO);
    RESC(alA); __syncthreads();
  }
  SBAR(); qkt<WIN, F8>(pB0, pB1, (bf16*)((char*)K_lds + SHM_K), qr, q8, r32, hi, tb0 + 64 * (NT - 1));
  finishSM(pA0, pA1, alA, l_reg, pa0, pa1, pa2, pa3); SBAR();
  pv_d0(o, vb0, pa0, pa1, pa2, pa3); partialSM<FIXM>(pB0, pB1, m_reg, mnB, alB);
  __syncthreads(); RESC(alB);
  finishSM(pB0, pB1, alB, l_reg, pa0, pa1, pa2, pa3); SBAR();
  pv_d0(o, vb0 + (int)SHM_V, pa0, pa1, pa2, pa3);
  }
  if (hi == 0) li_l[r32] = l_reg; asm volatile("s_waitcnt lgkmcnt(0)" ::: "memory");
  float rli[16];
#pragma unroll
  for (int r = 0; r < 16; ++r) rli[r] = __builtin_amdgcn_rcpf(li_l[crow(r, hi)]);
  unsigned char* Ow = Ob + (long)(wid * QBLK) * LDO;
#pragma unroll
  for (int r = 0; r < 16; ++r) { int orow = crow(r, hi); const float sc = rli[r] * oscale;
    for (int d0 = 0; d0 < 4; ++d0) Ow[(long)orow * LDO + d0 * 32 + r32] = (unsigned char)(__builtin_amdgcn_cvt_pk_fp8_f32(o[d0][r] * sc, 0.f, 0, false) & 0xff); }
  __syncthreads();
#undef SLOAD
#undef SWRITE
#undef SWAIT
#undef RESC
}
#undef KSWZ
#undef KSWZ8
#undef SBAR
}
constexpr int NWAVES = 8;
constexpr int SEQ = 8192, DM = 2048, HD = 128, NEXP = 64, TOPK = 8, FE = 512;
constexpr int INC = 7168;
constexpr int PLD = INC + PROJ_PAD;
constexpr int C_QA = 0, C_KA = 1024, C_VA = 1280, C_QB = 1536, C_KB = 2560, C_VB = 2816, C_GA = 3072, C_GB = 5120;
constexpr float LN_EPS = 1e-5f, RMS_EPS = 1e-6f;
constexpr float ALPHA = 1.189207115002721f;
constexpr float ROUTED_SCALE = 2.5f;
constexpr int LCAP = 8192;
constexpr int NEXP1 = NEXP + 1;

constexpr size_t MiB = 1u << 20;
constexpr size_t WS_CTL = 0, CTL_ZERO_BYTES = 1 * MiB;
constexpr size_t WS_WGU = 1 * MiB;
constexpr size_t WS_WINT = WS_WGU + 260 * MiB;
constexpr size_t WS_XBF = WS_WINT + 28 * MiB;
constexpr size_t WS_PROJ = WS_XBF + 32 * MiB;
constexpr size_t WS_OA = WS_PROJ + 116 * MiB;
constexpr size_t WS_OB = WS_OA + 16 * MiB;
constexpr size_t WS_MRG = WS_OB + 16 * MiB;
constexpr size_t WS_WAT = WS_MRG + 32 * MiB;
constexpr size_t WS_WBT = WS_WAT + 4 * MiB;
constexpr size_t WS_WOT = WS_WBT + 4 * MiB;
constexpr size_t WS_DEAD_END = WS_WOT + 8 * MiB;
constexpr size_t WS_Y = WS_WGU;
constexpr size_t WS_WD = WS_DEAD_END;
constexpr size_t WS_WR = WS_WD + 130 * MiB;
constexpr size_t WS_H32 = WS_WR + 1 * MiB;
constexpr size_t WS_HBF = WS_H32 + 64 * MiB;
constexpr size_t WS_HID = WS_HBF + 32 * MiB;
constexpr size_t WS_PRE = WS_HID + 88 * MiB;
constexpr size_t WS_LTOK = WS_PRE + 64 * MiB;
constexpr size_t WS_LW = WS_LTOK + 3 * MiB;
constexpr size_t WS_ROUTE = WS_LW + 3 * MiB;
constexpr size_t WS_HF8 = WS_H32;
constexpr size_t WS_KF8 = WS_H32 + 16 * MiB;
constexpr size_t WS_END = WS_ROUTE + 1 * MiB;
static_assert(WS_Y + 352 * MiB <= WS_WD, "Y overlay");
static_assert((size_t)SEQ * PLD * 2 <= 116 * MiB, "proj slot");
static_assert(WS_END <= 1024 * MiB, "d_ws map must fit 1 GiB");
constexpr int CW_TMO = 0;
constexpr int CW_CNT = 64;
constexpr int CW_BAR = 4096;

constexpr int RING_OFF = 0, RING_BYTES = 131072;
constexpr int LDSCTL_OFF = RING_BYTES;
constexpr int MISC_OFF = LDSCTL_OFF;
constexpr int IDXL_OFF = LDSCTL_OFF + 256;
constexpr int TST_OFF = IDXL_OFF + 1024 + 2048;
constexpr int LDS_BYTES = 147456;
static_assert(TST_OFF + 512 <= LDS_BYTES, "LDS map");

#define GAS __attribute__((address_space(1)))
#define LAS __attribute__((address_space(3)))
typedef unsigned short bf16;
typedef unsigned v4u __attribute__((ext_vector_type(4)));
typedef unsigned v2u __attribute__((ext_vector_type(2)));
typedef float f32x4 __attribute__((ext_vector_type(4)));
typedef short bf16x8 __attribute__((ext_vector_type(8)));
#define RLX_AGENT __ATOMIC_RELAXED, __HIP_MEMORY_SCOPE_AGENT
#define LDS_WAIT() asm volatile("s_waitcnt lgkmcnt(0)" ::: "memory")
#define VM_WAIT() asm volatile("s_waitcnt vmcnt(0)" ::: "memory")
__device__ __forceinline__ unsigned f2bf(float f) { unsigned u = __builtin_bit_cast(unsigned, f); return (u + 0x7fffu + ((u >> 16) & 1u)) >> 16; }
__device__ __forceinline__ unsigned pk2(float lo, float hi) { return f2bf(lo) | (f2bf(hi) << 16); }
__device__ __forceinline__ float bf2f(unsigned short h) { return __uint_as_float((unsigned)h << 16); }

#define XB_TMO      128
#define XB_XCNT(j)  (256  + 64 * (j))
#define XB_XSUB(j)  (1280 + 64 * (j))
#define XB_XGEN(j)  (2304 + 64 * (j))
#define XB_TOP      3328
#define XB_TOPGEN   3392
#define XCD_BAR_WORDS 3456
#define XB_SPIN_CAP (1u << 20)
__device__ __forceinline__ unsigned xb_ld(unsigned* p)              { return __hip_atomic_load(p, __ATOMIC_RELAXED, __HIP_MEMORY_SCOPE_AGENT); }
__device__ __forceinline__ unsigned xb_add(unsigned* p, unsigned v) { return __hip_atomic_fetch_add(p, v, __ATOMIC_RELAXED, __HIP_MEMORY_SCOPE_AGENT); }
__device__ __forceinline__ unsigned xb_xcc_id() { return (unsigned)__builtin_amdgcn_s_getreg((3 << 11) | 20) & 0xFu; }
#define XB_SPIN(cond, bar) do { unsigned _sp = 0; while (cond) { __builtin_amdgcn_s_sleep(1); \
    if ((++_sp & 255u) == 0u) { if (xb_ld(&(bar)[XB_TMO])) break; if (_sp > XB_SPIN_CAP) { atomicAdd(&(bar)[XB_TMO], 1u); break; } } } } while (0)
struct XcdBarrier { unsigned* bar; unsigned x; volatile LAS unsigned* st; unsigned total; };
__device__ __forceinline__ XcdBarrier xcd_barrier_post(unsigned* bar, volatile LAS unsigned* st, unsigned total) {
    XcdBarrier b; b.bar = bar; b.x = xb_xcc_id(); b.st = st; b.total = total;
    if (threadIdx.x == 0) (void)xb_add(&bar[XB_XCNT(b.x)], 1u);
    return b;
}
__device__ __forceinline__ void xcd_barrier_complete(unsigned* bar, unsigned x, unsigned G, unsigned& nloc, unsigned& nx) {
    unsigned sum, cnt, mine, sp = 0u;
    for (;;) {
        sum = 0u; cnt = 0u; mine = 0u;
#pragma unroll
        for (unsigned j = 0; j < 16; ++j) { const unsigned c = xb_ld(&bar[XB_XCNT(j)]); sum += c; cnt += (c > 0u) ? 1u : 0u; mine = (j == x) ? c : mine; }
        if (sum == G) break;
        __builtin_amdgcn_s_sleep(1);
        if ((++sp & 255u) == 0u) { if (xb_ld(&bar[XB_TMO])) break; if (sp > XB_SPIN_CAP) { atomicAdd(&bar[XB_TMO], 1u); break; } }
    }
    nloc = mine > 0u ? mine : 1u; nx = cnt > 0u ? cnt : 1u;
}
__device__ __forceinline__ void xcd_barrier(const XcdBarrier& b) {
    asm volatile("s_waitcnt vmcnt(0)" ::: "memory");
    __syncthreads();
    if (threadIdx.x == 0) {
        unsigned* bar = b.bar;
        __builtin_amdgcn_s_waitcnt(0);
        unsigned nloc = b.st[0], nx = b.st[1];
        if (nloc == 0u) { xcd_barrier_complete(bar, b.x, b.total, nloc, nx); b.st[0] = nloc; b.st[1] = nx; }
        const unsigned old = xb_add(&bar[XB_XSUB(b.x)], 1u);
        const unsigned gen = old / nloc;
        if (old + 1u == (gen + 1u) * nloc) {
            __builtin_amdgcn_fence(__ATOMIC_RELEASE, "agent");
            asm volatile("s_waitcnt vmcnt(0)" ::: "memory");
            const unsigned og = xb_add(&bar[XB_TOP], 1u);
            const unsigned tg = og / nx;
            if (og + 1u == (tg + 1u) * nx) xb_add(&bar[XB_TOPGEN], 1u);
            else XB_SPIN(xb_ld(&bar[XB_TOPGEN]) == tg, bar);
            __builtin_amdgcn_fence(__ATOMIC_ACQUIRE, "agent");
            xb_add(&bar[XB_XGEN(b.x)], 1u);
            asm volatile("s_waitcnt vmcnt(0)" ::: "memory");
        } else {
            XB_SPIN(xb_ld(&bar[XB_XGEN(b.x)]) == gen, bar);
            __builtin_amdgcn_fence(__ATOMIC_ACQUIRE, "agent");
            asm volatile("s_waitcnt vmcnt(0)" ::: "memory");
        }
    }
    __syncthreads();
}

__device__ __forceinline__ float wave_sum(float v) {
#pragma unroll
    for (int o = 1; o < 64; o <<= 1) v += __shfl_xor(v, o);
    return v;
}
__device__ __forceinline__ float sigmoidf_(float x) { return __builtin_amdgcn_rcpf(1.0f + __builtin_amdgcn_exp2f(-x * 1.4426950408889634f)); }

struct Args { const float* in[22]; float* out; unsigned char* ws; int ph_lo, ph_hi; };
struct Frame {
    LAS unsigned char* lds;
    volatile LAS unsigned* MISC;
    unsigned* ctl;
    int tid, lane, wave;
    int vcu, G;
    const float* in[22]; float* out; unsigned char* ws;
};

#ifndef G1_FP8
#define G1_FP8 1
#endif
#ifndef ATT_F8
#define ATT_F8 1
#endif
#ifndef P1_FP8
#define P1_FP8 1
#endif
struct TItem { const float* W; unsigned char* WT; int K, N, k0, n0, drow0, f8; };
constexpr float W8SCALE = 32.0f, H8SCALE = 8.0f, OA_SCALE = 16.0f, OB_SCALE = 64.0f, MG_SCALE = 32.0f;
__device__ __forceinline__ void titem_issue(const TItem& it, LAS unsigned char* buf, int lane) {
#pragma unroll
    for (int g = 0; g < 8; ++g) { const int k = 8 * g + (lane >> 3), pos = lane & 7;
        __builtin_amdgcn_global_load_lds((const unsigned*)(it.W + (size_t)(it.k0 + k) * it.N + it.n0 + 4 * (pos ^ g)), (LAS unsigned*)(buf + g * 1024), 16, 0, 0); }
}
__device__ __forceinline__ void titem_finish(const TItem& it, const LAS float* buf, int lane) {
    const int c = lane & 7;
#pragma unroll
    for (int j = 0; j < 4; ++j) { const int nn = (lane >> 3) + 8 * j; const LAS float* s = buf + (8 * c) * 32 + (((nn >> 2) ^ c) << 2) + (nn & 3);
        const size_t eo = (size_t)(it.drow0 + nn) * it.K + it.k0 + 8 * c;
        if (it.f8) { v2u o; int t = __builtin_amdgcn_cvt_pk_fp8_f32(s[0 * 32] * W8SCALE, s[1 * 32] * W8SCALE, 0, false); t = __builtin_amdgcn_cvt_pk_fp8_f32(s[2 * 32] * W8SCALE, s[3 * 32] * W8SCALE, t, true); o.x = (unsigned)t;
            t = __builtin_amdgcn_cvt_pk_fp8_f32(s[4 * 32] * W8SCALE, s[5 * 32] * W8SCALE, 0, false); t = __builtin_amdgcn_cvt_pk_fp8_f32(s[6 * 32] * W8SCALE, s[7 * 32] * W8SCALE, t, true); o.y = (unsigned)t;
            __builtin_nontemporal_store(o, (GAS v2u*)(it.WT + eo)); }
        else { v4u o; o.x = pg8::cvt_pk_bf16(s[0 * 32], s[1 * 32]); o.y = pg8::cvt_pk_bf16(s[2 * 32], s[3 * 32]); o.z = pg8::cvt_pk_bf16(s[4 * 32], s[5 * 32]); o.w = pg8::cvt_pk_bf16(s[6 * 32], s[7 * 32]);
            __builtin_nontemporal_store(o, (GAS v4u*)(it.WT + 2 * eo)); } }
}
constexpr int I_IN = (DM / 64) * (INC / 32);
constexpr int I_BR = (1024 / 64) * (DM / 32);
constexpr int I_WO = (DM / 64) * (DM / 32);
constexpr int I_GU = (DM / 64) * (FE / 32);
constexpr int I_DN = (FE / 64) * (DM / 32);
constexpr int NITEMS_E1 = 2 * I_BR + I_WO + NEXP1 * 2 * I_GU;
constexpr int NITEMS_E2 = NEXP1 * I_DN;
__device__ __forceinline__ void titem_plain(TItem& it, const float* W, int K, int N, void* WT, int item, int f8 = 0) {
    const int nblk = N / 32, kb = item / nblk, nb = item % nblk; it.W = W; it.WT = (unsigned char*)WT; it.K = K; it.N = N; it.k0 = 64 * kb; it.n0 = 32 * nb; it.drow0 = 32 * nb; it.f8 = f8;
}
template <int LIST>
__device__ __forceinline__ void titem_get(Frame& F, int r, TItem& it) {
    if constexpr (LIST == 0) { titem_plain(it, F.in[1], DM, INC, F.ws + WS_WINT, r, P1_FP8); }
    else if constexpr (LIST == 2) { const int e = r / I_DN; r -= e * I_DN;
        titem_plain(it, e < NEXP ? F.in[16] + (size_t)e * FE * DM : F.in[19], FE, DM, F.ws + WS_WD + (size_t)e * DM * FE, r, 1); }
    else {
        if (r < I_BR) { titem_plain(it, F.in[7], 1024, DM, F.ws + WS_WAT, r, 1); return; } r -= I_BR;
        if (r < I_BR) { titem_plain(it, F.in[8], 1024, DM, F.ws + WS_WBT, r, 1); return; } r -= I_BR;
        if (r < I_WO) { titem_plain(it, F.in[9], DM, DM, F.ws + WS_WOT, r, 1); return; } r -= I_WO;
        const int e = r / (2 * I_GU); r -= e * (2 * I_GU);
        const int half = r >= I_GU ? 1 : 0; r -= half * I_GU;
        const float* w = e < NEXP ? (half ? F.in[15] : F.in[14]) + (size_t)e * DM * FE : (half ? F.in[18] : F.in[17]);
        const int nblk = FE / 32, kb = r / nblk, nb = r % nblk, n0 = 32 * nb;
        it.W = w; it.WT = F.ws + WS_WGU + (size_t)e * 1024 * DM * (G1_FP8 ? 1 : 2); it.f8 = G1_FP8; it.K = DM; it.N = FE; it.k0 = 64 * kb; it.n0 = n0; it.drow0 = 256 * (n0 >> 7) + 128 * half + (n0 & 127);
    }
}
#ifndef CONV_D
#define CONV_D 4
#endif
__device__ __forceinline__ void titem_load(const TItem& it, f32x4 (&r)[8], int lane) {
#pragma unroll
    for (int g = 0; g < 8; ++g) r[g] = __builtin_nontemporal_load((const GAS f32x4*)(it.W + (size_t)(it.k0 + 8 * g + (lane >> 3)) * it.N + it.n0 + 4 * (lane & 7)));
}
__device__ __forceinline__ void titem_store(const TItem& it, const f32x4 (&r)[8], LAS float* buf, int lane) {
#pragma unroll
    for (int g = 0; g < 8; ++g) *(LAS f32x4*)(buf + (8 * g + (lane >> 3)) * 32 + (((lane & 7) ^ g) << 2)) = r[g];
    titem_finish(it, buf, lane);
}
template <int LISTE>
__device__ __forceinline__ void convert_items(Frame& F, int first, int step, int last) {
    LAS float* buf = (LAS float*)(F.lds + RING_OFF + F.wave * 8192);
    if (first >= last) return;
    const int n_my = (last - first + step - 1) / step;
    f32x4 r[CONV_D][8]; TItem it;
#pragma unroll
    for (int d = 0; d < CONV_D; ++d) if (d < n_my) { titem_get<LISTE>(F, first + d * step, it); titem_load(it, r[d], F.lane); }
    for (int base = 0; base < n_my; base += CONV_D) {
#pragma unroll
        for (int d = 0; d < CONV_D; ++d) { const int idx = base + d;
            if (idx < n_my) { titem_get<LISTE>(F, first + idx * step, it); titem_store(it, r[d], buf, F.lane);
                if (idx + CONV_D < n_my) { titem_get<LISTE>(F, first + (idx + CONV_D) * step, it); titem_load(it, r[d], F.lane); } } }
    }
}
#ifndef CONV_Q
#define CONV_Q 200
#endif
#ifndef P1_NCG
#define P1_NCG 23
#endif
constexpr int NCONV = 32, NCOMP = 256 - NCONV, NCONV1 = 8 * (32 - P1_NCG), NCOMP1 = 8 * P1_NCG, E_SPLIT = (NCONV1 * NWAVES * CONV_Q < NITEMS_E1) ? NCONV1 * NWAVES * CONV_Q : NITEMS_E1;
#ifndef CONV_Q2
#define CONV_Q2 100
#endif
#ifndef P1_QE2
#define P1_QE2 0
#endif
constexpr int E2_A = (NCONV1 * NWAVES * P1_QE2 < NITEMS_E2) ? NCONV1 * NWAVES * P1_QE2 : NITEMS_E2;
constexpr int E2_SPLIT = (E2_A + 32 * NWAVES * CONV_Q2 < NITEMS_E2) ? E2_A + 32 * NWAVES * CONV_Q2 : NITEMS_E2;
#ifndef CONV_G1
#define CONV_G1 1
#endif
__device__ __forceinline__ void p0_prologue(Frame& F, bool compute_only) {
    const int gw = (compute_only ? (F.vcu >> 5) * P1_NCG + (F.vcu & 31) : F.vcu) * NWAVES + F.wave, NGW = (compute_only ? NCOMP1 : F.G) * NWAVES;
    convert_items<0>(F, gw, NGW, I_IN);
    { const int gt = gw * 64 + F.lane, NT = NGW * 64; const GAS f32x4* xs = (const GAS f32x4*)F.in[0]; GAS v4u* xo = (GAS v4u*)(F.ws + WS_XBF);
      for (int i = gt; i < SEQ * DM / 8; i += 4 * NT) {
          f32x4 a[4], b[4];
#pragma unroll
          for (int u = 0; u < 4; ++u) if (i + u * NT < SEQ * DM / 8) { a[u] = __builtin_nontemporal_load(xs + 2 * (i + u * NT)); b[u] = __builtin_nontemporal_load(xs + 2 * (i + u * NT) + 1); }
#pragma unroll
          for (int u = 0; u < 4; ++u) if (i + u * NT < SEQ * DM / 8) {
              if (P1_FP8) { v2u o; int t = __builtin_amdgcn_cvt_pk_fp8_f32(a[u].x, a[u].y, 0, false); t = __builtin_amdgcn_cvt_pk_fp8_f32(a[u].z, a[u].w, t, true); o.x = (unsigned)t;
                  t = __builtin_amdgcn_cvt_pk_fp8_f32(b[u].x, b[u].y, 0, false); t = __builtin_amdgcn_cvt_pk_fp8_f32(b[u].z, b[u].w, t, true); o.y = (unsigned)t; ((GAS v2u*)xo)[i + u * NT] = o; }
              else { v4u o; o.x = pg8::cvt_pk_bf16(a[u].x, a[u].y); o.y = pg8::cvt_pk_bf16(a[u].z, a[u].w); o.z = pg8::cvt_pk_bf16(b[u].x, b[u].y); o.w = pg8::cvt_pk_bf16(b[u].z, b[u].w); xo[i + u * NT] = o; } } } }
    { const int gt = gw * 64 + F.lane, NT = NGW * 64; bf16* wr = (bf16*)(F.ws + WS_WR);
      for (int i = gt; i < NEXP * DM; i += NT) {
          const int j_ = i & 7, ln = (i >> 3) & 63, nt_ = (i >> 9) & 3, ks = i >> 11, q_ = ln >> 4, t_ = ln & 15;
          const int k = ks * 32 + (j_ < 4 ? 4 * q_ + j_ : 16 + 4 * q_ + j_ - 4), e = 16 * nt_ + t_;
          const float w = F.in[12][(size_t)k * NEXP + e]; const unsigned h = f2bf(w); const float lo = w - __uint_as_float(h << 16);
          wr[i] = (bf16)h; wr[NEXP * DM + i] = (bf16)f2bf(lo); } }
    { const int gt = gw * 64 + F.lane, NT = NGW * 64; int* lt = (int*)(F.ws + WS_LTOK); float* lw = (float*)(F.ws + WS_LW);
      for (int i = gt; i < NEXP1 * LCAP; i += NT) { const bool sh = i >= NEXP * LCAP; lt[i] = sh ? i - NEXP * LCAP : 0; lw[i] = sh ? 1.0f : 0.0f; } }
}

#ifndef WT_STORES
#define WT_STORES 0
#endif
__device__ __forceinline__ void st_wt8(void* p, v2u w) {
    if (WT_STORES) __hip_atomic_store((unsigned long long*)p, ((unsigned long long)w.y << 32) | w.x, __ATOMIC_RELAXED, __HIP_MEMORY_SCOPE_AGENT);
    else *(v2u*)p = w;
}
__device__ __forceinline__ v4u pair16(v2u a, v2u b) {
    auto sx = __builtin_amdgcn_permlane16_swap(a.x, b.x, false, false);
    auto sy = __builtin_amdgcn_permlane16_swap(a.y, b.y, false, false);
    return (v4u){sx[0], sy[0], sx[1], sy[1]};
}
struct DenseOrder {
    const char* A; const char* B; int nM, nN, nwg, G, c; size_t tstep;
    __device__ __forceinline__ void init(const void* A_, const void* B_, int M, int N, int K, int G_, int c_) { A = (const char*)A_; B = (const char*)B_; nM = M / 256; nN = N / 256; nwg = nM * nN; G = G_; c = c_; tstep = (size_t)256 * K * (P1_FP8 ? 1 : 2); }
    __device__ __forceinline__ bool next(int i, pg8::Unit& u) const {
#ifdef P1_DOUBLE
        const long L = (long)(i >> 1) * G + c; if (L >= nwg) return false;
#else
        const long L = (long)i * G + c; if (L >= nwg) return false;
#endif
        int wgid = (int)L; { const int q = nwg / 8, r = nwg % 8, xcd = wgid % 8, off = wgid / 8; wgid = (xcd < r ? xcd * (q + 1) : r * (q + 1) + (xcd - r) * q) + off; }
        const int nig = 8 * nN, gid = wgid / nig, fm = gid * 8, gsz = (nM - fm) < 8 ? (nM - fm) : 8;
        const int pm = fm + ((wgid % nig) % gsz), pn = (wgid % nig) / gsz;
        u.A = A + (size_t)pm * tstep; u.B = B + (size_t)pn * tstep; u.idx = nullptr; u.wts = nullptr; u.r0 = pm * 256; u.c0 = pn * 256; u.aux = 0; u.kind = 0; return true;
    }
};
struct BranchOrder {
    const char *OA, *OB, *WA, *WB; int vcu;
    __device__ __forceinline__ bool next(int i, pg8::Unit& u) const {
#ifdef P3_DOUBLE
        if (i >= 4) return false; i &= 1;
#else
        if (i >= 2) return false;
#endif
        const int pm = vcu >> 3, pn = vcu & 7; const size_t ts = (size_t)256 * 1024;
        u.A = (i ? OB : OA) + (size_t)pm * ts; u.B = (i ? WB : WA) + (size_t)pn * ts; u.idx = nullptr; u.wts = nullptr; u.r0 = pm * 256; u.c0 = pn * 256; u.aux = 0; u.kind = i; return true;
    }
};
struct OneTileOrder {
    const char *A, *B; int vcu; size_t ts;
    __device__ __forceinline__ bool next(int i, pg8::Unit& u) const {
#ifdef P4_DOUBLE
        if (i >= 2) return false;
#else
        if (i >= 1) return false;
#endif
        const int pm = vcu >> 3, pn = vcu & 7;
        u.A = A + (size_t)pm * ts; u.B = B + (size_t)pn * ts; u.idx = nullptr; u.wts = nullptr; u.r0 = pm * 256; u.c0 = pn * 256; u.aux = 0; u.kind = 0; return true;
    }
};
template <int NPN>
struct MoeOrder {
    const LAS int* tst; const char* A; const char* B; const int* ltok; const float* lwt; int vcu, G; size_t arow, bexp, bpn;
    bool gather;
    int l0, lend, nheavy;
    const unsigned* flag; int wait_gmt, need;
    mutable int ec = 0;
    __device__ __forceinline__ bool next(int i, pg8::Unit& u) const {
        const int T = tst[NEXP1]; const int end = lend < 0 ? T * NPN : lend;
        int L;
#ifdef G2_DOUBLE
        if (NPN == 8) i >>= 1;
#endif
        if (nheavy > 0) { const int NL = G - nheavy; if (vcu >= NL) L = 2 * NL + i * G + vcu; else L = i < 2 ? i * NL + vcu : 2 * NL + (i - 2) * G + vcu; }
        else L = l0 + i * G + vcu;
        if (L >= end) return false;
        const int gmt = L / NPN, pn = L % NPN; int e = ec; if (tst[e] > gmt) e = 0;
        while (e < NEXP && tst[e + 1] <= gmt) ++e;
        ec = e;
        const int mt = gmt - tst[e];
        if (need > 0 && gmt >= wait_gmt) {
            unsigned spins = 0; while (__hip_atomic_load(flag, __ATOMIC_RELAXED, __HIP_MEMORY_SCOPE_AGENT) < (unsigned)need && ++spins < (1u << 22)) __builtin_amdgcn_s_sleep(2);
            __builtin_amdgcn_fence(__ATOMIC_ACQUIRE, "agent"); asm volatile("s_waitcnt vmcnt(0)" ::: "memory"); }
        u.A = gather ? A : A + (size_t)gmt * 256 * arow; u.B = B + (size_t)e * bexp + (size_t)pn * bpn; u.idx = ltok + e * LCAP + mt * 256; u.wts = lwt + e * LCAP + mt * 256;
        u.r0 = gmt * 256; u.c0 = pn * 256; u.aux = e * LCAP + mt * 256; u.kind = 0; return true;
    }
};

constexpr float GSCALE = 256.0f;
typedef float f32x2v __attribute__((ext_vector_type(2)));
struct EpiProj {
    static constexpr bool PERM = true; static constexpr int NST = 8;
    bf16* O; const float* bgate;
    __device__ __forceinline__ bool operator()(const pg8::f32x4 (&acc)[2][2][4][2], const pg8::Unit& u, int wr, int wc, int fr, int fq, const LAS float* wl) const {
        const int row0 = u.r0 + wr * 64 + fr, col0 = u.c0 + wc * 32 + 8 * fq;
        constexpr float PS = P1_FP8 ? 1.0f / W8SCALE : 1.0f;
        if (u.c0 >= C_GA) {
            f32x4 bb[2][2];
#pragma unroll
            for (int bj = 0; bj < 2; ++bj) { bb[bj][0] = *(const f32x4*)(bgate + col0 + bj * 128 - C_GA); bb[bj][1] = *(const f32x4*)(bgate + col0 + bj * 128 - C_GA + 4); }
            const int odd = fq & 1; unsigned char* G = (unsigned char*)O + (size_t)C_GA * 2 + (col0 - 8 * odd - C_GA);
#pragma unroll
            for (int ai = 0; ai < 2; ++ai)
#pragma unroll
                for (int mp = 0; mp < 2; ++mp)
#pragma unroll
                    for (int bj = 0; bj < 2; ++bj) { v2u w[2];
#pragma unroll
                        for (int mm = 0; mm < 2; ++mm) { const int m = 2 * mp + mm; const f32x4 v0 = acc[ai][bj][m][0] * PS + bb[bj][0], v1 = acc[ai][bj][m][1] * PS + bb[bj][1];
                            int t = __builtin_amdgcn_cvt_pk_fp8_f32(GSCALE * sigmoidf_(v0[0]), GSCALE * sigmoidf_(v0[1]), 0, false); t = __builtin_amdgcn_cvt_pk_fp8_f32(GSCALE * sigmoidf_(v0[2]), GSCALE * sigmoidf_(v0[3]), t, true); w[mm].x = (unsigned)t;
                            t = __builtin_amdgcn_cvt_pk_fp8_f32(GSCALE * sigmoidf_(v1[0]), GSCALE * sigmoidf_(v1[1]), 0, false); t = __builtin_amdgcn_cvt_pk_fp8_f32(GSCALE * sigmoidf_(v1[2]), GSCALE * sigmoidf_(v1[3]), t, true); w[mm].y = (unsigned)t; }
                        *(v4u*)(G + (size_t)(row0 + ai * 128 + (2 * mp + odd) * 16) * (PLD * 2) + bj * 128) = pair16(w[0], w[1]); }
        } else {
#pragma unroll
            for (int ai = 0; ai < 2; ++ai)
#pragma unroll
                for (int m = 0; m < 4; ++m)
#pragma unroll
                    for (int bj = 0; bj < 2; ++bj) { const f32x4 v0 = acc[ai][bj][m][0] * PS, v1 = acc[ai][bj][m][1] * PS;
                        v4u w; w.x = pg8::cvt_pk_bf16(v0[0], v0[1]); w.y = pg8::cvt_pk_bf16(v0[2], v0[3]); w.z = pg8::cvt_pk_bf16(v1[0], v1[1]); w.w = pg8::cvt_pk_bf16(v1[2], v1[3]);
                        *(v4u*)(O + (size_t)(row0 + ai * 128 + m * 16) * PLD + col0 + bj * 128) = w; }
        }
        return false;
    }
};
struct EpiBranch {
    static constexpr bool PERM = true; static constexpr int NST = 0;
    const bf16* proj; unsigned char* O;
    __device__ __forceinline__ bool operator()(pg8::f32x4 (&acc)[2][2][4][2], const pg8::Unit& u, int wr, int wc, int fr, int fq, const LAS float* wl) const {
        const int row0 = u.r0 + wr * 64 + fr, col0 = u.c0 + wc * 32 + 8 * fq;
        const bool seg0 = u.kind == 0;
#pragma unroll
        for (int ai = 0; ai < 2; ++ai) {
            v2u gb[4][2], ga[4][2];
#pragma unroll
            for (int m = 0; m < 4; ++m)
#pragma unroll
                for (int bj = 0; bj < 2; ++bj) { const size_t r = (size_t)(row0 + ai * 128 + m * 16); const int c = col0 + bj * 128;
                    const unsigned char* gp = (const unsigned char*)proj + r * (PLD * 2) + (size_t)C_GA * 2 + c;
                    gb[m][bj] = *(const v2u*)(gp + (C_GB - C_GA)); ga[m][bj] = seg0 ? *(const v2u*)gp : (v2u){0u, 0u}; }
            __builtin_amdgcn_sched_barrier(0);
#pragma unroll
            for (int mp = 0; mp < 2; ++mp) {
                v2u wq[2][2];
#pragma unroll
                for (int mm = 0; mm < 2; ++mm)
#pragma unroll
                    for (int bj = 0; bj < 2; ++bj) { const int m = 2 * mp + mm;
                        const v2u gbv = gb[m][bj], gav = ga[m][bj];
                        const f32x2v g01 = __builtin_amdgcn_cvt_pk_f32_fp8((int)gbv.x, false), g23 = __builtin_amdgcn_cvt_pk_f32_fp8((int)gbv.x, true), g45 = __builtin_amdgcn_cvt_pk_f32_fp8((int)gbv.y, false), g67 = __builtin_amdgcn_cvt_pk_f32_fp8((int)gbv.y, true);
                        float g[8] = {g01[0], g01[1], g23[0], g23[1], g45[0], g45[1], g67[0], g67[1]};
                        if (seg0) {
                            const f32x2v a01 = __builtin_amdgcn_cvt_pk_f32_fp8((int)gav.x, false), a23 = __builtin_amdgcn_cvt_pk_f32_fp8((int)gav.x, true), a45 = __builtin_amdgcn_cvt_pk_f32_fp8((int)gav.y, false), a67 = __builtin_amdgcn_cvt_pk_f32_fp8((int)gav.y, true);
                            float a[8] = {a01[0], a01[1], a23[0], a23[1], a45[0], a45[1], a67[0], a67[1]};
#pragma unroll
                            for (int j = 0; j < 4; ++j) { acc[ai][bj][m][0][j] *= (OB_SCALE / OA_SCALE) * a[j] * __builtin_amdgcn_rcpf(fmaxf(g[j], 1e-30f)); acc[ai][bj][m][1][j] *= (OB_SCALE / OA_SCALE) * a[4 + j] * __builtin_amdgcn_rcpf(fmaxf(g[4 + j], 1e-30f)); }
                        } else {
                            const pg8::f32x4 v0 = acc[ai][bj][m][0], v1 = acc[ai][bj][m][1];
                            constexpr float S1 = MG_SCALE / (OB_SCALE * W8SCALE * GSCALE);
                            v2u w; int t = __builtin_amdgcn_cvt_pk_fp8_f32(v0[0] * g[0] * S1, v0[1] * g[1] * S1, 0, false); t = __builtin_amdgcn_cvt_pk_fp8_f32(v0[2] * g[2] * S1, v0[3] * g[3] * S1, t, true); w.x = (unsigned)t;
                            t = __builtin_amdgcn_cvt_pk_fp8_f32(v1[0] * g[4] * S1, v1[1] * g[5] * S1, 0, false); t = __builtin_amdgcn_cvt_pk_fp8_f32(v1[2] * g[6] * S1, v1[3] * g[7] * S1, t, true); w.y = (unsigned)t;
                            wq[mm][bj] = w;
                        }
                    }
                if (!seg0) { const int odd = fq & 1;
#pragma unroll
                    for (int bj = 0; bj < 2; ++bj) *(v4u*)(O + (size_t)(row0 + ai * 128 + (2 * mp + odd) * 16) * DM + col0 - 8 * odd + bj * 128) = pair16(wq[0][bj], wq[1][bj]); }
            }
            __builtin_amdgcn_sched_barrier(0);
        }
        return seg0;
    }
};
struct EpiMix {
    static constexpr bool PERM = true; static constexpr int NST = 16;
    bf16* O;
    __device__ __forceinline__ bool operator()(const pg8::f32x4 (&acc)[2][2][4][2], const pg8::Unit& u, int wr, int wc, int fr, int fq, const LAS float* wl) const {
        const int row0 = u.r0 + wr * 64 + fr, col0 = u.c0 + wc * 32 + 8 * fq;
#pragma unroll
        for (int ai = 0; ai < 2; ++ai)
#pragma unroll
            for (int m = 0; m < 4; ++m)
#pragma unroll
                for (int bj = 0; bj < 2; ++bj) { const pg8::f32x4 v0 = acc[ai][bj][m][0] * (1.0f / (MG_SCALE * W8SCALE)), v1 = acc[ai][bj][m][1] * (1.0f / (MG_SCALE * W8SCALE));
                    v4u w; w.x = pg8::cvt_pk_bf16(v0[0], v0[1]); w.y = pg8::cvt_pk_bf16(v0[2], v0[3]); w.z = pg8::cvt_pk_bf16(v1[0], v1[1]); w.w = pg8::cvt_pk_bf16(v1[2], v1[3]);
                    *(v4u*)(O + (size_t)(row0 + ai * 128 + m * 16) * DM + col0 + bj * 128) = w; }
        return false;
    }
};
struct EpiMoe1 {
    static constexpr bool PERM = true; static constexpr int NST = 4;
    unsigned char* H;
    __device__ __forceinline__ bool operator()(const pg8::f32x4 (&acc)[2][2][4][2], const pg8::Unit& u, int wr, int wc, int fr, int fq, const LAS float* wl) const {
        const int odd = fq & 1; const int row0 = u.r0 + wr * 64 + fr + odd * 16, col0 = (u.c0 >> 1) + wc * 32 + 8 * (fq - odd);
#pragma unroll
        for (int ai = 0; ai < 2; ++ai)
#pragma unroll
            for (int mp = 0; mp < 2; ++mp) { v2u w[2];
#pragma unroll
                for (int mm = 0; mm < 2; ++mm) { const int m = 2 * mp + mm; float h[8]; const float wt = wl[wr * 64 + fr + ai * 128 + m * 16] * H8SCALE;
#pragma unroll
                    for (int n = 0; n < 2; ++n)
#pragma unroll
                        for (int j = 0; j < 4; ++j) { const float g = acc[ai][0][m][n][j] * (G1_FP8 ? 1.0f / W8SCALE : 1.0f), up = acc[ai][1][m][n][j] * (G1_FP8 ? 1.0f / W8SCALE : 1.0f); h[4 * n + j] = __builtin_amdgcn_fmed3f(g * sigmoidf_(g) * up * wt, -448.0f, 448.0f); }
                    int t = __builtin_amdgcn_cvt_pk_fp8_f32(h[0], h[1], 0, false); t = __builtin_amdgcn_cvt_pk_fp8_f32(h[2], h[3], t, true); w[mm].x = (unsigned)t;
                    t = __builtin_amdgcn_cvt_pk_fp8_f32(h[4], h[5], 0, false); t = __builtin_amdgcn_cvt_pk_fp8_f32(h[6], h[7], t, true); w[mm].y = (unsigned)t; }
                *(v4u*)(H + (size_t)(row0 + ai * 128 + mp * 32) * FE + col0) = pair16(w[0], w[1]); }
        return false;
    }
};
constexpr float YSCALE = 16.0f;
struct EpiMoe2 {
    static constexpr bool PERM = true; static constexpr int NST = 8;
    unsigned char* Y;
    __device__ __forceinline__ bool operator()(const pg8::f32x4 (&acc)[2][2][4][2], const pg8::Unit& u, int wr, int wc, int fr, int fq, const LAS float* wl) const {
        const int odd = fq & 1; const int lr0 = wr * 64 + fr + odd * 16, col0 = u.c0 + wc * 32 + 8 * (fq - odd);
#pragma unroll
        for (int ai = 0; ai < 2; ++ai)
#pragma unroll
            for (int mp = 0; mp < 2; ++mp) { const int lr = lr0 + ai * 128 + mp * 32;
#pragma unroll
                for (int bj = 0; bj < 2; ++bj) { v2u w[2];
#pragma unroll
                    for (int mm = 0; mm < 2; ++mm) { pg8::f32x4 v0 = acc[ai][bj][2 * mp + mm][0] * (YSCALE / (W8SCALE * H8SCALE)), v1 = acc[ai][bj][2 * mp + mm][1] * (YSCALE / (W8SCALE * H8SCALE));
#pragma unroll
                        for (int j = 0; j < 4; ++j) { v0[j] = __builtin_amdgcn_fmed3f(v0[j], -448.0f, 448.0f); v1[j] = __builtin_amdgcn_fmed3f(v1[j], -448.0f, 448.0f); }
                        int t = __builtin_amdgcn_cvt_pk_fp8_f32(v0[0], v0[1], 0, false); t = __builtin_amdgcn_cvt_pk_fp8_f32(v0[2], v0[3], t, true); w[mm].x = (unsigned)t;
                        t = __builtin_amdgcn_cvt_pk_fp8_f32(v1[0], v1[1], 0, false); t = __builtin_amdgcn_cvt_pk_fp8_f32(v1[2], v1[3], t, true); w[mm].y = (unsigned)t; }
                    *(v4u*)(Y + (size_t)(u.r0 + lr) * DM + col0 + bj * 128) = pair16(w[0], w[1]); } }
        return false;
    }
};

__device__ __forceinline__ void p1b_qknorm(Frame& F) {
    const int gw = F.vcu * NWAVES + F.wave, NGW = F.G * NWAVES; const bf16* proj = (const bf16*)(F.ws + WS_PROJ);
    const int hf = F.lane >> 5, i = F.lane & 31;
    const float inv = __builtin_amdgcn_exp2f(-(float)(2 * i) * (1.0f / 64.0f) * 13.287712379549449f);
    const float gk0 = F.in[6][64 * hf + i], gk1 = F.in[6][64 * hf + 32 + i];
    for (int tok0 = gw; tok0 < SEQ; tok0 += 4 * NGW) {
        float x1[4][2], x2[4][2];
#pragma unroll
        for (int b = 0; b < 4; ++b) { const int tok = tok0 + b * NGW; const bf16* pq = proj + (size_t)(tok < SEQ ? tok : 0) * PLD + C_KB + 64 * hf + i;
#pragma unroll
            for (int hh = 0; hh < 2; ++hh) { x1[b][hh] = bf2f(pq[hh * HD]); x2[b][hh] = bf2f(pq[hh * HD + 32]); } }
        __builtin_amdgcn_sched_barrier(0);
#pragma unroll
        for (int b = 0; b < 4; ++b) { const int tok = tok0 + b * NGW;
            const float pos = (float)(hf == 0 ? (tok >> 6) : (tok & 63));
            const float rev = pos * inv * 0.15915494309189535f, fr = rev - floorf(rev);
            const float sn = __builtin_amdgcn_sinf(fr), cs = __builtin_amdgcn_cosf(fr);
#pragma unroll
            for (int hh = 0; hh < 2; ++hh) {
                const float ss = wave_sum(x1[b][hh] * x1[b][hh] + x2[b][hh] * x2[b][hh]);
                const float rs = 1.0f / sqrtf(ss * (1.0f / HD) + RMS_EPS);
                const float a = x1[b][hh] * rs * gk0, c = x2[b][hh] * rs * gk1;
                const float o1 = a * cs - c * sn, o2 = c * cs + a * sn;
                if (tok < SEQ) { unsigned char* kf = F.ws + WS_KF8 + (size_t)tok * 256 + hh * HD + 64 * hf + 32 * ((i >> 4) & 1) + (i & 15);
                    kf[0] = (unsigned char)(__builtin_amdgcn_cvt_pk_fp8_f32(o1, 0.f, 0, false) & 0xff); kf[16] = (unsigned char)(__builtin_amdgcn_cvt_pk_fp8_f32(o2, 0.f, 0, false) & 0xff); } } }
    }
}

__device__ __forceinline__ int t5_bucket(int rel) {
    const int n = rel < 0 ? -rel : rel; int b;
    if (n < 8) b = n; else if (n < 12) b = 8; else if (n < 16) b = 9; else if (n < 23) b = 10; else if (n < 32) b = 11; else if (n < 46) b = 12; else if (n < 64) b = 13; else if (n < 91) b = 14; else b = 15;
    return (rel > 0 ? 16 : 0) + b;
}
#ifndef ATT_PP
#define ATT_PP 1
#endif
#ifndef PROBE_ATT_KMASK
#define PROBE_ATT_KMASK (-1)
#endif
__device__ __forceinline__ void p3_dense_attention(Frame& F) {
    using abf = attn::bf16;
    char* lds = (char*)F.lds;
    const abf* proj = (const abf*)(F.ws + WS_PROJ);
    float gqm = fmaxf(fabsf(F.in[5][F.lane]), fabsf(F.in[5][F.lane + 64])), gkm = fmaxf(fabsf(F.in[6][F.lane]), fabsf(F.in[6][F.lane + 64]));
#pragma unroll
    for (int o = 1; o < 64; o <<= 1) { gqm = fmaxf(gqm, __shfl_xor(gqm, o)); gkm = fmaxf(gkm, __shfl_xor(gkm, o)); }
    const float sbound = 1.15f * 128.0f * gqm * gkm;
    for (int un = F.vcu; un < 256; un += F.G) {
        const int h = un >> 5, ub = un & 31, kvh = h >> 2;
        attn::attn_body<false, 1, true, true, true, -1, ATT_PP != 0>(proj + (size_t)(ub * 256) * PLD + C_QB + h * HD, proj + C_KB + kvh * HD, F.ws + WS_KF8 + kvh * HD, proj + C_VB + kvh * HD,
                               F.ws + WS_OB + (size_t)(ub * 256) * 1024 + h * HD, OB_SCALE, SEQ, lds, nullptr, 0, sbound, 0.f, F.in[5], ub * 256);
#ifdef PROBE_ATT2
        attn::attn_body<false, 1, true, true, true, PROBE_ATT_KMASK>(proj + (size_t)(ub * 256) * PLD + C_QB + h * HD, proj + C_KB + kvh * HD, F.ws + WS_KF8 + kvh * HD, proj + C_VB + kvh * HD,
                               F.ws + WS_MRG + (size_t)(ub * 256) * 1024 + h * HD, OB_SCALE, SEQ, lds, nullptr, 0, sbound, 0.f, F.in[5], ub * 256);
#endif
    }
}
__device__ __forceinline__ void win_attention(Frame& F, int first, int step) {
    using abf = attn::bf16;
    char* lds = (char*)F.lds;
    const abf* proj = (const abf*)(F.ws + WS_PROJ);
    for (int un = first; un < 256; un += step) {
        const int h = un >> 5, ub = un & 31, kvh = h >> 2;
        LAS float* tab = (LAS float*)(F.lds + attn::WIN_TAB);
        for (int e = F.tid; e < 1024; e += NWAVES * 64) { const int rel = e - 512; const int ar = rel < 0 ? -rel : rel;
            tab[e] = ar <= 128 ? F.in[4][t5_bucket(rel) * 8 + h] * (1.0f / attn::SCALE) : -1e30f; }
        __syncthreads();
        const int q0 = ub * 256; int kf = q0 - 128, ke = q0 + 384; if (kf < 0) kf = 0; if (ke > SEQ) ke = SEQ;
        const float sinkl = F.in[3][h] * (1.0f / attn::SCALE);
        attn::attn_body<true, 1, false, false>(proj + (size_t)q0 * PLD + C_QA + h * HD, proj + (size_t)kf * PLD + C_KA + kvh * HD, nullptr, proj + (size_t)kf * PLD + C_VA + kvh * HD,
                              F.ws + WS_OA + (size_t)q0 * 1024 + h * HD, OA_SCALE, ke - kf, lds, tab, kf - q0, sinkl, 1.0f);
    }
}

__device__ __forceinline__ void p5_ln_router(Frame& F, bool probe_rep = false) {
    typedef float f32x4v __attribute__((ext_vector_type(4)));
    const bf16* mixb = (const bf16*)(F.ws + WS_PRE); bf16* hbf = (bf16*)(F.ws + WS_HBF);
    const bf16* wrh = (const bf16*)(F.ws + WS_WR); const bf16* wrl = wrh + NEXP * DM;
    LAS float* red = (LAS float*)(F.lds);
    LAS float* part = (LAS float*)(F.lds + 4096);
    LAS int* cntl = (LAS int*)(F.lds + 4096 + 32768);
    LAS int* basel = cntl + 64;
    LAS int* rec_e = basel + 64;
    LAS int* rec_p = rec_e + 256;
    LAS float* rec_w = (LAS float*)(rec_p + 256);
    const int lane = F.lane, w = F.wave, gi = w >> 2, kq = w & 3, t = lane & 15, q = lane >> 4;
    for (int blk = F.vcu; blk < SEQ / 32; blk += F.G) {
        const int tok = blk * 32 + gi * 16 + t;
        if (F.tid < 64) cntl[F.tid] = 0;
        float s1 = 0.f, s2 = 0.f;
        const float* prow = F.in[0] + (size_t)tok * DM + kq * 512 + 4 * q; const bf16* mrow = mixb + (size_t)tok * DM + kq * 512 + 4 * q;
        f32x4v hv[16][2];
#pragma unroll
        for (int sg = 0; sg < 4; ++sg) {
            f32x4v xa[4][2]; v2u ma[4][2];
#pragma unroll
            for (int u = 0; u < 4; ++u) { const int s = 4 * sg + u; xa[u][0] = *(const f32x4v*)(prow + 32 * s); xa[u][1] = *(const f32x4v*)(prow + 32 * s + 16); ma[u][0] = *(const v2u*)(mrow + 32 * s); ma[u][1] = *(const v2u*)(mrow + 32 * s + 16); }
            __builtin_amdgcn_sched_barrier(0);
#pragma unroll
            for (int u = 0; u < 4; ++u) { const int s = 4 * sg + u; const v2u m0 = ma[u][0], m1 = ma[u][1];
                const f32x4v v0 = xa[u][0] * ALPHA + (f32x4v){pg8::bf_lo(m0.x), pg8::bf_hi(m0.x), pg8::bf_lo(m0.y), pg8::bf_hi(m0.y)}, v1 = xa[u][1] * ALPHA + (f32x4v){pg8::bf_lo(m1.x), pg8::bf_hi(m1.x), pg8::bf_lo(m1.y), pg8::bf_hi(m1.y)};
                hv[s][0] = v0; hv[s][1] = v1;
#pragma unroll
                for (int j = 0; j < 4; ++j) { s1 += v0[j] + v1[j]; s2 += v0[j] * v0[j] + v1[j] * v1[j]; } }
            __builtin_amdgcn_sched_barrier(0);
        }
        s1 += __shfl_xor(s1, 16); s1 += __shfl_xor(s1, 32); s2 += __shfl_xor(s2, 16); s2 += __shfl_xor(s2, 32);
        if (q == 0) { red[(w * 16 + t) * 2] = s1; red[(w * 16 + t) * 2 + 1] = s2; }
        __syncthreads();
        float m1 = 0.f, m2 = 0.f;
#pragma unroll
        for (int k = 0; k < 4; ++k) { m1 += red[((gi * 4 + k) * 16 + t) * 2]; m2 += red[((gi * 4 + k) * 16 + t) * 2 + 1]; }
        const float mean = m1 * (1.0f / DM); const float var = m2 * (1.0f / DM) - mean * mean; const float rstd = 1.0f / sqrtf(var + LN_EPS);
        f32x4v acc[4] = {};
        const float* gp = F.in[10] + kq * 512 + 4 * q; const float* bp = F.in[11] + kq * 512 + 4 * q;
        bf16* brow = hbf + (size_t)tok * DM + kq * 512 + 4 * q; unsigned char* frow = F.ws + WS_HF8 + (size_t)tok * DM + kq * 512 + 4 * q;
        struct P5Set { f32x4v g0, g1, b0, b1; bf16x8 Bh[4], Bl[4]; };
        P5Set A_; const unsigned lane8 = (unsigned)lane * 8u;
#define P5_LOAD(S, X) do { X.g0 = *(const f32x4v*)(gp + 32 * (S)); X.g1 = *(const f32x4v*)(gp + 32 * (S) + 16); X.b0 = *(const f32x4v*)(bp + 32 * (S)); X.b1 = *(const f32x4v*)(bp + 32 * (S) + 16); \
            { const bf16* wuh_ = wrh + (size_t)((kq * 16 + (S)) * 2048); const bf16* wul_ = wuh_ + NEXP * DM;     \
              asm volatile("" : "+s"(wuh_), "+s"(wul_));                                                         \
              _Pragma("unroll") for (int nt = 0; nt < 4; ++nt) { X.Bh[nt] = *(const bf16x8*)(wuh_ + nt * 512 + lane8); X.Bl[nt] = *(const bf16x8*)(wul_ + nt * 512 + lane8); } } } while (0)
#define P5_COMP(S, X) do { const f32x4v p0_ = hv[S][0], p1_ = hv[S][1]; \
            const f32x4v y0 = (p0_ - mean) * rstd * X.g0 + X.b0, y1 = (p1_ - mean) * rstd * X.g1 + X.b1; \
            v4u ah, al; ah.x = pg8::cvt_pk_bf16(y0[0], y0[1]); ah.y = pg8::cvt_pk_bf16(y0[2], y0[3]); ah.z = pg8::cvt_pk_bf16(y1[0], y1[1]); ah.w = pg8::cvt_pk_bf16(y1[2], y1[3]); \
            al.x = pg8::cvt_pk_bf16(y0[0] - pg8::bf_lo(ah.x), y0[1] - pg8::bf_hi(ah.x)); al.y = pg8::cvt_pk_bf16(y0[2] - pg8::bf_lo(ah.y), y0[3] - pg8::bf_hi(ah.y)); \
            al.z = pg8::cvt_pk_bf16(y1[0] - pg8::bf_lo(ah.z), y1[1] - pg8::bf_hi(ah.z)); al.w = pg8::cvt_pk_bf16(y1[2] - pg8::bf_lo(ah.w), y1[3] - pg8::bf_hi(ah.w)); \
            *(v2u*)(brow + 32 * (S)) = (v2u){ah.x, ah.y}; *(v2u*)(brow + 32 * (S) + 16) = (v2u){ah.z, ah.w}; \
            { int t0_ = __builtin_amdgcn_cvt_pk_fp8_f32(y0[0], y0[1], 0, false); t0_ = __builtin_amdgcn_cvt_pk_fp8_f32(y0[2], y0[3], t0_, true); \
              int t1_ = __builtin_amdgcn_cvt_pk_fp8_f32(y1[0], y1[1], 0, false); t1_ = __builtin_amdgcn_cvt_pk_fp8_f32(y1[2], y1[3], t1_, true); \
              *(int*)(frow + 32 * (S)) = t0_; *(int*)(frow + 32 * (S) + 16) = t1_; } \
            const bf16x8 Ah = __builtin_bit_cast(bf16x8, ah), Al = __builtin_bit_cast(bf16x8, al); \
            _Pragma("unroll") for (int nt = 0; nt < 4; ++nt) { acc[nt] = __builtin_amdgcn_mfma_f32_16x16x32_bf16(Ah, X.Bh[nt], acc[nt], 0, 0, 0); \
                acc[nt] = __builtin_amdgcn_mfma_f32_16x16x32_bf16(Al, X.Bh[nt], acc[nt], 0, 0, 0); acc[nt] = __builtin_amdgcn_mfma_f32_16x16x32_bf16(Ah, X.Bl[nt], acc[nt], 0, 0, 0); } } while (0)
#pragma unroll
        for (int s = 0; s < 16; ++s) {
            P5_LOAD(s, A_); __builtin_amdgcn_sched_barrier(0);
            P5_COMP(s, A_); __builtin_amdgcn_sched_barrier(0);
        }
#undef P5_LOAD
#undef P5_COMP
#pragma unroll
        for (int nt = 0; nt < 4; ++nt)
#pragma unroll
            for (int r = 0; r < 4; ++r) part[(w * 16 + 4 * q + r) * 64 + 16 * nt + t] = acc[nt][r];
        __syncthreads();
#ifdef PROBE_P5
        if (PROBE_P5 >= 2 && probe_rep) { __syncthreads(); continue; }
#endif
        const float rb = F.in[13][lane];
#pragma unroll 1
        for (int i = 0; i < 4; ++i) {
            const int tl = w * 4 + i, g2 = tl >> 4, tt = tl & 15;
            float logit = 0.f;
#pragma unroll
            for (int k = 0; k < 4; ++k) logit += part[((g2 * 4 + k) * 16 + tt) * 64 + lane];
            const float sc = 1.0f / (1.0f + expf(-logit));
            const float b = sc + rb;
            float mx = b; mx = fmaxf(mx, __shfl_xor(mx, 1)); mx = fmaxf(mx, __shfl_xor(mx, 2)); mx = fmaxf(mx, __shfl_xor(mx, 4));
            const unsigned long long bal = __ballot(b == mx); const unsigned gm = (unsigned)(bal >> (lane & ~7)) & 0xffu; const int first = __builtin_ctz(gm);
            float b2 = ((lane & 7) == first) ? -INFINITY : b; b2 = fmaxf(b2, __shfl_xor(b2, 1)); b2 = fmaxf(b2, __shfl_xor(b2, 2)); b2 = fmaxf(b2, __shfl_xor(b2, 4));
            const float gs = mx + b2; const int grp = lane >> 3; int gc = 0;
#pragma unroll
            for (int g3 = 0; g3 < 8; ++g3) { const float o = __uint_as_float(__builtin_amdgcn_readlane(__float_as_uint(gs), g3 * 8)); gc += (o > gs || (o == gs && g3 < grp)) ? 1 : 0; }
            const float mk = gc < 4 ? b : -INFINITY; int rank = 0;
#pragma unroll
            for (int j = 0; j < 64; ++j) { const float o = __uint_as_float(__builtin_amdgcn_readlane(__float_as_uint(mk), j)); rank += (o > mk || (o == mk && j < lane)) ? 1 : 0; }
            const bool sel = (gc < 4) && rank < 8;
            const float wsum = wave_sum(sel ? sc : 0.f);
            if (sel) { const int lp = atomicAdd((int*)(cntl + lane), 1); rec_e[tl * 8 + rank] = lane; rec_p[tl * 8 + rank] = lp; rec_w[tl * 8 + rank] = sc / wsum * ROUTED_SCALE; }
        }
        __syncthreads();
#ifdef PROBE_P5
        if (PROBE_P5 == 1 && probe_rep) { __syncthreads(); continue; }
#endif
        if (F.tid < 64) basel[F.tid] = (int)atomicAdd(F.ctl + CW_CNT + F.tid, (unsigned)cntl[F.tid]);
        __syncthreads();
        if (F.tid < 256) { const int tl = F.tid >> 3, e = rec_e[F.tid], pos = basel[e] + rec_p[F.tid]; const int token = blk * 32 + tl;
            ((int*)(F.ws + WS_LTOK))[e * LCAP + pos] = token; ((float*)(F.ws + WS_LW))[e * LCAP + pos] = rec_w[F.tid];
            int* rt = (int*)(F.ws + WS_ROUTE); rt[(token * 8 + (F.tid & 7)) * 2] = e; rt[(token * 8 + (F.tid & 7)) * 2 + 1] = pos; }
        __syncthreads();
    }
}

__device__ __forceinline__ void moe_build_tst(Frame& F) {
    LAS int* tst = (LAS int*)(F.lds + TST_OFF);
    if (F.tid == 0) { int acc = 0; for (int e = 0; e < NEXP1; ++e) { tst[e] = acc; const unsigned c = e < NEXP ? __hip_atomic_load(F.ctl + CW_CNT + e, RLX_AGENT) : (unsigned)SEQ; acc += (int)((c + 255u) >> 8); } tst[NEXP1] = acc; }
    __syncthreads();
}

__device__ __forceinline__ void p9_combine(Frame& F) {
    const LAS int* tst = (const LAS int*)(F.lds + TST_OFF);
    const int gw = F.vcu * NWAVES + F.wave, NGW = F.G * NWAVES; const int lane = F.lane;
    const unsigned char* Y = (const unsigned char*)(F.ws + WS_Y); const bf16* hbf = (const bf16*)(F.ws + WS_HBF); const int* rt = (const int*)(F.ws + WS_ROUTE);
    unsigned rows[9];
#define P9_ROWS(dst, tok_) do { _Pragma("unroll") for (int k = 0; k < 8; ++k) { const int e = rt[((tok_) * 8 + k) * 2], pos = rt[((tok_) * 8 + k) * 2 + 1]; dst[k] = (unsigned)(tst[e] * 256 + pos) * (DM / 8); } \
        dst[8] = (unsigned)(tst[NEXP] * 256 + (tok_)) * (DM / 8); } while (0)
    for (int tok = gw; tok < SEQ; tok += NGW) {
        P9_ROWS(rows, tok);
        float v[4][8]; float s1 = 0.f;
#pragma unroll
        for (int c = 0; c < 4; ++c) { const int col = 512 * c + 8 * lane;
            const v4u hv = __builtin_nontemporal_load((const v4u*)(hbf + (size_t)tok * DM + col));
            const f32x4 a = {pg8::bf_lo(hv.x), pg8::bf_hi(hv.x), pg8::bf_lo(hv.y), pg8::bf_hi(hv.y)}, b = {pg8::bf_lo(hv.z), pg8::bf_hi(hv.z), pg8::bf_lo(hv.w), pg8::bf_hi(hv.w)};
            float r[8] = {0.f, 0.f, 0.f, 0.f, 0.f, 0.f, 0.f, 0.f};
#pragma unroll
            for (int k = 0; k < 9; ++k) { const v2u y = __builtin_nontemporal_load((const v2u*)Y + (size_t)rows[k] + (col >> 3));
                const auto q0 = __builtin_amdgcn_cvt_pk_f32_fp8((int)y.x, false), q1 = __builtin_amdgcn_cvt_pk_f32_fp8((int)y.x, true), q2 = __builtin_amdgcn_cvt_pk_f32_fp8((int)y.y, false), q3 = __builtin_amdgcn_cvt_pk_f32_fp8((int)y.y, true);
                r[0] += q0[0]; r[1] += q0[1]; r[2] += q1[0]; r[3] += q1[1]; r[4] += q2[0]; r[5] += q2[1]; r[6] += q3[0]; r[7] += q3[1]; }
#pragma unroll
            for (int j = 0; j < 4; ++j) { v[c][j] = ALPHA * a[j] + r[j] * (1.0f / YSCALE); v[c][4 + j] = ALPHA * b[j] + r[4 + j] * (1.0f / YSCALE); }
#pragma unroll
            for (int j = 0; j < 8; ++j) s1 += v[c][j]; }
        const float mean = wave_sum(s1) * (1.0f / DM); float s2 = 0.f;
#pragma unroll
        for (int c = 0; c < 4; ++c)
#pragma unroll
            for (int j = 0; j < 8; ++j) { v[c][j] -= mean; s2 += v[c][j] * v[c][j]; }
        const float rstd = 1.0f / sqrtf(wave_sum(s2) * (1.0f / DM) + LN_EPS);
#pragma unroll
        for (int c = 0; c < 4; ++c) { const int col = 512 * c + 8 * lane;
            const f32x4 g0 = *(const f32x4*)(F.in[20] + col), g1 = *(const f32x4*)(F.in[20] + col + 4), b0 = *(const f32x4*)(F.in[21] + col), b1 = *(const f32x4*)(F.in[21] + col + 4);
            f32x4 o0, o1;
#pragma unroll
            for (int j = 0; j < 4; ++j) { o0[j] = v[c][j] * rstd * g0[j] + b0[j]; o1[j] = v[c][4 + j] * rstd * g1[j] + b1[j]; }
            __builtin_nontemporal_store(o0, (f32x4*)(F.out + (size_t)tok * DM + col)); __builtin_nontemporal_store(o1, (f32x4*)(F.out + (size_t)tok * DM + col + 4)); }
    }
#undef P9_ROWS
}

constexpr int NPHASES = 10;
#ifndef MK_ONE_LAUNCH
#define MK_ONE_LAUNCH 1
#endif
__global__ void __launch_bounds__(NWAVES * 64, 2) mega_fwd(Args args) {
    extern __shared__ __attribute__((aligned(16))) unsigned char lds[];
    Frame F;
    F.lds = (LAS unsigned char*)lds;
    F.MISC = (volatile LAS unsigned*)(F.lds + MISC_OFF);
    F.tid = threadIdx.x; F.lane = F.tid & 63; F.wave = __builtin_amdgcn_readfirstlane(F.tid >> 6);
    F.G = gridDim.x; { const int bx = blockIdx.x; F.vcu = (F.G % 8 == 0) ? (bx % 8) * (F.G / 8) + bx / 8 : bx; }
#pragma unroll
    for (int i = 0; i < 22; ++i) F.in[i] = args.in[i];
    F.out = args.out; F.ws = args.ws; F.ctl = (unsigned*)(args.ws + WS_CTL);
    for (int u = F.tid; u < (LDS_BYTES - LDSCTL_OFF) / 4; u += NWAVES * 64) ((LAS unsigned*)(F.lds + LDSCTL_OFF))[u] = 0u;
    __syncthreads();
    XcdBarrier bar; bar.bar = F.ctl + CW_BAR; bar.x = 0; bar.st = nullptr; bar.total = 0; XcdBarrier barB = bar;
    const bool conv1 = (F.G == 256) && (F.vcu & 31) >= P1_NCG;
    if (MK_ONE_LAUNCH) { bar = xcd_barrier_post(F.ctl + CW_BAR, F.MISC + 8, (unsigned)F.G); }
    const int lo = args.ph_lo, hi = args.ph_hi;
#ifndef PH_MASK
#define PH_MASK 0x3ff
#endif
#define IN(k) (((PH_MASK >> (k)) & 1) && lo <= (k) && (k) < hi)
#ifndef REP_MASK
#define REP_MASK 0
#endif
#define REP(k) for (int rep_ = 0; rep_ < 1 + ((REP_MASK >> (k)) & 1); ++rep_)
#ifndef BAR_REP
#define BAR_REP 1
#endif
#define SEAM(k) do { if (IN(k) && IN((k) + 1)) for (int br_ = 0; br_ < BAR_REP; ++br_) xcd_barrier(bar); } while (0)
    LAS int* idxl = (LAS int*)(F.lds + IDXL_OFF);
    const bool tst_needed = true;

    if (IN(0)) REP(0) { p0_prologue(F, false); } SEAM(0);
    if (IN(1)) REP(1) {
        const int grp = F.vcu >> 5, cin = F.vcu & 31;
        const bool conv = (F.G == 256) && cin >= P1_NCG;
        if (conv) { const int cw = (grp * (32 - P1_NCG) + (cin - P1_NCG)) * NWAVES + F.wave; convert_items<1>(F, cw, NCONV1 * NWAVES, E_SPLIT); convert_items<2>(F, cw, NCONV1 * NWAVES, E2_A); }
        else {
            DenseOrder S; if (F.G == 256) S.init(F.ws + WS_XBF, F.ws + WS_WINT, SEQ, INC, DM, NCOMP1, cin * 8 + grp); else S.init(F.ws + WS_XBF, F.ws + WS_WINT, SEQ, INC, DM, F.G, (int)blockIdx.x);
            EpiProj E{(bf16*)(F.ws + WS_PROJ), F.in[2]};
            pg8::gemm_phase<EpiProj, DenseOrder, true, false, P1_FP8 != 0>(F.lds + RING_OFF, idxl, DM, S, E);
        }
    } SEAM(1);
    if (IN(2)) {
        p1b_qknorm(F);
        if (F.G == 256) {
            if (E_SPLIT >= NITEMS_E1 && (CONV_G1 ? E2_SPLIT : E2_A) >= NITEMS_E2) win_attention(F, F.vcu, 256);
            else if (F.vcu & 1) win_attention(F, F.vcu >> 1, 128);
            else { const int cw = (F.vcu >> 1) * NWAVES + F.wave;
                convert_items<1>(F, E_SPLIT + cw, 128 * NWAVES, NITEMS_E1); convert_items<2>(F, (CONV_G1 ? E2_SPLIT : E2_A) + cw, 128 * NWAVES, NITEMS_E2); }
        } else { win_attention(F, F.vcu, F.G); convert_items<1>(F, F.vcu * NWAVES + F.wave, F.G * NWAVES, NITEMS_E1); convert_items<2>(F, F.vcu * NWAVES + F.wave, F.G * NWAVES, NITEMS_E2); }
    } SEAM(2);
    if (IN(3)) REP(3) { p3_dense_attention(F); } SEAM(3);
    if (IN(4)) REP(4) {
        BranchOrder S{(const char*)(F.ws + WS_OA), (const char*)(F.ws + WS_OB), (const char*)(F.ws + WS_WAT), (const char*)(F.ws + WS_WBT), F.vcu};
        EpiBranch E{(const bf16*)(F.ws + WS_PROJ), F.ws + WS_MRG};
        if (F.vcu < 256) pg8::gemm_phase<EpiBranch, BranchOrder, false, false, true>(F.lds + RING_OFF, idxl, 1024, S, E);
    } SEAM(4);
    if (IN(5)) REP(5) {
        OneTileOrder S{(const char*)(F.ws + WS_MRG), (const char*)(F.ws + WS_WOT), F.vcu, (size_t)256 * DM};
        EpiMix E{(bf16*)(F.ws + WS_PRE)};
        if (F.vcu < 256) pg8::gemm_phase<EpiMix, OneTileOrder, false, false, true>(F.lds + RING_OFF, idxl, DM, S, E);
    } SEAM(5);
    if (IN(6)) REP(6) { if (rep_) { xcd_barrier(bar);
#ifndef PROBE_P5
            if (blockIdx.x == 0 && F.tid < 64) __hip_atomic_store(F.ctl + CW_CNT + F.tid, 0u, RLX_AGENT);
#endif
            xcd_barrier(bar); } p5_ln_router(F, rep_ != 0); } SEAM(6);
    if (IN(7) || IN(8) || IN(9)) { if (tst_needed) moe_build_tst(F); }
#ifndef DEFER_MAX
#define DEFER_MAX 64
#endif
    int n_defer = 0, u1_end = -1;
    if (IN(7) || IN(8)) { const int T_ = ((const LAS int*)(F.lds + TST_OFF))[NEXP1]; const int r_ = (4 * T_) % 256;
        if (F.G == 256 && !CONV_G1 && 4 * T_ > 256 && r_ > 0 && r_ <= DEFER_MAX && (lo <= 7 && 8 < hi)) { n_defer = r_; u1_end = 4 * T_ - r_; } }
    if (IN(7)) REP(7) {
        const bool split = CONV_G1 && F.G == 256, conv = split && ((F.vcu & 7) == 7);
        if (conv) { convert_items<2>(F, E2_A + (F.vcu >> 3) * NWAVES + F.wave, NCONV * NWAVES, E2_SPLIT); }
        else {
        MoeOrder<4> S{(const LAS int*)(F.lds + TST_OFF), (const char*)(F.ws + (G1_FP8 ? WS_HF8 : WS_HBF)), (const char*)(F.ws + WS_WGU), (const int*)(F.ws + WS_LTOK), (const float*)(F.ws + WS_LW), split ? F.vcu - (F.vcu >> 3) : F.vcu, split ? NCOMP : F.G, 0, (size_t)1024 * DM * (G1_FP8 ? 1 : 2), (size_t)256 * DM * (G1_FP8 ? 1 : 2), true,
                      0, u1_end, 0, nullptr, 0, 0};
        EpiMoe1 E{F.ws + WS_HID};
        pg8::gemm_phase<EpiMoe1, MoeOrder<4>, true, true, G1_FP8 != 0>(F.lds + RING_OFF, idxl, DM, S, E);
        }
    } SEAM(7);
    if (IN(8)) REP(8) {
        unsigned* dflag = F.ctl + CW_CNT + 128;
        if (n_defer > 0 && F.vcu >= 256 - n_defer) {
            MoeOrder<4> S1{(const LAS int*)(F.lds + TST_OFF), (const char*)(F.ws + (G1_FP8 ? WS_HF8 : WS_HBF)), (const char*)(F.ws + WS_WGU), (const int*)(F.ws + WS_LTOK), (const float*)(F.ws + WS_LW), F.vcu - (256 - n_defer), 256, 0, (size_t)1024 * DM * (G1_FP8 ? 1 : 2), (size_t)256 * DM * (G1_FP8 ? 1 : 2), true,
                           u1_end, u1_end + n_defer, 0, nullptr, 0, 0};
            EpiMoe1 E1{F.ws + WS_HID};
            pg8::gemm_phase<EpiMoe1, MoeOrder<4>, true, true, G1_FP8 != 0>(F.lds + RING_OFF, idxl, DM, S1, E1);
            if (F.tid == 0) { __builtin_amdgcn_fence(__ATOMIC_RELEASE, "agent"); asm volatile("s_waitcnt vmcnt(0)" ::: "memory"); __hip_atomic_fetch_add(dflag, 1u, __ATOMIC_RELAXED, __HIP_MEMORY_SCOPE_AGENT); }
        }
        MoeOrder<8> S{(const LAS int*)(F.lds + TST_OFF), (const char*)(F.ws + WS_HID), (const char*)(F.ws + WS_WD), (const int*)(F.ws + WS_LTOK), (const float*)(F.ws + WS_LW), F.vcu, F.G, (size_t)FE, (size_t)DM * FE, (size_t)256 * FE, false,
                      0, -1, n_defer, dflag, n_defer > 0 ? u1_end / 4 : 0, n_defer};
#ifndef G2_ALIGN
#define G2_ALIGN true
#endif
        EpiMoe2 E{(unsigned char*)(F.ws + WS_Y)};
        pg8::gemm_phase<EpiMoe2, MoeOrder<8>, G2_ALIGN, false, true>(F.lds + RING_OFF, idxl, FE, S, E);
    } SEAM(8);
    if (IN(9)) REP(9) { p9_combine(F); }
#ifdef PROBE_T
    { const LAS int* tst_ = (const LAS int*)(F.lds + TST_OFF); if (tst_[NEXP1] > PROBE_T && blockIdx.x == 0 && F.tid == 0) F.out[0] = __builtin_nanf(""); }
#endif
#undef IN
#undef SEAM
}

extern "C" void kernel_launch(void* const* d_in, const int* in_sizes, int n_in, void* d_out, int out_size, void* d_ws, size_t ws_size, hipStream_t stream) {
    static int grid = 0;
    if (grid == 0) {
        if (n_in != 22 || out_size != SEQ * DM || ws_size < WS_END) { fprintf(stderr, "kernel_launch: unexpected shapes (n_in %d, out %d, ws %zu < %zu); nothing launched\n", n_in, out_size, ws_size, (size_t)WS_END); grid = -1; return; }
        int dev = 0, cus = 0, per_cu = 0;
        if (hipGetDevice(&dev) != hipSuccess || hipDeviceGetAttribute(&cus, hipDeviceAttributeMultiprocessorCount, dev) != hipSuccess) { grid = -1; return; }
        if (hipFuncSetAttribute((const void*)mega_fwd, hipFuncAttributeMaxDynamicSharedMemorySize, LDS_BYTES) != hipSuccess) { fprintf(stderr, "kernel_launch: hipFuncSetAttribute failed\n"); grid = -1; return; }
        if (hipOccupancyMaxActiveBlocksPerMultiprocessor(&per_cu, (const void*)mega_fwd, NWAVES * 64, LDS_BYTES) != hipSuccess || per_cu < 1) { fprintf(stderr, "kernel_launch: occupancy query says %d blocks per CU; nothing launched\n", per_cu); (void)hipGetLastError(); grid = -1; return; }
        grid = cus;
        if (grid > 256) grid = 256;
    }
    if (grid < 0) return;
    (void)hipMemsetAsync((char*)d_ws + WS_CTL, 0, CTL_ZERO_BYTES, stream);
    Args a{};
    for (int i = 0; i < 22; ++i) a.in[i] = (const float*)d_in[i];
    a.out = (float*)d_out; a.ws = (unsigned char*)d_ws;
#if MK_ONE_LAUNCH
    a.ph_lo = 0; a.ph_hi = NPHASES;
    hipLaunchKernelGGL(mega_fwd, dim3(grid), dim3(NWAVES * 64), LDS_BYTES, stream, a);
#else
    for (int p = 0; p < NPHASES; ++p) { a.ph_lo = p; a.ph_hi = p + 1; hipLaunchKernelGGL(mega_fwd, dim3(grid), dim3(NWAVES * 64), LDS_BYTES, stream, a); }
#endif
    const hipError_t le = hipPeekAtLastError();
    if (le != hipSuccess) fprintf(stderr, "kernel_launch: launch failed: %s\n", hipGetErrorName(le));
}
```

```cpp
#define P1_NCG 13
#define CONV_Q 59
#define P1_QE2 28
#define CONV_G1 0
#include <hip/hip_runtime.h>
#include <hip/hip_bf16.h>
#include <cstdio>
#include <cstdint>
#include <cmath>
namespace pg8 {
#define PG8_LAS __attribute__((address_space(3)))
typedef unsigned short bf16_t;
typedef short bf16x8 __attribute__((ext_vector_type(8)));
typedef float f32x4 __attribute__((ext_vector_type(4)));
typedef unsigned u32x4 __attribute__((ext_vector_type(4)));
typedef int v4i_t __attribute__((ext_vector_type(4)));
typedef int v8i_t __attribute__((ext_vector_type(8)));
constexpr int BM = 256, BK = 64, HALF = 128, HTB = HALF * BK * 2  , STAGE_BYTES = 8 * HTB;

__host__ __device__ __forceinline__ int lds_byte(int r, int c) { const int st = (r >> 4) * 2 + (c >> 5), rr = r & 15, cc = c & 31, ob = rr * 64 + cc * 2; return st * 1024 + (ob ^ (((ob >> 9) & 1) << 5)); }
__host__ __device__ __forceinline__ void stage_rc(int b, int& R, int& C) { const int st = b / 1024, sb = b % 1024, swz = sb ^ (((sb >> 9) & 1) << 5); R = (st >> 1) * 16 + swz / 64; C = (st & 1) * 32 + (swz % 64) / 2; }
__host__ __device__ __forceinline__ int perm32(int rho) { const int n = rho >> 4, i = rho & 15; return 8 * (i >> 2) + 4 * n + (i & 3); }

struct Unit { const char* A; const char* B; const int* idx; const float* wts; int r0, c0, aux, kind; };

typedef float f32x2_t __attribute__((ext_vector_type(2))); typedef __bf16 bf16x2_t __attribute__((ext_vector_type(2)));
__device__ __forceinline__ unsigned cvt_pk_bf16(float lo, float hi) { f32x2_t v = {lo, hi}; bf16x2_t b = __builtin_convertvector(v, bf16x2_t); return __builtin_bit_cast(unsigned, b); }
__device__ __forceinline__ float bf_lo(unsigned w) { return __uint_as_float(w << 16); }
__device__ __forceinline__ float bf_hi(unsigned w) { return __uint_as_float(w & 0xffff0000u); }

template <class Epi, class Sched, bool ALIGN_EPI, bool GATHER, bool FP8 = false>
__device__ __forceinline__ void gemm_phase(PG8_LAS unsigned char* lds, PG8_LAS int* idxl, const int K, const Sched& S, const Epi& E) {
    PG8_LAS float* wl = (PG8_LAS float*)(idxl + 256);
    const int tid = threadIdx.x, wid = __builtin_amdgcn_readfirstlane(tid >> 6), lane = tid & 63, wr = wid >> 2, wc = wid & 3, fr = lane & 15, fq = lane >> 4;
    const int KB = FP8 ? K : 2 * K;
    const int nt = KB / 128;
    const size_t kstep = (size_t)(BK * 2);
    const size_t hstep = (size_t)HALF * KB;
    unsigned voffA0[2], voffA1[2], voffB[2];
#pragma unroll
    for (int i = 0; i < 2; ++i) { int R, C; stage_rc(tid * 16 + i * 8192, R, C); const int Rb = Epi::PERM ? ((R & ~31) + perm32(R & 31)) : R;
        voffA0[i] = (unsigned)(R * KB + C * 2); voffA1[i] = voffA0[i] + (unsigned)hstep; voffB[i] = (unsigned)(Rb * KB + C * 2); }
    const unsigned ldsw = (unsigned)wid * 1024u;
    const int aoff = FP8 ? lds_byte(wr * 64 + fr, (fq >> 1) * 32 + (fq & 1) * 16) : lds_byte(wr * 64 + fr, fq * 8), boff = FP8 ? lds_byte(wc * 32 + fr, (fq >> 1) * 32 + (fq & 1) * 16) : lds_byte(wc * 32 + fr, fq * 8);
#define PG8_SA(b, h) (((b) * 2 + (h)) * HTB)
#define PG8_SB(b, h) ((4 + (b) * 2 + (h)) * HTB)
#define PG8_STAGE(bufoff, gbase, voff) do { _Pragma("unroll") for (int _i = 0; _i < 2; ++_i) \
        __builtin_amdgcn_global_load_lds((const unsigned*)((const char*)(gbase) + (voff)[_i]), (PG8_LAS unsigned*)(lds + (bufoff) + ldsw + _i * 8192), 16, 0, 0); } while (0)
#define PG8_LD8(addr) __builtin_shufflevector(*(const PG8_LAS v4i_t*)(addr), *(const PG8_LAS v4i_t*)((addr) + 16), 0, 1, 2, 3, 4, 5, 6, 7)
#define PG8_LDA(dst, b, h) do { if constexpr (FP8) { _Pragma("unroll") for (int m = 0; m < 4; ++m) dst##8[m] = PG8_LD8(lds + PG8_SA(b, h) + aoff + m * 2048); } \
        else { _Pragma("unroll") for (int m = 0; m < 4; ++m) _Pragma("unroll") for (int k = 0; k < 2; ++k) dst[m][k] = *(const PG8_LAS bf16x8*)(lds + PG8_SA(b, h) + aoff + m * 2048 + k * 1024); } } while (0)
#define PG8_LDB(dst, b, h) do { if constexpr (FP8) { _Pragma("unroll") for (int n = 0; n < 2; ++n) dst##8[n] = PG8_LD8(lds + PG8_SB(b, h) + boff + n * 2048); } \
        else { _Pragma("unroll") for (int n = 0; n < 2; ++n) _Pragma("unroll") for (int k = 0; k < 2; ++k) dst[n][k] = *(const PG8_LAS bf16x8*)(lds + PG8_SB(b, h) + boff + n * 2048 + k * 1024); } } while (0)
#define PG8_MMA(ai, bj, At, Bt) do { __builtin_amdgcn_s_setprio(1); _Pragma("unroll") for (int m = 0; m < 4; ++m) _Pragma("unroll") for (int n = 0; n < 2; ++n) { \
        if constexpr (FP8) asm volatile("v_mfma_scale_f32_16x16x128_f8f6f4 %0, %1, %2, %0, %3, %3 op_sel_hi:[0,0,0]" : "+v"(acc[ai][bj][m][n]) : "v"(Bt##8[n]), "v"(At##8[m]), "v"(one_scale)); \
        else { _Pragma("unroll") for (int k = 0; k < 2; ++k) acc[ai][bj][m][n] = __builtin_amdgcn_mfma_f32_16x16x32_bf16(Bt[n][k], At[m][k], acc[ai][bj][m][n], 0, 0, 0); } } __builtin_amdgcn_s_setprio(0); } while (0)
#define PG8_WAIT_V(n) asm volatile("s_waitcnt vmcnt(" #n ")" ::: "memory")
#define PG8_WAIT_L(n) asm volatile("s_waitcnt lgkmcnt(" #n ")" ::: "memory")
#define PG8_WAIT_VN(n) asm volatile("s_waitcnt vmcnt(%0)" :: "n"(n) : "memory")
#define PG8_WAIT_VR(sel) do { if constexpr (Epi::NST > 0) { int _sg; asm volatile("v_readfirstlane_b32 %0, %1\n\ts_nop 0\n\ts_cmp_lg_u32 %0, 0\n\ts_cbranch_scc1 1f\n\ts_waitcnt vmcnt(8)\n\ts_branch 2f\n1:\n\ts_waitcnt vmcnt(%2)\n2:" \
            : "=&s"(_sg) : "v"(sel), "n"(8 + Epi::NST) : "memory", "scc"); } \
        else asm volatile("s_waitcnt vmcnt(8)" ::: "memory"); } while (0)
#define PG8_BAR __builtin_amdgcn_s_barrier()
#define PG8_SCHED __builtin_amdgcn_sched_barrier(0)
#define PG8_GOFF(src) do { _Pragma("unroll") for (int _i = 0; _i < 2; ++_i) { int R_, C_; stage_rc(tid * 16 + _i * 8192, R_, C_); \
        voffA0[_i] = (unsigned)((src)[R_] * KB + C_ * 2); voffA1[_i] = (unsigned)((src)[R_ + HALF] * KB + C_ * 2); } } while (0)
    Unit cur, nxt; int ui = 0;
    if (!S.next(0, cur)) return;
    f32x4 acc[2][2][4][2];
#pragma unroll
    for (int a = 0; a < 2; ++a)
#pragma unroll
        for (int b = 0; b < 2; ++b)
#pragma unroll
            for (int m = 0; m < 4; ++m)
#pragma unroll
                for (int n = 0; n < 2; ++n) acc[a][b][m][n] = (f32x4){0.f, 0.f, 0.f, 0.f};
    bf16x8 At[4][2], B0[2][2], B1[2][2];
    v8i_t At8[4], B08[2], B18[2];
    int one_scale = 0x7f7f7f7f; asm volatile("" : "+v"(one_scale));
    const char* cA = cur.A; const char* cB = cur.B;
    if constexpr (GATHER) { PG8_GOFF(cur.idx); if (tid >= 256) wl[tid - 256] = cur.wts[tid - 256]; }
    PG8_STAGE(PG8_SB(0, 0), cB, voffB); PG8_STAGE(PG8_SB(0, 1), cB + hstep, voffB); PG8_STAGE(PG8_SA(0, 0), cA, voffA0); PG8_STAGE(PG8_SA(0, 1), cA, voffA1);
    if (wr == 1) PG8_BAR;
    PG8_WAIT_V(2); PG8_BAR;
    PG8_STAGE(PG8_SB(1, 0), cB + kstep, voffB); PG8_STAGE(PG8_SA(1, 0), cA + kstep, voffA0); PG8_STAGE(PG8_SB(1, 1), cB + hstep + kstep, voffB);
    PG8_WAIT_V(6); PG8_BAR;
    for (;;) {
        const bool has_next = S.next(ui + 1, nxt);
        const char* nA = has_next ? nxt.A : cA; const char* nB = has_next ? nxt.B : cB;
        if constexpr (GATHER) { if (has_next && tid < 256) {
            __builtin_amdgcn_global_load_lds((const unsigned*)(nxt.idx + tid), (PG8_LAS unsigned*)((PG8_LAS unsigned char*)idxl + wid * 256), 4, 0, 0); }
          if (has_next && tid >= 256) {
            __builtin_amdgcn_global_load_lds((const unsigned*)(nxt.wts + (tid - 256)), (PG8_LAS unsigned*)((PG8_LAS unsigned char*)(wl + ((ui + 1) & 1) * 256) + (wid - 4) * 256), 4, 0, 0); } }
#pragma unroll 1
        for (int t = 0; t < nt; t += 2) {
            const bool last = (t == nt - 2);
            const char* a1 = cA + (size_t)(t + 1) * kstep;
            const char* a2 = last ? nA : cA + (size_t)(t + 2) * kstep; const char* b2 = last ? nB : cB + (size_t)(t + 2) * kstep;
            const char* a3 = a2 + kstep; const char* b3 = b2 + kstep;
            const int rlx = (t == 0 && ui > 0) ? 1 : 0;
            PG8_LDB(B0, 0, 0); PG8_LDB(B1, 0, 1); PG8_SCHED; PG8_LDA(At, 0, 0); PG8_STAGE(PG8_SA(1, 1), a1, voffA1);
            if constexpr (GATHER) { if (last && has_next) { PG8_GOFF(idxl); } }
            PG8_WAIT_VR(rlx); PG8_WAIT_L(0); PG8_BAR; PG8_MMA(0, 0, At, B0); PG8_MMA(0, 1, At, B1); PG8_BAR; PG8_SCHED;
            PG8_LDA(At, 0, 1); PG8_STAGE(PG8_SB(0, 0), b2, voffB); PG8_STAGE(PG8_SB(0, 1), b2 + hstep, voffB); PG8_STAGE(PG8_SA(0, 0), a2, voffA0);
            PG8_WAIT_VR(rlx); PG8_WAIT_L(0); PG8_BAR; PG8_MMA(1, 0, At, B0); PG8_MMA(1, 1, At, B1); PG8_BAR; PG8_SCHED;
            PG8_LDB(B0, 1, 0); PG8_LDB(B1, 1, 1); PG8_SCHED; PG8_LDA(At, 1, 0); PG8_STAGE(PG8_SA(0, 1), a2, voffA1);
            PG8_WAIT_V(8); PG8_WAIT_L(0); PG8_BAR; PG8_MMA(0, 0, At, B0); PG8_MMA(0, 1, At, B1); PG8_BAR; PG8_SCHED;
            PG8_LDA(At, 1, 1); PG8_STAGE(PG8_SB(1, 0), b3, voffB); PG8_STAGE(PG8_SB(1, 1), b3 + hstep, voffB); PG8_STAGE(PG8_SA(1, 0), a3, voffA0);
            PG8_WAIT_V(8); PG8_WAIT_L(0); PG8_BAR; PG8_MMA(1, 0, At, B0); PG8_MMA(1, 1, At, B1); PG8_BAR; PG8_SCHED;
        }
        if constexpr (ALIGN_EPI) { if (wr == 0) PG8_BAR; }
        if constexpr (FP8) asm volatile("s_nop 15\n\ts_nop 15" ::: "memory");
        const bool keep = E(acc, cur, wr, wc, fr, fq, wl + (ui & 1) * 256);
        if (!has_next) break;
        if (!keep) {
#pragma unroll
        for (int a = 0; a < 2; ++a)
#pragma unroll
            for (int b = 0; b < 2; ++b)
#pragma unroll
                for (int m = 0; m < 4; ++m)
#pragma unroll
                    for (int n = 0; n < 2; ++n) acc[a][b][m][n] = (f32x4){0.f, 0.f, 0.f, 0.f};
        }
        cur = nxt; cA = nA; cB = nB; ++ui;
        if constexpr (ALIGN_EPI) { if (wr == 1) PG8_BAR; }
    }
    PG8_WAIT_V(0);
    if constexpr (!ALIGN_EPI) { if (wr == 0) PG8_BAR; }
    PG8_BAR;
#undef PG8_SA
#undef PG8_SB
#undef PG8_STAGE
#undef PG8_LDA
#undef PG8_LDB
#undef PG8_MMA
#undef PG8_LD8
#undef PG8_WAIT_V
#undef PG8_WAIT_L
#undef PG8_WAIT_VN
#undef PG8_WAIT_VR
#undef PG8_BAR
#undef PG8_SCHED
#undef PG8_GOFF
}
}
namespace attn {
using bf16 = __hip_bfloat16;
constexpr int   D = 128, NW = 8, QBLK = 32, KVBLK = 64;
constexpr float SCALE = 0.088388347648318440f;
constexpr float THR = 8.f;
constexpr float LOG2E = 1.4426950408889634f;
#ifndef PROJ_PAD
#define PROJ_PAD 64
#endif
constexpr int LDQ = 7168 + PROJ_PAD, LDK = 7168 + PROJ_PAD, LDO = 1024;
constexpr size_t SHM_V = KVBLK * D * 2, SHM_K = KVBLK * D * 2, SHM_ATTN = 2 * SHM_V + 2 * SHM_K + NW * 64 * 4;
constexpr int WIN_TAB = (int)SHM_ATTN;

using bf16x8 = __attribute__((ext_vector_type(8))) short;
using s16x4  = __attribute__((ext_vector_type(4))) short;
using f32x16 = __attribute__((ext_vector_type(16))) float;
using u32x4  = __attribute__((ext_vector_type(4))) unsigned;
using f32x4_a = __attribute__((ext_vector_type(4))) float;
#define KSWZ(row, colB) ((row) * 256 + ((colB) ^ (((row) & 7) << 4)))
#define SBAR() __builtin_amdgcn_sched_barrier(0)
__device__ __forceinline__ int crow(int r, int hi) { return (r & 3) + 8 * (r >> 2) + 4 * hi; }
__device__ __forceinline__ unsigned cvtpk(float lo, float hi) { return pg8::cvt_pk_bf16(lo, hi); }
template <bool FIXM, bool PRE = false>
__device__ __forceinline__ void partialSM(f32x16& p0, f32x16& p1, float& m_reg, float& mn, float& alpha) {
  constexpr float C = SCALE * LOG2E;
  if constexpr (PRE) {
    mn = m_reg; alpha = 1.f;
    for (int r = 0; r < 16; ++r) p0[r] = __builtin_amdgcn_exp2f(p0[r]);
    return;
  }
  if constexpr (FIXM) {
    mn = m_reg; alpha = 1.f; float mnC = -m_reg * C; asm volatile("" : "+v"(mnC));
    typedef float f32x2_p __attribute__((ext_vector_type(2))); const f32x2_p c2 = {C, C}, m2 = {mnC, mnC};
#pragma unroll
    for (int r = 0; r < 16; r += 2) { f32x2_p a = {p0[r], p0[r + 1]}, b = {p1[r], p1[r + 1]}; a = __builtin_elementwise_fma(a, c2, m2); b = __builtin_elementwise_fma(b, c2, m2); p0[r] = a[0]; p0[r + 1] = a[1]; p1[r] = b[0]; p1[r + 1] = b[1]; }
    for (int r = 0; r < 16; ++r) p0[r] = __builtin_amdgcn_exp2f(p0[r]);
    return;
  }
  float pmax = p0[0]; for (int r = 1; r < 16; ++r) pmax = fmaxf(pmax, p0[r]); for (int r = 0; r < 16; ++r) pmax = fmaxf(pmax, p1[r]);
  { auto rr = __builtin_amdgcn_permlane32_swap(__float_as_uint(pmax), __float_as_uint(pmax), false, false);
    pmax = fmaxf(__uint_as_float(rr[0]), __uint_as_float(rr[1])); }
  if (__builtin_expect(__all(pmax - m_reg <= THR / SCALE), 1)) { mn = m_reg; alpha = 1.f; }
  else { mn = fmaxf(m_reg, pmax); alpha = __builtin_amdgcn_exp2f((m_reg - mn) * C); m_reg = mn; }
  float mnC = -mn * C;
  for (int r = 0; r < 16; ++r) p0[r] = fmaf(p0[r], C, mnC); for (int r = 0; r < 16; ++r) p1[r] = fmaf(p1[r], C, mnC);
  for (int r = 0; r < 16; ++r) p0[r] = __builtin_amdgcn_exp2f(p0[r]);
}
__device__ __forceinline__ void finishSM(f32x16& p0, f32x16& p1, float alpha, float& l_reg, bf16x8& pa0, bf16x8& pa1, bf16x8& pa2, bf16x8& pa3) {
  for (int r = 0; r < 16; ++r) p1[r] = __builtin_amdgcn_exp2f(p1[r]);
  float ps = 0; for (int r = 0; r < 16; ++r) ps += p0[r]; for (int r = 0; r < 16; ++r) ps += p1[r];
  { auto rr = __builtin_amdgcn_permlane32_swap(__float_as_uint(ps), __float_as_uint(ps), false, false);
    ps = __uint_as_float(rr[0]) + __uint_as_float(rr[1]); }
  l_reg = l_reg * alpha + ps;
#define PK4(P, BASE, OUT) do { unsigned a0 = cvtpk(P[BASE + 0], P[BASE + 1]), a1 = cvtpk(P[BASE + 2], P[BASE + 3]);   \
    unsigned b0 = cvtpk(P[BASE + 4], P[BASE + 5]), b1 = cvtpk(P[BASE + 6], P[BASE + 7]);                              \
    auto r0 = __builtin_amdgcn_permlane32_swap(a0, b0, false, false); auto r1 = __builtin_amdgcn_permlane32_swap(a1, b1, false, false); \
    u32x4 w = {r0[0], r1[0], r0[1], r1[1]}; OUT = *reinterpret_cast<bf16x8*>(&w); } while (0)
  PK4(p0, 0, pa0); PK4(p0, 8, pa1); PK4(p1, 0, pa2); PK4(p1, 8, pa3);
#undef PK4
}
#define KSWZ8(row, colB) ((row) * 128 + ((colB) ^ (((row) & 7) << 4)))
typedef int v8i_a __attribute__((ext_vector_type(8))); typedef int v4i_a __attribute__((ext_vector_type(4)));
template <bool WIN, bool F8, bool PRE = false>
__device__ __forceinline__ void qkt(f32x16& p0, f32x16& p1, const bf16* Ks, const bf16x8* qr, const v8i_a* q8, int r32, int hi, const __attribute__((address_space(3))) float* tb, const f32x16* cinit = nullptr) {
  if constexpr (F8 && PRE) {
    int one = 0x7f7f7f7f, sc3 = 0x7c7c7c7c; asm volatile("" : "+v"(one), "+v"(sc3));
#pragma unroll
    for (int s = 0; s < 2; ++s) { const int cb = 64 * s + 32 * hi;
      const char* ka = (const char*)Ks + KSWZ8(r32, cb); const char* kb = (const char*)Ks + KSWZ8(32 + r32, cb);
      const v8i_a k0 = __builtin_shufflevector(*reinterpret_cast<const v4i_a*>(ka), *reinterpret_cast<const v4i_a*>((const char*)Ks + KSWZ8(r32, cb + 16)), 0, 1, 2, 3, 4, 5, 6, 7);
      const v8i_a k1 = __builtin_shufflevector(*reinterpret_cast<const v4i_a*>(kb), *reinterpret_cast<const v4i_a*>((const char*)Ks + KSWZ8(32 + r32, cb + 16)), 0, 1, 2, 3, 4, 5, 6, 7);
      if (s == 0) {
        asm volatile("s_nop 1\n\tv_mfma_scale_f32_32x32x64_f8f6f4 %0, %1, %2, %3, %4, %5 op_sel_hi:[0,0,0]" : "=&v"(p0) : "v"(k0), "v"(q8[s]), "v"(*cinit), "v"(one), "v"(sc3));
        asm volatile("v_mfma_scale_f32_32x32x64_f8f6f4 %0, %1, %2, %3, %4, %5 op_sel_hi:[0,0,0]" : "=&v"(p1) : "v"(k1), "v"(q8[s]), "v"(*cinit), "v"(one), "v"(sc3));
      } else {
        asm volatile("v_mfma_scale_f32_32x32x64_f8f6f4 %0, %1, %2, %0, %3, %4 op_sel_hi:[0,0,0]" : "+v"(p0) : "v"(k0), "v"(q8[s]), "v"(one), "v"(sc3));
        asm volatile("v_mfma_scale_f32_32x32x64_f8f6f4 %0, %1, %2, %0, %3, %4 op_sel_hi:[0,0,0]" : "+v"(p1) : "v"(k1), "v"(q8[s]), "v"(one), "v"(sc3)); } }
    asm volatile("s_nop 15\n\ts_nop 15" : "+v"(p0), "+v"(p1));
    return;
  }
  if constexpr (F8) {
    int one = 0x7f7f7f7f; asm volatile("" : "+v"(one));
#pragma unroll
    for (int s = 0; s < 2; ++s) { const int cb = 64 * s + 32 * hi;
      const char* ka = (const char*)Ks + KSWZ8(r32, cb); const char* kb = (const char*)Ks + KSWZ8(32 + r32, cb);
      const v8i_a k0 = __builtin_shufflevector(*reinterpret_cast<const v4i_a*>(ka), *reinterpret_cast<const v4i_a*>((const char*)Ks + KSWZ8(r32, cb + 16)), 0, 1, 2, 3, 4, 5, 6, 7);
      const v8i_a k1 = __builtin_shufflevector(*reinterpret_cast<const v4i_a*>(kb), *reinterpret_cast<const v4i_a*>((const char*)Ks + KSWZ8(32 + r32, cb + 16)), 0, 1, 2, 3, 4, 5, 6, 7);
      if (s == 0) {
        asm volatile("s_nop 1\n\tv_mfma_scale_f32_32x32x64_f8f6f4 %0, %1, %2, 0, %3, %3 op_sel_hi:[0,0,0]" : "=&v"(p0) : "v"(k0), "v"(q8[s]), "v"(one));
        asm volatile("v_mfma_scale_f32_32x32x64_f8f6f4 %0, %1, %2, 0, %3, %3 op_sel_hi:[0,0,0]" : "=&v"(p1) : "v"(k1), "v"(q8[s]), "v"(one));
      } else {
        asm volatile("v_mfma_scale_f32_32x32x64_f8f6f4 %0, %1, %2, %0, %3, %3 op_sel_hi:[0,0,0]" : "+v"(p0) : "v"(k0), "v"(q8[s]), "v"(one));
        asm volatile("v_mfma_scale_f32_32x32x64_f8f6f4 %0, %1, %2, %0, %3, %3 op_sel_hi:[0,0,0]" : "+v"(p1) : "v"(k1), "v"(q8[s]), "v"(one)); } }
    asm volatile("s_nop 15\n\ts_nop 15" : "+v"(p0), "+v"(p1));
    return;
  }
  if constexpr (WIN) {
#pragma unroll
    for (int r = 0; r < 16; ++r) { p0[r] = tb[(r & 3) + 8 * (r >> 2)]; p1[r] = tb[32 + (r & 3) + 8 * (r >> 2)]; }
  } else { p0 = f32x16{}; p1 = f32x16{}; }
  for (int d0 = 0; d0 < 8; ++d0) { int cb = (d0 * 16 + hi * 8) * 2;
    bf16x8 b0 = *reinterpret_cast<const bf16x8*>((const char*)Ks + KSWZ(r32, cb));
    bf16x8 b1 = *reinterpret_cast<const bf16x8*>((const char*)Ks + KSWZ(32 + r32, cb));
    p0 = __builtin_amdgcn_mfma_f32_32x32x16_bf16(b0, qr[d0], p0, 0, 0, 0);
    p1 = __builtin_amdgcn_mfma_f32_32x32x16_bf16(b1, qr[d0], p1, 0, 0, 0); }
}
__device__ __forceinline__ int v_st(int k, int c) { const int kk = (k & ~0xC) | ((k & 4) << 1) | ((k & 8) >> 1); return ((kk >> 3) * 4 + (c >> 5)) * 512 + ((kk & 7) * 32 + (c & 31)) * 2; }
__device__ __forceinline__ int v_rd_base(int lane) { return ((lane & 3) << 3) | (((lane >> 2) & 3) << 6) | (((lane >> 4) & 1) << 5) | (((lane >> 5) & 1) << 8); }
constexpr int v_rd_off(int d0, int ks, int half) { return d0 * 512 + ks * 4096 + half * 2048; }
template <int OFF> __device__ __forceinline__ s16x4 tr_read(int vb) {
  s16x4 r; asm volatile("ds_read_b64_tr_b16 %0, %1 offset:%2" : "=&v"(r) : "v"(vb), "i"(OFF) : "memory"); return r;
}
template <int D0> __device__ __forceinline__ void pv_one(f32x16& od, int vb, bf16x8 pa0, bf16x8 pa1, bf16x8 pa2, bf16x8 pa3) {
  const s16x4 l0 = tr_read<v_rd_off(D0, 0, 0)>(vb), h0 = tr_read<v_rd_off(D0, 0, 1)>(vb), l1 = tr_read<v_rd_off(D0, 1, 0)>(vb), h1 = tr_read<v_rd_off(D0, 1, 1)>(vb);
  const s16x4 l2 = tr_read<v_rd_off(D0, 2, 0)>(vb), h2 = tr_read<v_rd_off(D0, 2, 1)>(vb), l3 = tr_read<v_rd_off(D0, 3, 0)>(vb), h3 = tr_read<v_rd_off(D0, 3, 1)>(vb);
  asm volatile("s_waitcnt lgkmcnt(0)" ::: "memory"); SBAR();
#define PK(L, H) (bf16x8){L[0], L[1], L[2], L[3], H[0], H[1], H[2], H[3]}
  od = __builtin_amdgcn_mfma_f32_32x32x16_bf16(pa0, PK(l0, h0), od, 0, 0, 0);
  od = __builtin_amdgcn_mfma_f32_32x32x16_bf16(pa1, PK(l1, h1), od, 0, 0, 0);
  od = __builtin_amdgcn_mfma_f32_32x32x16_bf16(pa2, PK(l2, h2), od, 0, 0, 0);
  od = __builtin_amdgcn_mfma_f32_32x32x16_bf16(pa3, PK(l3, h3), od, 0, 0, 0);
#undef PK
}
__device__ __forceinline__ void pv_d0(f32x16* o, int vb, bf16x8 pa0, bf16x8 pa1, bf16x8 pa2, bf16x8 pa3) {
  pv_one<0>(o[0], vb, pa0, pa1, pa2, pa3); pv_one<1>(o[1], vb, pa0, pa1, pa2, pa3); pv_one<2>(o[2], vb, pa0, pa1, pa2, pa3); pv_one<3>(o[3], vb, pa0, pa1, pa2, pa3);
}

template <bool WIN, int SDEPTH, bool F8, bool FIXM, bool QN = false, int kmask = -1, bool PP = false>
__device__ __forceinline__ void attn_body(const bf16* __restrict__ Qb, const bf16* __restrict__ Kh, const unsigned char* __restrict__ Kh8, const bf16* __restrict__ Vh,
                                          unsigned char* __restrict__ Ob, float oscale, int seq, char* lds, const __attribute__((address_space(3))) float* tab, int relbase, float m0, float l0,
                                          const float* __restrict__ gq = nullptr, int qpos0 = 0) {
  int tid_ = threadIdx.x; asm volatile("" : "+v"(tid_));
  const int tid = tid_, wid = tid >> 6, lane = tid & 63, r32 = lane & 31, hi = lane >> 5;
  bf16* V_lds = (bf16*)lds; bf16* K_lds = (bf16*)(lds + 2 * SHM_V);
  float* ws = (float*)(lds + 2 * SHM_V + 2 * SHM_K) + wid * 64; float* li_l = ws; float* al_l = ws + 32;
  float m_reg = m0, l_reg = l0; f32x16 o[4]; bf16x8 qr[8];
  const bf16* Qw = Qb + (long)(wid * QBLK + r32) * LDQ + hi * 8;
  v8i_a q8[2];
  if constexpr (F8 && QN) {
    const bf16* Qr = Qb + (long)(wid * QBLK + r32) * LDQ + hi * 16;
    u32x4 raw[2][2][2];
#pragma unroll
    for (int s = 0; s < 2; ++s)
#pragma unroll
      for (int pt = 0; pt < 2; ++pt)
#pragma unroll
        for (int c = 0; c < 2; ++c) raw[s][pt][c] = *reinterpret_cast<const u32x4*>(Qr + 64 * s + 32 * pt + 8 * c);
#define QLO(w_) __uint_as_float((w_) << 16)
#define QHI(w_) __uint_as_float((w_) & 0xffff0000u)
    float ss = 0.f;
#pragma unroll
    for (int s = 0; s < 2; ++s)
#pragma unroll
      for (int pt = 0; pt < 2; ++pt)
#pragma unroll
        for (int c = 0; c < 2; ++c) { const u32x4 v = raw[s][pt][c];
          ss = fmaf(QLO(v.x), QLO(v.x), ss); ss = fmaf(QHI(v.x), QHI(v.x), ss); ss = fmaf(QLO(v.y), QLO(v.y), ss); ss = fmaf(QHI(v.y), QHI(v.y), ss);
          ss = fmaf(QLO(v.z), QLO(v.z), ss); ss = fmaf(QHI(v.z), QHI(v.z), ss); ss = fmaf(QLO(v.w), QLO(v.w), ss); ss = fmaf(QHI(v.w), QHI(v.w), ss); }
    { auto rr = __builtin_amdgcn_permlane32_swap(__float_as_uint(ss), __float_as_uint(ss), false, false); ss = __uint_as_float(rr[0]) + __uint_as_float(rr[1]); }
    const float rs = 1.0f / sqrtf(ss * (1.0f / D) + 1e-6f);
    constexpr float qsc = PP ? 8.0f * SCALE * LOG2E : 1.0f;
    const int tok = qpos0 + wid * QBLK + r32;
#pragma unroll
    for (int s = 0; s < 2; ++s) { int w[8]; const float pos = (float)(s == 0 ? (tok >> 6) : (tok & 63));
#pragma unroll
      for (int c = 0; c < 2; ++c) {
        const u32x4 va = raw[s][0][c], vb = raw[s][1][c];
        const float xa[8] = {QLO(va.x), QHI(va.x), QLO(va.y), QHI(va.y), QLO(va.z), QHI(va.z), QLO(va.w), QHI(va.w)}, xb[8] = {QLO(vb.x), QHI(vb.x), QLO(vb.y), QHI(vb.y), QLO(vb.z), QHI(vb.z), QLO(vb.w), QHI(vb.w)};
        float o1[8], o2[8];
#pragma unroll
        for (int u4 = 0; u4 < 2; ++u4) { const f32x4_a g1 = *reinterpret_cast<const f32x4_a*>(gq + 64 * s + 16 * hi + 8 * c + 4 * u4), g2 = *reinterpret_cast<const f32x4_a*>(gq + 64 * s + 32 + 16 * hi + 8 * c + 4 * u4);
#pragma unroll
          for (int u = 0; u < 4; ++u) { const int t = 4 * u4 + u; const float inv = __builtin_amdgcn_exp2f(-(float)(2 * (16 * hi + 8 * c + t)) * (1.0f / 64.0f) * 13.287712379549449f);
            const float rev = pos * inv * 0.15915494309189535f, fr = rev - floorf(rev); const float sn = __builtin_amdgcn_sinf(fr), cs = __builtin_amdgcn_cosf(fr);
            const float a = xa[t] * rs * g1[u], b = xb[t] * rs * g2[u]; o1[t] = (a * cs - b * sn) * qsc; o2[t] = (b * cs + a * sn) * qsc; } }
        int t0 = __builtin_amdgcn_cvt_pk_fp8_f32(o1[0], o1[1], 0, false); t0 = __builtin_amdgcn_cvt_pk_fp8_f32(o1[2], o1[3], t0, true); w[2 * c] = t0;
        t0 = __builtin_amdgcn_cvt_pk_fp8_f32(o1[4], o1[5], 0, false); t0 = __builtin_amdgcn_cvt_pk_fp8_f32(o1[6], o1[7], t0, true); w[2 * c + 1] = t0;
        t0 = __builtin_amdgcn_cvt_pk_fp8_f32(o2[0], o2[1], 0, false); t0 = __builtin_amdgcn_cvt_pk_fp8_f32(o2[2], o2[3], t0, true); w[4 + 2 * c] = t0;
        t0 = __builtin_amdgcn_cvt_pk_fp8_f32(o2[4], o2[5], 0, false); t0 = __builtin_amdgcn_cvt_pk_fp8_f32(o2[6], o2[7], t0, true); w[4 + 2 * c + 1] = t0; }
      q8[s] = (v8i_a){w[0], w[1], w[2], w[3], w[4], w[5], w[6], w[7]}; }
#undef QLO
#undef QHI
  } else if constexpr (F8) {
    const bf16* Qr = Qb + (long)(wid * QBLK + r32) * LDQ + hi * 32;
#pragma unroll
    for (int s = 0; s < 2; ++s) { int w[8];
#pragma unroll
      for (int c = 0; c < 4; ++c) { const u32x4 v = *reinterpret_cast<const u32x4*>(Qr + 64 * s + 8 * c);
        int t = __builtin_amdgcn_cvt_pk_fp8_f32(__uint_as_float(v.x << 16), __uint_as_float(v.x & 0xffff0000u), 0, false); t = __builtin_amdgcn_cvt_pk_fp8_f32(__uint_as_float(v.y << 16), __uint_as_float(v.y & 0xffff0000u), t, true); w[2 * c] = t;
        t = __builtin_amdgcn_cvt_pk_fp8_f32(__uint_as_float(v.z << 16), __uint_as_float(v.z & 0xffff0000u), 0, false); t = __builtin_amdgcn_cvt_pk_fp8_f32(__uint_as_float(v.w << 16), __uint_as_float(v.w & 0xffff0000u), t, true); w[2 * c + 1] = t; }
      q8[s] = (v8i_a){w[0], w[1], w[2], w[3], w[4], w[5], w[6], w[7]}; }
  } else {
#pragma unroll
    for (int d0 = 0; d0 < 8; ++d0) qr[d0] = *reinterpret_cast<const bf16x8*>(Qw + d0 * 16);
  }
#pragma unroll
  for (int d = 0; d < 4; ++d) { float z_; asm volatile("v_mov_b32 %0, 0" : "=v"(z_));
#pragma unroll
    for (int r = 0; r < 16; ++r) o[d][r] = z_; }
  const int sr = tid >> 4, sc = (tid & 15) * 8, vst0 = v_st(sr, sc), vst1 = v_st(32 + sr, sc);
  const int vb0 = (int)(uintptr_t)V_lds + v_rd_base(lane);
  const __attribute__((address_space(3))) float* tb0 = tab + (relbase - (wid * QBLK + r32) + 512 + 4 * hi);
  struct { bf16x8 vs0, vs1, ks0, ks1; } sr_[SDEPTH];
#define SLOAD(i, k0) do { sr_[i].vs0 = *reinterpret_cast<const bf16x8*>(&Vh[(long)(((k0) & kmask) + sr) * LDK + sc]); sr_[i].vs1 = *reinterpret_cast<const bf16x8*>(&Vh[(long)(((k0) & kmask) + 32 + sr) * LDK + sc]); \
    if constexpr (F8) { sr_[i].ks0 = *reinterpret_cast<const bf16x8*>(&Kh8[(long)(((k0) & kmask) + (tid >> 3)) * 256 + (tid & 7) * 16]); } \
    else { sr_[i].ks0 = *reinterpret_cast<const bf16x8*>(&Kh[(long)(((k0) & kmask) + sr) * LDK + sc]); sr_[i].ks1 = *reinterpret_cast<const bf16x8*>(&Kh[(long)(((k0) & kmask) + 32 + sr) * LDK + sc]); } } while (0)
#define SWRITE(b, i) do { *(bf16x8*)((char*)V_lds + (b) * SHM_V + vst0) = sr_[i].vs0;          \
    *(bf16x8*)((char*)V_lds + (b) * SHM_V + vst1) = sr_[i].vs1; int kc = sc * 2;               \
    if constexpr (F8) { *(bf16x8*)((char*)K_lds + (b) * SHM_K + KSWZ8(tid >> 3, (tid & 7) * 16)) = sr_[i].ks0; } \
    else { *(bf16x8*)((char*)K_lds + (b) * SHM_K + KSWZ(sr, kc)) = sr_[i].ks0;                       \
    *(bf16x8*)((char*)K_lds + (b) * SHM_K + KSWZ(32 + sr, kc)) = sr_[i].ks1; } } while (0)
#define SWAIT() do { if constexpr (SDEPTH == 2) asm volatile("s_waitcnt vmcnt(4)" ::: "memory"); else asm volatile("s_waitcnt vmcnt(0)" ::: "memory"); } while (0)
#define RESC(a) do { if (!FIXM && __any((a) < 1.f)) { if (hi == 0) al_l[r32] = (a); asm volatile("s_waitcnt lgkmcnt(0)" ::: "memory"); \
    for (int d = 0; d < 4; ++d) for (int r = 0; r < 16; ++r) o[d][r] *= al_l[crow(r, hi)]; } } while (0)
  f32x16 pA0, pA1, pB0, pB1; float mnA, mnB, alA, alB; bf16x8 pa0, pa1, pa2, pa3; const int NT = seq / KVBLK;
  if constexpr (PP) {
    static_assert(!PP || (F8 && FIXM && !WIN), "ping-pong path: dense fp8 fixed-reference attention only");
    constexpr int NS = 4, KSLOT = KVBLK * D, VSLOT = KVBLK * D * 2, KRING = NS * VSLOT;
    typedef __attribute__((address_space(3))) unsigned lds_u32;
    const int widu = __builtin_amdgcn_readfirstlane(wid), grp = widu >> 2;
    li_l = (float*)(lds + KRING + NS * KSLOT) + widu * 64; al_l = li_l + 32;
    const __attribute__((address_space(3))) unsigned char* ldsb = (const __attribute__((address_space(3))) unsigned char*)(unsigned)(uintptr_t)lds;
    const int krow = widu * 8 + (lane >> 3);
    const unsigned kofs = (unsigned)(krow * 256 + (((lane & 7) ^ (krow & 7)) << 4));
    unsigned vofs[2];
#pragma unroll
    for (int i = 0; i < 2; ++i) { const int blk = (widu * 2 + i) * 2 + (lane >> 5), kk = (blk >> 2) * 8 + ((lane & 31) >> 2), k = (kk & ~0xC) | ((kk & 4) << 1) | ((kk & 8) >> 1);
      vofs[i] = (unsigned)((k * LDK + (blk & 3) * 32 + 8 * (lane & 3)) * 2); }
#define DMAK(t) do { const int t_ = (t) < NT ? (t) : NT - 1; const unsigned char* kb_ = Kh8 + (long)t_ * (KVBLK * 256); asm volatile("" : "+s"(kb_)); \
      __builtin_amdgcn_global_load_lds((const unsigned*)(kb_ + kofs), (lds_u32*)(ldsb + KRING + ((t) & (NS - 1)) * KSLOT + widu * 1024), 16, 0, 0); } while (0)
#define DMAV(t) do { const int t_ = (t) < NT ? (t) : NT - 1; const unsigned char* vb_ = (const unsigned char*)(Vh + (long)t_ * (KVBLK * LDK)); asm volatile("" : "+s"(vb_)); _Pragma("unroll") for (int i_ = 0; i_ < 2; ++i_) \
      __builtin_amdgcn_global_load_lds((const unsigned*)(vb_ + vofs[i_]), (lds_u32*)(ldsb + ((t) & (NS - 1)) * VSLOT + (widu * 2 + i_) * 1024), 16, 0, 0); } while (0)
#define PBAR() do { asm volatile("s_waitcnt lgkmcnt(0)" ::: "memory"); __builtin_amdgcn_s_barrier(); } while (0)
#define PEND() do { asm volatile("s_waitcnt vmcnt(6)" ::: "memory"); PBAR(); } while (0)
#define KSL(t) ((bf16*)(lds + KRING + ((t) & (NS - 1)) * KSLOT))
#define VSL(t) (vb0 + ((t) & (NS - 1)) * VSLOT)
    DMAK(0); DMAV(0); DMAK(1); DMAV(1); DMAK(2); DMAK(3); DMAV(2);
    asm volatile("s_waitcnt vmcnt(0)" ::: "memory"); PBAR();
    f32x16 cinit; { float nm_ = -m0 * (SCALE * LOG2E); asm volatile("" : "+v"(nm_));
#pragma unroll
      for (int r = 0; r < 16; ++r) cinit[r] = nm_; }
    qkt<WIN, F8, true>(pA0, pA1, KSL(0), qr, q8, r32, hi, tb0, &cinit); partialSM<FIXM, true>(pA0, pA1, m_reg, mnA, alA);
    if (grp == 1) PBAR();
#pragma unroll 1
    for (int t = 1; t < NT; ++t) {
      SBAR(); DMAK(t + 3); SBAR();
      finishSM(pA0, pA1, alA, l_reg, pa0, pa1, pa2, pa3); SBAR();
      qkt<WIN, F8, true>(pA0, pA1, KSL(t), qr, q8, r32, hi, tb0, &cinit); SBAR();
      PEND();
      SBAR(); DMAV(t + 2); SBAR();
      pv_d0(o, VSL(t - 1), pa0, pa1, pa2, pa3); partialSM<FIXM, true>(pA0, pA1, m_reg, mnA, alA); SBAR();
      PEND();
    }
    if (grp == 0) PBAR();
    finishSM(pA0, pA1, alA, l_reg, pa0, pa1, pa2, pa3); SBAR();
    pv_d0(o, VSL(NT - 1), pa0, pa1, pa2, pa3);
    asm volatile("s_waitcnt vmcnt(0)" ::: "memory");
#undef DMAK
#undef DMAV
#undef PBAR
#undef PEND
#undef KSL
#undef VSL
  } else {
  constexpr int SE = 0, SO = SDEPTH - 1;
  SLOAD(SE, 0); asm volatile("s_waitcnt vmcnt(0)" ::: "memory"); SWRITE(0, SE); __syncthreads();
  qkt<WIN, F8>(pA0, pA1, K_lds, qr, q8, r32, hi, tb0); partialSM<FIXM>(pA0, pA1, m_reg, mnA, alA);
  SLOAD(SO, KVBLK); if constexpr (SDEPTH == 2) { if (2 < NT) SLOAD(SE, 2 * KVBLK); }
  SWAIT(); SWRITE(1, SO); __syncthreads();
  for (int j = 1; j + 1 < NT; j += 2) {
    SBAR(); qkt<WIN, F8>(pB0, pB1, (bf16*)((char*)K_lds + SHM_K), qr, q8, r32, hi, tb0 + 64 * j);
    finishSM(pA0, pA1, alA, l_reg, pa0, pa1, pa2, pa3); SBAR();
    SLOAD(SO, (j + SDEPTH) * KVBLK); SBAR();
    pv_d0(o, vb0, pa0, pa1, pa2, pa3); partialSM<FIXM>(pB0, pB1, m_reg, mnB, alB);
    __syncthreads(); SWAIT(); SWRITE(0, SE);
    RESC(alB); __syncthreads();
    SBAR(); qkt<WIN, F8>(pA0, pA1, K_lds, qr, q8, r32, hi, tb0 + 64 * (j + 1));
    finishSM(pB0, pB1, alB, l_reg, pa0, pa1, pa2, pa3); SBAR();
    if (SDEPTH == 1 || j + 3 < NT) SLOAD(SE, (j + 1 + SDEPTH) * KVBLK); SBAR();
    pv_d0(o, vb0 + (int)SHM_V, pa0, pa1, pa2, pa3); partialSM<FIXM>(pA0, pA1, m_reg, mnA, alA);
    __syncthreads(); SWAIT(); SWRITE(1, SO);
    RESC(alA); __syncthreads();
  }
  SBAR(); qkt<WIN, F8>(pB0, pB1, (bf16*)((char*)K_lds + SHM_K), qr, q8, r32, hi, tb0 + 64 * (NT - 1));
  finishSM(pA0, pA1, alA, l_reg, pa0, pa1, pa2, pa3); SBAR();
  pv_d0(o, vb0, pa0, pa1, pa2, pa3); partialSM<FIXM>(pB0, pB1, m_reg, mnB, alB);
  __syncthreads(); RESC(alB);
  finishSM(pB0, pB1, alB, l_reg, pa0, pa1, pa2, pa3); SBAR();
  pv_d0(o, vb0 + (int)SHM_V, pa0, pa1, pa2, pa3);
  }
  if (hi == 0) li_l[r32] = l_reg; asm volatile("s_waitcnt lgkmcnt(0)" ::: "memory");
  float rli[16];
#pragma unroll
  for (int r = 0; r < 16; ++r) rli[r] = __builtin_amdgcn_rcpf(li_l[crow(r, hi)]);
  unsigned char* Ow = Ob + (long)(wid * QBLK) * LDO;
#pragma unroll
  for (int r = 0; r < 16; ++r) { int orow = crow(r, hi); const float sc = rli[r] * oscale;
    for (int d0 = 0; d0 < 4; ++d0) Ow[(long)orow * LDO + d0 * 32 + r32] = (unsigned char)(__builtin_amdgcn_cvt_pk_fp8_f32(o[d0][r] * sc, 0.f, 0, false) & 0xff); }
  __syncthreads();
#undef SLOAD
#undef SWRITE
#undef SWAIT
#undef RESC
}
#undef KSWZ
#undef KSWZ8
#undef SBAR
}
constexpr int NWAVES = 8;
constexpr int SEQ = 8192, DM = 2048, HD = 128, NEXP = 64, TOPK = 8, FE = 512;
constexpr int INC = 7168;
constexpr int PLD = INC + PROJ_PAD;
constexpr int C_QA = 0, C_KA = 1024, C_VA = 1280, C_QB = 1536, C_KB = 2560, C_VB = 2816, C_GA = 3072, C_GB = 5120;
constexpr float LN_EPS = 1e-5f, RMS_EPS = 1e-6f;
constexpr float ALPHA = 1.189207115002721f;
constexpr float ROUTED_SCALE = 2.5f;
constexpr int LCAP = 8192;
constexpr int NEXP1 = NEXP + 1;

constexpr size_t MiB = 1u << 20;
constexpr size_t WS_CTL = 0, CTL_ZERO_BYTES = 1 * MiB;
constexpr size_t WS_WGU = 1 * MiB;
constexpr size_t WS_WINT = WS_WGU + 260 * MiB;
constexpr size_t WS_XBF = WS_WINT + 28 * MiB;
constexpr size_t WS_PROJ = WS_XBF + 32 * MiB;
constexpr size_t WS_OA = WS_PROJ + 116 * MiB;
constexpr size_t WS_OB = WS_OA + 16 * MiB;
constexpr size_t WS_MRG = WS_OB + 16 * MiB;
constexpr size_t WS_WAT = WS_MRG + 32 * MiB;
constexpr size_t WS_WBT = WS_WAT + 4 * MiB;
constexpr size_t WS_WOT = WS_WBT + 4 * MiB;
constexpr size_t WS_DEAD_END = WS_WOT + 8 * MiB;
constexpr size_t WS_Y = WS_WGU;
constexpr size_t WS_WD = WS_DEAD_END;
constexpr size_t WS_WR = WS_WD + 130 * MiB;
constexpr size_t WS_H32 = WS_WR + 1 * MiB;
constexpr size_t WS_HBF = WS_H32 + 64 * MiB;
constexpr size_t WS_HID = WS_HBF + 32 * MiB;
constexpr size_t WS_PRE = WS_HID + 88 * MiB;
constexpr size_t WS_LTOK = WS_PRE + 64 * MiB;
constexpr size_t WS_LW = WS_LTOK + 3 * MiB;
constexpr size_t WS_ROUTE = WS_LW + 3 * MiB;
constexpr size_t WS_HF8 = WS_H32;
constexpr size_t WS_KF8 = WS_H32 + 16 * MiB;
constexpr size_t WS_END = WS_ROUTE + 1 * MiB;
static_assert(WS_Y + 352 * MiB <= WS_WD, "Y overlay");
static_assert((size_t)SEQ * PLD * 2 <= 116 * MiB, "proj slot");
static_assert(WS_END <= 1024 * MiB, "d_ws map must fit 1 GiB");
constexpr int CW_TMO = 0;
constexpr int CW_CNT = 64;
constexpr int CW_BAR = 4096;

constexpr int RING_OFF = 0, RING_BYTES = 131072;
constexpr int LDSCTL_OFF = RING_BYTES;
constexpr int MISC_OFF = LDSCTL_OFF;
constexpr int IDXL_OFF = LDSCTL_OFF + 256;
constexpr int TST_OFF = IDXL_OFF + 1024 + 2048;
constexpr int LDS_BYTES = 147456;
static_assert(TST_OFF + 512 <= LDS_BYTES, "LDS map");

#define GAS __attribute__((address_space(1)))
#define LAS __attribute__((address_space(3)))
typedef unsigned short bf16;
typedef unsigned v4u __attribute__((ext_vector_type(4)));
typedef unsigned v2u __attribute__((ext_vector_type(2)));
typedef float f32x4 __attribute__((ext_vector_type(4)));
typedef short bf16x8 __attribute__((ext_vector_type(8)));
#define RLX_AGENT __ATOMIC_RELAXED, __HIP_MEMORY_SCOPE_AGENT
#define LDS_WAIT() asm volatile("s_waitcnt lgkmcnt(0)" ::: "memory")
#define VM_WAIT() asm volatile("s_waitcnt vmcnt(0)" ::: "memory")
__device__ __forceinline__ unsigned f2bf(float f) { unsigned u = __builtin_bit_cast(unsigned, f); return (u + 0x7fffu + ((u >> 16) & 1u)) >> 16; }
__device__ __forceinline__ unsigned pk2(float lo, float hi) { return f2bf(lo) | (f2bf(hi) << 16); }
__device__ __forceinline__ float bf2f(unsigned short h) { return __uint_as_float((unsigned)h << 16); }

#define XB_TMO      128
#define XB_XCNT(j)  (256  + 64 * (j))
#define XB_XSUB(j)  (1280 + 64 * (j))
#define XB_XGEN(j)  (2304 + 64 * (j))
#define XB_TOP      3328
#define XB_TOPGEN   3392
#define XCD_BAR_WORDS 3456
#define XB_SPIN_CAP (1u << 20)
__device__ __forceinline__ unsigned xb_ld(unsigned* p)              { return __hip_atomic_load(p, __ATOMIC_RELAXED, __HIP_MEMORY_SCOPE_AGENT); }
__device__ __forceinline__ unsigned xb_add(unsigned* p, unsigned v) { return __hip_atomic_fetch_add(p, v, __ATOMIC_RELAXED, __HIP_MEMORY_SCOPE_AGENT); }
__device__ __forceinline__ unsigned xb_xcc_id() { return (unsigned)__builtin_amdgcn_s_getreg((3 << 11) | 20) & 0xFu; }
#define XB_SPIN(cond, bar) do { unsigned _sp = 0; while (cond) { __builtin_amdgcn_s_sleep(1); \
    if ((++_sp & 255u) == 0u) { if (xb_ld(&(bar)[XB_TMO])) break; if (_sp > XB_SPIN_CAP) { atomicAdd(&(bar)[XB_TMO], 1u); break; } } } } while (0)
struct XcdBarrier { unsigned* bar; unsigned x; volatile LAS unsigned* st; unsigned total; };
__device__ __forceinline__ XcdBarrier xcd_barrier_post(unsigned* bar, volatile LAS unsigned* st, unsigned total) {
    XcdBarrier b; b.bar = bar; b.x = xb_xcc_id(); b.st = st; b.total = total;
    if (threadIdx.x == 0) (void)xb_add(&bar[XB_XCNT(b.x)], 1u);
    return b;
}
__device__ __forceinline__ void xcd_barrier_complete(unsigned* bar, unsigned x, unsigned G, unsigned& nloc, unsigned& nx) {
    unsigned sum, cnt, mine, sp = 0u;
    for (;;) {
        sum = 0u; cnt = 0u; mine = 0u;
#pragma unroll
        for (unsigned j = 0; j < 16; ++j) { const unsigned c = xb_ld(&bar[XB_XCNT(j)]); sum += c; cnt += (c > 0u) ? 1u : 0u; mine = (j == x) ? c : mine; }
        if (sum == G) break;
        __builtin_amdgcn_s_sleep(1);
        if ((++sp & 255u) == 0u) { if (xb_ld(&bar[XB_TMO])) break; if (sp > XB_SPIN_CAP) { atomicAdd(&bar[XB_TMO], 1u); break; } }
    }
    nloc = mine > 0u ? mine : 1u; nx = cnt > 0u ? cnt : 1u;
}
__device__ __forceinline__ void xcd_barrier(const XcdBarrier& b) {
    asm volatile("s_waitcnt vmcnt(0)" ::: "memory");
    __syncthreads();
    if (threadIdx.x == 0) {
        unsigned* bar = b.bar;
        __builtin_amdgcn_s_waitcnt(0);
        unsigned nloc = b.st[0], nx = b.st[1];
        if (nloc == 0u) { xcd_barrier_complete(bar, b.x, b.total, nloc, nx); b.st[0] = nloc; b.st[1] = nx; }
        const unsigned old = xb_add(&bar[XB_XSUB(b.x)], 1u);
        const unsigned gen = old / nloc;
        if (old + 1u == (gen + 1u) * nloc) {
            __builtin_amdgcn_fence(__ATOMIC_RELEASE, "agent");
            asm volatile("s_waitcnt vmcnt(0)" ::: "memory");
            const unsigned og = xb_add(&bar[XB_TOP], 1u);
            const unsigned tg = og / nx;
            if (og + 1u == (tg + 1u) * nx) xb_add(&bar[XB_TOPGEN], 1u);
            else XB_SPIN(xb_ld(&bar[XB_TOPGEN]) == tg, bar);
            __builtin_amdgcn_fence(__ATOMIC_ACQUIRE, "agent");
            xb_add(&bar[XB_XGEN(b.x)], 1u);
            asm volatile("s_waitcnt vmcnt(0)" ::: "memory");
        } else {
            XB_SPIN(xb_ld(&bar[XB_XGEN(b.x)]) == gen, bar);
            __builtin_amdgcn_fence(__ATOMIC_ACQUIRE, "agent");
            asm volatile("s_waitcnt vmcnt(0)" ::: "memory");
        }
    }
    __syncthreads();
}

__device__ __forceinline__ float wave_sum(float v) {
#pragma unroll
    for (int o = 1; o < 64; o <<= 1) v += __shfl_xor(v, o);
    return v;
}
__device__ __forceinline__ float sigmoidf_(float x) { return __builtin_amdgcn_rcpf(1.0f + __builtin_amdgcn_exp2f(-x * 1.4426950408889634f)); }

struct Args { const float* in[22]; float* out; unsigned char* ws; int ph_lo, ph_hi; };
struct Frame {
    LAS unsigned char* lds;
    volatile LAS unsigned* MISC;
    unsigned* ctl;
    int tid, lane, wave;
    int vcu, G;
    const float* in[22]; float* out; unsigned char* ws;
};

#ifndef G1_FP8
#define G1_FP8 1
#endif
#ifndef ATT_F8
#define ATT_F8 1
#endif
#ifndef P1_FP8
#define P1_FP8 1
#endif
struct TItem { const float* W; unsigned char* WT; int K, N, k0, n0, drow0, f8; };
constexpr float W8SCALE = 32.0f, H8SCALE = 8.0f, OA_SCALE = 16.0f, OB_SCALE = 64.0f, MG_SCALE = 32.0f;
__device__ __forceinline__ void titem_issue(const TItem& it, LAS unsigned char* buf, int lane) {
#pragma unroll
    for (int g = 0; g < 8; ++g) { const int k = 8 * g + (lane >> 3), pos = lane & 7;
        __builtin_amdgcn_global_load_lds((const unsigned*)(it.W + (size_t)(it.k0 + k) * it.N + it.n0 + 4 * (pos ^ g)), (LAS unsigned*)(buf + g * 1024), 16, 0, 0); }
}
__device__ __forceinline__ void titem_finish(const TItem& it, const LAS float* buf, int lane) {
    const int c = lane & 7;
#pragma unroll
    for (int j = 0; j < 4; ++j) { const int nn = (lane >> 3) + 8 * j; const LAS float* s = buf + (8 * c) * 32 + (((nn >> 2) ^ c) << 2) + (nn & 3);
        const size_t eo = (size_t)(it.drow0 + nn) * it.K + it.k0 + 8 * c;
        if (it.f8) { v2u o; int t = __builtin_amdgcn_cvt_pk_fp8_f32(s[0 * 32] * W8SCALE, s[1 * 32] * W8SCALE, 0, false); t = __builtin_amdgcn_cvt_pk_fp8_f32(s[2 * 32] * W8SCALE, s[3 * 32] * W8SCALE, t, true); o.x = (unsigned)t;
            t = __builtin_amdgcn_cvt_pk_fp8_f32(s[4 * 32] * W8SCALE, s[5 * 32] * W8SCALE, 0, false); t = __builtin_amdgcn_cvt_pk_fp8_f32(s[6 * 32] * W8SCALE, s[7 * 32] * W8SCALE, t, true); o.y = (unsigned)t;
            __builtin_nontemporal_store(o, (GAS v2u*)(it.WT + eo)); }
        else { v4u o; o.x = pg8::cvt_pk_bf16(s[0 * 32], s[1 * 32]); o.y = pg8::cvt_pk_bf16(s[2 * 32], s[3 * 32]); o.z = pg8::cvt_pk_bf16(s[4 * 32], s[5 * 32]); o.w = pg8::cvt_pk_bf16(s[6 * 32], s[7 * 32]);
            __builtin_nontemporal_store(o, (GAS v4u*)(it.WT + 2 * eo)); } }
}
constexpr int I_IN = (DM / 64) * (INC / 32);
constexpr int I_BR = (1024 / 64) * (DM / 32);
constexpr int I_WO = (DM / 64) * (DM / 32);
constexpr int I_GU = (DM / 64) * (FE / 32);
constexpr int I_DN = (FE / 64) * (DM / 32);
constexpr int NITEMS_E1 = 2 * I_BR + I_WO + NEXP1 * 2 * I_GU;
constexpr int NITEMS_E2 = NEXP1 * I_DN;
__device__ __forceinline__ void titem_plain(TItem& it, const float* W, int K, int N, void* WT, int item, int f8 = 0) {
    const int nblk = N / 32, kb = item / nblk, nb = item % nblk; it.W = W; it.WT = (unsigned char*)WT; it.K = K; it.N = N; it.k0 = 64 * kb; it.n0 = 32 * nb; it.drow0 = 32 * nb; it.f8 = f8;
}
template <int LIST>
__device__ __forceinline__ void titem_get(Frame& F, int r, TItem& it) {
    if constexpr (LIST == 0) { titem_plain(it, F.in[1], DM, INC, F.ws + WS_WINT, r, P1_FP8); }
    else if constexpr (LIST == 2) { const int e = r / I_DN; r -= e * I_DN;
        titem_plain(it, e < NEXP ? F.in[16] + (size_t)e * FE * DM : F.in[19], FE, DM, F.ws + WS_WD + (size_t)e * DM * FE, r, 1); }
    else {
        if (r < I_BR) { titem_plain(it, F.in[7], 1024, DM, F.ws + WS_WAT, r, 1); return; } r -= I_BR;
        if (r < I_BR) { titem_plain(it, F.in[8], 1024, DM, F.ws + WS_WBT, r, 1); return; } r -= I_BR;
        if (r < I_WO) { titem_plain(it, F.in[9], DM, DM, F.ws + WS_WOT, r, 1); return; } r -= I_WO;
        const int e = r / (2 * I_GU); r -= e * (2 * I_GU);
        const int half = r >= I_GU ? 1 : 0; r -= half * I_GU;
        const float* w = e < NEXP ? (half ? F.in[15] : F.in[14]) + (size_t)e * DM * FE : (half ? F.in[18] : F.in[17]);
        const int nblk = FE / 32, kb = r / nblk, nb = r % nblk, n0 = 32 * nb;
        it.W = w; it.WT = F.ws + WS_WGU + (size_t)e * 1024 * DM * (G1_FP8 ? 1 : 2); it.f8 = G1_FP8; it.K = DM; it.N = FE; it.k0 = 64 * kb; it.n0 = n0; it.drow0 = 256 * (n0 >> 7) + 128 * half + (n0 & 127);
    }
}
#ifndef CONV_D
#define CONV_D 4
#endif
__device__ __forceinline__ void titem_load(const TItem& it, f32x4 (&r)[8], int lane) {
#pragma unroll
    for (int g = 0; g < 8; ++g) r[g] = __builtin_nontemporal_load((const GAS f32x4*)(it.W + (size_t)(it.k0 + 8 * g + (lane >> 3)) * it.N + it.n0 + 4 * (lane & 7)));
}
__device__ __forceinline__ void titem_store(const TItem& it, const f32x4 (&r)[8], LAS float* buf, int lane) {
#pragma unroll
    for (int g = 0; g < 8; ++g) *(LAS f32x4*)(buf + (8 * g + (lane >> 3)) * 32 + (((lane & 7) ^ g) << 2)) = r[g];
    titem_finish(it, buf, lane);
}
template <int LISTE>
__device__ __forceinline__ void convert_items(Frame& F, int first, int step, int last) {
    LAS float* buf = (LAS float*)(F.lds + RING_OFF + F.wave * 8192);
    if (first >= last) return;
    const int n_my = (last - first + step - 1) / step;
    f32x4 r[CONV_D][8]; TItem it;
#pragma unroll
    for (int d = 0; d < CONV_D; ++d) if (d < n_my) { titem_get<LISTE>(F, first + d * step, it); titem_load(it, r[d], F.lane); }
    for (int base = 0; base < n_my; base += CONV_D) {
#pragma unroll
        for (int d = 0; d < CONV_D; ++d) { const int idx = base + d;
            if (idx < n_my) { titem_get<LISTE>(F, first + idx * step, it); titem_store(it, r[d], buf, F.lane);
                if (idx + CONV_D < n_my) { titem_get<LISTE>(F, first + (idx + CONV_D) * step, it); titem_load(it, r[d], F.lane); } } }
    }
}
#ifndef CONV_Q
#define CONV_Q 200
#endif
#ifndef P1_NCG
#define P1_NCG 23
#endif
constexpr int NCONV = 32, NCOMP = 256 - NCONV, NCONV1 = 8 * (32 - P1_NCG), NCOMP1 = 8 * P1_NCG, E_SPLIT = (NCONV1 * NWAVES * CONV_Q < NITEMS_E1) ? NCONV1 * NWAVES * CONV_Q : NITEMS_E1;
#ifndef CONV_Q2
#define CONV_Q2 100
#endif
#ifndef P1_QE2
#define P1_QE2 0
#endif
constexpr int E2_A = (NCONV1 * NWAVES * P1_QE2 < NITEMS_E2) ? NCONV1 * NWAVES * P1_QE2 : NITEMS_E2;
constexpr int E2_SPLIT = (E2_A + 32 * NWAVES * CONV_Q2 < NITEMS_E2) ? E2_A + 32 * NWAVES * CONV_Q2 : NITEMS_E2;
#ifndef CONV_G1
#define CONV_G1 1
#endif
__device__ __forceinline__ void p0_prologue(Frame& F, bool compute_only) {
    const int gw = (compute_only ? (F.vcu >> 5) * P1_NCG + (F.vcu & 31) : F.vcu) * NWAVES + F.wave, NGW = (compute_only ? NCOMP1 : F.G) * NWAVES;
    convert_items<0>(F, gw, NGW, I_IN);
    { const int gt = gw * 64 + F.lane, NT = NGW * 64; const GAS f32x4* xs = (const GAS f32x4*)F.in[0]; GAS v4u* xo = (GAS v4u*)(F.ws + WS_XBF);
      for (int i = gt; i < SEQ * DM / 8; i += 4 * NT) {
          f32x4 a[4], b[4];
#pragma unroll
          for (int u = 0; u < 4; ++u) if (i + u * NT < SEQ * DM / 8) { a[u] = __builtin_nontemporal_load(xs + 2 * (i + u * NT)); b[u] = __builtin_nontemporal_load(xs + 2 * (i + u * NT) + 1); }
#pragma unroll
          for (int u = 0; u < 4; ++u) if (i + u * NT < SEQ * DM / 8) {
              if (P1_FP8) { v2u o; int t = __builtin_amdgcn_cvt_pk_fp8_f32(a[u].x, a[u].y, 0, false); t = __builtin_amdgcn_cvt_pk_fp8_f32(a[u].z, a[u].w, t, true); o.x = (unsigned)t;
                  t = __builtin_amdgcn_cvt_pk_fp8_f32(b[u].x, b[u].y, 0, false); t = __builtin_amdgcn_cvt_pk_fp8_f32(b[u].z, b[u].w, t, true); o.y = (unsigned)t; ((GAS v2u*)xo)[i + u * NT] = o; }
              else { v4u o; o.x = pg8::cvt_pk_bf16(a[u].x, a[u].y); o.y = pg8::cvt_pk_bf16(a[u].z, a[u].w); o.z = pg8::cvt_pk_bf16(b[u].x, b[u].y); o.w = pg8::cvt_pk_bf16(b[u].z, b[u].w); xo[i + u * NT] = o; } } } }
    { const int gt = gw * 64 + F.lane, NT = NGW * 64; bf16* wr = (bf16*)(F.ws + WS_WR);
      for (int i = gt; i < NEXP * DM; i += NT) {
          const int j_ = i & 7, ln = (i >> 3) & 63, nt_ = (i >> 9) & 3, ks = i >> 11, q_ = ln >> 4, t_ = ln & 15;
          const int k = ks * 32 + (j_ < 4 ? 4 * q_ + j_ : 16 + 4 * q_ + j_ - 4), e = 16 * nt_ + t_;
          const float w = F.in[12][(size_t)k * NEXP + e]; const unsigned h = f2bf(w); const float lo = w - __uint_as_float(h << 16);
          wr[i] = (bf16)h; wr[NEXP * DM + i] = (bf16)f2bf(lo); } }
    { const int gt = gw * 64 + F.lane, NT = NGW * 64; int* lt = (int*)(F.ws + WS_LTOK); float* lw = (float*)(F.ws + WS_LW);
      for (int i = gt; i < NEXP1 * LCAP; i += NT) { const bool sh = i >= NEXP * LCAP; lt[i] = sh ? i - NEXP * LCAP : 0; lw[i] = sh ? 1.0f : 0.0f; } }
}

#ifndef WT_STORES
#define WT_STORES 0
#endif
__device__ __forceinline__ void st_wt8(void* p, v2u w) {
    if (WT_STORES) __hip_atomic_store((unsigned long long*)p, ((unsigned long long)w.y << 32) | w.x, __ATOMIC_RELAXED, __HIP_MEMORY_SCOPE_AGENT);
    else *(v2u*)p = w;
}
__device__ __forceinline__ v4u pair16(v2u a, v2u b) {
    auto sx = __builtin_amdgcn_permlane16_swap(a.x, b.x, false, false);
    auto sy = __builtin_amdgcn_permlane16_swap(a.y, b.y, false, false);
    return (v4u){sx[0], sy[0], sx[1], sy[1]};
}
struct DenseOrder {
    const char* A; const char* B; int nM, nN, nwg, G, c; size_t tstep;
    __device__ __forceinline__ void init(const void* A_, const void* B_, int M, int N, int K, int G_, int c_) { A = (const char*)A_; B = (const char*)B_; nM = M / 256; nN = N / 256; nwg = nM * nN; G = G_; c = c_; tstep = (size_t)256 * K * (P1_FP8 ? 1 : 2); }
    __device__ __forceinline__ bool next(int i, pg8::Unit& u) const {
#ifdef P1_DOUBLE
        const long L = (long)(i >> 1) * G + c; if (L >= nwg) return false;
#else
        const long L = (long)i * G + c; if (L >= nwg) return false;
#endif
        int wgid = (int)L; { const int q = nwg / 8, r = nwg % 8, xcd = wgid % 8, off = wgid / 8; wgid = (xcd < r ? xcd * (q + 1) : r * (q + 1) + (xcd - r) * q) + off; }
        const int nig = 8 * nN, gid = wgid / nig, fm = gid * 8, gsz = (nM - fm) < 8 ? (nM - fm) : 8;
        const int pm = fm + ((wgid % nig) % gsz), pn = (wgid % nig) / gsz;
        u.A = A + (size_t)pm * tstep; u.B = B + (size_t)pn * tstep; u.idx = nullptr; u.wts = nullptr; u.r0 = pm * 256; u.c0 = pn * 256; u.aux = 0; u.kind = 0; return true;
    }
};
struct BranchOrder {
    const char *OA, *OB, *WA, *WB; int vcu;
    __device__ __forceinline__ bool next(int i, pg8::Unit& u) const {
#ifdef P3_DOUBLE
        if (i >= 4) return false; i &= 1;
#else
        if (i >= 2) return false;
#endif
        const int pm = vcu >> 3, pn = vcu & 7; const size_t ts = (size_t)256 * 1024;
        u.A = (i ? OB : OA) + (size_t)pm * ts; u.B = (i ? WB : WA) + (size_t)pn * ts; u.idx = nullptr; u.wts = nullptr; u.r0 = pm * 256; u.c0 = pn * 256; u.aux = 0; u.kind = i; return true;
    }
};
struct OneTileOrder {
    const char *A, *B; int vcu; size_t ts;
    __device__ __forceinline__ bool next(int i, pg8::Unit& u) const {
#ifdef P4_DOUBLE
        if (i >= 2) return false;
#else
        if (i >= 1) return false;
#endif
        const int pm = vcu >> 3, pn = vcu & 7;
        u.A = A + (size_t)pm * ts; u.B = B + (size_t)pn * ts; u.idx = nullptr; u.wts = nullptr; u.r0 = pm * 256; u.c0 = pn * 256; u.aux = 0; u.kind = 0; return true;
    }
};
template <int NPN>
struct MoeOrder {
    const LAS int* tst; const char* A; const char* B; const int* ltok; const float* lwt; int vcu, G; size_t arow, bexp, bpn;
    bool gather;
    int l0, lend, nheavy;
    const unsigned* flag; int wait_gmt, need;
    mutable int ec = 0;
    __device__ __forceinline__ bool next(int i, pg8::Unit& u) const {
        const int T = tst[NEXP1]; const int end = lend < 0 ? T * NPN : lend;
        int L;
#ifdef G2_DOUBLE
        if (NPN == 8) i >>= 1;
#endif
        if (nheavy > 0) { const int NL = G - nheavy; if (vcu >= NL) L = 2 * NL + i * G + vcu; else L = i < 2 ? i * NL + vcu : 2 * NL + (i - 2) * G + vcu; }
        else L = l0 + i * G + vcu;
        if (L >= end) return false;
        const int gmt = L / NPN, pn = L % NPN; int e = ec; if (tst[e] > gmt) e = 0;
        while (e < NEXP && tst[e + 1] <= gmt) ++e;
        ec = e;
        const int mt = gmt - tst[e];
        if (need > 0 && gmt >= wait_gmt) {
            unsigned spins = 0; while (__hip_atomic_load(flag, __ATOMIC_RELAXED, __HIP_MEMORY_SCOPE_AGENT) < (unsigned)need && ++spins < (1u << 22)) __builtin_amdgcn_s_sleep(2);
            __builtin_amdgcn_fence(__ATOMIC_ACQUIRE, "agent"); asm volatile("s_waitcnt vmcnt(0)" ::: "memory"); }
        u.A = gather ? A : A + (size_t)gmt * 256 * arow; u.B = B + (size_t)e * bexp + (size_t)pn * bpn; u.idx = ltok + e * LCAP + mt * 256; u.wts = lwt + e * LCAP + mt * 256;
        u.r0 = gmt * 256; u.c0 = pn * 256; u.aux = e * LCAP + mt * 256; u.kind = 0; return true;
    }
};

constexpr float GSCALE = 256.0f;
typedef float f32x2v __attribute__((ext_vector_type(2)));
struct EpiProj {
    static constexpr bool PERM = true; static constexpr int NST = 8;
    bf16* O; const float* bgate;
    __device__ __forceinline__ bool operator()(const pg8::f32x4 (&acc)[2][2][4][2], const pg8::Unit& u, int wr, int wc, int fr, int fq, const LAS float* wl) const {
        const int row0 = u.r0 + wr * 64 + fr, col0 = u.c0 + wc * 32 + 8 * fq;
        constexpr float PS = P1_FP8 ? 1.0f / W8SCALE : 1.0f;
        if (u.c0 >= C_GA) {
            f32x4 bb[2][2];
#pragma unroll
            for (int bj = 0; bj < 2; ++bj) { bb[bj][0] = *(const f32x4*)(bgate + col0 + bj * 128 - C_GA); bb[bj][1] = *(const f32x4*)(bgate + col0 + bj * 128 - C_GA + 4); }
            const int odd = fq & 1; unsigned char* G = (unsigned char*)O + (size_t)C_GA * 2 + (col0 - 8 * odd - C_GA);
#pragma unroll
            for (int ai = 0; ai < 2; ++ai)
#pragma unroll
                for (int mp = 0; mp < 2; ++mp)
#pragma unroll
                    for (int bj = 0; bj < 2; ++bj) { v2u w[2];
#pragma unroll
                        for (int mm = 0; mm < 2; ++mm) { const int m = 2 * mp + mm; const f32x4 v0 = acc[ai][bj][m][0] * PS + bb[bj][0], v1 = acc[ai][bj][m][1] * PS + bb[bj][1];
                            int t = __builtin_amdgcn_cvt_pk_fp8_f32(GSCALE * sigmoidf_(v0[0]), GSCALE * sigmoidf_(v0[1]), 0, false); t = __builtin_amdgcn_cvt_pk_fp8_f32(GSCALE * sigmoidf_(v0[2]), GSCALE * sigmoidf_(v0[3]), t, true); w[mm].x = (unsigned)t;
                            t = __builtin_amdgcn_cvt_pk_fp8_f32(GSCALE * sigmoidf_(v1[0]), GSCALE * sigmoidf_(v1[1]), 0, false); t = __builtin_amdgcn_cvt_pk_fp8_f32(GSCALE * sigmoidf_(v1[2]), GSCALE * sigmoidf_(v1[3]), t, true); w[mm].y = (unsigned)t; }
                        *(v4u*)(G + (size_t)(row0 + ai * 128 + (2 * mp + odd) * 16) * (PLD * 2) + bj * 128) = pair16(w[0], w[1]); }
        } else {
#pragma unroll
            for (int ai = 0; ai < 2; ++ai)
#pragma unroll
                for (int m = 0; m < 4; ++m)
#pragma unroll
                    for (int bj = 0; bj < 2; ++bj) { const f32x4 v0 = acc[ai][bj][m][0] * PS, v1 = acc[ai][bj][m][1] * PS;
                        v4u w; w.x = pg8::cvt_pk_bf16(v0[0], v0[1]); w.y = pg8::cvt_pk_bf16(v0[2], v0[3]); w.z = pg8::cvt_pk_bf16(v1[0], v1[1]); w.w = pg8::cvt_pk_bf16(v1[2], v1[3]);
                        *(v4u*)(O + (size_t)(row0 + ai * 128 + m * 16) * PLD + col0 + bj * 128) = w; }
        }
        return false;
    }
};
struct EpiBranch {
    static constexpr bool PERM = true; static constexpr int NST = 0;
    const bf16* proj; unsigned char* O;
    __device__ __forceinline__ bool operator()(pg8::f32x4 (&acc)[2][2][4][2], const pg8::Unit& u, int wr, int wc, int fr, int fq, const LAS float* wl) const {
        const int row0 = u.r0 + wr * 64 + fr, col0 = u.c0 + wc * 32 + 8 * fq;
        const bool seg0 = u.kind == 0;
#pragma unroll
        for (int ai = 0; ai < 2; ++ai) {
            v2u gb[4][2], ga[4][2];
#pragma unroll
            for (int m = 0; m < 4; ++m)
#pragma unroll
                for (int bj = 0; bj < 2; ++bj) { const size_t r = (size_t)(row0 + ai * 128 + m * 16); const int c = col0 + bj * 128;
                    const unsigned char* gp = (const unsigned char*)proj + r * (PLD * 2) + (size_t)C_GA * 2 + c;
                    gb[m][bj] = *(const v2u*)(gp + (C_GB - C_GA)); ga[m][bj] = seg0 ? *(const v2u*)gp : (v2u){0u, 0u}; }
            __builtin_amdgcn_sched_barrier(0);
#pragma unroll
            for (int mp = 0; mp < 2; ++mp) {
                v2u wq[2][2];
#pragma unroll
                for (int mm = 0; mm < 2; ++mm)
#pragma unroll
                    for (int bj = 0; bj < 2; ++bj) { const int m = 2 * mp + mm;
                        const v2u gbv = gb[m][bj], gav = ga[m][bj];
                        const f32x2v g01 = __builtin_amdgcn_cvt_pk_f32_fp8((int)gbv.x, false), g23 = __builtin_amdgcn_cvt_pk_f32_fp8((int)gbv.x, true), g45 = __builtin_amdgcn_cvt_pk_f32_fp8((int)gbv.y, false), g67 = __builtin_amdgcn_cvt_pk_f32_fp8((int)gbv.y, true);
                        float g[8] = {g01[0], g01[1], g23[0], g23[1], g45[0], g45[1], g67[0], g67[1]};
                        if (seg0) {
                            const f32x2v a01 = __builtin_amdgcn_cvt_pk_f32_fp8((int)gav.x, false), a23 = __builtin_amdgcn_cvt_pk_f32_fp8((int)gav.x, true), a45 = __builtin_amdgcn_cvt_pk_f32_fp8((int)gav.y, false), a67 = __builtin_amdgcn_cvt_pk_f32_fp8((int)gav.y, true);
                            float a[8] = {a01[0], a01[1], a23[0], a23[1], a45[0], a45[1], a67[0], a67[1]};
#pragma unroll
                            for (int j = 0; j < 4; ++j) { acc[ai][bj][m][0][j] *= (OB_SCALE / OA_SCALE) * a[j] * __builtin_amdgcn_rcpf(fmaxf(g[j], 1e-30f)); acc[ai][bj][m][1][j] *= (OB_SCALE / OA_SCALE) * a[4 + j] * __builtin_amdgcn_rcpf(fmaxf(g[4 + j], 1e-30f)); }
                        } else {
                            const pg8::f32x4 v0 = acc[ai][bj][m][0], v1 = acc[ai][bj][m][1];
                            constexpr float S1 = MG_SCALE / (OB_SCALE * W8SCALE * GSCALE);
                            v2u w; int t = __builtin_amdgcn_cvt_pk_fp8_f32(v0[0] * g[0] * S1, v0[1] * g[1] * S1, 0, false); t = __builtin_amdgcn_cvt_pk_fp8_f32(v0[2] * g[2] * S1, v0[3] * g[3] * S1, t, true); w.x = (unsigned)t;
                            t = __builtin_amdgcn_cvt_pk_fp8_f32(v1[0] * g[4] * S1, v1[1] * g[5] * S1, 0, false); t = __builtin_amdgcn_cvt_pk_fp8_f32(v1[2] * g[6] * S1, v1[3] * g[7] * S1, t, true); w.y = (unsigned)t;
                            wq[mm][bj] = w;
                        }
                    }
                if (!seg0) { const int odd = fq & 1;
#pragma unroll
                    for (int bj = 0; bj < 2; ++bj) *(v4u*)(O + (size_t)(row0 + ai * 128 + (2 * mp + odd) * 16) * DM + col0 - 8 * odd + bj * 128) = pair16(wq[0][bj], wq[1][bj]); }
            }
            __builtin_amdgcn_sched_barrier(0);
        }
        return seg0;
    }
};
struct EpiMix {
    static constexpr bool PERM = true; static constexpr int NST = 16;
    bf16* O;
    __device__ __forceinline__ bool operator()(const pg8::f32x4 (&acc)[2][2][4][2], const pg8::Unit& u, int wr, int wc, int fr, int fq, const LAS float* wl) const {
        const int row0 = u.r0 + wr * 64 + fr, col0 = u.c0 + wc * 32 + 8 * fq;
#pragma unroll
        for (int ai = 0; ai < 2; ++ai)
#pragma unroll
            for (int m = 0; m < 4; ++m)
#pragma unroll
                for (int bj = 0; bj < 2; ++bj) { const pg8::f32x4 v0 = acc[ai][bj][m][0] * (1.0f / (MG_SCALE * W8SCALE)), v1 = acc[ai][bj][m][1] * (1.0f / (MG_SCALE * W8SCALE));
                    v4u w; w.x = pg8::cvt_pk_bf16(v0[0], v0[1]); w.y = pg8::cvt_pk_bf16(v0[2], v0[3]); w.z = pg8::cvt_pk_bf16(v1[0], v1[1]); w.w = pg8::cvt_pk_bf16(v1[2], v1[3]);
                    *(v4u*)(O + (size_t)(row0 + ai * 128 + m * 16) * DM + col0 + bj * 128) = w; }
        return false;
    }
};
struct EpiMoe1 {
    static constexpr bool PERM = true; static constexpr int NST = 4;
    unsigned char* H;
    __device__ __forceinline__ bool operator()(const pg8::f32x4 (&acc)[2][2][4][2], const pg8::Unit& u, int wr, int wc, int fr, int fq, const LAS float* wl) const {
        const int odd = fq & 1; const int row0 = u.r0 + wr * 64 + fr + odd * 16, col0 = (u.c0 >> 1) + wc * 32 + 8 * (fq - odd);
#pragma unroll
        for (int ai = 0; ai < 2; ++ai)
#pragma unroll
            for (int mp = 0; mp < 2; ++mp) { v2u w[2];
#pragma unroll
                for (int mm = 0; mm < 2; ++mm) { const int m = 2 * mp + mm; float h[8]; const float wt = wl[wr * 64 + fr + ai * 128 + m * 16] * H8SCALE;
#pragma unroll
                    for (int n = 0; n < 2; ++n)
#pragma unroll
                        for (int j = 0; j < 4; ++j) { const float g = acc[ai][0][m][n][j] * (G1_FP8 ? 1.0f / W8SCALE : 1.0f), up = acc[ai][1][m][n][j] * (G1_FP8 ? 1.0f / W8SCALE : 1.0f); h[4 * n + j] = __builtin_amdgcn_fmed3f(g * sigmoidf_(g) * up * wt, -448.0f, 448.0f); }
                    int t = __builtin_amdgcn_cvt_pk_fp8_f32(h[0], h[1], 0, false); t = __builtin_amdgcn_cvt_pk_fp8_f32(h[2], h[3], t, true); w[mm].x = (unsigned)t;
                    t = __builtin_amdgcn_cvt_pk_fp8_f32(h[4], h[5], 0, false); t = __builtin_amdgcn_cvt_pk_fp8_f32(h[6], h[7], t, true); w[mm].y = (unsigned)t; }
                *(v4u*)(H + (size_t)(row0 + ai * 128 + mp * 32) * FE + col0) = pair16(w[0], w[1]); }
        return false;
    }
};
constexpr float YSCALE = 16.0f;
struct EpiMoe2 {
    static constexpr bool PERM = true; static constexpr int NST = 8;
    unsigned char* Y;
    __device__ __forceinline__ bool operator()(const pg8::f32x4 (&acc)[2][2][4][2], const pg8::Unit& u, int wr, int wc, int fr, int fq, const LAS float* wl) const {
        const int odd = fq & 1; const int lr0 = wr * 64 + fr + odd * 16, col0 = u.c0 + wc * 32 + 8 * (fq - odd);
#pragma unroll
        for (int ai = 0; ai < 2; ++ai)
#pragma unroll
            for (int mp = 0; mp < 2; ++mp) { const int lr = lr0 + ai * 128 + mp * 32;
#pragma unroll
                for (int bj = 0; bj < 2; ++bj) { v2u w[2];
#pragma unroll
                    for (int mm = 0; mm < 2; ++mm) { pg8::f32x4 v0 = acc[ai][bj][2 * mp + mm][0] * (YSCALE / (W8SCALE * H8SCALE)), v1 = acc[ai][bj][2 * mp + mm][1] * (YSCALE / (W8SCALE * H8SCALE));
#pragma unroll
                        for (int j = 0; j < 4; ++j) { v0[j] = __builtin_amdgcn_fmed3f(v0[j], -448.0f, 448.0f); v1[j] = __builtin_amdgcn_fmed3f(v1[j], -448.0f, 448.0f); }
                        int t = __builtin_amdgcn_cvt_pk_fp8_f32(v0[0], v0[1], 0, false); t = __builtin_amdgcn_cvt_pk_fp8_f32(v0[2], v0[3], t, true); w[mm].x = (unsigned)t;
                        t = __builtin_amdgcn_cvt_pk_fp8_f32(v1[0], v1[1], 0, false); t = __builtin_amdgcn_cvt_pk_fp8_f32(v1[2], v1[3], t, true); w[mm].y = (unsigned)t; }
                    *(v4u*)(Y + (size_t)(u.r0 + lr) * DM + col0 + bj * 128) = pair16(w[0], w[1]); } }
        return false;
    }
};

__device__ __forceinline__ void p1b_qknorm(Frame& F) {
    const int gw = F.vcu * NWAVES + F.wave, NGW = F.G * NWAVES; const bf16* proj = (const bf16*)(F.ws + WS_PROJ);
    const int hf = F.lane >> 5, i = F.lane & 31;
    const float inv = __builtin_amdgcn_exp2f(-(float)(2 * i) * (1.0f / 64.0f) * 13.287712379549449f);
    const float gk0 = F.in[6][64 * hf + i], gk1 = F.in[6][64 * hf + 32 + i];
    for (int tok0 = gw; tok0 < SEQ; tok0 += 4 * NGW) {
        float x1[4][2], x2[4][2];
#pragma unroll
        for (int b = 0; b < 4; ++b) { const int tok = tok0 + b * NGW; const bf16* pq = proj + (size_t)(tok < SEQ ? tok : 0) * PLD + C_KB + 64 * hf + i;
#pragma unroll
            for (int hh = 0; hh < 2; ++hh) { x1[b][hh] = bf2f(pq[hh * HD]); x2[b][hh] = bf2f(pq[hh * HD + 32]); } }
        __builtin_amdgcn_sched_barrier(0);
#pragma unroll
        for (int b = 0; b < 4; ++b) { const int tok = tok0 + b * NGW;
            const float pos = (float)(hf == 0 ? (tok >> 6) : (tok & 63));
            const float rev = pos * inv * 0.15915494309189535f, fr = rev - floorf(rev);
            const float sn = __builtin_amdgcn_sinf(fr), cs = __builtin_amdgcn_cosf(fr);
#pragma unroll
            for (int hh = 0; hh < 2; ++hh) {
                const float ss = wave_sum(x1[b][hh] * x1[b][hh] + x2[b][hh] * x2[b][hh]);
                const float rs = 1.0f / sqrtf(ss * (1.0f / HD) + RMS_EPS);
                const float a = x1[b][hh] * rs * gk0, c = x2[b][hh] * rs * gk1;
                const float o1 = a * cs - c * sn, o2 = c * cs + a * sn;
                if (tok < SEQ) { unsigned char* kf = F.ws + WS_KF8 + (size_t)tok * 256 + hh * HD + 64 * hf + 32 * ((i >> 4) & 1) + (i & 15);
                    kf[0] = (unsigned char)(__builtin_amdgcn_cvt_pk_fp8_f32(o1, 0.f, 0, false) & 0xff); kf[16] = (unsigned char)(__builtin_amdgcn_cvt_pk_fp8_f32(o2, 0.f, 0, false) & 0xff); } } }
    }
}

__device__ __forceinline__ int t5_bucket(int rel) {
    const int n = rel < 0 ? -rel : rel; int b;
    if (n < 8) b = n; else if (n < 12) b = 8; else if (n < 16) b = 9; else if (n < 23) b = 10; else if (n < 32) b = 11; else if (n < 46) b = 12; else if (n < 64) b = 13; else if (n < 91) b = 14; else b = 15;
    return (rel > 0 ? 16 : 0) + b;
}
#ifndef ATT_PP
#define ATT_PP 1
#endif
#ifndef PROBE_ATT_KMASK
#define PROBE_ATT_KMASK (-1)
#endif
__device__ __forceinline__ void p3_dense_attention(Frame& F) {
    using abf = attn::bf16;
    char* lds = (char*)F.lds;
    const abf* proj = (const abf*)(F.ws + WS_PROJ);
    float gqm = fmaxf(fabsf(F.in[5][F.lane]), fabsf(F.in[5][F.lane + 64])), gkm = fmaxf(fabsf(F.in[6][F.lane]), fabsf(F.in[6][F.lane + 64]));
#pragma unroll
    for (int o = 1; o < 64; o <<= 1) { gqm = fmaxf(gqm, __shfl_xor(gqm, o)); gkm = fmaxf(gkm, __shfl_xor(gkm, o)); }
    const float sbound = 1.15f * 128.0f * gqm * gkm;
    for (int un = F.vcu; un < 256; un += F.G) {
        const int h = un >> 5, ub = un & 31, kvh = h >> 2;
        attn::attn_body<false, 1, true, true, true, -1, ATT_PP != 0>(proj + (size_t)(ub * 256) * PLD + C_QB + h * HD, proj + C_KB + kvh * HD, F.ws + WS_KF8 + kvh * HD, proj + C_VB + kvh * HD,
                               F.ws + WS_OB + (size_t)(ub * 256) * 1024 + h * HD, OB_SCALE, SEQ, lds, nullptr, 0, sbound, 0.f, F.in[5], ub * 256);
#ifdef PROBE_ATT2
        attn::attn_body<false, 1, true, true, true, PROBE_ATT_KMASK>(proj + (size_t)(ub * 256) * PLD + C_QB + h * HD, proj + C_KB + kvh * HD, F.ws + WS_KF8 + kvh * HD, proj + C_VB + kvh * HD,
                               F.ws + WS_MRG + (size_t)(ub * 256) * 1024 + h * HD, OB_SCALE, SEQ, lds, nullptr, 0, sbound, 0.f, F.in[5], ub * 256);
#endif
    }
}
__device__ __forceinline__ void win_attention(Frame& F, int first, int step) {
    using abf = attn::bf16;
    char* lds = (char*)F.lds;
    const abf* proj = (const abf*)(F.ws + WS_PROJ);
    for (int un = first; un < 256; un += step) {
        const int h = un >> 5, ub = un & 31, kvh = h >> 2;
        LAS float* tab = (LAS float*)(F.lds + attn::WIN_TAB);
        for (int e = F.tid; e < 1024; e += NWAVES * 64) { const int rel = e - 512; const int ar = rel < 0 ? -rel : rel;
            tab[e] = ar <= 128 ? F.in[4][t5_bucket(rel) * 8 + h] * (1.0f / attn::SCALE) : -1e30f; }
        __syncthreads();
        const int q0 = ub * 256; int kf = q0 - 128, ke = q0 + 384; if (kf < 0) kf = 0; if (ke > SEQ) ke = SEQ;
        const float sinkl = F.in[3][h] * (1.0f / attn::SCALE);
        attn::attn_body<true, 1, false, false>(proj + (size_t)q0 * PLD + C_QA + h * HD, proj + (size_t)kf * PLD + C_KA + kvh * HD, nullptr, proj + (size_t)kf * PLD + C_VA + kvh * HD,
                              F.ws + WS_OA + (size_t)q0 * 1024 + h * HD, OA_SCALE, ke - kf, lds, tab, kf - q0, sinkl, 1.0f);
    }
}

__device__ __forceinline__ void p5_ln_router(Frame& F, bool probe_rep = false) {
    typedef float f32x4v __attribute__((ext_vector_type(4)));
    const bf16* mixb = (const bf16*)(F.ws + WS_PRE); bf16* hbf = (bf16*)(F.ws + WS_HBF);
    const bf16* wrh = (const bf16*)(F.ws + WS_WR); const bf16* wrl = wrh + NEXP * DM;
    LAS float* red = (LAS float*)(F.lds);
    LAS float* part = (LAS float*)(F.lds + 4096);
    LAS int* cntl = (LAS int*)(F.lds + 4096 + 32768);
    LAS int* basel = cntl + 64;
    LAS int* rec_e = basel + 64;
    LAS int* rec_p = rec_e + 256;
    LAS float* rec_w = (LAS float*)(rec_p + 256);
    const int lane = F.lane, w = F.wave, gi = w >> 2, kq = w & 3, t = lane & 15, q = lane >> 4;
    for (int blk = F.vcu; blk < SEQ / 32; blk += F.G) {
        const int tok = blk * 32 + gi * 16 + t;
        if (F.tid < 64) cntl[F.tid] = 0;
        float s1 = 0.f, s2 = 0.f;
        const float* prow = F.in[0] + (size_t)tok * DM + kq * 512 + 4 * q; const bf16* mrow = mixb + (size_t)tok * DM + kq * 512 + 4 * q;
        f32x4v hv[16][2];
#pragma unroll
        for (int sg = 0; sg < 4; ++sg) {
            f32x4v xa[4][2]; v2u ma[4][2];
#pragma unroll
            for (int u = 0; u < 4; ++u) { const int s = 4 * sg + u; xa[u][0] = *(const f32x4v*)(prow + 32 * s); xa[u][1] = *(const f32x4v*)(prow + 32 * s + 16); ma[u][0] = *(const v2u*)(mrow + 32 * s); ma[u][1] = *(const v2u*)(mrow + 32 * s + 16); }
            __builtin_amdgcn_sched_barrier(0);
#pragma unroll
            for (int u = 0; u < 4; ++u) { const int s = 4 * sg + u; const v2u m0 = ma[u][0], m1 = ma[u][1];
                const f32x4v v0 = xa[u][0] * ALPHA + (f32x4v){pg8::bf_lo(m0.x), pg8::bf_hi(m0.x), pg8::bf_lo(m0.y), pg8::bf_hi(m0.y)}, v1 = xa[u][1] * ALPHA + (f32x4v){pg8::bf_lo(m1.x), pg8::bf_hi(m1.x), pg8::bf_lo(m1.y), pg8::bf_hi(m1.y)};
                hv[s][0] = v0; hv[s][1] = v1;
#pragma unroll
                for (int j = 0; j < 4; ++j) { s1 += v0[j] + v1[j]; s2 += v0[j] * v0[j] + v1[j] * v1[j]; } }
            __builtin_amdgcn_sched_barrier(0);
        }
        s1 += __shfl_xor(s1, 16); s1 += __shfl_xor(s1, 32); s2 += __shfl_xor(s2, 16); s2 += __shfl_xor(s2, 32);
        if (q == 0) { red[(w * 16 + t) * 2] = s1; red[(w * 16 + t) * 2 + 1] = s2; }
        __syncthreads();
        float m1 = 0.f, m2 = 0.f;
#pragma unroll
        for (int k = 0; k < 4; ++k) { m1 += red[((gi * 4 + k) * 16 + t) * 2]; m2 += red[((gi * 4 + k) * 16 + t) * 2 + 1]; }
        const float mean = m1 * (1.0f / DM); const float var = m2 * (1.0f / DM) - mean * mean; const float rstd = 1.0f / sqrtf(var + LN_EPS);
        f32x4v acc[4] = {};
        const float* gp = F.in[10] + kq * 512 + 4 * q; const float* bp = F.in[11] + kq * 512 + 4 * q;
        bf16* brow = hbf + (size_t)tok * DM + kq * 512 + 4 * q; unsigned char* frow = F.ws + WS_HF8 + (size_t)tok * DM + kq * 512 + 4 * q;
        struct P5Set { f32x4v g0, g1, b0, b1; bf16x8 Bh[4], Bl[4]; };
        P5Set A_; const unsigned lane8 = (unsigned)lane * 8u;
#define P5_LOAD(S, X) do { X.g0 = *(const f32x4v*)(gp + 32 * (S)); X.g1 = *(const f32x4v*)(gp + 32 * (S) + 16); X.b0 = *(const f32x4v*)(bp + 32 * (S)); X.b1 = *(const f32x4v*)(bp + 32 * (S) + 16); \
            { const bf16* wuh_ = wrh + (size_t)((kq * 16 + (S)) * 2048); const bf16* wul_ = wuh_ + NEXP * DM;     \
              asm volatile("" : "+s"(wuh_), "+s"(wul_));                                                         \
              _Pragma("unroll") for (int nt = 0; nt < 4; ++nt) { X.Bh[nt] = *(const bf16x8*)(wuh_ + nt * 512 + lane8); X.Bl[nt] = *(const bf16x8*)(wul_ + nt * 512 + lane8); } } } while (0)
#define P5_COMP(S, X) do { const f32x4v p0_ = hv[S][0], p1_ = hv[S][1]; \
            const f32x4v y0 = (p0_ - mean) * rstd * X.g0 + X.b0, y1 = (p1_ - mean) * rstd * X.g1 + X.b1; \
            v4u ah, al; ah.x = pg8::cvt_pk_bf16(y0[0], y0[1]); ah.y = pg8::cvt_pk_bf16(y0[2], y0[3]); ah.z = pg8::cvt_pk_bf16(y1[0], y1[1]); ah.w = pg8::cvt_pk_bf16(y1[2], y1[3]); \
            al.x = pg8::cvt_pk_bf16(y0[0] - pg8::bf_lo(ah.x), y0[1] - pg8::bf_hi(ah.x)); al.y = pg8::cvt_pk_bf16(y0[2] - pg8::bf_lo(ah.y), y0[3] - pg8::bf_hi(ah.y)); \
            al.z = pg8::cvt_pk_bf16(y1[0] - pg8::bf_lo(ah.z), y1[1] - pg8::bf_hi(ah.z)); al.w = pg8::cvt_pk_bf16(y1[2] - pg8::bf_lo(ah.w), y1[3] - pg8::bf_hi(ah.w)); \
            *(v2u*)(brow + 32 * (S)) = (v2u){ah.x, ah.y}; *(v2u*)(brow + 32 * (S) + 16) = (v2u){ah.z, ah.w}; \
            { int t0_ = __builtin_amdgcn_cvt_pk_fp8_f32(y0[0], y0[1], 0, false); t0_ = __builtin_amdgcn_cvt_pk_fp8_f32(y0[2], y0[3], t0_, true); \
              int t1_ = __builtin_amdgcn_cvt_pk_fp8_f32(y1[0], y1[1], 0, false); t1_ = __builtin_amdgcn_cvt_pk_fp8_f32(y1[2], y1[3], t1_, true); \
              *(int*)(frow + 32 * (S)) = t0_; *(int*)(frow + 32 * (S) + 16) = t1_; } \
            const bf16x8 Ah = __builtin_bit_cast(bf16x8, ah), Al = __builtin_bit_cast(bf16x8, al); \
            _Pragma("unroll") for (int nt = 0; nt < 4; ++nt) { acc[nt] = __builtin_amdgcn_mfma_f32_16x16x32_bf16(Ah, X.Bh[nt], acc[nt], 0, 0, 0); \
                acc[nt] = __builtin_amdgcn_mfma_f32_16x16x32_bf16(Al, X.Bh[nt], acc[nt], 0, 0, 0); acc[nt] = __builtin_amdgcn_mfma_f32_16x16x32_bf16(Ah, X.Bl[nt], acc[nt], 0, 0, 0); } } while (0)
#pragma unroll
        for (int s = 0; s < 16; ++s) {
            P5_LOAD(s, A_); __builtin_amdgcn_sched_barrier(0);
            P5_COMP(s, A_); __builtin_amdgcn_sched_barrier(0);
        }
#undef P5_LOAD
#undef P5_COMP
#pragma unroll
        for (int nt = 0; nt < 4; ++nt)
#pragma unroll
            for (int r = 0; r < 4; ++r) part[(w * 16 + 4 * q + r) * 64 + 16 * nt + t] = acc[nt][r];
        __syncthreads();
#ifdef PROBE_P5
        if (PROBE_P5 >= 2 && probe_rep) { __syncthreads(); continue; }
#endif
        const float rb = F.in[13][lane];
#pragma unroll 1
        for (int i = 0; i < 4; ++i) {
            const int tl = w * 4 + i, g2 = tl >> 4, tt = tl & 15;
            float logit = 0.f;
#pragma unroll
            for (int k = 0; k < 4; ++k) logit += part[((g2 * 4 + k) * 16 + tt) * 64 + lane];
            const float sc = 1.0f / (1.0f + expf(-logit));
            const float b = sc + rb;
            float mx = b; mx = fmaxf(mx, __shfl_xor(mx, 1)); mx = fmaxf(mx, __shfl_xor(mx, 2)); mx = fmaxf(mx, __shfl_xor(mx, 4));
            const unsigned long long bal = __ballot(b == mx); const unsigned gm = (unsigned)(bal >> (lane & ~7)) & 0xffu; const int first = __builtin_ctz(gm);
            float b2 = ((lane & 7) == first) ? -INFINITY : b; b2 = fmaxf(b2, __shfl_xor(b2, 1)); b2 = fmaxf(b2, __shfl_xor(b2, 2)); b2 = fmaxf(b2, __shfl_xor(b2, 4));
            const float gs = mx + b2; const int grp = lane >> 3; int gc = 0;
#pragma unroll
            for (int g3 = 0; g3 < 8; ++g3) { const float o = __uint_as_float(__builtin_amdgcn_readlane(__float_as_uint(gs), g3 * 8)); gc += (o > gs || (o == gs && g3 < grp)) ? 1 : 0; }
            const float mk = gc < 4 ? b : -INFINITY; int rank = 0;
#pragma unroll
            for (int j = 0; j < 64; ++j) { const float o = __uint_as_float(__builtin_amdgcn_readlane(__float_as_uint(mk), j)); rank += (o > mk || (o == mk && j < lane)) ? 1 : 0; }
            const bool sel = (gc < 4) && rank < 8;
            const float wsum = wave_sum(sel ? sc : 0.f);
            if (sel) { const int lp = atomicAdd((int*)(cntl + lane), 1); rec_e[tl * 8 + rank] = lane; rec_p[tl * 8 + rank] = lp; rec_w[tl * 8 + rank] = sc / wsum * ROUTED_SCALE; }
        }
        __syncthreads();
#ifdef PROBE_P5
        if (PROBE_P5 == 1 && probe_rep) { __syncthreads(); continue; }
#endif
        if (F.tid < 64) basel[F.tid] = (int)atomicAdd(F.ctl + CW_CNT + F.tid, (unsigned)cntl[F.tid]);
        __syncthreads();
        if (F.tid < 256) { const int tl = F.tid >> 3, e = rec_e[F.tid], pos = basel[e] + rec_p[F.tid]; const int token = blk * 32 + tl;
            ((int*)(F.ws + WS_LTOK))[e * LCAP + pos] = token; ((float*)(F.ws + WS_LW))[e * LCAP + pos] = rec_w[F.tid];
            int* rt = (int*)(F.ws + WS_ROUTE); rt[(token * 8 + (F.tid & 7)) * 2] = e; rt[(token * 8 + (F.tid & 7)) * 2 + 1] = pos; }
        __syncthreads();
    }
}

__device__ __forceinline__ void moe_build_tst(Frame& F) {
    LAS int* tst = (LAS int*)(F.lds + TST_OFF);
    if (F.tid == 0) { int acc = 0; for (int e = 0; e < NEXP1; ++e) { tst[e] = acc; const unsigned c = e < NEXP ? __hip_atomic_load(F.ctl + CW_CNT + e, RLX_AGENT) : (unsigned)SEQ; acc += (int)((c + 255u) >> 8); } tst[NEXP1] = acc; }
    __syncthreads();
}

__device__ __forceinline__ void p9_combine(Frame& F) {
    const LAS int* tst = (const LAS int*)(F.lds + TST_OFF);
    const int gw = F.vcu * NWAVES + F.wave, NGW = F.G * NWAVES; const int lane = F.lane;
    const unsigned char* Y = (const unsigned char*)(F.ws + WS_Y); const bf16* hbf = (const bf16*)(F.ws + WS_HBF); const int* rt = (const int*)(F.ws + WS_ROUTE);
    unsigned rows[9];
#define P9_ROWS(dst, tok_) do { _Pragma("unroll") for (int k = 0; k < 8; ++k) { const int e = rt[((tok_) * 8 + k) * 2], pos = rt[((tok_) * 8 + k) * 2 + 1]; dst[k] = (unsigned)(tst[e] * 256 + pos) * (DM / 8); } \
        dst[8] = (unsigned)(tst[NEXP] * 256 + (tok_)) * (DM / 8); } while (0)
    for (int tok = gw; tok < SEQ; tok += NGW) {
        P9_ROWS(rows, tok);
        float v[4][8]; float s1 = 0.f;
#pragma unroll
        for (int c = 0; c < 4; ++c) { const int col = 512 * c + 8 * lane;
            const v4u hv = __builtin_nontemporal_load((const v4u*)(hbf + (size_t)tok * DM + col));
            const f32x4 a = {pg8::bf_lo(hv.x), pg8::bf_hi(hv.x), pg8::bf_lo(hv.y), pg8::bf_hi(hv.y)}, b = {pg8::bf_lo(hv.z), pg8::bf_hi(hv.z), pg8::bf_lo(hv.w), pg8::bf_hi(hv.w)};
            float r[8] = {0.f, 0.f, 0.f, 0.f, 0.f, 0.f, 0.f, 0.f};
#pragma unroll
            for (int k = 0; k < 9; ++k) { const v2u y = __builtin_nontemporal_load((const v2u*)Y + (size_t)rows[k] + (col >> 3));
                const auto q0 = __builtin_amdgcn_cvt_pk_f32_fp8((int)y.x, false), q1 = __builtin_amdgcn_cvt_pk_f32_fp8((int)y.x, true), q2 = __builtin_amdgcn_cvt_pk_f32_fp8((int)y.y, false), q3 = __builtin_amdgcn_cvt_pk_f32_fp8((int)y.y, true);
                r[0] += q0[0]; r[1] += q0[1]; r[2] += q1[0]; r[3] += q1[1]; r[4] += q2[0]; r[5] += q2[1]; r[6] += q3[0]; r[7] += q3[1]; }
#pragma unroll
            for (int j = 0; j < 4; ++j) { v[c][j] = ALPHA * a[j] + r[j] * (1.0f / YSCALE); v[c][4 + j] = ALPHA * b[j] + r[4 + j] * (1.0f / YSCALE); }
#pragma unroll
            for (int j = 0; j < 8; ++j) s1 += v[c][j]; }
        const float mean = wave_sum(s1) * (1.0f / DM); float s2 = 0.f;
#pragma unroll
        for (int c = 0; c < 4; ++c)
#pragma unroll
            for (int j = 0; j < 8; ++j) { v[c][j] -= mean; s2 += v[c][j] * v[c][j]; }
        const float rstd = 1.0f / sqrtf(wave_sum(s2) * (1.0f / DM) + LN_EPS);
#pragma unroll
        for (int c = 0; c < 4; ++c) { const int col = 512 * c + 8 * lane;
            const f32x4 g0 = *(const f32x4*)(F.in[20] + col), g1 = *(const f32x4*)(F.in[20] + col + 4), b0 = *(const f32x4*)(F.in[21] + col), b1 = *(const f32x4*)(F.in[21] + col + 4);
            f32x4 o0, o1;
#pragma unroll
            for (int j = 0; j < 4; ++j) { o0[j] = v[c][j] * rstd * g0[j] + b0[j]; o1[j] = v[c][4 + j] * rstd * g1[j] + b1[j]; }
            __builtin_nontemporal_store(o0, (f32x4*)(F.out + (size_t)tok * DM + col)); __builtin_nontemporal_store(o1, (f32x4*)(F.out + (size_t)tok * DM + col + 4)); }
    }
#undef P9_ROWS
}

constexpr int NPHASES = 10;
#ifndef MK_ONE_LAUNCH
#define MK_ONE_LAUNCH 1
#endif
__global__ void __launch_bounds__(NWAVES * 64, 2) mega_fwd(Args args) {
    extern __shared__ __attribute__((aligned(16))) unsigned char lds[];
    Frame F;
    F.lds = (LAS unsigned char*)lds;
    F.MISC = (volatile LAS unsigned*)(F.lds + MISC_OFF);
    F.tid = threadIdx.x; F.lane = F.tid & 63; F.wave = __builtin_amdgcn_readfirstlane(F.tid >> 6);
    F.G = gridDim.x; { const int bx = blockIdx.x; F.vcu = (F.G % 8 == 0) ? (bx % 8) * (F.G / 8) + bx / 8 : bx; }
#pragma unroll
    for (int i = 0; i < 22; ++i) F.in[i] = args.in[i];
    F.out = args.out; F.ws = args.ws; F.ctl = (unsigned*)(args.ws + WS_CTL);
    for (int u = F.tid; u < (LDS_BYTES - LDSCTL_OFF) / 4; u += NWAVES * 64) ((LAS unsigned*)(F.lds + LDSCTL_OFF))[u] = 0u;
    __syncthreads();
    XcdBarrier bar; bar.bar = F.ctl + CW_BAR; bar.x = 0; bar.st = nullptr; bar.total = 0; XcdBarrier barB = bar;
    const bool conv1 = (F.G == 256) && (F.vcu & 31) >= P1_NCG;
    if (MK_ONE_LAUNCH) { bar = xcd_barrier_post(F.ctl + CW_BAR, F.MISC + 8, (unsigned)F.G); }
    const int lo = args.ph_lo, hi = args.ph_hi;
#ifndef PH_MASK
#define PH_MASK 0x3ff
#endif
#define IN(k) (((PH_MASK >> (k)) & 1) && lo <= (k) && (k) < hi)
#ifndef REP_MASK
#define REP_MASK 0
#endif
#define REP(k) for (int rep_ = 0; rep_ < 1 + ((REP_MASK >> (k)) & 1); ++rep_)
#ifndef BAR_REP
#define BAR_REP 1
#endif
#define SEAM(k) do { if (IN(k) && IN((k) + 1)) for (int br_ = 0; br_ < BAR_REP; ++br_) xcd_barrier(bar); } while (0)
    LAS int* idxl = (LAS int*)(F.lds + IDXL_OFF);
    const bool tst_needed = true;

    if (IN(0)) REP(0) { p0_prologue(F, false); } SEAM(0);
    if (IN(1)) REP(1) {
        const int grp = F.vcu >> 5, cin = F.vcu & 31;
        const bool conv = (F.G == 256) && cin >= P1_NCG;
        if (conv) { const int cw = (grp * (32 - P1_NCG) + (cin - P1_NCG)) * NWAVES + F.wave; convert_items<1>(F, cw, NCONV1 * NWAVES, E_SPLIT); convert_items<2>(F, cw, NCONV1 * NWAVES, E2_A); }
        else {
            DenseOrder S; if (F.G == 256) S.init(F.ws + WS_XBF, F.ws + WS_WINT, SEQ, INC, DM, NCOMP1, cin * 8 + grp); else S.init(F.ws + WS_XBF, F.ws + WS_WINT, SEQ, INC, DM, F.G, (int)blockIdx.x);
            EpiProj E{(bf16*)(F.ws + WS_PROJ), F.in[2]};
            pg8::gemm_phase<EpiProj, DenseOrder, true, false, P1_FP8 != 0>(F.lds + RING_OFF, idxl, DM, S, E);
        }
    } SEAM(1);
    if (IN(2)) {
        p1b_qknorm(F);
        if (F.G == 256) {
            if (E_SPLIT >= NITEMS_E1 && (CONV_G1 ? E2_SPLIT : E2_A) >= NITEMS_E2) win_attention(F, F.vcu, 256);
            else if (F.vcu & 1) win_attention(F, F.vcu >> 1, 128);
            else { const int cw = (F.vcu >> 1) * NWAVES + F.wave;
                convert_items<1>(F, E_SPLIT + cw, 128 * NWAVES, NITEMS_E1); convert_items<2>(F, (CONV_G1 ? E2_SPLIT : E2_A) + cw, 128 * NWAVES, NITEMS_E2); }
        } else { win_attention(F, F.vcu, F.G); convert_items<1>(F, F.vcu * NWAVES + F.wave, F.G * NWAVES, NITEMS_E1); convert_items<2>(F, F.vcu * NWAVES + F.wave, F.G * NWAVES, NITEMS_E2); }
    } SEAM(2);
    if (IN(3)) REP(3) { p3_dense_attention(F); } SEAM(3);
    if (IN(4)) REP(4) {
        BranchOrder S{(const char*)(F.ws + WS_OA), (const char*)(F.ws + WS_OB), (const char*)(F.ws + WS_WAT), (const char*)(F.ws + WS_WBT), F.vcu};
        EpiBranch E{(const bf16*)(F.ws + WS_PROJ), F.ws + WS_MRG};
        if (F.vcu < 256) pg8::gemm_phase<EpiBranch, BranchOrder, false, false, true>(F.lds + RING_OFF, idxl, 1024, S, E);
    } SEAM(4);
    if (IN(5)) REP(5) {
        OneTileOrder S{(const char*)(F.ws + WS_MRG), (const char*)(F.ws + WS_WOT), F.vcu, (size_t)256 * DM};
        EpiMix E{(bf16*)(F.ws + WS_PRE)};
        if (F.vcu < 256) pg8::gemm_phase<EpiMix, OneTileOrder, false, false, true>(F.lds + RING_OFF, idxl, DM, S, E);
    } SEAM(5);
    if (IN(6)) REP(6) { if (rep_) { xcd_barrier(bar);
#ifndef PROBE_P5
            if (blockIdx.x == 0 && F.tid < 64) __hip_atomic_store(F.ctl + CW_CNT + F.tid, 0u, RLX_AGENT);
#endif
            xcd_barrier(bar); } p5_ln_router(F, rep_ != 0); } SEAM(6);
    if (IN(7) || IN(8) || IN(9)) { if (tst_needed) moe_build_tst(F); }
#ifndef DEFER_MAX
#define DEFER_MAX 64
#endif
    int n_defer = 0, u1_end = -1;
    if (IN(7) || IN(8)) { const int T_ = ((const LAS int*)(F.lds + TST_OFF))[NEXP1]; const int r_ = (4 * T_) % 256;
        if (F.G == 256 && !CONV_G1 && 4 * T_ > 256 && r_ > 0 && r_ <= DEFER_MAX && (lo <= 7 && 8 < hi)) { n_defer = r_; u1_end = 4 * T_ - r_; } }
    if (IN(7)) REP(7) {
        const bool split = CONV_G1 && F.G == 256, conv = split && ((F.vcu & 7) == 7);
        if (conv) { convert_items<2>(F, E2_A + (F.vcu >> 3) * NWAVES + F.wave, NCONV * NWAVES, E2_SPLIT); }
        else {
        MoeOrder<4> S{(const LAS int*)(F.lds + TST_OFF), (const char*)(F.ws + (G1_FP8 ? WS_HF8 : WS_HBF)), (const char*)(F.ws + WS_WGU), (const int*)(F.ws + WS_LTOK), (const float*)(F.ws + WS_LW), split ? F.vcu - (F.vcu >> 3) : F.vcu, split ? NCOMP : F.G, 0, (size_t)1024 * DM * (G1_FP8 ? 1 : 2), (size_t)256 * DM * (G1_FP8 ? 1 : 2), true,
                      0, u1_end, 0, nullptr, 0, 0};
        EpiMoe1 E{F.ws + WS_HID};
        pg8::gemm_phase<EpiMoe1, MoeOrder<4>, true, true, G1_FP8 != 0>(F.lds + RING_OFF, idxl, DM, S, E);
        }
    } SEAM(7);
    if (IN(8)) REP(8) {
        unsigned* dflag = F.ctl + CW_CNT + 128;
        if (n_defer > 0 && F.vcu >= 256 - n_defer) {
            MoeOrder<4> S1{(const LAS int*)(F.lds + TST_OFF), (const char*)(F.ws + (G1_FP8 ? WS_HF8 : WS_HBF)), (const char*)(F.ws + WS_WGU), (const int*)(F.ws + WS_LTOK), (const float*)(F.ws + WS_LW), F.vcu - (256 - n_defer), 256, 0, (size_t)1024 * DM * (G1_FP8 ? 1 : 2), (size_t)256 * DM * (G1_FP8 ? 1 : 2), true,
                           u1_end, u1_end + n_defer, 0, nullptr, 0, 0};
            EpiMoe1 E1{F.ws + WS_HID};
            pg8::gemm_phase<EpiMoe1, MoeOrder<4>, true, true, G1_FP8 != 0>(F.lds + RING_OFF, idxl, DM, S1, E1);
            if (F.tid == 0) { __builtin_amdgcn_fence(__ATOMIC_RELEASE, "agent"); asm volatile("s_waitcnt vmcnt(0)" ::: "memory"); __hip_atomic_fetch_add(dflag, 1u, __ATOMIC_RELAXED, __HIP_MEMORY_SCOPE_AGENT); }
        }
        MoeOrder<8> S{(const LAS int*)(F.lds + TST_OFF), (const char*)(F.ws + WS_HID), (const char*)(F.ws + WS_WD), (const int*)(F.ws + WS_LTOK), (const float*)(F.ws + WS_LW), F.vcu, F.G, (size_t)FE, (size_t)DM * FE, (size_t)256 * FE, false,
                      0, -1, n_defer, dflag, n_defer > 0 ? u1_end / 4 : 0, n_defer};
#ifndef G2_ALIGN
#define G2_ALIGN true
#endif
        EpiMoe2 E{(unsigned char*)(F.ws + WS_Y)};
        pg8::gemm_phase<EpiMoe2, MoeOrder<8>, G2_ALIGN, false, true>(F.lds + RING_OFF, idxl, FE, S, E);
    } SEAM(8);
    if (IN(9)) REP(9) { p9_combine(F); }
#ifdef PROBE_T
    { const LAS int* tst_ = (const LAS int*)(F.lds + TST_OFF); if (tst_[NEXP1] > PROBE_T && blockIdx.x == 0 && F.tid == 0) F.out[0] = __builtin_nanf(""); }
#endif
#undef IN
#undef SEAM
}

extern "C" void kernel_launch(void* const* d_in, const int* in_sizes, int n_in, void* d_out, int out_size, void* d_ws, size_t ws_size, hipStream_t stream) {
    static int grid = 0;
    if (grid == 0) {
        if (n_in != 22 || out_size != SEQ * DM || ws_size < WS_END) { fprintf(stderr, "kernel_launch: unexpected shapes (n_in %d, out %d, ws %zu < %zu); nothing launched\n", n_in, out_size, ws_size, (size_t)WS_END); grid = -1; return; }
        int dev = 0, cus = 0, per_cu = 0;
        if (hipGetDevice(&dev) != hipSuccess || hipDeviceGetAttribute(&cus, hipDeviceAttributeMultiprocessorCount, dev) != hipSuccess) { grid = -1; return; }
        if (hipFuncSetAttribute((const void*)mega_fwd, hipFuncAttributeMaxDynamicSharedMemorySize, LDS_BYTES) != hipSuccess) { fprintf(stderr, "kernel_launch: hipFuncSetAttribute failed\n"); grid = -1; return; }
        if (hipOccupancyMaxActiveBlocksPerMultiprocessor(&per_cu, (const void*)mega_fwd, NWAVES * 64, LDS_BYTES) != hipSuccess || per_cu < 1) { fprintf(stderr, "kernel_launch: occupancy query says %d blocks per CU; nothing launched\n", per_cu); (void)hipGetLastError(); grid = -1; return; }
        grid = cus;
        if (grid > 256) grid = 256;
    }
    if (grid < 0) return;
    (void)hipMemsetAsync((char*)d_ws + WS_CTL, 0, CTL_ZERO_BYTES, stream);
    Args a{};
    for (int i = 0; i < 22; ++i) a.in[i] = (const float*)d_in[i];
    a.out = (float*)d_out; a.ws = (unsigned char*)d_ws;
#if MK_ONE_LAUNCH
    a.ph_lo = 0; a.ph_hi = NPHASES;
    hipLaunchKernelGGL(mega_fwd, dim3(grid), dim3(NWAVES * 64), LDS_BYTES, stream, a);
#else
    for (int p = 0; p < NPHASES; ++p) { a.ph_lo = p; a.ph_hi = p + 1; hipLaunchKernelGGL(mega_fwd, dim3(grid), dim3(NWAVES * 64), LDS_BYTES, stream, a); }
#endif
    const hipError_t le = hipPeekAtLastError();
    if (le != hipSuccess) fprintf(stderr, "kernel_launch: launch failed: %s\n", hipGetErrorName(le));
}
```

```cpp
#define P1_NCG 13
#define CONV_Q 59
#define P1_QE2 28
#define CONV_G1 0
#include <hip/hip_runtime.h>
#include <hip/hip_bf16.h>
#include <cstdio>
#include <cstdint>
#include <cmath>
namespace pg8 {
#define PG8_LAS __attribute__((address_space(3)))
typedef unsigned short bf16_t;
typedef short bf16x8 __attribute__((ext_vector_type(8)));
typedef float f32x4 __attribute__((ext_vector_type(4)));
typedef unsigned u32x4 __attribute__((ext_vector_type(4)));
typedef int v4i_t __attribute__((ext_vector_type(4)));
typedef int v8i_t __attribute__((ext_vector_type(8)));
constexpr int BM = 256, BK = 64, HALF = 128, HTB = HALF * BK * 2  , STAGE_BYTES = 8 * HTB;

__host__ __device__ __forceinline__ int lds_byte(int r, int c) { const int st = (r >> 4) * 2 + (c >> 5), rr = r & 15, cc = c & 31, ob = rr * 64 + cc * 2; return st * 1024 + (ob ^ (((ob >> 9) & 1) << 5)); }
__host__ __device__ __forceinline__ void stage_rc(int b, int& R, int& C) { const int st = b / 1024, sb = b % 1024, swz = sb ^ (((sb >> 9) & 1) << 5); R = (st >> 1) * 16 + swz / 64; C = (st & 1) * 32 + (swz % 64) / 2; }
__host__ __device__ __forceinline__ int perm32(int rho) { const int n = rho >> 4, i = rho & 15; return 8 * (i >> 2) + 4 * n + (i & 3); }

struct Unit { const char* A; const char* B; const int* idx; const float* wts; int r0, c0, aux, kind; };

typedef float f32x2_t __attribute__((ext_vector_type(2))); typedef __bf16 bf16x2_t __attribute__((ext_vector_type(2)));
__device__ __forceinline__ unsigned cvt_pk_bf16(float lo, float hi) { f32x2_t v = {lo, hi}; bf16x2_t b = __builtin_convertvector(v, bf16x2_t); return __builtin_bit_cast(unsigned, b); }
__device__ __forceinline__ float bf_lo(unsigned w) { return __uint_as_float(w << 16); }
__device__ __forceinline__ float bf_hi(unsigned w) { return __uint_as_float(w & 0xffff0000u); }

template <class Epi, class Sched, bool ALIGN_EPI, bool GATHER, bool FP8 = false>
__device__ __forceinline__ void gemm_phase(PG8_LAS unsigned char* lds, PG8_LAS int* idxl, const int K, const Sched& S, const Epi& E) {
    PG8_LAS float* wl = (PG8_LAS float*)(idxl + 256);
    const int tid = threadIdx.x, wid = __builtin_amdgcn_readfirstlane(tid >> 6), lane = tid & 63, wr = wid >> 2, wc = wid & 3, fr = lane & 15, fq = lane >> 4;
    const int KB = FP8 ? K : 2 * K;
    const int nt = KB / 128;
    const size_t kstep = (size_t)(BK * 2);
    const size_t hstep = (size_t)HALF * KB;
    unsigned voffA0[2], voffA1[2], voffB[2];
#pragma unroll
    for (int i = 0; i < 2; ++i) { int R, C; stage_rc(tid * 16 + i * 8192, R, C); const int Rb = Epi::PERM ? ((R & ~31) + perm32(R & 31)) : R;
        voffA0[i] = (unsigned)(R * KB + C * 2); voffA1[i] = voffA0[i] + (unsigned)hstep; voffB[i] = (unsigned)(Rb * KB + C * 2); }
    const unsigned ldsw = (unsigned)wid * 1024u;
    const int aoff = FP8 ? lds_byte(wr * 64 + fr, (fq >> 1) * 32 + (fq & 1) * 16) : lds_byte(wr * 64 + fr, fq * 8), boff = FP8 ? lds_byte(wc * 32 + fr, (fq >> 1) * 32 + (fq & 1) * 16) : lds_byte(wc * 32 + fr, fq * 8);
#define PG8_SA(b, h) (((b) * 2 + (h)) * HTB)
#define PG8_SB(b, h) ((4 + (b) * 2 + (h)) * HTB)
#define PG8_STAGE(bufoff, gbase, voff) do { _Pragma("unroll") for (int _i = 0; _i < 2; ++_i) \
        __builtin_amdgcn_global_load_lds((const unsigned*)((const char*)(gbase) + (voff)[_i]), (PG8_LAS unsigned*)(lds + (bufoff) + ldsw + _i * 8192), 16, 0, 0); } while (0)
#define PG8_LD8(addr) __builtin_shufflevector(*(const PG8_LAS v4i_t*)(addr), *(const PG8_LAS v4i_t*)((addr) + 16), 0, 1, 2, 3, 4, 5, 6, 7)
#define PG8_LDA(dst, b, h) do { if constexpr (FP8) { _Pragma("unroll") for (int m = 0; m < 4; ++m) dst##8[m] = PG8_LD8(lds + PG8_SA(b, h) + aoff + m * 2048); } \
        else { _Pragma("unroll") for (int m = 0; m < 4; ++m) _Pragma("unroll") for (int k = 0; k < 2; ++k) dst[m][k] = *(const PG8_LAS bf16x8*)(lds + PG8_SA(b, h) + aoff + m * 2048 + k * 1024); } } while (0)
#define PG8_LDB(dst, b, h) do { if constexpr (FP8) { _Pragma("unroll") for (int n = 0; n < 2; ++n) dst##8[n] = PG8_LD8(lds + PG8_SB(b, h) + boff + n * 2048); } \
        else { _Pragma("unroll") for (int n = 0; n < 2; ++n) _Pragma("unroll") for (int k = 0; k < 2; ++k) dst[n][k] = *(const PG8_LAS bf16x8*)(lds + PG8_SB(b, h) + boff + n * 2048 + k * 1024); } } while (0)
#define PG8_MMA(ai, bj, At, Bt) do { __builtin_amdgcn_s_setprio(1); _Pragma("unroll") for (int m = 0; m < 4; ++m) _Pragma("unroll") for (int n = 0; n < 2; ++n) { \
        if constexpr (FP8) asm volatile("v_mfma_scale_f32_16x16x128_f8f6f4 %0, %1, %2, %0, %3, %3 op_sel_hi:[0,0,0]" : "+v"(acc[ai][bj][m][n]) : "v"(Bt##8[n]), "v"(At##8[m]), "v"(one_scale)); \
        else { _Pragma("unroll") for (int k = 0; k < 2; ++k) acc[ai][bj][m][n] = __builtin_amdgcn_mfma_f32_16x16x32_bf16(Bt[n][k], At[m][k], acc[ai][bj][m][n], 0, 0, 0); } } __builtin_amdgcn_s_setprio(0); } while (0)
#define PG8_WAIT_V(n) asm volatile("s_waitcnt vmcnt(" #n ")" ::: "memory")
#define PG8_WAIT_L(n) asm volatile("s_waitcnt lgkmcnt(" #n ")" ::: "memory")
#define PG8_WAIT_VN(n) asm volatile("s_waitcnt vmcnt(%0)" :: "n"(n) : "memory")
#define PG8_WAIT_VR(sel) do { if constexpr (Epi::NST > 0) { int _sg; asm volatile("v_readfirstlane_b32 %0, %1\n\ts_nop 0\n\ts_cmp_lg_u32 %0, 0\n\ts_cbranch_scc1 1f\n\ts_waitcnt vmcnt(8)\n\ts_branch 2f\n1:\n\ts_waitcnt vmcnt(%2)\n2:" \
            : "=&s"(_sg) : "v"(sel), "n"(8 + Epi::NST) : "memory", "scc"); } \
        else asm volatile("s_waitcnt vmcnt(8)" ::: "memory"); } while (0)
#define PG8_BAR __builtin_amdgcn_s_barrier()
#define PG8_SCHED __builtin_amdgcn_sched_barrier(0)
#define PG8_GOFF(src) do { _Pragma("unroll") for (int _i = 0; _i < 2; ++_i) { int R_, C_; stage_rc(tid * 16 + _i * 8192, R_, C_); \
        voffA0[_i] = (unsigned)((src)[R_] * KB + C_ * 2); voffA1[_i] = (unsigned)((src)[R_ + HALF] * KB + C_ * 2); } } while (0)
    Unit cur, nxt; int ui = 0;
    if (!S.next(0, cur)) return;
    f32x4 acc[2][2][4][2];
#pragma unroll
    for (int a = 0; a < 2; ++a)
#pragma unroll
        for (int b = 0; b < 2; ++b)
#pragma unroll
            for (int m = 0; m < 4; ++m)
#pragma unroll
                for (int n = 0; n < 2; ++n) acc[a][b][m][n] = (f32x4){0.f, 0.f, 0.f, 0.f};
    bf16x8 At[4][2], B0[2][2], B1[2][2];
    v8i_t At8[4], B08[2], B18[2];
    int one_scale = 0x7f7f7f7f; asm volatile("" : "+v"(one_scale));
    const char* cA = cur.A; const char* cB = cur.B;
    if constexpr (GATHER) { PG8_GOFF(cur.idx); if (tid >= 256) wl[tid - 256] = cur.wts[tid - 256]; }
    PG8_STAGE(PG8_SB(0, 0), cB, voffB); PG8_STAGE(PG8_SB(0, 1), cB + hstep, voffB); PG8_STAGE(PG8_SA(0, 0), cA, voffA0); PG8_STAGE(PG8_SA(0, 1), cA, voffA1);
    if (wr == 1) PG8_BAR;
    PG8_WAIT_V(2); PG8_BAR;
    PG8_STAGE(PG8_SB(1, 0), cB + kstep, voffB); PG8_STAGE(PG8_SA(1, 0), cA + kstep, voffA0); PG8_STAGE(PG8_SB(1, 1), cB + hstep + kstep, voffB);
    PG8_WAIT_V(6); PG8_BAR;
    for (;;) {
        const bool has_next = S.next(ui + 1, nxt);
        const char* nA = has_next ? nxt.A : cA; const char* nB = has_next ? nxt.B : cB;
        if constexpr (GATHER) { if (has_next && tid < 256) {
            __builtin_amdgcn_global_load_lds((const unsigned*)(nxt.idx + tid), (PG8_LAS unsigned*)((PG8_LAS unsigned char*)idxl + wid * 256), 4, 0, 0); }
          if (has_next && tid >= 256) {
            __builtin_amdgcn_global_load_lds((const unsigned*)(nxt.wts + (tid - 256)), (PG8_LAS unsigned*)((PG8_LAS unsigned char*)(wl + ((ui + 1) & 1) * 256) + (wid - 4) * 256), 4, 0, 0); } }
#pragma unroll 1
        for (int t = 0; t < nt; t += 2) {
            const bool last = (t == nt - 2);
            const char* a1 = cA + (size_t)(t + 1) * kstep;
            const char* a2 = last ? nA : cA + (size_t)(t + 2) * kstep; const char* b2 = last ? nB : cB + (size_t)(t + 2) * kstep;
            const char* a3 = a2 + kstep; const char* b3 = b2 + kstep;
            const int rlx = (t == 0 && ui > 0) ? 1 : 0;
            PG8_LDB(B0, 0, 0); PG8_LDB(B1, 0, 1); PG8_SCHED; PG8_LDA(At, 0, 0); PG8_STAGE(PG8_SA(1, 1), a1, voffA1);
            if constexpr (GATHER) { if (last && has_next) { PG8_GOFF(idxl); } }
            PG8_WAIT_VR(rlx); PG8_WAIT_L(0); PG8_BAR; PG8_MMA(0, 0, At, B0); PG8_MMA(0, 1, At, B1); PG8_BAR; PG8_SCHED;
            PG8_LDA(At, 0, 1); PG8_STAGE(PG8_SB(0, 0), b2, voffB); PG8_STAGE(PG8_SB(0, 1), b2 + hstep, voffB); PG8_STAGE(PG8_SA(0, 0), a2, voffA0);
            PG8_WAIT_VR(rlx); PG8_WAIT_L(0); PG8_BAR; PG8_MMA(1, 0, At, B0); PG8_MMA(1, 1, At, B1); PG8_BAR; PG8_SCHED;
            PG8_LDB(B0, 1, 0); PG8_LDB(B1, 1, 1); PG8_SCHED; PG8_LDA(At, 1, 0); PG8_STAGE(PG8_SA(0, 1), a2, voffA1);
            PG8_WAIT_V(8); PG8_WAIT_L(0); PG8_BAR; PG8_MMA(0, 0, At, B0); PG8_MMA(0, 1, At, B1); PG8_BAR; PG8_SCHED;
            PG8_LDA(At, 1, 1); PG8_STAGE(PG8_SB(1, 0), b3, voffB); PG8_STAGE(PG8_SB(1, 1), b3 + hstep, voffB); PG8_STAGE(PG8_SA(1, 0), a3, voffA0);
            PG8_WAIT_V(8); PG8_WAIT_L(0); PG8_BAR; PG8_MMA(1, 0, At, B0); PG8_MMA(1, 1, At, B1); PG8_BAR; PG8_SCHED;
        }
        if constexpr (ALIGN_EPI) { if (wr == 0) PG8_BAR; }
        if constexpr (FP8) asm volatile("s_nop 15\n\ts_nop 15" ::: "memory");
        const bool keep = E(acc, cur, wr, wc, fr, fq, wl + (ui & 1) * 256);
        if (!has_next) break;
        if (!keep) {
#pragma unroll
        for (int a = 0; a < 2; ++a)
#pragma unroll
            for (int b = 0; b < 2; ++b)
#pragma unroll
                for (int m = 0; m < 4; ++m)
#pragma unroll
                    for (int n = 0; n < 2; ++n) acc[a][b][m][n] = (f32x4){0.f, 0.f, 0.f, 0.f};
        }
        cur = nxt; cA = nA; cB = nB; ++ui;
        if constexpr (ALIGN_EPI) { if (wr == 1) PG8_BAR; }
    }
    PG8_WAIT_V(0);
    if constexpr (!ALIGN_EPI) { if (wr == 0) PG8_BAR; }
    PG8_BAR;
#undef PG8_SA
#undef PG8_SB
#undef PG8_STAGE
#undef PG8_LDA
#undef PG8_LDB
#undef PG8_MMA
#undef PG8_LD8
#undef PG8_WAIT_V
#undef PG8_WAIT_L
#undef PG8_WAIT_VN
#undef PG8_WAIT_VR
#undef PG8_BAR
#undef PG8_SCHED
#undef PG8_GOFF
}
}
namespace attn {
using bf16 = __hip_bfloat16;
constexpr int   D = 128, NW = 8, QBLK = 32, KVBLK = 64;
constexpr float SCALE = 0.088388347648318440f;
constexpr float THR = 8.f;
constexpr float LOG2E = 1.4426950408889634f;
#ifndef PROJ_PAD
#define PROJ_PAD 64
#endif
constexpr int LDQ = 7168 + PROJ_PAD, LDK = 7168 + PROJ_PAD, LDO = 1024;
constexpr size_t SHM_V = KVBLK * D * 2, SHM_K = KVBLK * D * 2, SHM_ATTN = 2 * SHM_V + 2 * SHM_K + NW * 64 * 4;
constexpr int WIN_TAB = (int)SHM_ATTN;

using bf16x8 = __attribute__((ext_vector_type(8))) short;
using s16x4  = __attribute__((ext_vector_type(4))) short;
using f32x16 = __attribute__((ext_vector_type(16))) float;
using u32x4  = __attribute__((ext_vector_type(4))) unsigned;
using f32x4_a = __attribute__((ext_vector_type(4))) float;
#define KSWZ(row, colB) ((row) * 256 + ((colB) ^ (((row) & 7) << 4)))
#define SBAR() __builtin_amdgcn_sched_barrier(0)
__device__ __forceinline__ int crow(int r, int hi) { return (r & 3) + 8 * (r >> 2) + 4 * hi; }
__device__ __forceinline__ unsigned cvtpk(float lo, float hi) { return pg8::cvt_pk_bf16(lo, hi); }
template <bool FIXM, bool PRE = false>
__device__ __forceinline__ void partialSM(f32x16& p0, f32x16& p1, float& m_reg, float& mn, float& alpha) {
  constexpr float C = SCALE * LOG2E;
  if constexpr (PRE) {
    mn = m_reg; alpha = 1.f;
    for (int r = 0; r < 16; ++r) p0[r] = __builtin_amdgcn_exp2f(p0[r]);
    return;
  }
  if constexpr (FIXM) {
    mn = m_reg; alpha = 1.f; float mnC = -m_reg * C; asm volatile("" : "+v"(mnC));
    typedef float f32x2_p __attribute__((ext_vector_type(2))); const f32x2_p c2 = {C, C}, m2 = {mnC, mnC};
#pragma unroll
    for (int r = 0; r < 16; r += 2) { f32x2_p a = {p0[r], p0[r + 1]}, b = {p1[r], p1[r + 1]}; a = __builtin_elementwise_fma(a, c2, m2); b = __builtin_elementwise_fma(b, c2, m2); p0[r] = a[0]; p0[r + 1] = a[1]; p1[r] = b[0]; p1[r + 1] = b[1]; }
    for (int r = 0; r < 16; ++r) p0[r] = __builtin_amdgcn_exp2f(p0[r]);
    return;
  }
  float pmax = p0[0]; for (int r = 1; r < 16; ++r) pmax = fmaxf(pmax, p0[r]); for (int r = 0; r < 16; ++r) pmax = fmaxf(pmax, p1[r]);
  { auto rr = __builtin_amdgcn_permlane32_swap(__float_as_uint(pmax), __float_as_uint(pmax), false, false);
    pmax = fmaxf(__uint_as_float(rr[0]), __uint_as_float(rr[1])); }
  if (__builtin_expect(__all(pmax - m_reg <= THR / SCALE), 1)) { mn = m_reg; alpha = 1.f; }
  else { mn = fmaxf(m_reg, pmax); alpha = __builtin_amdgcn_exp2f((m_reg - mn) * C); m_reg = mn; }
  float mnC = -mn * C;
  for (int r = 0; r < 16; ++r) p0[r] = fmaf(p0[r], C, mnC); for (int r = 0; r < 16; ++r) p1[r] = fmaf(p1[r], C, mnC);
  for (int r = 0; r < 16; ++r) p0[r] = __builtin_amdgcn_exp2f(p0[r]);
}
__device__ __forceinline__ void finishSM(f32x16& p0, f32x16& p1, float alpha, float& l_reg, bf16x8& pa0, bf16x8& pa1, bf16x8& pa2, bf16x8& pa3) {
  for (int r = 0; r < 16; ++r) p1[r] = __builtin_amdgcn_exp2f(p1[r]);
  float ps = 0; for (int r = 0; r < 16; ++r) ps += p0[r]; for (int r = 0; r < 16; ++r) ps += p1[r];
  { auto rr = __builtin_amdgcn_permlane32_swap(__float_as_uint(ps), __float_as_uint(ps), false, false);
    ps = __uint_as_float(rr[0]) + __uint_as_float(rr[1]); }
  l_reg = l_reg * alpha + ps;
#define PK4(P, BASE, OUT) do { unsigned a0 = cvtpk(P[BASE + 0], P[BASE + 1]), a1 = cvtpk(P[BASE + 2], P[BASE + 3]);   \
    unsigned b0 = cvtpk(P[BASE + 4], P[BASE + 5]), b1 = cvtpk(P[BASE + 6], P[BASE + 7]);                              \
    auto r0 = __builtin_amdgcn_permlane32_swap(a0, b0, false, false); auto r1 = __builtin_amdgcn_permlane32_swap(a1, b1, false, false); \
    u32x4 w = {r0[0], r1[0], r0[1], r1[1]}; OUT = *reinterpret_cast<bf16x8*>(&w); } while (0)
  PK4(p0, 0, pa0); PK4(p0, 8, pa1); PK4(p1, 0, pa2); PK4(p1, 8, pa3);
#undef PK4
}
#define KSWZ8(row, colB) ((row) * 128 + ((colB) ^ (((row) & 7) << 4)))
typedef int v8i_a __attribute__((ext_vector_type(8))); typedef int v4i_a __attribute__((ext_vector_type(4)));
template <bool WIN, bool F8, bool PRE = false>
__device__ __forceinline__ void qkt(f32x16& p0, f32x16& p1, const bf16* Ks, const bf16x8* qr, const v8i_a* q8, int r32, int hi, const __attribute__((address_space(3))) float* tb, const f32x16* cinit = nullptr) {
  if constexpr (F8 && PRE) {
    int one = 0x7f7f7f7f, sc3 = 0x7c7c7c7c; asm volatile("" : "+v"(one), "+v"(sc3));
#pragma unroll
    for (int s = 0; s < 2; ++s) { const int cb = 64 * s + 32 * hi;
      const char* ka = (const char*)Ks + KSWZ8(r32, cb); const char* kb = (const char*)Ks + KSWZ8(32 + r32, cb);
      const v8i_a k0 = __builtin_shufflevector(*reinterpret_cast<const v4i_a*>(ka), *reinterpret_cast<const v4i_a*>((const char*)Ks + KSWZ8(r32, cb + 16)), 0, 1, 2, 3, 4, 5, 6, 7);
      const v8i_a k1 = __builtin_shufflevector(*reinterpret_cast<const v4i_a*>(kb), *reinterpret_cast<const v4i_a*>((const char*)Ks + KSWZ8(32 + r32, cb + 16)), 0, 1, 2, 3, 4, 5, 6, 7);
      if (s == 0) {
        asm volatile("s_nop 1\n\tv_mfma_scale_f32_32x32x64_f8f6f4 %0, %1, %2, %3, %4, %5 op_sel_hi:[0,0,0]" : "=&v"(p0) : "v"(k0), "v"(q8[s]), "v"(*cinit), "v"(one), "v"(sc3));
        asm volatile("v_mfma_scale_f32_32x32x64_f8f6f4 %0, %1, %2, %3, %4, %5 op_sel_hi:[0,0,0]" : "=&v"(p1) : "v"(k1), "v"(q8[s]), "v"(*cinit), "v"(one), "v"(sc3));
      } else {
        asm volatile("v_mfma_scale_f32_32x32x64_f8f6f4 %0, %1, %2, %0, %3, %4 op_sel_hi:[0,0,0]" : "+v"(p0) : "v"(k0), "v"(q8[s]), "v"(one), "v"(sc3));
        asm volatile("v_mfma_scale_f32_32x32x64_f8f6f4 %0, %1, %2, %0, %3, %4 op_sel_hi:[0,0,0]" : "+v"(p1) : "v"(k1), "v"(q8[s]), "v"(one), "v"(sc3)); } }
    asm volatile("s_nop 15\n\ts_nop 15" : "+v"(p0), "+v"(p1));
    return;
  }
  if constexpr (F8) {
    int one = 0x7f7f7f7f; asm volatile("" : "+v"(one));
#pragma unroll
    for (int s = 0; s < 2; ++s) { const int cb = 64 * s + 32 * hi;
      const char* ka = (const char*)Ks + KSWZ8(r32, cb); const char* kb = (const char*)Ks + KSWZ8(32 + r32, cb);
      const v8i_a k0 = __builtin_shufflevector(*reinterpret_cast<const v4i_a*>(ka), *reinterpret_cast<const v4i_a*>((const char*)Ks + KSWZ8(r32, cb + 16)), 0, 1, 2, 3, 4, 5, 6, 7);
      const v8i_a k1 = __builtin_shufflevector(*reinterpret_cast<const v4i_a*>(kb), *reinterpret_cast<const v4i_a*>((const char*)Ks + KSWZ8(32 + r32, cb + 16)), 0, 1, 2, 3, 4, 5, 6, 7);
      if (s == 0) {
        asm volatile("s_nop 1\n\tv_mfma_scale_f32_32x32x64_f8f6f4 %0, %1, %2, 0, %3, %3 op_sel_hi:[0,0,0]" : "=&v"(p0) : "v"(k0), "v"(q8[s]), "v"(one));
        asm volatile("v_mfma_scale_f32_32x32x64_f8f6f4 %0, %1, %2, 0, %3, %3 op_sel_hi:[0,0,0]" : "=&v"(p1) : "v"(k1), "v"(q8[s]), "v"(one));
      } else {
        asm volatile("v_mfma_scale_f32_32x32x64_f8f6f4 %0, %1, %2, %0, %3, %3 op_sel_hi:[0,0,0]" : "+v"(p0) : "v"(k0), "v"(q8[s]), "v"(one));
        asm volatile("v_mfma_scale_f32_32x32x64_f8f6f4 %0, %1, %2, %0, %3, %3 op_sel_hi:[0,0,0]" : "+v"(p1) : "v"(k1), "v"(q8[s]), "v"(one)); } }
    asm volatile("s_nop 15\n\ts_nop 15" : "+v"(p0), "+v"(p1));
    return;
  }
  if constexpr (WIN) {
#pragma unroll
    for (int r = 0; r < 16; ++r) { p0[r] = tb[(r & 3) + 8 * (r >> 2)]; p1[r] = tb[32 + (r & 3) + 8 * (r >> 2)]; }
  } else { p0 = f32x16{}; p1 = f32x16{}; }
  for (int d0 = 0; d0 < 8; ++d0) { int cb = (d0 * 16 + hi * 8) * 2;
    bf16x8 b0 = *reinterpret_cast<const bf16x8*>((const char*)Ks + KSWZ(r32, cb));
    bf16x8 b1 = *reinterpret_cast<const bf16x8*>((const char*)Ks + KSWZ(32 + r32, cb));
    p0 = __builtin_amdgcn_mfma_f32_32x32x16_bf16(b0, qr[d0], p0, 0, 0, 0);
    p1 = __builtin_amdgcn_mfma_f32_32x32x16_bf16(b1, qr[d0], p1, 0, 0, 0); }
}
__device__ __forceinline__ int v_st(int k, int c) { const int kk = (k & ~0xC) | ((k & 4) << 1) | ((k & 8) >> 1); return ((kk >> 3) * 4 + (c >> 5)) * 512 + ((kk & 7) * 32 + (c & 31)) * 2; }
__device__ __forceinline__ int v_rd_base(int lane) { return ((lane & 3) << 3) | (((lane >> 2) & 3) << 6) | (((lane >> 4) & 1) << 5) | (((lane >> 5) & 1) << 8); }
constexpr int v_rd_off(int d0, int ks, int half) { return d0 * 512 + ks * 4096 + half * 2048; }
template <int OFF> __device__ __forceinline__ s16x4 tr_read(int vb) {
  s16x4 r; asm volatile("ds_read_b64_tr_b16 %0, %1 offset:%2" : "=&v"(r) : "v"(vb), "i"(OFF) : "memory"); return r;
}
template <int D0> __device__ __forceinline__ void pv_one(f32x16& od, int vb, bf16x8 pa0, bf16x8 pa1, bf16x8 pa2, bf16x8 pa3) {
  const s16x4 l0 = tr_read<v_rd_off(D0, 0, 0)>(vb), h0 = tr_read<v_rd_off(D0, 0, 1)>(vb), l1 = tr_read<v_rd_off(D0, 1, 0)>(vb), h1 = tr_read<v_rd_off(D0, 1, 1)>(vb);
  const s16x4 l2 = tr_read<v_rd_off(D0, 2, 0)>(vb), h2 = tr_read<v_rd_off(D0, 2, 1)>(vb), l3 = tr_read<v_rd_off(D0, 3, 0)>(vb), h3 = tr_read<v_rd_off(D0, 3, 1)>(vb);
  asm volatile("s_waitcnt lgkmcnt(0)" ::: "memory"); SBAR();
#define PK(L, H) (bf16x8){L[0], L[1], L[2], L[3], H[0], H[1], H[2], H[3]}
  od = __builtin_amdgcn_mfma_f32_32x32x16_bf16(pa0, PK(l0, h0), od, 0, 0, 0);
  od = __builtin_amdgcn_mfma_f32_32x32x16_bf16(pa1, PK(l1, h1), od, 0, 0, 0);
  od = __builtin_amdgcn_mfma_f32_32x32x16_bf16(pa2, PK(l2, h2), od, 0, 0, 0);
  od = __builtin_amdgcn_mfma_f32_32x32x16_bf16(pa3, PK(l3, h3), od, 0, 0, 0);
#undef PK
}
__device__ __forceinline__ void pv_d0(f32x16* o, int vb, bf16x8 pa0, bf16x8 pa1, bf16x8 pa2, bf16x8 pa3) {
  pv_one<0>(o[0], vb, pa0, pa1, pa2, pa3); pv_one<1>(o[1], vb, pa0, pa1, pa2, pa3); pv_one<2>(o[2], vb, pa0, pa1, pa2, pa3); pv_one<3>(o[3], vb, pa0, pa1, pa2, pa3);
}

template <bool WIN, int SDEPTH, bool F8, bool FIXM, bool QN = false, int kmask = -1, bool PP = false>
__device__ __forceinline__ void attn_body(const bf16* __restrict__ Qb, const bf16* __restrict__ Kh, const unsigned char* __restrict__ Kh8, const bf16* __restrict__ Vh,
                                          unsigned char* __restrict__ Ob, float oscale, int seq, char* lds, const __attribute__((address_space(3))) float* tab, int relbase, float m0, float l0,
                                          const float* __restrict__ gq = nullptr, int qpos0 = 0) {
  int tid_ = threadIdx.x; asm volatile("" : "+v"(tid_));
  const int tid = tid_, wid = tid >> 6, lane = tid & 63, r32 = lane & 31, hi = lane >> 5;
  bf16* V_lds = (bf16*)lds; bf16* K_lds = (bf16*)(lds + 2 * SHM_V);
  float* ws = (float*)(lds + 2 * SHM_V + 2 * SHM_K) + wid * 64; float* li_l = ws; float* al_l = ws + 32;
  float m_reg = m0, l_reg = l0; f32x16 o[4]; bf16x8 qr[8];
  const bf16* Qw = Qb + (long)(wid * QBLK + r32) * LDQ + hi * 8;
  v8i_a q8[2];
  if constexpr (F8 && QN) {
    const bf16* Qr = Qb + (long)(wid * QBLK + r32) * LDQ + hi * 16;
    u32x4 raw[2][2][2];
#pragma unroll
    for (int s = 0; s < 2; ++s)
#pragma unroll
      for (int pt = 0; pt < 2; ++pt)
#pragma unroll
        for (int c = 0; c < 2; ++c) raw[s][pt][c] = *reinterpret_cast<const u32x4*>(Qr + 64 * s + 32 * pt + 8 * c);
#define QLO(w_) __uint_as_float((w_) << 16)
#define QHI(w_) __uint_as_float((w_) & 0xffff0000u)
    float ss = 0.f;
#pragma unroll
    for (int s = 0; s < 2; ++s)
#pragma unroll
      for (int pt = 0; pt < 2; ++pt)
#pragma unroll
        for (int c = 0; c < 2; ++c) { const u32x4 v = raw[s][pt][c];
          ss = fmaf(QLO(v.x), QLO(v.x), ss); ss = fmaf(QHI(v.x), QHI(v.x), ss); ss = fmaf(QLO(v.y), QLO(v.y), ss); ss = fmaf(QHI(v.y), QHI(v.y), ss);
          ss = fmaf(QLO(v.z), QLO(v.z), ss); ss = fmaf(QHI(v.z), QHI(v.z), ss); ss = fmaf(QLO(v.w), QLO(v.w), ss); ss = fmaf(QHI(v.w), QHI(v.w), ss); }
    { auto rr = __builtin_amdgcn_permlane32_swap(__float_as_uint(ss), __float_as_uint(ss), false, false); ss = __uint_as_float(rr[0]) + __uint_as_float(rr[1]); }
    const float rs = 1.0f / sqrtf(ss * (1.0f / D) + 1e-6f);
    constexpr float qsc = PP ? 8.0f * SCALE * LOG2E : 1.0f;
    const int tok = qpos0 + wid * QBLK + r32;
#pragma unroll
    for (int s = 0; s < 2; ++s) { int w[8]; const float pos = (float)(s == 0 ? (tok >> 6) : (tok & 63));
#pragma unroll
      for (int c = 0; c < 2; ++c) {
        const u32x4 va = raw[s][0][c], vb = raw[s][1][c];
        const float xa[8] = {QLO(va.x), QHI(va.x), QLO(va.y), QHI(va.y), QLO(va.z), QHI(va.z), QLO(va.w), QHI(va.w)}, xb[8] = {QLO(vb.x), QHI(vb.x), QLO(vb.y), QHI(vb.y), QLO(vb.z), QHI(vb.z), QLO(vb.w), QHI(vb.w)};
        float o1[8], o2[8];
#pragma unroll
        for (int u4 = 0; u4 < 2; ++u4) { const f32x4_a g1 = *reinterpret_cast<const f32x4_a*>(gq + 64 * s + 16 * hi + 8 * c + 4 * u4), g2 = *reinterpret_cast<const f32x4_a*>(gq + 64 * s + 32 + 16 * hi + 8 * c + 4 * u4);
#pragma unroll
          for (int u = 0; u < 4; ++u) { const int t = 4 * u4 + u; const float inv = __builtin_amdgcn_exp2f(-(float)(2 * (16 * hi + 8 * c + t)) * (1.0f / 64.0f) * 13.287712379549449f);
            const float rev = pos * inv * 0.15915494309189535f, fr = rev - floorf(rev); const float sn = __builtin_amdgcn_sinf(fr), cs = __builtin_amdgcn_cosf(fr);
            const float a = xa[t] * rs * g1[u], b = xb[t] * rs * g2[u]; o1[t] = (a * cs - b * sn) * qsc; o2[t] = (b * cs + a * sn) * qsc; } }
        int t0 = __builtin_amdgcn_cvt_pk_fp8_f32(o1[0], o1[1], 0, false); t0 = __builtin_amdgcn_cvt_pk_fp8_f32(o1[2], o1[3], t0, true); w[2 * c] = t0;
        t0 = __builtin_amdgcn_cvt_pk_fp8_f32(o1[4], o1[5], 0, false); t0 = __builtin_amdgcn_cvt_pk_fp8_f32(o1[6], o1[7], t0, true); w[2 * c + 1] = t0;
        t0 = __builtin_amdgcn_cvt_pk_fp8_f32(o2[0], o2[1], 0, false); t0 = __builtin_amdgcn_cvt_pk_fp8_f32(o2[2], o2[3], t0, true); w[4 + 2 * c] = t0;
        t0 = __builtin_amdgcn_cvt_pk_fp8_f32(o2[4], o2[5], 0, false); t0 = __builtin_amdgcn_cvt_pk_fp8_f32(o2[6], o2[7], t0, true); w[4 + 2 * c + 1] = t0; }
      q8[s] = (v8i_a){w[0], w[1], w[2], w[3], w[4], w[5], w[6], w[7]}; }
#undef QLO
#undef QHI
  } else if constexpr (F8) {
    const bf16* Qr = Qb + (long)(wid * QBLK + r32) * LDQ + hi * 32;
#pragma unroll
    for (int s = 0; s < 2; ++s) { int w[8];
#pragma unroll
      for (int c = 0; c < 4; ++c) { const u32x4 v = *reinterpret_cast<const u32x4*>(Qr + 64 * s + 8 * c);
        int t = __builtin_amdgcn_cvt_pk_fp8_f32(__uint_as_float(v.x << 16), __uint_as_float(v.x & 0xffff0000u), 0, false); t = __builtin_amdgcn_cvt_pk_fp8_f32(__uint_as_float(v.y << 16), __uint_as_float(v.y & 0xffff0000u), t, true); w[2 * c] = t;
        t = __builtin_amdgcn_cvt_pk_fp8_f32(__uint_as_float(v.z << 16), __uint_as_float(v.z & 0xffff0000u), 0, false); t = __builtin_amdgcn_cvt_pk_fp8_f32(__uint_as_float(v.w << 16), __uint_as_float(v.w & 0xffff0000u), t, true); w[2 * c + 1] = t; }
      q8[s] = (v8i_a){w[0], w[1], w[2], w[3], w[4], w[5], w[6], w[7]}; }
  } else {
#pragma unroll
    for (int d0 = 0; d0 < 8; ++d0) qr[d0] = *reinterpret_cast<const bf16x8*>(Qw + d0 * 16);
  }
#pragma unroll
  for (int d = 0; d < 4; ++d) { float z_; asm volatile("v_mov_b32 %0, 0" : "=v"(z_));
#pragma unroll
    for (int r = 0; r < 16; ++r) o[d][r] = z_; }
  const int sr = tid >> 4, sc = (tid & 15) * 8, vst0 = v_st(sr, sc), vst1 = v_st(32 + sr, sc);
  const int vb0 = (int)(uintptr_t)V_lds + v_rd_base(lane);
  const __attribute__((address_space(3))) float* tb0 = tab + (relbase - (wid * QBLK + r32) + 512 + 4 * hi);
  struct { bf16x8 vs0, vs1, ks0, ks1; } sr_[SDEPTH];
#define SLOAD(i, k0) do { sr_[i].vs0 = *reinterpret_cast<const bf16x8*>(&Vh[(long)(((k0) & kmask) + sr) * LDK + sc]); sr_[i].vs1 = *reinterpret_cast<const bf16x8*>(&Vh[(long)(((k0) & kmask) + 32 + sr) * LDK + sc]); \
    if constexpr (F8) { sr_[i].ks0 = *reinterpret_cast<const bf16x8*>(&Kh8[(long)(((k0) & kmask) + (tid >> 3)) * 256 + (tid & 7) * 16]); } \
    else { sr_[i].ks0 = *reinterpret_cast<const bf16x8*>(&Kh[(long)(((k0) & kmask) + sr) * LDK + sc]); sr_[i].ks1 = *reinterpret_cast<const bf16x8*>(&Kh[(long)(((k0) & kmask) + 32 + sr) * LDK + sc]); } } while (0)
#define SWRITE(b, i) do { *(bf16x8*)((char*)V_lds + (b) * SHM_V + vst0) = sr_[i].vs0;          \
    *(bf16x8*)((char*)V_lds + (b) * SHM_V + vst1) = sr_[i].vs1; int kc = sc * 2;               \
    if constexpr (F8) { *(bf16x8*)((char*)K_lds + (b) * SHM_K + KSWZ8(tid >> 3, (tid & 7) * 16)) = sr_[i].ks0; } \
    else { *(bf16x8*)((char*)K_lds + (b) * SHM_K + KSWZ(sr, kc)) = sr_[i].ks0;                       \
    *(bf16x8*)((char*)K_lds + (b) * SHM_K + KSWZ(32 + sr, kc)) = sr_[i].ks1; } } while (0)
#define SWAIT() do { if constexpr (SDEPTH == 2) asm volatile("s_waitcnt vmcnt(4)" ::: "memory"); else asm volatile("s_waitcnt vmcnt(0)" ::: "memory"); } while (0)
#define RESC(a) do { if (!FIXM && __any((a) < 1.f)) { if (hi == 0) al_l[r32] = (a); asm volatile("s_waitcnt lgkmcnt(0)" ::: "memory"); \
    for (int d = 0; d < 4; ++d) for (int r = 0; r < 16; ++r) o[d][r] *= al_l[crow(r, hi)]; } } while (0)
  f32x16 pA0, pA1, pB0, pB1; float mnA, mnB, alA, alB; bf16x8 pa0, pa1, pa2, pa3; const int NT = seq / KVBLK;
  if constexpr (PP) {
    static_assert(!PP || (F8 && FIXM && !WIN), "ping-pong path: dense fp8 fixed-reference attention only");
    constexpr int NS = 4, KSLOT = KVBLK * D, VSLOT = KVBLK * D * 2, KRING = NS * VSLOT;
    typedef __attribute__((address_space(3))) unsigned lds_u32;
    const int widu = __builtin_amdgcn_readfirstlane(wid), grp = widu >> 2;
    li_l = (float*)(lds + KRING + NS * KSLOT) + widu * 64; al_l = li_l + 32;
    const __attribute__((address_space(3))) unsigned char* ldsb = (const __attribute__((address_space(3))) unsigned char*)(unsigned)(uintptr_t)lds;
    const int krow = widu * 8 + (lane >> 3);
    const unsigned kofs = (unsigned)(krow * 256 + (((lane & 7) ^ (krow & 7)) << 4));
    unsigned vofs[2];
#pragma unroll
    for (int i = 0; i < 2; ++i) { const int blk = (widu * 2 + i) * 2 + (lane >> 5), kk = (blk >> 2) * 8 + ((lane & 31) >> 2), k = (kk & ~0xC) | ((kk & 4) << 1) | ((kk & 8) >> 1);
      vofs[i] = (unsigned)((k * LDK + (blk & 3) * 32 + 8 * (lane & 3)) * 2); }
#define DMAK(t) do { const int t_ = (t) < NT ? (t) : NT - 1; const unsigned char* kb_ = Kh8 + (long)t_ * (KVBLK * 256); asm volatile("" : "+s"(kb_)); \
      __builtin_amdgcn_global_load_lds((const unsigned*)(kb_ + kofs), (lds_u32*)(ldsb + KRING + ((t) & (NS - 1)) * KSLOT + widu * 1024), 16, 0, 0); } while (0)
#define DMAV(t) do { const int t_ = (t) < NT ? (t) : NT - 1; const unsigned char* vb_ = (const unsigned char*)(Vh + (long)t_ * (KVBLK * LDK)); asm volatile("" : "+s"(vb_)); _Pragma("unroll") for (int i_ = 0; i_ < 2; ++i_) \
      __builtin_amdgcn_global_load_lds((const unsigned*)(vb_ + vofs[i_]), (lds_u32*)(ldsb + ((t) & (NS - 1)) * VSLOT + (widu * 2 + i_) * 1024), 16, 0, 0); } while (0)
#define PBAR() do { asm volatile("s_waitcnt lgkmcnt(0)" ::: "memory"); __builtin_amdgcn_s_barrier(); } while (0)
#define PEND() do { asm volatile("s_waitcnt vmcnt(6)" ::: "memory"); PBAR(); } while (0)
#define KSL(t) ((bf16*)(lds + KRING + ((t) & (NS - 1)) * KSLOT))
#define VSL(t) (vb0 + ((t) & (NS - 1)) * VSLOT)
    DMAK(0); DMAV(0); DMAK(1); DMAV(1); DMAK(2); DMAK(3); DMAV(2);
    asm volatile("s_waitcnt vmcnt(0)" ::: "memory"); PBAR();
    f32x16 cinit; { float nm_ = -m0 * (SCALE * LOG2E); asm volatile("" : "+v"(nm_));
#pragma unroll
      for (int r = 0; r < 16; ++r) cinit[r] = nm_; }
    qkt<WIN, F8, true>(pA0, pA1, KSL(0), qr, q8, r32, hi, tb0, &cinit); partialSM<FIXM, true>(pA0, pA1, m_reg, mnA, alA);
    PBAR();
    if (grp == 1) PBAR();
#pragma unroll 1
    for (int t = 1; t < NT; ++t) {
      SBAR(); DMAK(t + 3); SBAR();
      finishSM(pA0, pA1, alA, l_reg, pa0, pa1, pa2, pa3); SBAR();
      qkt<WIN, F8, true>(pA0, pA1, KSL(t), qr, q8, r32, hi, tb0, &cinit); SBAR();
      PEND();
      SBAR(); DMAV(t + 2); SBAR();
      pv_d0(o, VSL(t - 1), pa0, pa1, pa2, pa3); partialSM<FIXM, true>(pA0, pA1, m_reg, mnA, alA); SBAR();
      PEND();
    }
    if (grp == 0) PBAR();
    finishSM(pA0, pA1, alA, l_reg, pa0, pa1, pa2, pa3); SBAR();
    pv_d0(o, VSL(NT - 1), pa0, pa1, pa2, pa3);
    asm volatile("s_waitcnt vmcnt(0)" ::: "memory");
#undef DMAK
#undef DMAV
#undef PBAR
#undef PEND
#undef KSL
#undef VSL
  } else {
  constexpr int SE = 0, SO = SDEPTH - 1;
  SLOAD(SE, 0); asm volatile("s_waitcnt vmcnt(0)" ::: "memory"); SWRITE(0, SE); __syncthreads();
  qkt<WIN, F8>(pA0, pA1, K_lds, qr, q8, r32, hi, tb0); partialSM<FIXM>(pA0, pA1, m_reg, mnA, alA);
  SLOAD(SO, KVBLK); if constexpr (SDEPTH == 2) { if (2 < NT) SLOAD(SE, 2 * KVBLK); }
  SWAIT(); SWRITE(1, SO); __syncthreads();
  for (int j = 1; j + 1 < NT; j += 2) {
    SBAR(); qkt<WIN, F8>(pB0, pB1, (bf16*)((char*)K_lds + SHM_K), qr, q8, r32, hi, tb0 + 64 * j);
    finishSM(pA0, pA1, alA, l_reg, pa0, pa1, pa2, pa3); SBAR();
    SLOAD(SO, (j + SDEPTH) * KVBLK); SBAR();
    pv_d0(o, vb0, pa0, pa1, pa2, pa3); partialSM<FIXM>(pB0, pB1, m_reg, mnB, alB);
    __syncthreads(); SWAIT(); SWRITE(0, SE);
    RESC(alB); __syncthreads();
    SBAR(); qkt<WIN, F8>(pA0, pA1, K_lds, qr, q8, r32, hi, tb0 + 64 * (j + 1));
    finishSM(pB0, pB1, alB, l_reg, pa0, pa1, pa2, pa3); SBAR();
    if (SDEPTH == 1 || j + 3 < NT) SLOAD(SE, (j + 1 + SDEPTH) * KVBLK); SBAR();
    pv_d0(o, vb0 + (int)SHM_V, pa0, pa1, pa2, pa3); partialSM<FIXM>(pA0, pA1, m_reg, mnA, alA);
    __syncthreads(); SWAIT(); SWRITE(1, SO);
    RESC(alA); __syncthreads();
  }
  SBAR(); qkt<WIN, F8>(pB0, pB1, (bf16*)((char*)K_lds + SHM_K), qr, q8, r32, hi, tb0 + 64 * (NT - 1));
  finishSM(pA0, pA1, alA, l_reg, pa0, pa1, pa2, pa3); SBAR();
  pv_d0(o, vb0, pa0, pa1, pa2, pa3); partialSM<FIXM>(pB0, pB1, m_reg, mnB, alB);
  __syncthreads(); RESC(alB);
  finishSM(pB0, pB1, alB, l_reg, pa0, pa1, pa2, pa3); SBAR();
  pv_d0(o, vb0 + (int)SHM_V, pa0, pa1, pa2, pa3);
  }
  if (hi == 0) li_l[r32] = l_reg; asm volatile("s_waitcnt lgkmcnt(0)" ::: "memory");
  float rli[16];
#pragma unroll
  for (int r = 0; r < 16; ++r) rli[r] = __builtin_amdgcn_rcpf(li_l[crow(r, hi)]);
  unsigned char* Ow = Ob + (long)(wid * QBLK) * LDO;
#pragma unroll
  for (int r = 0; r < 16; ++r) { int orow = crow(r, hi); const float sc = rli[r] * oscale;
    for (int d0 = 0; d0 < 4; ++d0) Ow[(long)orow * LDO + d0 * 32 + r32] = (unsigned char)(__builtin_amdgcn_cvt_pk_fp8_f32(o[d0][r] * sc, 0.f, 0, false) & 0xff); }
  __syncthreads();
#undef SLOAD
#undef SWRITE
#undef SWAIT
#undef RESC
}
#undef KSWZ
#undef KSWZ8
#undef SBAR
}
constexpr int NWAVES = 8;
constexpr int SEQ = 8192, DM = 2048, HD = 128, NEXP = 64, TOPK = 8, FE = 512;
constexpr int INC = 7168;
constexpr int PLD = INC + PROJ_PAD;
constexpr int C_QA = 0, C_KA = 1024, C_VA = 1280, C_QB = 1536, C_KB = 2560, C_VB = 2816, C_GA = 3072, C_GB = 5120;
constexpr float LN_EPS = 1e-5f, RMS_EPS = 1e-6f;
constexpr float ALPHA = 1.189207115002721f;
constexpr float ROUTED_SCALE = 2.5f;
constexpr int LCAP = 8192;
constexpr int NEXP1 = NEXP + 1;

constexpr size_t MiB = 1u << 20;
constexpr size_t WS_CTL = 0, CTL_ZERO_BYTES = 1 * MiB;
constexpr size_t WS_WGU = 1 * MiB;
constexpr size_t WS_WINT = WS_WGU + 260 * MiB;
constexpr size_t WS_XBF = WS_WINT + 28 * MiB;
constexpr size_t WS_PROJ = WS_XBF + 32 * MiB;
constexpr size_t WS_OA = WS_PROJ + 116 * MiB;
constexpr size_t WS_OB = WS_OA + 16 * MiB;
constexpr size_t WS_MRG = WS_OB + 16 * MiB;
constexpr size_t WS_WAT = WS_MRG + 32 * MiB;
constexpr size_t WS_WBT = WS_WAT + 4 * MiB;
constexpr size_t WS_WOT = WS_WBT + 4 * MiB;
constexpr size_t WS_DEAD_END = WS_WOT + 8 * MiB;
constexpr size_t WS_Y = WS_WGU;
constexpr size_t WS_WD = WS_DEAD_END;
constexpr size_t WS_WR = WS_WD + 130 * MiB;
constexpr size_t WS_H32 = WS_WR + 1 * MiB;
constexpr size_t WS_HBF = WS_H32 + 64 * MiB;
constexpr size_t WS_HID = WS_HBF + 32 * MiB;
constexpr size_t WS_PRE = WS_HID + 88 * MiB;
constexpr size_t WS_LTOK = WS_PRE + 64 * MiB;
constexpr size_t WS_LW = WS_LTOK + 3 * MiB;
constexpr size_t WS_ROUTE = WS_LW + 3 * MiB;
constexpr size_t WS_HF8 = WS_H32;
constexpr size_t WS_KF8 = WS_H32 + 16 * MiB;
constexpr size_t WS_END = WS_ROUTE + 1 * MiB;
static_assert(WS_Y + 352 * MiB <= WS_WD, "Y overlay");
static_assert((size_t)SEQ * PLD * 2 <= 116 * MiB, "proj slot");
static_assert(WS_END <= 1024 * MiB, "d_ws map must fit 1 GiB");
constexpr int CW_TMO = 0;
constexpr int CW_CNT = 64;
constexpr int CW_BAR = 4096;

constexpr int RING_OFF = 0, RING_BYTES = 131072;
constexpr int LDSCTL_OFF = RING_BYTES;
constexpr int MISC_OFF = LDSCTL_OFF;
constexpr int IDXL_OFF = LDSCTL_OFF + 256;
constexpr int TST_OFF = IDXL_OFF + 1024 + 2048;
constexpr int LDS_BYTES = 147456;
static_assert(TST_OFF + 512 <= LDS_BYTES, "LDS map");

#define GAS __attribute__((address_space(1)))
#define LAS __attribute__((address_space(3)))
typedef unsigned short bf16;
typedef unsigned v4u __attribute__((ext_vector_type(4)));
typedef unsigned v2u __attribute__((ext_vector_type(2)));
typedef float f32x4 __attribute__((ext_vector_type(4)));
typedef short bf16x8 __attribute__((ext_vector_type(8)));
#define RLX_AGENT __ATOMIC_RELAXED, __HIP_MEMORY_SCOPE_AGENT
#define LDS_WAIT() asm volatile("s_waitcnt lgkmcnt(0)" ::: "memory")
#define VM_WAIT() asm volatile("s_waitcnt vmcnt(0)" ::: "memory")
__device__ __forceinline__ unsigned f2bf(float f) { unsigned u = __builtin_bit_cast(unsigned, f); return (u + 0x7fffu + ((u >> 16) & 1u)) >> 16; }
__device__ __forceinline__ unsigned pk2(float lo, float hi) { return f2bf(lo) | (f2bf(hi) << 16); }
__device__ __forceinline__ float bf2f(unsigned short h) { return __uint_as_float((unsigned)h << 16); }

#define XB_TMO      128
#define XB_XCNT(j)  (256  + 64 * (j))
#define XB_XSUB(j)  (1280 + 64 * (j))
#define XB_XGEN(j)  (2304 + 64 * (j))
#define XB_TOP      3328
#define XB_TOPGEN   3392
#define XCD_BAR_WORDS 3456
#define XB_SPIN_CAP (1u << 20)
__device__ __forceinline__ unsigned xb_ld(unsigned* p)              { return __hip_atomic_load(p, __ATOMIC_RELAXED, __HIP_MEMORY_SCOPE_AGENT); }
__device__ __forceinline__ unsigned xb_add(unsigned* p, unsigned v) { return __hip_atomic_fetch_add(p, v, __ATOMIC_RELAXED, __HIP_MEMORY_SCOPE_AGENT); }
__device__ __forceinline__ unsigned xb_xcc_id() { return (unsigned)__builtin_amdgcn_s_getreg((3 << 11) | 20) & 0xFu; }
#define XB_SPIN(cond, bar) do { unsigned _sp = 0; while (cond) { __builtin_amdgcn_s_sleep(1); \
    if ((++_sp & 255u) == 0u) { if (xb_ld(&(bar)[XB_TMO])) break; if (_sp > XB_SPIN_CAP) { atomicAdd(&(bar)[XB_TMO], 1u); break; } } } } while (0)
struct XcdBarrier { unsigned* bar; unsigned x; volatile LAS unsigned* st; unsigned total; };
__device__ __forceinline__ XcdBarrier xcd_barrier_post(unsigned* bar, volatile LAS unsigned* st, unsigned total) {
    XcdBarrier b; b.bar = bar; b.x = xb_xcc_id(); b.st = st; b.total = total;
    if (threadIdx.x == 0) (void)xb_add(&bar[XB_XCNT(b.x)], 1u);
    return b;
}
__device__ __forceinline__ void xcd_barrier_complete(unsigned* bar, unsigned x, unsigned G, unsigned& nloc, unsigned& nx) {
    unsigned sum, cnt, mine, sp = 0u;
    for (;;) {
        sum = 0u; cnt = 0u; mine = 0u;
#pragma unroll
        for (unsigned j = 0; j < 16; ++j) { const unsigned c = xb_ld(&bar[XB_XCNT(j)]); sum += c; cnt += (c > 0u) ? 1u : 0u; mine = (j == x) ? c : mine; }
        if (sum == G) break;
        __builtin_amdgcn_s_sleep(1);
        if ((++sp & 255u) == 0u) { if (xb_ld(&bar[XB_TMO])) break; if (sp > XB_SPIN_CAP) { atomicAdd(&bar[XB_TMO], 1u); break; } }
    }
    nloc = mine > 0u ? mine : 1u; nx = cnt > 0u ? cnt : 1u;
}
__device__ __forceinline__ void xcd_barrier(const XcdBarrier& b) {
    asm volatile("s_waitcnt vmcnt(0)" ::: "memory");
    __syncthreads();
    if (threadIdx.x == 0) {
        unsigned* bar = b.bar;
        __builtin_amdgcn_s_waitcnt(0);
        unsigned nloc = b.st[0], nx = b.st[1];
        if (nloc == 0u) { xcd_barrier_complete(bar, b.x, b.total, nloc, nx); b.st[0] = nloc; b.st[1] = nx; }
        const unsigned old = xb_add(&bar[XB_XSUB(b.x)], 1u);
        const unsigned gen = old / nloc;
        if (old + 1u == (gen + 1u) * nloc) {
            __builtin_amdgcn_fence(__ATOMIC_RELEASE, "agent");
            asm volatile("s_waitcnt vmcnt(0)" ::: "memory");
            const unsigned og = xb_add(&bar[XB_TOP], 1u);
            const unsigned tg = og / nx;
            if (og + 1u == (tg + 1u) * nx) xb_add(&bar[XB_TOPGEN], 1u);
            else XB_SPIN(xb_ld(&bar[XB_TOPGEN]) == tg, bar);
            __builtin_amdgcn_fence(__ATOMIC_ACQUIRE, "agent");
            xb_add(&bar[XB_XGEN(b.x)], 1u);
            asm volatile("s_waitcnt vmcnt(0)" ::: "memory");
        } else {
            XB_SPIN(xb_ld(&bar[XB_XGEN(b.x)]) == gen, bar);
            __builtin_amdgcn_fence(__ATOMIC_ACQUIRE, "agent");
            asm volatile("s_waitcnt vmcnt(0)" ::: "memory");
        }
    }
    __syncthreads();
}

__device__ __forceinline__ float wave_sum(float v) {
#pragma unroll
    for (int o = 1; o < 64; o <<= 1) v += __shfl_xor(v, o);
    return v;
}
__device__ __forceinline__ float sigmoidf_(float x) { return __builtin_amdgcn_rcpf(1.0f + __builtin_amdgcn_exp2f(-x * 1.4426950408889634f)); }

struct Args { const float* in[22]; float* out; unsigned char* ws; int ph_lo, ph_hi; };
struct Frame {
    LAS unsigned char* lds;
    volatile LAS unsigned* MISC;
    unsigned* ctl;
    int tid, lane, wave;
    int vcu, G;
    const float* in[22]; float* out; unsigned char* ws;
};

#ifndef G1_FP8
#define G1_FP8 1
#endif
#ifndef ATT_F8
#define ATT_F8 1
#endif
#ifndef P1_FP8
#define P1_FP8 1
#endif
struct TItem { const float* W; unsigned char* WT; int K, N, k0, n0, drow0, f8; };
constexpr float W8SCALE = 32.0f, H8SCALE = 8.0f, OA_SCALE = 16.0f, OB_SCALE = 64.0f, MG_SCALE = 32.0f;
__device__ __forceinline__ void titem_issue(const TItem& it, LAS unsigned char* buf, int lane) {
#pragma unroll
    for (int g = 0; g < 8; ++g) { const int k = 8 * g + (lane >> 3), pos = lane & 7;
        __builtin_amdgcn_global_load_lds((const unsigned*)(it.W + (size_t)(it.k0 + k) * it.N + it.n0 + 4 * (pos ^ g)), (LAS unsigned*)(buf + g * 1024), 16, 0, 0); }
}
__device__ __forceinline__ void titem_finish(const TItem& it, const LAS float* buf, int lane) {
    const int c = lane & 7;
#pragma unroll
    for (int j = 0; j < 4; ++j) { const int nn = (lane >> 3) + 8 * j; const LAS float* s = buf + (8 * c) * 32 + (((nn >> 2) ^ c) << 2) + (nn & 3);
        const size_t eo = (size_t)(it.drow0 + nn) * it.K + it.k0 + 8 * c;
        if (it.f8) { v2u o; int t = __builtin_amdgcn_cvt_pk_fp8_f32(s[0 * 32] * W8SCALE, s[1 * 32] * W8SCALE, 0, false); t = __builtin_amdgcn_cvt_pk_fp8_f32(s[2 * 32] * W8SCALE, s[3 * 32] * W8SCALE, t, true); o.x = (unsigned)t;
            t = __builtin_amdgcn_cvt_pk_fp8_f32(s[4 * 32] * W8SCALE, s[5 * 32] * W8SCALE, 0, false); t = __builtin_amdgcn_cvt_pk_fp8_f32(s[6 * 32] * W8SCALE, s[7 * 32] * W8SCALE, t, true); o.y = (unsigned)t;
            __builtin_nontemporal_store(o, (GAS v2u*)(it.WT + eo)); }
        else { v4u o; o.x = pg8::cvt_pk_bf16(s[0 * 32], s[1 * 32]); o.y = pg8::cvt_pk_bf16(s[2 * 32], s[3 * 32]); o.z = pg8::cvt_pk_bf16(s[4 * 32], s[5 * 32]); o.w = pg8::cvt_pk_bf16(s[6 * 32], s[7 * 32]);
            __builtin_nontemporal_store(o, (GAS v4u*)(it.WT + 2 * eo)); } }
}
constexpr int I_IN = (DM / 64) * (INC / 32);
constexpr int I_BR = (1024 / 64) * (DM / 32);
constexpr int I_WO = (DM / 64) * (DM / 32);
constexpr int I_GU = (DM / 64) * (FE / 32);
constexpr int I_DN = (FE / 64) * (DM / 32);
constexpr int NITEMS_E1 = 2 * I_BR + I_WO + NEXP1 * 2 * I_GU;
constexpr int NITEMS_E2 = NEXP1 * I_DN;
__device__ __forceinline__ void titem_plain(TItem& it, const float* W, int K, int N, void* WT, int item, int f8 = 0) {
    const int nblk = N / 32, kb = item / nblk, nb = item % nblk; it.W = W; it.WT = (unsigned char*)WT; it.K = K; it.N = N; it.k0 = 64 * kb; it.n0 = 32 * nb; it.drow0 = 32 * nb; it.f8 = f8;
}
template <int LIST>
__device__ __forceinline__ void titem_get(Frame& F, int r, TItem& it) {
    if constexpr (LIST == 0) { titem_plain(it, F.in[1], DM, INC, F.ws + WS_WINT, r, P1_FP8); }
    else if constexpr (LIST == 2) { const int e = r / I_DN; r -= e * I_DN;
        titem_plain(it, e < NEXP ? F.in[16] + (size_t)e * FE * DM : F.in[19], FE, DM, F.ws + WS_WD + (size_t)e * DM * FE, r, 1); }
    else {
        if (r < I_BR) { titem_plain(it, F.in[7], 1024, DM, F.ws + WS_WAT, r, 1); return; } r -= I_BR;
        if (r < I_BR) { titem_plain(it, F.in[8], 1024, DM, F.ws + WS_WBT, r, 1); return; } r -= I_BR;
        if (r < I_WO) { titem_plain(it, F.in[9], DM, DM, F.ws + WS_WOT, r, 1); return; } r -= I_WO;
        const int e = r / (2 * I_GU); r -= e * (2 * I_GU);
        const int half = r >= I_GU ? 1 : 0; r -= half * I_GU;
        const float* w = e < NEXP ? (half ? F.in[15] : F.in[14]) + (size_t)e * DM * FE : (half ? F.in[18] : F.in[17]);
        const int nblk = FE / 32, kb = r / nblk, nb = r % nblk, n0 = 32 * nb;
        it.W = w; it.WT = F.ws + WS_WGU + (size_t)e * 1024 * DM * (G1_FP8 ? 1 : 2); it.f8 = G1_FP8; it.K = DM; it.N = FE; it.k0 = 64 * kb; it.n0 = n0; it.drow0 = 256 * (n0 >> 7) + 128 * half + (n0 & 127);
    }
}
#ifndef CONV_D
#define CONV_D 4
#endif
__device__ __forceinline__ void titem_load(const TItem& it, f32x4 (&r)[8], int lane) {
#pragma unroll
    for (int g = 0; g < 8; ++g) r[g] = __builtin_nontemporal_load((const GAS f32x4*)(it.W + (size_t)(it.k0 + 8 * g + (lane >> 3)) * it.N + it.n0 + 4 * (lane & 7)));
}
__device__ __forceinline__ void titem_store(const TItem& it, const f32x4 (&r)[8], LAS float* buf, int lane) {
#pragma unroll
    for (int g = 0; g < 8; ++g) *(LAS f32x4*)(buf + (8 * g + (lane >> 3)) * 32 + (((lane & 7) ^ g) << 2)) = r[g];
    titem_finish(it, buf, lane);
}
template <int LISTE>
__device__ __forceinline__ void convert_items(Frame& F, int first, int step, int last) {
    LAS float* buf = (LAS float*)(F.lds + RING_OFF + F.wave * 8192);
    if (first >= last) return;
    const int n_my = (last - first + step - 1) / step;
    f32x4 r[CONV_D][8]; TItem it;
#pragma unroll
    for (int d = 0; d < CONV_D; ++d) if (d < n_my) { titem_get<LISTE>(F, first + d * step, it); titem_load(it, r[d], F.lane); }
    for (int base = 0; base < n_my; base += CONV_D) {
#pragma unroll
        for (int d = 0; d < CONV_D; ++d) { const int idx = base + d;
            if (idx < n_my) { titem_get<LISTE>(F, first + idx * step, it); titem_store(it, r[d], buf, F.lane);
                if (idx + CONV_D < n_my) { titem_get<LISTE>(F, first + (idx + CONV_D) * step, it); titem_load(it, r[d], F.lane); } } }
    }
}
#ifndef CONV_Q
#define CONV_Q 200
#endif
#ifndef P1_NCG
#define P1_NCG 23
#endif
constexpr int NCONV = 32, NCOMP = 256 - NCONV, NCONV1 = 8 * (32 - P1_NCG), NCOMP1 = 8 * P1_NCG, E_SPLIT = (NCONV1 * NWAVES * CONV_Q < NITEMS_E1) ? NCONV1 * NWAVES * CONV_Q : NITEMS_E1;
#ifndef CONV_Q2
#define CONV_Q2 100
#endif
#ifndef P1_QE2
#define P1_QE2 0
#endif
constexpr int E2_A = (NCONV1 * NWAVES * P1_QE2 < NITEMS_E2) ? NCONV1 * NWAVES * P1_QE2 : NITEMS_E2;
constexpr int E2_SPLIT = (E2_A + 32 * NWAVES * CONV_Q2 < NITEMS_E2) ? E2_A + 32 * NWAVES * CONV_Q2 : NITEMS_E2;
#ifndef CONV_G1
#define CONV_G1 1
#endif
__device__ __forceinline__ void p0_prologue(Frame& F, bool compute_only) {
    const int gw = (compute_only ? (F.vcu >> 5) * P1_NCG + (F.vcu & 31) : F.vcu) * NWAVES + F.wave, NGW = (compute_only ? NCOMP1 : F.G) * NWAVES;
    convert_items<0>(F, gw, NGW, I_IN);
    { const int gt = gw * 64 + F.lane, NT = NGW * 64; const GAS f32x4* xs = (const GAS f32x4*)F.in[0]; GAS v4u* xo = (GAS v4u*)(F.ws + WS_XBF);
      for (int i = gt; i < SEQ * DM / 8; i += 4 * NT) {
          f32x4 a[4], b[4];
#pragma unroll
          for (int u = 0; u < 4; ++u) if (i + u * NT < SEQ * DM / 8) { a[u] = __builtin_nontemporal_load(xs + 2 * (i + u * NT)); b[u] = __builtin_nontemporal_load(xs + 2 * (i + u * NT) + 1); }
#pragma unroll
          for (int u = 0; u < 4; ++u) if (i + u * NT < SEQ * DM / 8) {
              if (P1_FP8) { v2u o; int t = __builtin_amdgcn_cvt_pk_fp8_f32(a[u].x, a[u].y, 0, false); t = __builtin_amdgcn_cvt_pk_fp8_f32(a[u].z, a[u].w, t, true); o.x = (unsigned)t;
                  t = __builtin_amdgcn_cvt_pk_fp8_f32(b[u].x, b[u].y, 0, false); t = __builtin_amdgcn_cvt_pk_fp8_f32(b[u].z, b[u].w, t, true); o.y = (unsigned)t; ((GAS v2u*)xo)[i + u * NT] = o; }
              else { v4u o; o.x = pg8::cvt_pk_bf16(a[u].x, a[u].y); o.y = pg8::cvt_pk_bf16(a[u].z, a[u].w); o.z = pg8::cvt_pk_bf16(b[u].x, b[u].y); o.w = pg8::cvt_pk_bf16(b[u].z, b[u].w); xo[i + u * NT] = o; } } } }
    { const int gt = gw * 64 + F.lane, NT = NGW * 64; bf16* wr = (bf16*)(F.ws + WS_WR);
      for (int i = gt; i < NEXP * DM; i += NT) {
          const int j_ = i & 7, ln = (i >> 3) & 63, nt_ = (i >> 9) & 3, ks = i >> 11, q_ = ln >> 4, t_ = ln & 15;
          const int k = ks * 32 + (j_ < 4 ? 4 * q_ + j_ : 16 + 4 * q_ + j_ - 4), e = 16 * nt_ + t_;
          const float w = F.in[12][(size_t)k * NEXP + e]; const unsigned h = f2bf(w); const float lo = w - __uint_as_float(h << 16);
          wr[i] = (bf16)h; wr[NEXP * DM + i] = (bf16)f2bf(lo); } }
    { const int gt = gw * 64 + F.lane, NT = NGW * 64; int* lt = (int*)(F.ws + WS_LTOK); float* lw = (float*)(F.ws + WS_LW);
      for (int i = gt; i < NEXP1 * LCAP; i += NT) { const bool sh = i >= NEXP * LCAP; lt[i] = sh ? i - NEXP * LCAP : 0; lw[i] = sh ? 1.0f : 0.0f; } }
}

#ifndef WT_STORES
#define WT_STORES 0
#endif
__device__ __forceinline__ void st_wt8(void* p, v2u w) {
    if (WT_STORES) __hip_atomic_store((unsigned long long*)p, ((unsigned long long)w.y << 32) | w.x, __ATOMIC_RELAXED, __HIP_MEMORY_SCOPE_AGENT);
    else *(v2u*)p = w;
}
__device__ __forceinline__ v4u pair16(v2u a, v2u b) {
    auto sx = __builtin_amdgcn_permlane16_swap(a.x, b.x, false, false);
    auto sy = __builtin_amdgcn_permlane16_swap(a.y, b.y, false, false);
    return (v4u){sx[0], sy[0], sx[1], sy[1]};
}
struct DenseOrder {
    const char* A; const char* B; int nM, nN, nwg, G, c; size_t tstep;
    __device__ __forceinline__ void init(const void* A_, const void* B_, int M, int N, int K, int G_, int c_) { A = (const char*)A_; B = (const char*)B_; nM = M / 256; nN = N / 256; nwg = nM * nN; G = G_; c = c_; tstep = (size_t)256 * K * (P1_FP8 ? 1 : 2); }
    __device__ __forceinline__ bool next(int i, pg8::Unit& u) const {
#ifdef P1_DOUBLE
        const long L = (long)(i >> 1) * G + c; if (L >= nwg) return false;
#else
        const long L = (long)i * G + c; if (L >= nwg) return false;
#endif
        int wgid = (int)L; { const int q = nwg / 8, r = nwg % 8, xcd = wgid % 8, off = wgid / 8; wgid = (xcd < r ? xcd * (q + 1) : r * (q + 1) + (xcd - r) * q) + off; }
        const int nig = 8 * nN, gid = wgid / nig, fm = gid * 8, gsz = (nM - fm) < 8 ? (nM - fm) : 8;
        const int pm = fm + ((wgid % nig) % gsz), pn = (wgid % nig) / gsz;
        u.A = A + (size_t)pm * tstep; u.B = B + (size_t)pn * tstep; u.idx = nullptr; u.wts = nullptr; u.r0 = pm * 256; u.c0 = pn * 256; u.aux = 0; u.kind = 0; return true;
    }
};
struct BranchOrder {
    const char *OA, *OB, *WA, *WB; int vcu;
    __device__ __forceinline__ bool next(int i, pg8::Unit& u) const {
#ifdef P3_DOUBLE
        if (i >= 4) return false; i &= 1;
#else
        if (i >= 2) return false;
#endif
        const int pm = vcu >> 3, pn = vcu & 7; const size_t ts = (size_t)256 * 1024;
        u.A = (i ? OB : OA) + (size_t)pm * ts; u.B = (i ? WB : WA) + (size_t)pn * ts; u.idx = nullptr; u.wts = nullptr; u.r0 = pm * 256; u.c0 = pn * 256; u.aux = 0; u.kind = i; return true;
    }
};
struct OneTileOrder {
    const char *A, *B; int vcu; size_t ts;
    __device__ __forceinline__ bool next(int i, pg8::Unit& u) const {
#ifdef P4_DOUBLE
        if (i >= 2) return false;
#else
        if (i >= 1) return false;
#endif
        const int pm = vcu >> 3, pn = vcu & 7;
        u.A = A + (size_t)pm * ts; u.B = B + (size_t)pn * ts; u.idx = nullptr; u.wts = nullptr; u.r0 = pm * 256; u.c0 = pn * 256; u.aux = 0; u.kind = 0; return true;
    }
};
template <int NPN>
struct MoeOrder {
    const LAS int* tst; const char* A; const char* B; const int* ltok; const float* lwt; int vcu, G; size_t arow, bexp, bpn;
    bool gather;
    int l0, lend, nheavy;
    const unsigned* flag; int wait_gmt, need;
    mutable int ec = 0;
    __device__ __forceinline__ bool next(int i, pg8::Unit& u) const {
        const int T = tst[NEXP1]; const int end = lend < 0 ? T * NPN : lend;
        int L;
#ifdef G2_DOUBLE
        if (NPN == 8) i >>= 1;
#endif
        if (nheavy > 0) { const int NL = G - nheavy; if (vcu >= NL) L = 2 * NL + i * G + vcu; else L = i < 2 ? i * NL + vcu : 2 * NL + (i - 2) * G + vcu; }
        else L = l0 + i * G + vcu;
        if (L >= end) return false;
        const int gmt = L / NPN, pn = L % NPN; int e = ec; if (tst[e] > gmt) e = 0;
        while (e < NEXP && tst[e + 1] <= gmt) ++e;
        ec = e;
        const int mt = gmt - tst[e];
        if (need > 0 && gmt >= wait_gmt) {
            unsigned spins = 0; while (__hip_atomic_load(flag, __ATOMIC_RELAXED, __HIP_MEMORY_SCOPE_AGENT) < (unsigned)need && ++spins < (1u << 22)) __builtin_amdgcn_s_sleep(2);
            __builtin_amdgcn_fence(__ATOMIC_ACQUIRE, "agent"); asm volatile("s_waitcnt vmcnt(0)" ::: "memory"); }
        u.A = gather ? A : A + (size_t)gmt * 256 * arow; u.B = B + (size_t)e * bexp + (size_t)pn * bpn; u.idx = ltok + e * LCAP + mt * 256; u.wts = lwt + e * LCAP + mt * 256;
        u.r0 = gmt * 256; u.c0 = pn * 256; u.aux = e * LCAP + mt * 256; u.kind = 0; return true;
    }
};

constexpr float GSCALE = 256.0f;
typedef float f32x2v __attribute__((ext_vector_type(2)));
struct EpiProj {
    static constexpr bool PERM = true; static constexpr int NST = 8;
    bf16* O; const float* bgate;
    __device__ __forceinline__ bool operator()(const pg8::f32x4 (&acc)[2][2][4][2], const pg8::Unit& u, int wr, int wc, int fr, int fq, const LAS float* wl) const {
        const int row0 = u.r0 + wr * 64 + fr, col0 = u.c0 + wc * 32 + 8 * fq;
        constexpr float PS = P1_FP8 ? 1.0f / W8SCALE : 1.0f;
        if (u.c0 >= C_GA) {
            f32x4 bb[2][2];
#pragma unroll
            for (int bj = 0; bj < 2; ++bj) { bb[bj][0] = *(const f32x4*)(bgate + col0 + bj * 128 - C_GA); bb[bj][1] = *(const f32x4*)(bgate + col0 + bj * 128 - C_GA + 4); }
            const int odd = fq & 1; unsigned char* G = (unsigned char*)O + (size_t)C_GA * 2 + (col0 - 8 * odd - C_GA);
#pragma unroll
            for (int ai = 0; ai < 2; ++ai)
#pragma unroll
                for (int mp = 0; mp < 2; ++mp)
#pragma unroll
                    for (int bj = 0; bj < 2; ++bj) { v2u w[2];
#pragma unroll
                        for (int mm = 0; mm < 2; ++mm) { const int m = 2 * mp + mm; const f32x4 v0 = acc[ai][bj][m][0] * PS + bb[bj][0], v1 = acc[ai][bj][m][1] * PS + bb[bj][1];
                            int t = __builtin_amdgcn_cvt_pk_fp8_f32(GSCALE * sigmoidf_(v0[0]), GSCALE * sigmoidf_(v0[1]), 0, false); t = __builtin_amdgcn_cvt_pk_fp8_f32(GSCALE * sigmoidf_(v0[2]), GSCALE * sigmoidf_(v0[3]), t, true); w[mm].x = (unsigned)t;
                            t = __builtin_amdgcn_cvt_pk_fp8_f32(GSCALE * sigmoidf_(v1[0]), GSCALE * sigmoidf_(v1[1]), 0, false); t = __builtin_amdgcn_cvt_pk_fp8_f32(GSCALE * sigmoidf_(v1[2]), GSCALE * sigmoidf_(v1[3]), t, true); w[mm].y = (unsigned)t; }
                        *(v4u*)(G + (size_t)(row0 + ai * 128 + (2 * mp + odd) * 16) * (PLD * 2) + bj * 128) = pair16(w[0], w[1]); }
        } else {
#pragma unroll
            for (int ai = 0; ai < 2; ++ai)
#pragma unroll
                for (int m = 0; m < 4; ++m)
#pragma unroll
                    for (int bj = 0; bj < 2; ++bj) { const f32x4 v0 = acc[ai][bj][m][0] * PS, v1 = acc[ai][bj][m][1] * PS;
                        v4u w; w.x = pg8::cvt_pk_bf16(v0[0], v0[1]); w.y = pg8::cvt_pk_bf16(v0[2], v0[3]); w.z = pg8::cvt_pk_bf16(v1[0], v1[1]); w.w = pg8::cvt_pk_bf16(v1[2], v1[3]);
                        *(v4u*)(O + (size_t)(row0 + ai * 128 + m * 16) * PLD + col0 + bj * 128) = w; }
        }
        return false;
    }
};
struct EpiBranch {
    static constexpr bool PERM = true; static constexpr int NST = 0;
    const bf16* proj; unsigned char* O;
    __device__ __forceinline__ bool operator()(pg8::f32x4 (&acc)[2][2][4][2], const pg8::Unit& u, int wr, int wc, int fr, int fq, const LAS float* wl) const {
        const int row0 = u.r0 + wr * 64 + fr, col0 = u.c0 + wc * 32 + 8 * fq;
        const bool seg0 = u.kind == 0;
#pragma unroll
        for (int ai = 0; ai < 2; ++ai) {
            v2u gb[4][2], ga[4][2];
#pragma unroll
            for (int m = 0; m < 4; ++m)
#pragma unroll
                for (int bj = 0; bj < 2; ++bj) { const size_t r = (size_t)(row0 + ai * 128 + m * 16); const int c = col0 + bj * 128;
                    const unsigned char* gp = (const unsigned char*)proj + r * (PLD * 2) + (size_t)C_GA * 2 + c;
                    gb[m][bj] = *(const v2u*)(gp + (C_GB - C_GA)); ga[m][bj] = seg0 ? *(const v2u*)gp : (v2u){0u, 0u}; }
            __builtin_amdgcn_sched_barrier(0);
#pragma unroll
            for (int mp = 0; mp < 2; ++mp) {
                v2u wq[2][2];
#pragma unroll
                for (int mm = 0; mm < 2; ++mm)
#pragma unroll
                    for (int bj = 0; bj < 2; ++bj) { const int m = 2 * mp + mm;
                        const v2u gbv = gb[m][bj], gav = ga[m][bj];
                        const f32x2v g01 = __builtin_amdgcn_cvt_pk_f32_fp8((int)gbv.x, false), g23 = __builtin_amdgcn_cvt_pk_f32_fp8((int)gbv.x, true), g45 = __builtin_amdgcn_cvt_pk_f32_fp8((int)gbv.y, false), g67 = __builtin_amdgcn_cvt_pk_f32_fp8((int)gbv.y, true);
                        float g[8] = {g01[0], g01[1], g23[0], g23[1], g45[0], g45[1], g67[0], g67[1]};
                        if (seg0) {
                            const f32x2v a01 = __builtin_amdgcn_cvt_pk_f32_fp8((int)gav.x, false), a23 = __builtin_amdgcn_cvt_pk_f32_fp8((int)gav.x, true), a45 = __builtin_amdgcn_cvt_pk_f32_fp8((int)gav.y, false), a67 = __builtin_amdgcn_cvt_pk_f32_fp8((int)gav.y, true);
                            float a[8] = {a01[0], a01[1], a23[0], a23[1], a45[0], a45[1], a67[0], a67[1]};
#pragma unroll
                            for (int j = 0; j < 4; ++j) { acc[ai][bj][m][0][j] *= (OB_SCALE / OA_SCALE) * a[j] * __builtin_amdgcn_rcpf(fmaxf(g[j], 1e-30f)); acc[ai][bj][m][1][j] *= (OB_SCALE / OA_SCALE) * a[4 + j] * __builtin_amdgcn_rcpf(fmaxf(g[4 + j], 1e-30f)); }
                        } else {
                            const pg8::f32x4 v0 = acc[ai][bj][m][0], v1 = acc[ai][bj][m][1];
                            constexpr float S1 = MG_SCALE / (OB_SCALE * W8SCALE * GSCALE);
                            v2u w; int t = __builtin_amdgcn_cvt_pk_fp8_f32(v0[0] * g[0] * S1, v0[1] * g[1] * S1, 0, false); t = __builtin_amdgcn_cvt_pk_fp8_f32(v0[2] * g[2] * S1, v0[3] * g[3] * S1, t, true); w.x = (unsigned)t;
                            t = __builtin_amdgcn_cvt_pk_fp8_f32(v1[0] * g[4] * S1, v1[1] * g[5] * S1, 0, false); t = __builtin_amdgcn_cvt_pk_fp8_f32(v1[2] * g[6] * S1, v1[3] * g[7] * S1, t, true); w.y = (unsigned)t;
                            wq[mm][bj] = w;
                        }
                    }
                if (!seg0) { const int odd = fq & 1;
#pragma unroll
                    for (int bj = 0; bj < 2; ++bj) *(v4u*)(O + (size_t)(row0 + ai * 128 + (2 * mp + odd) * 16) * DM + col0 - 8 * odd + bj * 128) = pair16(wq[0][bj], wq[1][bj]); }
            }
            __builtin_amdgcn_sched_barrier(0);
        }
        return seg0;
    }
};
struct EpiMix {
    static constexpr bool PERM = true; static constexpr int NST = 16;
    bf16* O;
    __device__ __forceinline__ bool operator()(const pg8::f32x4 (&acc)[2][2][4][2], const pg8::Unit& u, int wr, int wc, int fr, int fq, const LAS float* wl) const {
        const int row0 = u.r0 + wr * 64 + fr, col0 = u.c0 + wc * 32 + 8 * fq;
#pragma unroll
        for (int ai = 0; ai < 2; ++ai)
#pragma unroll
            for (int m = 0; m < 4; ++m)
#pragma unroll
                for (int bj = 0; bj < 2; ++bj) { const pg8::f32x4 v0 = acc[ai][bj][m][0] * (1.0f / (MG_SCALE * W8SCALE)), v1 = acc[ai][bj][m][1] * (1.0f / (MG_SCALE * W8SCALE));
                    v4u w; w.x = pg8::cvt_pk_bf16(v0[0], v0[1]); w.y = pg8::cvt_pk_bf16(v0[2], v0[3]); w.z = pg8::cvt_pk_bf16(v1[0], v1[1]); w.w = pg8::cvt_pk_bf16(v1[2], v1[3]);
                    *(v4u*)(O + (size_t)(row0 + ai * 128 + m * 16) * DM + col0 + bj * 128) = w; }
        return false;
    }
};
struct EpiMoe1 {
    static constexpr bool PERM = true; static constexpr int NST = 4;
    unsigned char* H;
    __device__ __forceinline__ bool operator()(const pg8::f32x4 (&acc)[2][2][4][2], const pg8::Unit& u, int wr, int wc, int fr, int fq, const LAS float* wl) const {
        const int odd = fq & 1; const int row0 = u.r0 + wr * 64 + fr + odd * 16, col0 = (u.c0 >> 1) + wc * 32 + 8 * (fq - odd);
#pragma unroll
        for (int ai = 0; ai < 2; ++ai)
#pragma unroll
            for (int mp = 0; mp < 2; ++mp) { v2u w[2];
#pragma unroll
                for (int mm = 0; mm < 2; ++mm) { const int m = 2 * mp + mm; float h[8]; const float wt = wl[wr * 64 + fr + ai * 128 + m * 16] * H8SCALE;
#pragma unroll
                    for (int n = 0; n < 2; ++n)
#pragma unroll
                        for (int j = 0; j < 4; ++j) { const float g = acc[ai][0][m][n][j] * (G1_FP8 ? 1.0f / W8SCALE : 1.0f), up = acc[ai][1][m][n][j] * (G1_FP8 ? 1.0f / W8SCALE : 1.0f); h[4 * n + j] = __builtin_amdgcn_fmed3f(g * sigmoidf_(g) * up * wt, -448.0f, 448.0f); }
                    int t = __builtin_amdgcn_cvt_pk_fp8_f32(h[0], h[1], 0, false); t = __builtin_amdgcn_cvt_pk_fp8_f32(h[2], h[3], t, true); w[mm].x = (unsigned)t;
                    t = __builtin_amdgcn_cvt_pk_fp8_f32(h[4], h[5], 0, false); t = __builtin_amdgcn_cvt_pk_fp8_f32(h[6], h[7], t, true); w[mm].y = (unsigned)t; }
                *(v4u*)(H + (size_t)(row0 + ai * 128 + mp * 32) * FE + col0) = pair16(w[0], w[1]); }
        return false;
    }
};
constexpr float YSCALE = 16.0f;
struct EpiMoe2 {
    static constexpr bool PERM = true; static constexpr int NST = 8;
    unsigned char* Y;
    __device__ __forceinline__ bool operator()(const pg8::f32x4 (&acc)[2][2][4][2], const pg8::Unit& u, int wr, int wc, int fr, int fq, const LAS float* wl) const {
        const int odd = fq & 1; const int lr0 = wr * 64 + fr + odd * 16, col0 = u.c0 + wc * 32 + 8 * (fq - odd);
#pragma unroll
        for (int ai = 0; ai < 2; ++ai)
#pragma unroll
            for (int mp = 0; mp < 2; ++mp) { const int lr = lr0 + ai * 128 + mp * 32;
#pragma unroll
                for (int bj = 0; bj < 2; ++bj) { v2u w[2];
#pragma unroll
                    for (int mm = 0; mm < 2; ++mm) { pg8::f32x4 v0 = acc[ai][bj][2 * mp + mm][0] * (YSCALE / (W8SCALE * H8SCALE)), v1 = acc[ai][bj][2 * mp + mm][1] * (YSCALE / (W8SCALE * H8SCALE));
#pragma unroll
                        for (int j = 0; j < 4; ++j) { v0[j] = __builtin_amdgcn_fmed3f(v0[j], -448.0f, 448.0f); v1[j] = __builtin_amdgcn_fmed3f(v1[j], -448.0f, 448.0f); }
                        int t = __builtin_amdgcn_cvt_pk_fp8_f32(v0[0], v0[1], 0, false); t = __builtin_amdgcn_cvt_pk_fp8_f32(v0[2], v0[3], t, true); w[mm].x = (unsigned)t;
                        t = __builtin_amdgcn_cvt_pk_fp8_f32(v1[0], v1[1], 0, false); t = __builtin_amdgcn_cvt_pk_fp8_f32(v1[2], v1[3], t, true); w[mm].y = (unsigned)t; }
                    *(v4u*)(Y + (size_t)(u.r0 + lr) * DM + col0 + bj * 128) = pair16(w[0], w[1]); } }
        return false;
    }
};

__device__ __forceinline__ void p1b_qknorm(Frame& F) {
    const int gw = F.vcu * NWAVES + F.wave, NGW = F.G * NWAVES; const bf16* proj = (const bf16*)(F.ws + WS_PROJ);
    const int hf = F.lane >> 5, i = F.lane & 31;
    const float inv = __builtin_amdgcn_exp2f(-(float)(2 * i) * (1.0f / 64.0f) * 13.287712379549449f);
    const float gk0 = F.in[6][64 * hf + i], gk1 = F.in[6][64 * hf + 32 + i];
    for (int tok0 = gw; tok0 < SEQ; tok0 += 4 * NGW) {
        float x1[4][2], x2[4][2];
#pragma unroll
        for (int b = 0; b < 4; ++b) { const int tok = tok0 + b * NGW; const bf16* pq = proj + (size_t)(tok < SEQ ? tok : 0) * PLD + C_KB + 64 * hf + i;
#pragma unroll
            for (int hh = 0; hh < 2; ++hh) { x1[b][hh] = bf2f(pq[hh * HD]); x2[b][hh] = bf2f(pq[hh * HD + 32]); } }
        __builtin_amdgcn_sched_barrier(0);
#pragma unroll
        for (int b = 0; b < 4; ++b) { const int tok = tok0 + b * NGW;
            const float pos = (float)(hf == 0 ? (tok >> 6) : (tok & 63));
            const float rev = pos * inv * 0.15915494309189535f, fr = rev - floorf(rev);
            const float sn = __builtin_amdgcn_sinf(fr), cs = __builtin_amdgcn_cosf(fr);
#pragma unroll
            for (int hh = 0; hh < 2; ++hh) {
                const float ss = wave_sum(x1[b][hh] * x1[b][hh] + x2[b][hh] * x2[b][hh]);
                const float rs = 1.0f / sqrtf(ss * (1.0f / HD) + RMS_EPS);
                const float a = x1[b][hh] * rs * gk0, c = x2[b][hh] * rs * gk1;
                const float o1 = a * cs - c * sn, o2 = c * cs + a * sn;
                if (tok < SEQ) { unsigned char* kf = F.ws + WS_KF8 + (size_t)tok * 256 + hh * HD + 64 * hf + 32 * ((i >> 4) & 1) + (i & 15);
                    kf[0] = (unsigned char)(__builtin_amdgcn_cvt_pk_fp8_f32(o1, 0.f, 0, false) & 0xff); kf[16] = (unsigned char)(__builtin_amdgcn_cvt_pk_fp8_f32(o2, 0.f, 0, false) & 0xff); } } }
    }
}

__device__ __forceinline__ int t5_bucket(int rel) {
    const int n = rel < 0 ? -rel : rel; int b;
    if (n < 8) b = n; else if (n < 12) b = 8; else if (n < 16) b = 9; else if (n < 23) b = 10; else if (n < 32) b = 11; else if (n < 46) b = 12; else if (n < 64) b = 13; else if (n < 91) b = 14; else b = 15;
    return (rel > 0 ? 16 : 0) + b;
}
#ifndef ATT_PP
#define ATT_PP 1
#endif
#ifndef PROBE_ATT_KMASK
#define PROBE_ATT_KMASK (-1)
#endif
__device__ __forceinline__ void p3_dense_attention(Frame& F) {
    using abf = attn::bf16;
    char* lds = (char*)F.lds;
    const abf* proj = (const abf*)(F.ws + WS_PROJ);
    float gqm = fmaxf(fabsf(F.in[5][F.lane]), fabsf(F.in[5][F.lane + 64])), gkm = fmaxf(fabsf(F.in[6][F.lane]), fabsf(F.in[6][F.lane + 64]));
#pragma unroll
    for (int o = 1; o < 64; o <<= 1) { gqm = fmaxf(gqm, __shfl_xor(gqm, o)); gkm = fmaxf(gkm, __shfl_xor(gkm, o)); }
    const float sbound = 1.15f * 128.0f * gqm * gkm;
    for (int un = F.vcu; un < 256; un += F.G) {
        const int h = un >> 5, ub = un & 31, kvh = h >> 2;
        attn::attn_body<false, 1, true, true, true, -1, ATT_PP != 0>(proj + (size_t)(ub * 256) * PLD + C_QB + h * HD, proj + C_KB + kvh * HD, F.ws + WS_KF8 + kvh * HD, proj + C_VB + kvh * HD,
                               F.ws + WS_OB + (size_t)(ub * 256) * 1024 + h * HD, OB_SCALE, SEQ, lds, nullptr, 0, sbound, 0.f, F.in[5], ub * 256);
#ifdef PROBE_ATT2
        attn::attn_body<false, 1, true, true, true, PROBE_ATT_KMASK>(proj + (size_t)(ub * 256) * PLD + C_QB + h * HD, proj + C_KB + kvh * HD, F.ws + WS_KF8 + kvh * HD, proj + C_VB + kvh * HD,
                               F.ws + WS_MRG + (size_t)(ub * 256) * 1024 + h * HD, OB_SCALE, SEQ, lds, nullptr, 0, sbound, 0.f, F.in[5], ub * 256);
#endif
    }
}
__device__ __forceinline__ void win_attention(Frame& F, int first, int step) {
    using abf = attn::bf16;
    char* lds = (char*)F.lds;
    const abf* proj = (const abf*)(F.ws + WS_PROJ);
    for (int un = first; un < 256; un += step) {
        const int h = un >> 5, ub = un & 31, kvh = h >> 2;
        LAS float* tab = (LAS float*)(F.lds + attn::WIN_TAB);
        for (int e = F.tid; e < 1024; e += NWAVES * 64) { const int rel = e - 512; const int ar = rel < 0 ? -rel : rel;
            tab[e] = ar <= 128 ? F.in[4][t5_bucket(rel) * 8 + h] * (1.0f / attn::SCALE) : -1e30f; }
        __syncthreads();
        const int q0 = ub * 256; int kf = q0 - 128, ke = q0 + 384; if (kf < 0) kf = 0; if (ke > SEQ) ke = SEQ;
        const float sinkl = F.in[3][h] * (1.0f / attn::SCALE);
        attn::attn_body<true, 1, false, false>(proj + (size_t)q0 * PLD + C_QA + h * HD, proj + (size_t)kf * PLD + C_KA + kvh * HD, nullptr, proj + (size_t)kf * PLD + C_VA + kvh * HD,
                              F.ws + WS_OA + (size_t)q0 * 1024 + h * HD, OA_SCALE, ke - kf, lds, tab, kf - q0, sinkl, 1.0f);
    }
}

__device__ __forceinline__ void p5_ln_router(Frame& F, bool probe_rep = false) {
    typedef float f32x4v __attribute__((ext_vector_type(4)));
    const bf16* mixb = (const bf16*)(F.ws + WS_PRE); bf16* hbf = (bf16*)(F.ws + WS_HBF);
    const bf16* wrh = (const bf16*)(F.ws + WS_WR); const bf16* wrl = wrh + NEXP * DM;
    LAS float* red = (LAS float*)(F.lds);
    LAS float* part = (LAS float*)(F.lds + 4096);
    LAS int* cntl = (LAS int*)(F.lds + 4096 + 32768);
    LAS int* basel = cntl + 64;
    LAS int* rec_e = basel + 64;
    LAS int* rec_p = rec_e + 256;
    LAS float* rec_w = (LAS float*)(rec_p + 256);
    const int lane = F.lane, w = F.wave, gi = w >> 2, kq = w & 3, t = lane & 15, q = lane >> 4;
    for (int blk = F.vcu; blk < SEQ / 32; blk += F.G) {
        const int tok = blk * 32 + gi * 16 + t;
        if (F.tid < 64) cntl[F.tid] = 0;
        float s1 = 0.f, s2 = 0.f;
        const float* prow = F.in[0] + (size_t)tok * DM + kq * 512 + 4 * q; const bf16* mrow = mixb + (size_t)tok * DM + kq * 512 + 4 * q;
        f32x4v hv[16][2];
#pragma unroll
        for (int sg = 0; sg < 4; ++sg) {
            f32x4v xa[4][2]; v2u ma[4][2];
#pragma unroll
            for (int u = 0; u < 4; ++u) { const int s = 4 * sg + u; xa[u][0] = *(const f32x4v*)(prow + 32 * s); xa[u][1] = *(const f32x4v*)(prow + 32 * s + 16); ma[u][0] = *(const v2u*)(mrow + 32 * s); ma[u][1] = *(const v2u*)(mrow + 32 * s + 16); }
            __builtin_amdgcn_sched_barrier(0);
#pragma unroll
            for (int u = 0; u < 4; ++u) { const int s = 4 * sg + u; const v2u m0 = ma[u][0], m1 = ma[u][1];
                const f32x4v v0 = xa[u][0] * ALPHA + (f32x4v){pg8::bf_lo(m0.x), pg8::bf_hi(m0.x), pg8::bf_lo(m0.y), pg8::bf_hi(m0.y)}, v1 = xa[u][1] * ALPHA + (f32x4v){pg8::bf_lo(m1.x), pg8::bf_hi(m1.x), pg8::bf_lo(m1.y), pg8::bf_hi(m1.y)};
                hv[s][0] = v0; hv[s][1] = v1;
#pragma unroll
                for (int j = 0; j < 4; ++j) { s1 += v0[j] + v1[j]; s2 += v0[j] * v0[j] + v1[j] * v1[j]; } }
            __builtin_amdgcn_sched_barrier(0);
        }
        s1 += __shfl_xor(s1, 16); s1 += __shfl_xor(s1, 32); s2 += __shfl_xor(s2, 16); s2 += __shfl_xor(s2, 32);
        if (q == 0) { red[(w * 16 + t) * 2] = s1; red[(w * 16 + t) * 2 + 1] = s2; }
        __syncthreads();
        float m1 = 0.f, m2 = 0.f;
#pragma unroll
        for (int k = 0; k < 4; ++k) { m1 += red[((gi * 4 + k) * 16 + t) * 2]; m2 += red[((gi * 4 + k) * 16 + t) * 2 + 1]; }
        const float mean = m1 * (1.0f / DM); const float var = m2 * (1.0f / DM) - mean * mean; const float rstd = 1.0f / sqrtf(var + LN_EPS);
        f32x4v acc[4] = {};
        const float* gp = F.in[10] + kq * 512 + 4 * q; const float* bp = F.in[11] + kq * 512 + 4 * q;
        bf16* brow = hbf + (size_t)tok * DM + kq * 512 + 4 * q; unsigned char* frow = F.ws + WS_HF8 + (size_t)tok * DM + kq * 512 + 4 * q;
        struct P5Set { f32x4v g0, g1, b0, b1; bf16x8 Bh[4], Bl[4]; };
        P5Set A_; const unsigned lane8 = (unsigned)lane * 8u;
#define P5_LOAD(S, X) do { X.g0 = *(const f32x4v*)(gp + 32 * (S)); X.g1 = *(const f32x4v*)(gp + 32 * (S) + 16); X.b0 = *(const f32x4v*)(bp + 32 * (S)); X.b1 = *(const f32x4v*)(bp + 32 * (S) + 16); \
            { const bf16* wuh_ = wrh + (size_t)((kq * 16 + (S)) * 2048); const bf16* wul_ = wuh_ + NEXP * DM;     \
              asm volatile("" : "+s"(wuh_), "+s"(wul_));                                                         \
              _Pragma("unroll") for (int nt = 0; nt < 4; ++nt) { X.Bh[nt] = *(const bf16x8*)(wuh_ + nt * 512 + lane8); X.Bl[nt] = *(const bf16x8*)(wul_ + nt * 512 + lane8); } } } while (0)
#define P5_COMP(S, X) do { const f32x4v p0_ = hv[S][0], p1_ = hv[S][1]; \
            const f32x4v y0 = (p0_ - mean) * rstd * X.g0 + X.b0, y1 = (p1_ - mean) * rstd * X.g1 + X.b1; \
            v4u ah, al; ah.x = pg8::cvt_pk_bf16(y0[0], y0[1]); ah.y = pg8::cvt_pk_bf16(y0[2], y0[3]); ah.z = pg8::cvt_pk_bf16(y1[0], y1[1]); ah.w = pg8::cvt_pk_bf16(y1[2], y1[3]); \
            al.x = pg8::cvt_pk_bf16(y0[0] - pg8::bf_lo(ah.x), y0[1] - pg8::bf_hi(ah.x)); al.y = pg8::cvt_pk_bf16(y0[2] - pg8::bf_lo(ah.y), y0[3] - pg8::bf_hi(ah.y)); \
            al.z = pg8::cvt_pk_bf16(y1[0] - pg8::bf_lo(ah.z), y1[1] - pg8::bf_hi(ah.z)); al.w = pg8::cvt_pk_bf16(y1[2] - pg8::bf_lo(ah.w), y1[3] - pg8::bf_hi(ah.w)); \
            *(v2u*)(brow + 32 * (S)) = (v2u){ah.x, ah.y}; *(v2u*)(brow + 32 * (S) + 16) = (v2u){ah.z, ah.w}; \
            { int t0_ = __builtin_amdgcn_cvt_pk_fp8_f32(y0[0], y0[1], 0, false); t0_ = __builtin_amdgcn_cvt_pk_fp8_f32(y0[2], y0[3], t0_, true); \
              int t1_ = __builtin_amdgcn_cvt_pk_fp8_f32(y1[0], y1[1], 0, false); t1_ = __builtin_amdgcn_cvt_pk_fp8_f32(y1[2], y1[3], t1_, true); \
              *(int*)(frow + 32 * (S)) = t0_; *(int*)(frow + 32 * (S) + 16) = t1_; } \
            const bf16x8 Ah = __builtin_bit_cast(bf16x8, ah), Al = __builtin_bit_cast(bf16x8, al); \
            _Pragma("unroll") for (int nt = 0; nt < 4; ++nt) { acc[nt] = __builtin_amdgcn_mfma_f32_16x16x32_bf16(Ah, X.Bh[nt], acc[nt], 0, 0, 0); \
                acc[nt] = __builtin_amdgcn_mfma_f32_16x16x32_bf16(Al, X.Bh[nt], acc[nt], 0, 0, 0); acc[nt] = __builtin_amdgcn_mfma_f32_16x16x32_bf16(Ah, X.Bl[nt], acc[nt], 0, 0, 0); } } while (0)
#pragma unroll
        for (int s = 0; s < 16; ++s) {
            P5_LOAD(s, A_); __builtin_amdgcn_sched_barrier(0);
            P5_COMP(s, A_); __builtin_amdgcn_sched_barrier(0);
        }
#undef P5_LOAD
#undef P5_COMP
#pragma unroll
        for (int nt = 0; nt < 4; ++nt)
#pragma unroll
            for (int r = 0; r < 4; ++r) part[(w * 16 + 4 * q + r) * 64 + 16 * nt + t] = acc[nt][r];
        __syncthreads();
#ifdef PROBE_P5
        if (PROBE_P5 >= 2 && probe_rep) { __syncthreads(); continue; }
#endif
        const float rb = F.in[13][lane];
#pragma unroll 1
        for (int i = 0; i < 4; ++i) {
            const int tl = w * 4 + i, g2 = tl >> 4, tt = tl & 15;
            float logit = 0.f;
#pragma unroll
            for (int k = 0; k < 4; ++k) logit += part[((g2 * 4 + k) * 16 + tt) * 64 + lane];
            const float sc = 1.0f / (1.0f + expf(-logit));
            const float b = sc + rb;
            float mx = b; mx = fmaxf(mx, __shfl_xor(mx, 1)); mx = fmaxf(mx, __shfl_xor(mx, 2)); mx = fmaxf(mx, __shfl_xor(mx, 4));
            const unsigned long long bal = __ballot(b == mx); const unsigned gm = (unsigned)(bal >> (lane & ~7)) & 0xffu; const int first = __builtin_ctz(gm);
            float b2 = ((lane & 7) == first) ? -INFINITY : b; b2 = fmaxf(b2, __shfl_xor(b2, 1)); b2 = fmaxf(b2, __shfl_xor(b2, 2)); b2 = fmaxf(b2, __shfl_xor(b2, 4));
            const float gs = mx + b2; const int grp = lane >> 3; int gc = 0;
#pragma unroll
            for (int g3 = 0; g3 < 8; ++g3) { const float o = __uint_as_float(__builtin_amdgcn_readlane(__float_as_uint(gs), g3 * 8)); gc += (o > gs || (o == gs && g3 < grp)) ? 1 : 0; }
            const float mk = gc < 4 ? b : -INFINITY; int rank = 0;
#pragma unroll
            for (int j = 0; j < 64; ++j) { const float o = __uint_as_float(__builtin_amdgcn_readlane(__float_as_uint(mk), j)); rank += (o > mk || (o == mk && j < lane)) ? 1 : 0; }
            const bool sel = (gc < 4) && rank < 8;
            const float wsum = wave_sum(sel ? sc : 0.f);
            if (sel) { const int lp = atomicAdd((int*)(cntl + lane), 1); rec_e[tl * 8 + rank] = lane; rec_p[tl * 8 + rank] = lp; rec_w[tl * 8 + rank] = sc / wsum * ROUTED_SCALE; }
        }
        __syncthreads();
#ifdef PROBE_P5
        if (PROBE_P5 == 1 && probe_rep) { __syncthreads(); continue; }
#endif
        if (F.tid < 64) basel[F.tid] = (int)atomicAdd(F.ctl + CW_CNT + F.tid, (unsigned)cntl[F.tid]);
        __syncthreads();
        if (F.tid < 256) { const int tl = F.tid >> 3, e = rec_e[F.tid], pos = basel[e] + rec_p[F.tid]; const int token = blk * 32 + tl;
            ((int*)(F.ws + WS_LTOK))[e * LCAP + pos] = token; ((float*)(F.ws + WS_LW))[e * LCAP + pos] = rec_w[F.tid];
            int* rt = (int*)(F.ws + WS_ROUTE); rt[(token * 8 + (F.tid & 7)) * 2] = e; rt[(token * 8 + (F.tid & 7)) * 2 + 1] = pos; }
        __syncthreads();
    }
}

__device__ __forceinline__ void moe_build_tst(Frame& F) {
    LAS int* tst = (LAS int*)(F.lds + TST_OFF);
    if (F.tid == 0) { int acc = 0; for (int e = 0; e < NEXP1; ++e) { tst[e] = acc; const unsigned c = e < NEXP ? __hip_atomic_load(F.ctl + CW_CNT + e, RLX_AGENT) : (unsigned)SEQ; acc += (int)((c + 255u) >> 8); } tst[NEXP1] = acc; }
    __syncthreads();
}

__device__ __forceinline__ void p9_combine(Frame& F) {
    const LAS int* tst = (const LAS int*)(F.lds + TST_OFF);
    const int gw = F.vcu * NWAVES + F.wave, NGW = F.G * NWAVES; const int lane = F.lane;
    const unsigned char* Y = (const unsigned char*)(F.ws + WS_Y); const bf16* hbf = (const bf16*)(F.ws + WS_HBF); const int* rt = (const int*)(F.ws + WS_ROUTE);
    unsigned rows[9];
#define P9_ROWS(dst, tok_) do { _Pragma("unroll") for (int k = 0; k < 8; ++k) { const int e = rt[((tok_) * 8 + k) * 2], pos = rt[((tok_) * 8 + k) * 2 + 1]; dst[k] = (unsigned)(tst[e] * 256 + pos) * (DM / 8); } \
        dst[8] = (unsigned)(tst[NEXP] * 256 + (tok_)) * (DM / 8); } while (0)
    for (int tok = gw; tok < SEQ; tok += NGW) {
        P9_ROWS(rows, tok);
        float v[4][8]; float s1 = 0.f;
#pragma unroll
        for (int c = 0; c < 4; ++c) { const int col = 512 * c + 8 * lane;
            const v4u hv = __builtin_nontemporal_load((const v4u*)(hbf + (size_t)tok * DM + col));
            const f32x4 a = {pg8::bf_lo(hv.x), pg8::bf_hi(hv.x), pg8::bf_lo(hv.y), pg8::bf_hi(hv.y)}, b = {pg8::bf_lo(hv.z), pg8::bf_hi(hv.z), pg8::bf_lo(hv.w), pg8::bf_hi(hv.w)};
            float r[8] = {0.f, 0.f, 0.f, 0.f, 0.f, 0.f, 0.f, 0.f};
#pragma unroll
            for (int k = 0; k < 9; ++k) { const v2u y = __builtin_nontemporal_load((const v2u*)Y + (size_t)rows[k] + (col >> 3));
                const auto q0 = __builtin_amdgcn_cvt_pk_f32_fp8((int)y.x, false), q1 = __builtin_amdgcn_cvt_pk_f32_fp8((int)y.x, true), q2 = __builtin_amdgcn_cvt_pk_f32_fp8((int)y.y, false), q3 = __builtin_amdgcn_cvt_pk_f32_fp8((int)y.y, true);
                r[0] += q0[0]; r[1] += q0[1]; r[2] += q1[0]; r[3] += q1[1]; r[4] += q2[0]; r[5] += q2[1]; r[6] += q3[0]; r[7] += q3[1]; }
#pragma unroll
            for (int j = 0; j < 4; ++j) { v[c][j] = ALPHA * a[j] + r[j] * (1.0f / YSCALE); v[c][4 + j] = ALPHA * b[j] + r[4 + j] * (1.0f / YSCALE); }
#pragma unroll
            for (int j = 0; j < 8; ++j) s1 += v[c][j]; }
        const float mean = wave_sum(s1) * (1.0f / DM); float s2 = 0.f;
#pragma unroll
        for (int c = 0; c < 4; ++c)
#pragma unroll
            for (int j = 0; j < 8; ++j) { v[c][j] -= mean; s2 += v[c][j] * v[c][j]; }
        const float rstd = 1.0f / sqrtf(wave_sum(s2) * (1.0f / DM) + LN_EPS);
#pragma unroll
        for (int c = 0; c < 4; ++c) { const int col = 512 * c + 8 * lane;
            const f32x4 g0 = *(const f32x4*)(F.in[20] + col), g1 = *(const f32x4*)(F.in[20] + col + 4), b0 = *(const f32x4*)(F.in[21] + col), b1 = *(const f32x4*)(F.in[21] + col + 4);
            f32x4 o0, o1;
#pragma unroll
            for (int j = 0; j < 4; ++j) { o0[j] = v[c][j] * rstd * g0[j] + b0[j]; o1[j] = v[c][4 + j] * rstd * g1[j] + b1[j]; }
            __builtin_nontemporal_store(o0, (f32x4*)(F.out + (size_t)tok * DM + col)); __builtin_nontemporal_store(o1, (f32x4*)(F.out + (size_t)tok * DM + col + 4)); }
    }
#undef P9_ROWS
}

constexpr int NPHASES = 10;
#ifndef MK_ONE_LAUNCH
#define MK_ONE_LAUNCH 1
#endif
__global__ void __launch_bounds__(NWAVES * 64, 2) mega_fwd(Args args) {
    extern __shared__ __attribute__((aligned(16))) unsigned char lds[];
    Frame F;
    F.lds = (LAS unsigned char*)lds;
    F.MISC = (volatile LAS unsigned*)(F.lds + MISC_OFF);
    F.tid = threadIdx.x; F.lane = F.tid & 63; F.wave = __builtin_amdgcn_readfirstlane(F.tid >> 6);
    F.G = gridDim.x; { const int bx = blockIdx.x; F.vcu = (F.G % 8 == 0) ? (bx % 8) * (F.G / 8) + bx / 8 : bx; }
#pragma unroll
    for (int i = 0; i < 22; ++i) F.in[i] = args.in[i];
    F.out = args.out; F.ws = args.ws; F.ctl = (unsigned*)(args.ws + WS_CTL);
    for (int u = F.tid; u < (LDS_BYTES - LDSCTL_OFF) / 4; u += NWAVES * 64) ((LAS unsigned*)(F.lds + LDSCTL_OFF))[u] = 0u;
    __syncthreads();
    XcdBarrier bar; bar.bar = F.ctl + CW_BAR; bar.x = 0; bar.st = nullptr; bar.total = 0; XcdBarrier barB = bar;
    const bool conv1 = (F.G == 256) && (F.vcu & 31) >= P1_NCG;
    if (MK_ONE_LAUNCH) { bar = xcd_barrier_post(F.ctl + CW_BAR, F.MISC + 8, (unsigned)F.G); }
    const int lo = args.ph_lo, hi = args.ph_hi;
#ifndef PH_MASK
#define PH_MASK 0x3ff
#endif
#define IN(k) (((PH_MASK >> (k)) & 1) && lo <= (k) && (k) < hi)
#ifndef REP_MASK
#define REP_MASK 0
#endif
#define REP(k) for (int rep_ = 0; rep_ < 1 + ((REP_MASK >> (k)) & 1); ++rep_)
#ifndef BAR_REP
#define BAR_REP 1
#endif
#define SEAM(k) do { if (IN(k) && IN((k) + 1)) for (int br_ = 0; br_ < BAR_REP; ++br_) xcd_barrier(bar); } while (0)
    LAS int* idxl = (LAS int*)(F.lds + IDXL_OFF);
    const bool tst_needed = true;

    if (IN(0)) REP(0) { p0_prologue(F, false); } SEAM(0);
    if (IN(1)) REP(1) {
        const int grp = F.vcu >> 5, cin = F.vcu & 31;
        const bool conv = (F.G == 256) && cin >= P1_NCG;
        if (conv) { const int cw = (grp * (32 - P1_NCG) + (cin - P1_NCG)) * NWAVES + F.wave; convert_items<1>(F, cw, NCONV1 * NWAVES, E_SPLIT); convert_items<2>(F, cw, NCONV1 * NWAVES, E2_A); }
        else {
            DenseOrder S; if (F.G == 256) S.init(F.ws + WS_XBF, F.ws + WS_WINT, SEQ, INC, DM, NCOMP1, cin * 8 + grp); else S.init(F.ws + WS_XBF, F.ws + WS_WINT, SEQ, INC, DM, F.G, (int)blockIdx.x);
            EpiProj E{(bf16*)(F.ws + WS_PROJ), F.in[2]};
            pg8::gemm_phase<EpiProj, DenseOrder, true, false, P1_FP8 != 0>(F.lds + RING_OFF, idxl, DM, S, E);
        }
    } SEAM(1);
    if (IN(2)) {
        p1b_qknorm(F);
        if (F.G == 256) {
            if (E_SPLIT >= NITEMS_E1 && (CONV_G1 ? E2_SPLIT : E2_A) >= NITEMS_E2) win_attention(F, F.vcu, 256);
            else if (F.vcu & 1) win_attention(F, F.vcu >> 1, 128);
            else { const int cw = (F.vcu >> 1) * NWAVES + F.wave;
                convert_items<1>(F, E_SPLIT + cw, 128 * NWAVES, NITEMS_E1); convert_items<2>(F, (CONV_G1 ? E2_SPLIT : E2_A) + cw, 128 * NWAVES, NITEMS_E2); }
        } else { win_attention(F, F.vcu, F.G); convert_items<1>(F, F.vcu * NWAVES + F.wave, F.G * NWAVES, NITEMS_E1); convert_items<2>(F, F.vcu * NWAVES + F.wave, F.G * NWAVES, NITEMS_E2); }
    } SEAM(2);
    if (IN(3)) REP(3) { p3_dense_attention(F); } SEAM(3);
    if (IN(4)) REP(4) {
        BranchOrder S{(const char*)(F.ws + WS_OA), (const char*)(F.ws + WS_OB), (const char*)(F.ws + WS_WAT), (const char*)(F.ws + WS_WBT), F.vcu};
        EpiBranch E{(const bf16*)(F.ws + WS_PROJ), F.ws + WS_MRG};
        if (F.vcu < 256) pg8::gemm_phase<EpiBranch, BranchOrder, false, false, true>(F.lds + RING_OFF, idxl, 1024, S, E);
    } SEAM(4);
    if (IN(5)) REP(5) {
        OneTileOrder S{(const char*)(F.ws + WS_MRG), (const char*)(F.ws + WS_WOT), F.vcu, (size_t)256 * DM};
        EpiMix E{(bf16*)(F.ws + WS_PRE)};
        if (F.vcu < 256) pg8::gemm_phase<EpiMix, OneTileOrder, false, false, true>(F.lds + RING_OFF, idxl, DM, S, E);
    } SEAM(5);
    if (IN(6)) REP(6) { if (rep_) { xcd_barrier(bar);
#ifndef PROBE_P5
            if (blockIdx.x == 0 && F.tid < 64) __hip_atomic_store(F.ctl + CW_CNT + F.tid, 0u, RLX_AGENT);
#endif
            xcd_barrier(bar); } p5_ln_router(F, rep_ != 0); } SEAM(6);
    if (IN(7) || IN(8) || IN(9)) { if (tst_needed) moe_build_tst(F); }
#ifndef DEFER_MAX
#define DEFER_MAX 64
#endif
    int n_defer = 0, u1_end = -1;
    if (IN(7) || IN(8)) { const int T_ = ((const LAS int*)(F.lds + TST_OFF))[NEXP1]; const int r_ = (4 * T_) % 256;
        if (F.G == 256 && !CONV_G1 && 4 * T_ > 256 && r_ > 0 && r_ <= DEFER_MAX && (lo <= 7 && 8 < hi)) { n_defer = r_; u1_end = 4 * T_ - r_; } }
    if (IN(7)) REP(7) {
        const bool split = CONV_G1 && F.G == 256, conv = split && ((F.vcu & 7) == 7);
        if (conv) { convert_items<2>(F, E2_A + (F.vcu >> 3) * NWAVES + F.wave, NCONV * NWAVES, E2_SPLIT); }
        else {
        MoeOrder<4> S{(const LAS int*)(F.lds + TST_OFF), (const char*)(F.ws + (G1_FP8 ? WS_HF8 : WS_HBF)), (const char*)(F.ws + WS_WGU), (const int*)(F.ws + WS_LTOK), (const float*)(F.ws + WS_LW), split ? F.vcu - (F.vcu >> 3) : F.vcu, split ? NCOMP : F.G, 0, (size_t)1024 * DM * (G1_FP8 ? 1 : 2), (size_t)256 * DM * (G1_FP8 ? 1 : 2), true,
                      0, u1_end, 0, nullptr, 0, 0};
        EpiMoe1 E{F.ws + WS_HID};
        pg8::gemm_phase<EpiMoe1, MoeOrder<4>, true, true, G1_FP8 != 0>(F.lds + RING_OFF, idxl, DM, S, E);
        }
    } SEAM(7);
    if (IN(8)) REP(8) {
        unsigned* dflag = F.ctl + CW_CNT + 128;
        if (n_defer > 0 && F.vcu >= 256 - n_defer) {
            MoeOrder<4> S1{(const LAS int*)(F.lds + TST_OFF), (const char*)(F.ws + (G1_FP8 ? WS_HF8 : WS_HBF)), (const char*)(F.ws + WS_WGU), (const int*)(F.ws + WS_LTOK), (const float*)(F.ws + WS_LW), F.vcu - (256 - n_defer), 256, 0, (size_t)1024 * DM * (G1_FP8 ? 1 : 2), (size_t)256 * DM * (G1_FP8 ? 1 : 2), true,
                           u1_end, u1_end + n_defer, 0, nullptr, 0, 0};
            EpiMoe1 E1{F.ws + WS_HID};
            pg8::gemm_phase<EpiMoe1, MoeOrder<4>, true, true, G1_FP8 != 0>(F.lds + RING_OFF, idxl, DM, S1, E1);
            if (F.tid == 0) { __builtin_amdgcn_fence(__ATOMIC_RELEASE, "agent"); asm volatile("s_waitcnt vmcnt(0)" ::: "memory"); __hip_atomic_fetch_add(dflag, 1u, __ATOMIC_RELAXED, __HIP_MEMORY_SCOPE_AGENT); }
        }
        MoeOrder<8> S{(const LAS int*)(F.lds + TST_OFF), (const char*)(F.ws + WS_HID), (const char*)(F.ws + WS_WD), (const int*)(F.ws + WS_LTOK), (const float*)(F.ws + WS_LW), F.vcu, F.G, (size_t)FE, (size_t)DM * FE, (size_t)256 * FE, false,
                      0, -1, n_defer, dflag, n_defer > 0 ? u1_end / 4 : 0, n_defer};
#ifndef G2_ALIGN
#define G2_ALIGN true
#endif
        EpiMoe2 E{(unsigned char*)(F.ws + WS_Y)};
        pg8::gemm_phase<EpiMoe2, MoeOrder<8>, G2_ALIGN, false, true>(F.lds + RING_OFF, idxl, FE, S, E);
    } SEAM(8);
    if (IN(9)) REP(9) { p9_combine(F); }
#ifdef PROBE_T
    { const LAS int* tst_ = (const LAS int*)(F.lds + TST_OFF); if (tst_[NEXP1] > PROBE_T && blockIdx.x == 0 && F.tid == 0) F.out[0] = __builtin_nanf(""); }
#endif
#undef IN
#undef SEAM
}

extern "C" void kernel_launch(void* const* d_in, const int* in_sizes, int n_in, void* d_out, int out_size, void* d_ws, size_t ws_size, hipStream_t stream) {
    static int grid = 0;
    if (grid == 0) {
        if (n_in != 22 || out_size != SEQ * DM || ws_size < WS_END) { fprintf(stderr, "kernel_launch: unexpected shapes (n_in %d, out %d, ws %zu < %zu); nothing launched\n", n_in, out_size, ws_size, (size_t)WS_END); grid = -1; return; }
        int dev = 0, cus = 0, per_cu = 0;
        if (hipGetDevice(&dev) != hipSuccess || hipDeviceGetAttribute(&cus, hipDeviceAttributeMultiprocessorCount, dev) != hipSuccess) { grid = -1; return; }
        if (hipFuncSetAttribute((const void*)mega_fwd, hipFuncAttributeMaxDynamicSharedMemorySize, LDS_BYTES) != hipSuccess) { fprintf(stderr, "kernel_launch: hipFuncSetAttribute failed\n"); grid = -1; return; }
        if (hipOccupancyMaxActiveBlocksPerMultiprocessor(&per_cu, (const void*)mega_fwd, NWAVES * 64, LDS_BYTES) != hipSuccess || per_cu < 1) { fprintf(stderr, "kernel_launch: occupancy query says %d blocks per CU; nothing launched\n", per_cu); (void)hipGetLastError(); grid = -1; return; }
        grid = cus;
        if (grid > 256) grid = 256;
    }
    if (grid < 0) return;
    (void)hipMemsetAsync((char*)d_ws + WS_CTL, 0, CTL_ZERO_BYTES, stream);
    Args a{};
    for (int i = 0; i < 22; ++i) a.in[i] = (const float*)d_in[i];
    a.out = (float*)d_out; a.ws = (unsigned char*)d_ws;
#if MK_ONE_LAUNCH
    a.ph_lo = 0; a.ph_hi = NPHASES;
    hipLaunchKernelGGL(mega_fwd, dim3(grid), dim3(NWAVES * 64), LDS_BYTES, stream, a);
#else
    for (int p = 0; p < NPHASES; ++p) { a.ph_lo = p; a.ph_hi = p + 1; hipLaunchKernelGGL(mega_fwd, dim3(grid), dim3(NWAVES * 64), LDS_BYTES, stream, a); }
#endif
    const hipError_t le = hipPeekAtLastError();
    if (le != hipSuccess) fprintf(stderr, "kernel_launch: launch failed: %s\n", hipGetErrorName(le));
}
```

```cpp
#define P1_NCG 13
#define CONV_Q 59
#define P1_QE2 28
#define CONV_G1 0
#include <hip/hip_runtime.h>
#include <hip/hip_bf16.h>
#include <cstdio>
#include <cstdint>
#include <cmath>
namespace pg8 {
#define PG8_LAS __attribute__((address_space(3)))
typedef unsigned short bf16_t;
typedef short bf16x8 __attribute__((ext_vector_type(8)));
typedef float f32x4 __attribute__((ext_vector_type(4)));
typedef unsigned u32x4 __attribute__((ext_vector_type(4)));
typedef int v4i_t __attribute__((ext_vector_type(4)));
typedef int v8i_t __attribute__((ext_vector_type(8)));
constexpr int BM = 256, BK = 64, HALF = 128, HTB = HALF * BK * 2  , STAGE_BYTES = 8 * HTB;

__host__ __device__ __forceinline__ int lds_byte(int r, int c) { const int st = (r >> 4) * 2 + (c >> 5), rr = r & 15, cc = c & 31, ob = rr * 64 + cc * 2; return st * 1024 + (ob ^ (((ob >> 9) & 1) << 5)); }
__host__ __device__ __forceinline__ void stage_rc(int b, int& R, int& C) { const int st = b / 1024, sb = b % 1024, swz = sb ^ (((sb >> 9) & 1) << 5); R = (st >> 1) * 16 + swz / 64; C = (st & 1) * 32 + (swz % 64) / 2; }
__host__ __device__ __forceinline__ int perm32(int rho) { const int n = rho >> 4, i = rho & 15; return 8 * (i >> 2) + 4 * n + (i & 3); }

struct Unit { const char* A; const char* B; const int* idx; const float* wts; int r0, c0, aux, kind; };

typedef float f32x2_t __attribute__((ext_vector_type(2))); typedef __bf16 bf16x2_t __attribute__((ext_vector_type(2)));
__device__ __forceinline__ unsigned cvt_pk_bf16(float lo, float hi) { f32x2_t v = {lo, hi}; bf16x2_t b = __builtin_convertvector(v, bf16x2_t); return __builtin_bit_cast(unsigned, b); }
__device__ __forceinline__ float bf_lo(unsigned w) { return __uint_as_float(w << 16); }
__device__ __forceinline__ float bf_hi(unsigned w) { return __uint_as_float(w & 0xffff0000u); }

template <class Epi, class Sched, bool ALIGN_EPI, bool GATHER, bool FP8 = false>
__device__ __forceinline__ void gemm_phase(PG8_LAS unsigned char* lds, PG8_LAS int* idxl, const int K, const Sched& S, const Epi& E) {
    PG8_LAS float* wl = (PG8_LAS float*)(idxl + 256);
    const int tid = threadIdx.x, wid = __builtin_amdgcn_readfirstlane(tid >> 6), lane = tid & 63, wr = wid >> 2, wc = wid & 3, fr = lane & 15, fq = lane >> 4;
    const int KB = FP8 ? K : 2 * K;
    const int nt = KB / 128;
    const size_t kstep = (size_t)(BK * 2);
    const size_t hstep = (size_t)HALF * KB;
    unsigned voffA0[2], voffA1[2], voffB[2];
#pragma unroll
    for (int i = 0; i < 2; ++i) { int R, C; stage_rc(tid * 16 + i * 8192, R, C); const int Rb = Epi::PERM ? ((R & ~31) + perm32(R & 31)) : R;
        voffA0[i] = (unsigned)(R * KB + C * 2); voffA1[i] = voffA0[i] + (unsigned)hstep; voffB[i] = (unsigned)(Rb * KB + C * 2); }
    const unsigned ldsw = (unsigned)wid * 1024u;
    const int aoff = FP8 ? lds_byte(wr * 64 + fr, (fq >> 1) * 32 + (fq & 1) * 16) : lds_byte(wr * 64 + fr, fq * 8), boff = FP8 ? lds_byte(wc * 32 + fr, (fq >> 1) * 32 + (fq & 1) * 16) : lds_byte(wc * 32 + fr, fq * 8);
#define PG8_SA(b, h) (((b) * 2 + (h)) * HTB)
#define PG8_SB(b, h) ((4 + (b) * 2 + (h)) * HTB)
#define PG8_STAGE(bufoff, gbase, voff) do { _Pragma("unroll") for (int _i = 0; _i < 2; ++_i) \
        __builtin_amdgcn_global_load_lds((const unsigned*)((const char*)(gbase) + (voff)[_i]), (PG8_LAS unsigned*)(lds + (bufoff) + ldsw + _i * 8192), 16, 0, 0); } while (0)
#define PG8_LD8(addr) __builtin_shufflevector(*(const PG8_LAS v4i_t*)(addr), *(const PG8_LAS v4i_t*)((addr) + 16), 0, 1, 2, 3, 4, 5, 6, 7)
#define PG8_LDA(dst, b, h) do { if constexpr (FP8) { _Pragma("unroll") for (int m = 0; m < 4; ++m) dst##8[m] = PG8_LD8(lds + PG8_SA(b, h) + aoff + m * 2048); } \
        else { _Pragma("unroll") for (int m = 0; m < 4; ++m) _Pragma("unroll") for (int k = 0; k < 2; ++k) dst[m][k] = *(const PG8_LAS bf16x8*)(lds + PG8_SA(b, h) + aoff + m * 2048 + k * 1024); } } while (0)
#define PG8_LDB(dst, b, h) do { if constexpr (FP8) { _Pragma("unroll") for (int n = 0; n < 2; ++n) dst##8[n] = PG8_LD8(lds + PG8_SB(b, h) + boff + n * 2048); } \
        else { _Pragma("unroll") for (int n = 0; n < 2; ++n) _Pragma("unroll") for (int k = 0; k < 2; ++k) dst[n][k] = *(const PG8_LAS bf16x8*)(lds + PG8_SB(b, h) + boff + n * 2048 + k * 1024); } } while (0)
#define PG8_MMA(ai, bj, At, Bt) do { __builtin_amdgcn_s_setprio(1); _Pragma("unroll") for (int m = 0; m < 4; ++m) _Pragma("unroll") for (int n = 0; n < 2; ++n) { \
        if constexpr (FP8) asm volatile("v_mfma_scale_f32_16x16x128_f8f6f4 %0, %1, %2, %0, %3, %3 op_sel_hi:[0,0,0]" : "+v"(acc[ai][bj][m][n]) : "v"(Bt##8[n]), "v"(At##8[m]), "v"(one_scale)); \
        else { _Pragma("unroll") for (int k = 0; k < 2; ++k) acc[ai][bj][m][n] = __builtin_amdgcn_mfma_f32_16x16x32_bf16(Bt[n][k], At[m][k], acc[ai][bj][m][n], 0, 0, 0); } } __builtin_amdgcn_s_setprio(0); } while (0)
#define PG8_WAIT_V(n) asm volatile("s_waitcnt vmcnt(" #n ")" ::: "memory")
#define PG8_WAIT_L(n) asm volatile("s_waitcnt lgkmcnt(" #n ")" ::: "memory")
#define PG8_WAIT_VN(n) asm volatile("s_waitcnt vmcnt(%0)" :: "n"(n) : "memory")
#define PG8_WAIT_VR(sel) do { if constexpr (Epi::NST > 0) { int _sg; asm volatile("v_readfirstlane_b32 %0, %1\n\ts_nop 0\n\ts_cmp_lg_u32 %0, 0\n\ts_cbranch_scc1 1f\n\ts_waitcnt vmcnt(8)\n\ts_branch 2f\n1:\n\ts_waitcnt vmcnt(%2)\n2:" \
            : "=&s"(_sg) : "v"(sel), "n"(8 + Epi::NST) : "memory", "scc"); } \
        else asm volatile("s_waitcnt vmcnt(8)" ::: "memory"); } while (0)
#define PG8_BAR __builtin_amdgcn_s_barrier()
#define PG8_SCHED __builtin_amdgcn_sched_barrier(0)
#define PG8_GOFF(src) do { _Pragma("unroll") for (int _i = 0; _i < 2; ++_i) { int R_, C_; stage_rc(tid * 16 + _i * 8192, R_, C_); \
        voffA0[_i] = (unsigned)((src)[R_] * KB + C_ * 2); voffA1[_i] = (unsigned)((src)[R_ + HALF] * KB + C_ * 2); } } while (0)
    Unit cur, nxt; int ui = 0;
    if (!S.next(0, cur)) return;
    f32x4 acc[2][2][4][2];
#pragma unroll
    for (int a = 0; a < 2; ++a)
#pragma unroll
        for (int b = 0; b < 2; ++b)
#pragma unroll
            for (int m = 0; m < 4; ++m)
#pragma unroll
                for (int n = 0; n < 2; ++n) acc[a][b][m][n] = (f32x4){0.f, 0.f, 0.f, 0.f};
    bf16x8 At[4][2], B0[2][2], B1[2][2];
    v8i_t At8[4], B08[2], B18[2];
    int one_scale = 0x7f7f7f7f; asm volatile("" : "+v"(one_scale));
    const char* cA = cur.A; const char* cB = cur.B;
    if constexpr (GATHER) { PG8_GOFF(cur.idx); if (tid >= 256) wl[tid - 256] = cur.wts[tid - 256]; }
    PG8_STAGE(PG8_SB(0, 0), cB, voffB); PG8_STAGE(PG8_SB(0, 1), cB + hstep, voffB); PG8_STAGE(PG8_SA(0, 0), cA, voffA0); PG8_STAGE(PG8_SA(0, 1), cA, voffA1);
    if (wr == 1) PG8_BAR;
    PG8_WAIT_V(2); PG8_BAR;
    PG8_STAGE(PG8_SB(1, 0), cB + kstep, voffB); PG8_STAGE(PG8_SA(1, 0), cA + kstep, voffA0); PG8_STAGE(PG8_SB(1, 1), cB + hstep + kstep, voffB);
    PG8_WAIT_V(6); PG8_BAR;
    for (;;) {
        const bool has_next = S.next(ui + 1, nxt);
        const char* nA = has_next ? nxt.A : cA; const char* nB = has_next ? nxt.B : cB;
        if constexpr (GATHER) { if (has_next && tid < 256) {
            __builtin_amdgcn_global_load_lds((const unsigned*)(nxt.idx + tid), (PG8_LAS unsigned*)((PG8_LAS unsigned char*)idxl + wid * 256), 4, 0, 0); }
          if (has_next && tid >= 256) {
            __builtin_amdgcn_global_load_lds((const unsigned*)(nxt.wts + (tid - 256)), (PG8_LAS unsigned*)((PG8_LAS unsigned char*)(wl + ((ui + 1) & 1) * 256) + (wid - 4) * 256), 4, 0, 0); } }
#pragma unroll 1
        for (int t = 0; t < nt; t += 2) {
            const bool last = (t == nt - 2);
            const char* a1 = cA + (size_t)(t + 1) * kstep;
            const char* a2 = last ? nA : cA + (size_t)(t + 2) * kstep; const char* b2 = last ? nB : cB + (size_t)(t + 2) * kstep;
            const char* a3 = a2 + kstep; const char* b3 = b2 + kstep;
            const int rlx = (t == 0 && ui > 0) ? 1 : 0;
            PG8_LDB(B0, 0, 0); PG8_LDB(B1, 0, 1); PG8_SCHED; PG8_LDA(At, 0, 0); PG8_STAGE(PG8_SA(1, 1), a1, voffA1);
            if constexpr (GATHER) { if (last && has_next) { PG8_GOFF(idxl); } }
            PG8_WAIT_VR(rlx); PG8_WAIT_L(0); PG8_BAR; PG8_MMA(0, 0, At, B0); PG8_MMA(0, 1, At, B1); PG8_BAR; PG8_SCHED;
            PG8_LDA(At, 0, 1); PG8_STAGE(PG8_SB(0, 0), b2, voffB); PG8_STAGE(PG8_SB(0, 1), b2 + hstep, voffB); PG8_STAGE(PG8_SA(0, 0), a2, voffA0);
            PG8_WAIT_VR(rlx); PG8_WAIT_L(0); PG8_BAR; PG8_MMA(1, 0, At, B0); PG8_MMA(1, 1, At, B1); PG8_BAR; PG8_SCHED;
            PG8_LDB(B0, 1, 0); PG8_LDB(B1, 1, 1); PG8_SCHED; PG8_LDA(At, 1, 0); PG8_STAGE(PG8_SA(0, 1), a2, voffA1);
            PG8_WAIT_V(8); PG8_WAIT_L(0); PG8_BAR; PG8_MMA(0, 0, At, B0); PG8_MMA(0, 1, At, B1); PG8_BAR; PG8_SCHED;
            PG8_LDA(At, 1, 1); PG8_STAGE(PG8_SB(1, 0), b3, voffB); PG8_STAGE(PG8_SB(1, 1), b3 + hstep, voffB); PG8_STAGE(PG8_SA(1, 0), a3, voffA0);
            PG8_WAIT_V(8); PG8_WAIT_L(0); PG8_BAR; PG8_MMA(1, 0, At, B0); PG8_MMA(1, 1, At, B1); PG8_BAR; PG8_SCHED;
        }
        if constexpr (ALIGN_EPI) { if (wr == 0) PG8_BAR; }
        if constexpr (FP8) asm volatile("s_nop 15\n\ts_nop 15" ::: "memory");
        const bool keep = E(acc, cur, wr, wc, fr, fq, wl + (ui & 1) * 256);
        if (!has_next) break;
        if (!keep) {
#pragma unroll
        for (int a = 0; a < 2; ++a)
#pragma unroll
            for (int b = 0; b < 2; ++b)
#pragma unroll
                for (int m = 0; m < 4; ++m)
#pragma unroll
                    for (int n = 0; n < 2; ++n) acc[a][b][m][n] = (f32x4){0.f, 0.f, 0.f, 0.f};
        }
        cur = nxt; cA = nA; cB = nB; ++ui;
        if constexpr (ALIGN_EPI) { if (wr == 1) PG8_BAR; }
    }
    PG8_WAIT_V(0);
    if constexpr (!ALIGN_EPI) { if (wr == 0) PG8_BAR; }
    PG8_BAR;
#undef PG8_SA
#undef PG8_SB
#undef PG8_STAGE
#undef PG8_LDA
#undef PG8_LDB
#undef PG8_MMA
#undef PG8_LD8
#undef PG8_WAIT_V
#undef PG8_WAIT_L
#undef PG8_WAIT_VN
#undef PG8_WAIT_VR
#undef PG8_BAR
#undef PG8_SCHED
#undef PG8_GOFF
}
}
namespace attn {
using bf16 = __hip_bfloat16;
constexpr int   D = 128, NW = 8, QBLK = 32, KVBLK = 64;
constexpr float SCALE = 0.088388347648318440f;
constexpr float THR = 8.f;
constexpr float LOG2E = 1.4426950408889634f;
#ifndef PROJ_PAD
#define PROJ_PAD 64
#endif
constexpr int LDQ = 7168 + PROJ_PAD, LDK = 7168 + PROJ_PAD, LDO = 1024;
constexpr size_t SHM_V = KVBLK * D * 2, SHM_K = KVBLK * D * 2, SHM_ATTN = 2 * SHM_V + 2 * SHM_K + NW * 64 * 4;
constexpr int WIN_TAB = (int)SHM_ATTN;

using bf16x8 = __attribute__((ext_vector_type(8))) short;
using s16x4  = __attribute__((ext_vector_type(4))) short;
using f32x16 = __attribute__((ext_vector_type(16))) float;
using u32x4  = __attribute__((ext_vector_type(4))) unsigned;
using f32x4_a = __attribute__((ext_vector_type(4))) float;
#define KSWZ(row, colB) ((row) * 256 + ((colB) ^ (((row) & 7) << 4)))
#define SBAR() __builtin_amdgcn_sched_barrier(0)
__device__ __forceinline__ int crow(int r, int hi) { return (r & 3) + 8 * (r >> 2) + 4 * hi; }
__device__ __forceinline__ unsigned cvtpk(float lo, float hi) { return pg8::cvt_pk_bf16(lo, hi); }
template <bool FIXM, bool PRE = false>
__device__ __forceinline__ void partialSM(f32x16& p0, f32x16& p1, float& m_reg, float& mn, float& alpha) {
  constexpr float C = SCALE * LOG2E;
  if constexpr (PRE) {
    mn = m_reg; alpha = 1.f;
    for (int r = 0; r < 16; ++r) p0[r] = __builtin_amdgcn_exp2f(p0[r]);
    return;
  }
  if constexpr (FIXM) {
    mn = m_reg; alpha = 1.f; float mnC = -m_reg * C; asm volatile("" : "+v"(mnC));
    typedef float f32x2_p __attribute__((ext_vector_type(2))); const f32x2_p c2 = {C, C}, m2 = {mnC, mnC};
#pragma unroll
    for (int r = 0; r < 16; r += 2) { f32x2_p a = {p0[r], p0[r + 1]}, b = {p1[r], p1[r + 1]}; a = __builtin_elementwise_fma(a, c2, m2); b = __builtin_elementwise_fma(b, c2, m2); p0[r] = a[0]; p0[r + 1] = a[1]; p1[r] = b[0]; p1[r + 1] = b[1]; }
    for (int r = 0; r < 16; ++r) p0[r] = __builtin_amdgcn_exp2f(p0[r]);
    return;
  }
  float pmax = p0[0]; for (int r = 1; r < 16; ++r) pmax = fmaxf(pmax, p0[r]); for (int r = 0; r < 16; ++r) pmax = fmaxf(pmax, p1[r]);
  { auto rr = __builtin_amdgcn_permlane32_swap(__float_as_uint(pmax), __float_as_uint(pmax), false, false);
    pmax = fmaxf(__uint_as_float(rr[0]), __uint_as_float(rr[1])); }
  if (__builtin_expect(__all(pmax - m_reg <= THR / SCALE), 1)) { mn = m_reg; alpha = 1.f; }
  else { mn = fmaxf(m_reg, pmax); alpha = __builtin_amdgcn_exp2f((m_reg - mn) * C); m_reg = mn; }
  float mnC = -mn * C;
  for (int r = 0; r < 16; ++r) p0[r] = fmaf(p0[r], C, mnC); for (int r = 0; r < 16; ++r) p1[r] = fmaf(p1[r], C, mnC);
  for (int r = 0; r < 16; ++r) p0[r] = __builtin_amdgcn_exp2f(p0[r]);
}
__device__ __forceinline__ void finishSM(f32x16& p0, f32x16& p1, float alpha, float& l_reg, bf16x8& pa0, bf16x8& pa1, bf16x8& pa2, bf16x8& pa3) {
  for (int r = 0; r < 16; ++r) p1[r] = __builtin_amdgcn_exp2f(p1[r]);
  float ps = 0; for (int r = 0; r < 16; ++r) ps += p0[r]; for (int r = 0; r < 16; ++r) ps += p1[r];
  { auto rr = __builtin_amdgcn_permlane32_swap(__float_as_uint(ps), __float_as_uint(ps), false, false);
    ps = __uint_as_float(rr[0]) + __uint_as_float(rr[1]); }
  l_reg = l_reg * alpha + ps;
#define PK4(P, BASE, OUT) do { unsigned a0 = cvtpk(P[BASE + 0], P[BASE + 1]), a1 = cvtpk(P[BASE + 2], P[BASE + 3]);   \
    unsigned b0 = cvtpk(P[BASE + 4], P[BASE + 5]), b1 = cvtpk(P[BASE + 6], P[BASE + 7]);                              \
    auto r0 = __builtin_amdgcn_permlane32_swap(a0, b0, false, false); auto r1 = __builtin_amdgcn_permlane32_swap(a1, b1, false, false); \
    u32x4 w = {r0[0], r1[0], r0[1], r1[1]}; OUT = *reinterpret_cast<bf16x8*>(&w); } while (0)
  PK4(p0, 0, pa0); PK4(p0, 8, pa1); PK4(p1, 0, pa2); PK4(p1, 8, pa3);
#undef PK4
}
#define KSWZ8(row, colB) ((row) * 128 + ((colB) ^ (((row) & 7) << 4)))
typedef int v8i_a __attribute__((ext_vector_type(8))); typedef int v4i_a __attribute__((ext_vector_type(4)));
template <bool WIN, bool F8, bool PRE = false>
__device__ __forceinline__ void qkt(f32x16& p0, f32x16& p1, const bf16* Ks, const bf16x8* qr, const v8i_a* q8, int r32, int hi, const __attribute__((address_space(3))) float* tb, const f32x16* cinit = nullptr) {
  if constexpr (F8 && PRE) {
    int one = 0x7f7f7f7f, sc3 = 0x7c7c7c7c; asm volatile("" : "+v"(one), "+v"(sc3));
#pragma unroll
    for (int s = 0; s < 2; ++s) { const int cb = 64 * s + 32 * hi;
      const char* ka = (const char*)Ks + KSWZ8(r32, cb); const char* kb = (const char*)Ks + KSWZ8(32 + r32, cb);
      const v8i_a k0 = __builtin_shufflevector(*reinterpret_cast<const v4i_a*>(ka), *reinterpret_cast<const v4i_a*>((const char*)Ks + KSWZ8(r32, cb + 16)), 0, 1, 2, 3, 4, 5, 6, 7);
      const v8i_a k1 = __builtin_shufflevector(*reinterpret_cast<const v4i_a*>(kb), *reinterpret_cast<const v4i_a*>((const char*)Ks + KSWZ8(32 + r32, cb + 16)), 0, 1, 2, 3, 4, 5, 6, 7);
      if (s == 0) {
        asm volatile("s_nop 1\n\tv_mfma_scale_f32_32x32x64_f8f6f4 %0, %1, %2, %3, %4, %5 op_sel_hi:[0,0,0]" : "=&v"(p0) : "v"(k0), "v"(q8[s]), "v"(*cinit), "v"(one), "v"(sc3));
        asm volatile("v_mfma_scale_f32_32x32x64_f8f6f4 %0, %1, %2, %3, %4, %5 op_sel_hi:[0,0,0]" : "=&v"(p1) : "v"(k1), "v"(q8[s]), "v"(*cinit), "v"(one), "v"(sc3));
      } else {
        asm volatile("v_mfma_scale_f32_32x32x64_f8f6f4 %0, %1, %2, %0, %3, %4 op_sel_hi:[0,0,0]" : "+v"(p0) : "v"(k0), "v"(q8[s]), "v"(one), "v"(sc3));
        asm volatile("v_mfma_scale_f32_32x32x64_f8f6f4 %0, %1, %2, %0, %3, %4 op_sel_hi:[0,0,0]" : "+v"(p1) : "v"(k1), "v"(q8[s]), "v"(one), "v"(sc3)); } }
    asm volatile("s_nop 15\n\ts_nop 15" : "+v"(p0), "+v"(p1));
    return;
  }
  if constexpr (F8) {
    int one = 0x7f7f7f7f; asm volatile("" : "+v"(one));
#pragma unroll
    for (int s = 0; s < 2; ++s) { const int cb = 64 * s + 32 * hi;
      const char* ka = (const char*)Ks + KSWZ8(r32, cb); const char* kb = (const char*)Ks + KSWZ8(32 + r32, cb);
      const v8i_a k0 = __builtin_shufflevector(*reinterpret_cast<const v4i_a*>(ka), *reinterpret_cast<const v4i_a*>((const char*)Ks + KSWZ8(r32, cb + 16)), 0, 1, 2, 3, 4, 5, 6, 7);
      const v8i_a k1 = __builtin_shufflevector(*reinterpret_cast<const v4i_a*>(kb), *reinterpret_cast<const v4i_a*>((const char*)Ks + KSWZ8(32 + r32, cb + 16)), 0, 1, 2, 3, 4, 5, 6, 7);
      if (s == 0) {
        asm volatile("s_nop 1\n\tv_mfma_scale_f32_32x32x64_f8f6f4 %0, %1, %2, 0, %3, %3 op_sel_hi:[0,0,0]" : "=&v"(p0) : "v"(k0), "v"(q8[s]), "v"(one));
        asm volatile("v_mfma_scale_f32_32x32x64_f8f6f4 %0, %1, %2, 0, %3, %3 op_sel_hi:[0,0,0]" : "=&v"(p1) : "v"(k1), "v"(q8[s]), "v"(one));
      } else {
        asm volatile("v_mfma_scale_f32_32x32x64_f8f6f4 %0, %1, %2, %0, %3, %3 op_sel_hi:[0,0,0]" : "+v"(p0) : "v"(k0), "v"(q8[s]), "v"(one));
        asm volatile("v_mfma_scale_f32_32x32x64_f8f6f4 %0, %1, %2, %0, %3, %3 op_sel_hi:[0,0,0]" : "+v"(p1) : "v"(k1), "v"(q8[s]), "v"(one)); } }
    asm volatile("s_nop 15\n\ts_nop 15" : "+v"(p0), "+v"(p1));
    return;
  }
  if constexpr (WIN) {
#pragma unroll
    for (int r = 0; r < 16; ++r) { p0[r] = tb[(r & 3) + 8 * (r >> 2)]; p1[r] = tb[32 + (r & 3) + 8 * (r >> 2)]; }
  } else { p0 = f32x16{}; p1 = f32x16{}; }
  for (int d0 = 0; d0 < 8; ++d0) { int cb = (d0 * 16 + hi * 8) * 2;
    bf16x8 b0 = *reinterpret_cast<const bf16x8*>((const char*)Ks + KSWZ(r32, cb));
    bf16x8 b1 = *reinterpret_cast<const bf16x8*>((const char*)Ks + KSWZ(32 + r32, cb));
    p0 = __builtin_amdgcn_mfma_f32_32x32x16_bf16(b0, qr[d0], p0, 0, 0, 0);
    p1 = __builtin_amdgcn_mfma_f32_32x32x16_bf16(b1, qr[d0], p1, 0, 0, 0); }
}
__device__ __forceinline__ int v_st(int k, int c) { const int kk = (k & ~0xC) | ((k & 4) << 1) | ((k & 8) >> 1); return ((kk >> 3) * 4 + (c >> 5)) * 512 + ((kk & 7) * 32 + (c & 31)) * 2; }
__device__ __forceinline__ int v_rd_base(int lane) { return ((lane & 3) << 3) | (((lane >> 2) & 3) << 6) | (((lane >> 4) & 1) << 5) | (((lane >> 5) & 1) << 8); }
constexpr int v_rd_off(int d0, int ks, int half) { return d0 * 512 + ks * 4096 + half * 2048; }
template <int OFF> __device__ __forceinline__ s16x4 tr_read(int vb) {
  s16x4 r; asm volatile("ds_read_b64_tr_b16 %0, %1 offset:%2" : "=&v"(r) : "v"(vb), "i"(OFF) : "memory"); return r;
}
template <int D0> __device__ __forceinline__ void pv_one(f32x16& od, int vb, bf16x8 pa0, bf16x8 pa1, bf16x8 pa2, bf16x8 pa3) {
  const s16x4 l0 = tr_read<v_rd_off(D0, 0, 0)>(vb), h0 = tr_read<v_rd_off(D0, 0, 1)>(vb), l1 = tr_read<v_rd_off(D0, 1, 0)>(vb), h1 = tr_read<v_rd_off(D0, 1, 1)>(vb);
  const s16x4 l2 = tr_read<v_rd_off(D0, 2, 0)>(vb), h2 = tr_read<v_rd_off(D0, 2, 1)>(vb), l3 = tr_read<v_rd_off(D0, 3, 0)>(vb), h3 = tr_read<v_rd_off(D0, 3, 1)>(vb);
  asm volatile("s_waitcnt lgkmcnt(0)" ::: "memory"); SBAR();
#define PK(L, H) (bf16x8){L[0], L[1], L[2], L[3], H[0], H[1], H[2], H[3]}
  od = __builtin_amdgcn_mfma_f32_32x32x16_bf16(pa0, PK(l0, h0), od, 0, 0, 0);
  od = __builtin_amdgcn_mfma_f32_32x32x16_bf16(pa1, PK(l1, h1), od, 0, 0, 0);
  od = __builtin_amdgcn_mfma_f32_32x32x16_bf16(pa2, PK(l2, h2), od, 0, 0, 0);
  od = __builtin_amdgcn_mfma_f32_32x32x16_bf16(pa3, PK(l3, h3), od, 0, 0, 0);
#undef PK
}
__device__ __forceinline__ void pv_d0(f32x16* o, int vb, bf16x8 pa0, bf16x8 pa1, bf16x8 pa2, bf16x8 pa3) {
  pv_one<0>(o[0], vb, pa0, pa1, pa2, pa3); pv_one<1>(o[1], vb, pa0, pa1, pa2, pa3); pv_one<2>(o[2], vb, pa0, pa1, pa2, pa3); pv_one<3>(o[3], vb, pa0, pa1, pa2, pa3);
}

template <bool WIN, int SDEPTH, bool F8, bool FIXM, bool QN = false, int kmask = -1, bool PP = false>
__device__ __forceinline__ void attn_body(const bf16* __restrict__ Qb, const bf16* __restrict__ Kh, const unsigned char* __restrict__ Kh8, const bf16* __restrict__ Vh,
                                          unsigned char* __restrict__ Ob, float oscale, int seq, char* lds, const __attribute__((address_space(3))) float* tab, int relbase, float m0, float l0,
                                          const float* __restrict__ gq = nullptr, int qpos0 = 0) {
  int tid_ = threadIdx.x; asm volatile("" : "+v"(tid_));
  const int tid = tid_, wid = tid >> 6, lane = tid & 63, r32 = lane & 31, hi = lane >> 5;
  bf16* V_lds = (bf16*)lds; bf16* K_lds = (bf16*)(lds + 2 * SHM_V);
  float* ws = (float*)(lds + 2 * SHM_V + 2 * SHM_K) + wid * 64; float* li_l = ws; float* al_l = ws + 32;
  float m_reg = m0, l_reg = l0; f32x16 o[4]; bf16x8 qr[8];
  const bf16* Qw = Qb + (long)(wid * QBLK + r32) * LDQ + hi * 8;
  v8i_a q8[2];
  if constexpr (F8 && QN) {
    const bf16* Qr = Qb + (long)(wid * QBLK + r32) * LDQ + hi * 16;
    u32x4 raw[2][2][2];
#pragma unroll
    for (int s = 0; s < 2; ++s)
#pragma unroll
      for (int pt = 0; pt < 2; ++pt)
#pragma unroll
        for (int c = 0; c < 2; ++c) raw[s][pt][c] = *reinterpret_cast<const u32x4*>(Qr + 64 * s + 32 * pt + 8 * c);
#define QLO(w_) __uint_as_float((w_) << 16)
#define QHI(w_) __uint_as_float((w_) & 0xffff0000u)
    float ss = 0.f;
#pragma unroll
    for (int s = 0; s < 2; ++s)
#pragma unroll
      for (int pt = 0; pt < 2; ++pt)
#pragma unroll
        for (int c = 0; c < 2; ++c) { const u32x4 v = raw[s][pt][c];
          ss = fmaf(QLO(v.x), QLO(v.x), ss); ss = fmaf(QHI(v.x), QHI(v.x), ss); ss = fmaf(QLO(v.y), QLO(v.y), ss); ss = fmaf(QHI(v.y), QHI(v.y), ss);
          ss = fmaf(QLO(v.z), QLO(v.z), ss); ss = fmaf(QHI(v.z), QHI(v.z), ss); ss = fmaf(QLO(v.w), QLO(v.w), ss); ss = fmaf(QHI(v.w), QHI(v.w), ss); }
    { auto rr = __builtin_amdgcn_permlane32_swap(__float_as_uint(ss), __float_as_uint(ss), false, false); ss = __uint_as_float(rr[0]) + __uint_as_float(rr[1]); }
    const float rs = 1.0f / sqrtf(ss * (1.0f / D) + 1e-6f);
    constexpr float qsc = PP ? 8.0f * SCALE * LOG2E : 1.0f;
    const int tok = qpos0 + wid * QBLK + r32;
#pragma unroll
    for (int s = 0; s < 2; ++s) { int w[8]; const float pos = (float)(s == 0 ? (tok >> 6) : (tok & 63));
#pragma unroll
      for (int c = 0; c < 2; ++c) {
        const u32x4 va = raw[s][0][c], vb = raw[s][1][c];
        const float xa[8] = {QLO(va.x), QHI(va.x), QLO(va.y), QHI(va.y), QLO(va.z), QHI(va.z), QLO(va.w), QHI(va.w)}, xb[8] = {QLO(vb.x), QHI(vb.x), QLO(vb.y), QHI(vb.y), QLO(vb.z), QHI(vb.z), QLO(vb.w), QHI(vb.w)};
        float o1[8], o2[8];
#pragma unroll
        for (int u4 = 0; u4 < 2; ++u4) { const f32x4_a g1 = *reinterpret_cast<const f32x4_a*>(gq + 64 * s + 16 * hi + 8 * c + 4 * u4), g2 = *reinterpret_cast<const f32x4_a*>(gq + 64 * s + 32 + 16 * hi + 8 * c + 4 * u4);
#pragma unroll
          for (int u = 0; u < 4; ++u) { const int t = 4 * u4 + u; const float inv = __builtin_amdgcn_exp2f(-(float)(2 * (16 * hi + 8 * c + t)) * (1.0f / 64.0f) * 13.287712379549449f);
            const float rev = pos * inv * 0.15915494309189535f, fr = rev - floorf(rev); const float sn = __builtin_amdgcn_sinf(fr), cs = __builtin_amdgcn_cosf(fr);
            const float a = xa[t] * rs * g1[u], b = xb[t] * rs * g2[u]; o1[t] = (a * cs - b * sn) * qsc; o2[t] = (b * cs + a * sn) * qsc; } }
        int t0 = __builtin_amdgcn_cvt_pk_fp8_f32(o1[0], o1[1], 0, false); t0 = __builtin_amdgcn_cvt_pk_fp8_f32(o1[2], o1[3], t0, true); w[2 * c] = t0;
        t0 = __builtin_amdgcn_cvt_pk_fp8_f32(o1[4], o1[5], 0, false); t0 = __builtin_amdgcn_cvt_pk_fp8_f32(o1[6], o1[7], t0, true); w[2 * c + 1] = t0;
        t0 = __builtin_amdgcn_cvt_pk_fp8_f32(o2[0], o2[1], 0, false); t0 = __builtin_amdgcn_cvt_pk_fp8_f32(o2[2], o2[3], t0, true); w[4 + 2 * c] = t0;
        t0 = __builtin_amdgcn_cvt_pk_fp8_f32(o2[4], o2[5], 0, false); t0 = __builtin_amdgcn_cvt_pk_fp8_f32(o2[6], o2[7], t0, true); w[4 + 2 * c + 1] = t0; }
      q8[s] = (v8i_a){w[0], w[1], w[2], w[3], w[4], w[5], w[6], w[7]}; }
#undef QLO
#undef QHI
  } else if constexpr (F8) {
    const bf16* Qr = Qb + (long)(wid * QBLK + r32) * LDQ + hi * 32;
#pragma unroll
    for (int s = 0; s < 2; ++s) { int w[8];
#pragma unroll
      for (int c = 0; c < 4; ++c) { const u32x4 v = *reinterpret_cast<const u32x4*>(Qr + 64 * s + 8 * c);
        int t = __builtin_amdgcn_cvt_pk_fp8_f32(__uint_as_float(v.x << 16), __uint_as_float(v.x & 0xffff0000u), 0, false); t = __builtin_amdgcn_cvt_pk_fp8_f32(__uint_as_float(v.y << 16), __uint_as_float(v.y & 0xffff0000u), t, true); w[2 * c] = t;
        t = __builtin_amdgcn_cvt_pk_fp8_f32(__uint_as_float(v.z << 16), __uint_as_float(v.z & 0xffff0000u), 0, false); t = __builtin_amdgcn_cvt_pk_fp8_f32(__uint_as_float(v.w << 16), __uint_as_float(v.w & 0xffff0000u), t, true); w[2 * c + 1] = t; }
      q8[s] = (v8i_a){w[0], w[1], w[2], w[3], w[4], w[5], w[6], w[7]}; }
  } else {
#pragma unroll
    for (int d0 = 0; d0 < 8; ++d0) qr[d0] = *reinterpret_cast<const bf16x8*>(Qw + d0 * 16);
  }
#pragma unroll
  for (int d = 0; d < 4; ++d) { float z_; asm volatile("v_mov_b32 %0, 0" : "=v"(z_));
#pragma unroll
    for (int r = 0; r < 16; ++r) o[d][r] = z_; }
  const int sr = tid >> 4, sc = (tid & 15) * 8, vst0 = v_st(sr, sc), vst1 = v_st(32 + sr, sc);
  const int vb0 = (int)(uintptr_t)V_lds + v_rd_base(lane);
  const __attribute__((address_space(3))) float* tb0 = tab + (relbase - (wid * QBLK + r32) + 512 + 4 * hi);
  struct { bf16x8 vs0, vs1, ks0, ks1; } sr_[SDEPTH];
#define SLOAD(i, k0) do { sr_[i].vs0 = *reinterpret_cast<const bf16x8*>(&Vh[(long)(((k0) & kmask) + sr) * LDK + sc]); sr_[i].vs1 = *reinterpret_cast<const bf16x8*>(&Vh[(long)(((k0) & kmask) + 32 + sr) * LDK + sc]); \
    if constexpr (F8) { sr_[i].ks0 = *reinterpret_cast<const bf16x8*>(&Kh8[(long)(((k0) & kmask) + (tid >> 3)) * 256 + (tid & 7) * 16]); } \
    else { sr_[i].ks0 = *reinterpret_cast<const bf16x8*>(&Kh[(long)(((k0) & kmask) + sr) * LDK + sc]); sr_[i].ks1 = *reinterpret_cast<const bf16x8*>(&Kh[(long)(((k0) & kmask) + 32 + sr) * LDK + sc]); } } while (0)
#define SWRITE(b, i) do { *(bf16x8*)((char*)V_lds + (b) * SHM_V + vst0) = sr_[i].vs0;          \
    *(bf16x8*)((char*)V_lds + (b) * SHM_V + vst1) = sr_[i].vs1; int kc = sc * 2;               \
    if constexpr (F8) { *(bf16x8*)((char*)K_lds + (b) * SHM_K + KSWZ8(tid >> 3, (tid & 7) * 16)) = sr_[i].ks0; } \
    else { *(bf16x8*)((char*)K_lds + (b) * SHM_K + KSWZ(sr, kc)) = sr_[i].ks0;                       \
    *(bf16x8*)((char*)K_lds + (b) * SHM_K + KSWZ(32 + sr, kc)) = sr_[i].ks1; } } while (0)
#define SWAIT() do { if constexpr (SDEPTH == 2) asm volatile("s_waitcnt vmcnt(4)" ::: "memory"); else asm volatile("s_waitcnt vmcnt(0)" ::: "memory"); } while (0)
#define RESC(a) do { if (!FIXM && __any((a) < 1.f)) { if (hi == 0) al_l[r32] = (a); asm volatile("s_waitcnt lgkmcnt(0)" ::: "memory"); \
    for (int d = 0; d < 4; ++d) for (int r = 0; r < 16; ++r) o[d][r] *= al_l[crow(r, hi)]; } } while (0)
  f32x16 pA0, pA1, pB0, pB1; float mnA, mnB, alA, alB; bf16x8 pa0, pa1, pa2, pa3; const int NT = seq / KVBLK;
  if constexpr (PP) {
    static_assert(!PP || (F8 && FIXM && !WIN), "ping-pong path: dense fp8 fixed-reference attention only");
    constexpr int NS = 4, KSLOT = KVBLK * D, VSLOT = KVBLK * D * 2, KRING = NS * VSLOT;
    typedef __attribute__((address_space(3))) unsigned lds_u32;
    const int widu = __builtin_amdgcn_readfirstlane(wid), grp = widu >> 2;
    li_l = (float*)(lds + KRING + NS * KSLOT) + widu * 64; al_l = li_l + 32;
    const __attribute__((address_space(3))) unsigned char* ldsb = (const __attribute__((address_space(3))) unsigned char*)(unsigned)(uintptr_t)lds;
    const int krow = widu * 8 + (lane >> 3);
    const unsigned kofs = (unsigned)(krow * 256 + (((lane & 7) ^ (krow & 7)) << 4));
    unsigned vofs[2];
#pragma unroll
    for (int i = 0; i < 2; ++i) { const int blk = (widu * 2 + i) * 2 + (lane >> 5), kk = (blk >> 2) * 8 + ((lane & 31) >> 2), k = (kk & ~0xC) | ((kk & 4) << 1) | ((kk & 8) >> 1);
      vofs[i] = (unsigned)((k * LDK + (blk & 3) * 32 + 8 * (lane & 3)) * 2); }
#define DMAK(t) do { const int t_ = (t) < NT ? (t) : NT - 1; const unsigned char* kb_ = Kh8 + (long)t_ * (KVBLK * 256); asm volatile("" : "+s"(kb_)); \
      __builtin_amdgcn_global_load_lds((const unsigned*)(kb_ + kofs), (lds_u32*)(ldsb + KRING + ((t) & (NS - 1)) * KSLOT + widu * 1024), 16, 0, 0); } while (0)
#define DMAV(t) do { const int t_ = (t) < NT ? (t) : NT - 1; const unsigned char* vb_ = (const unsigned char*)(Vh + (long)t_ * (KVBLK * LDK)); asm volatile("" : "+s"(vb_)); _Pragma("unroll") for (int i_ = 0; i_ < 2; ++i_) \
      __builtin_amdgcn_global_load_lds((const unsigned*)(vb_ + vofs[i_]), (lds_u32*)(ldsb + ((t) & (NS - 1)) * VSLOT + (widu * 2 + i_) * 1024), 16, 0, 0); } while (0)
#define PBAR() do { asm volatile("s_waitcnt lgkmcnt(0)" ::: "memory"); __builtin_amdgcn_s_barrier(); } while (0)
#define PEND() do { asm volatile("s_waitcnt vmcnt(6)" ::: "memory"); PBAR(); } while (0)
#define KSL(t) ((bf16*)(lds + KRING + ((t) & (NS - 1)) * KSLOT))
#define VSL(t) (vb0 + ((t) & (NS - 1)) * VSLOT)
    DMAK(0); DMAV(0); DMAK(1); DMAV(1); DMAK(2); DMAK(3); DMAV(2);
    asm volatile("s_waitcnt vmcnt(0)" ::: "memory"); PBAR();
    f32x16 cinit; { float nm_ = -m0 * (SCALE * LOG2E); asm volatile("" : "+v"(nm_));
#pragma unroll
      for (int r = 0; r < 16; ++r) cinit[r] = nm_; }
    qkt<WIN, F8, true>(pA0, pA1, KSL(0), qr, q8, r32, hi, tb0, &cinit); partialSM<FIXM, true>(pA0, pA1, m_reg, mnA, alA);
    PBAR();
    if (grp == 1) PBAR();
#pragma unroll 1
    for (int t = 1; t < NT; ++t) {
      SBAR(); DMAK(t + 3); SBAR();
      finishSM(pA0, pA1, alA, l_reg, pa0, pa1, pa2, pa3); SBAR();
      qkt<WIN, F8, true>(pA0, pA1, KSL(t), qr, q8, r32, hi, tb0, &cinit); SBAR();
      PEND();
      SBAR(); DMAV(t + 2); SBAR();
      pv_d0(o, VSL(t - 1), pa0, pa1, pa2, pa3); partialSM<FIXM, true>(pA0, pA1, m_reg, mnA, alA); SBAR();
      PEND();
    }
    if (grp == 0) PBAR();
    finishSM(pA0, pA1, alA, l_reg, pa0, pa1, pa2, pa3); SBAR();
    pv_d0(o, VSL(NT - 1), pa0, pa1, pa2, pa3);
    asm volatile("s_waitcnt vmcnt(0)" ::: "memory");
#undef DMAK
#undef DMAV
#undef PBAR
#undef PEND
#undef KSL
#undef VSL
  } else {
  constexpr int SE = 0, SO = SDEPTH - 1;
  SLOAD(SE, 0); asm volatile("s_waitcnt vmcnt(0)" ::: "memory"); SWRITE(0, SE); __syncthreads();
  qkt<WIN, F8>(pA0, pA1, K_lds, qr, q8, r32, hi, tb0); partialSM<FIXM>(pA0, pA1, m_reg, mnA, alA);
  SLOAD(SO, KVBLK); if constexpr (SDEPTH == 2) { if (2 < NT) SLOAD(SE, 2 * KVBLK); }
  SWAIT(); SWRITE(1, SO); __syncthreads();
  for (int j = 1; j + 1 < NT; j += 2) {
    SBAR(); qkt<WIN, F8>(pB0, pB1, (bf16*)((char*)K_lds + SHM_K), qr, q8, r32, hi, tb0 + 64 * j);
    finishSM(pA0, pA1, alA, l_reg, pa0, pa1, pa2, pa3); SBAR();
    SLOAD(SO, (j + SDEPTH) * KVBLK); SBAR();
    pv_d0(o, vb0, pa0, pa1, pa2, pa3); partialSM<FIXM>(pB0, pB1, m_reg, mnB, alB);
    __syncthreads(); SWAIT(); SWRITE(0, SE);
    RESC(alB); __syncthreads();
    SBAR(); qkt<WIN, F8>(pA0, pA1, K_lds, qr, q8, r32, hi, tb0 + 64 * (j + 1));
    finishSM(pB0, pB1, alB, l_reg, pa0, pa1, pa2, pa3); SBAR();
    if (SDEPTH == 1 || j + 3 < NT) SLOAD(SE, (j + 1 + SDEPTH) * KVBLK); SBAR();
    pv_d0(o, vb0 + (int)SHM_V, pa0, pa1, pa2, pa3); partialSM<FIXM>(pA0, pA1, m_reg, mnA, alA);
    __syncthreads(); SWAIT(); SWRITE(1, SO);
    RESC(alA); __syncthreads();
  }
  SBAR(); qkt<WIN, F8>(pB0, pB1, (bf16*)((char*)K_lds + SHM_K), qr, q8, r32, hi, tb0 + 64 * (NT - 1));
  finishSM(pA0, pA1, alA, l_reg, pa0, pa1, pa2, pa3); SBAR();
  pv_d0(o, vb0, pa0, pa1, pa2, pa3); partialSM<FIXM>(pB0, pB1, m_reg, mnB, alB);
  __syncthreads(); RESC(alB);
  finishSM(pB0, pB1, alB, l_reg, pa0, pa1, pa2, pa3); SBAR();
  pv_d0(o, vb0 + (int)SHM_V, pa0, pa1, pa2, pa3);
  }
  if (hi == 0) li_l[r32] = l_reg; asm volatile("s_waitcnt lgkmcnt(0)" ::: "memory");
  float rli[16];
#pragma unroll
  for (int r = 0; r < 16; ++r) rli[r] = __builtin_amdgcn_rcpf(li_l[crow(r, hi)]);
  unsigned char* Ow = Ob + (long)(wid * QBLK) * LDO;
#pragma unroll
  for (int r = 0; r < 16; ++r) { int orow = crow(r, hi); const float sc = rli[r] * oscale;
    for (int d0 = 0; d0 < 4; ++d0) Ow[(long)orow * LDO + d0 * 32 + r32] = (unsigned char)(__builtin_amdgcn_cvt_pk_fp8_f32(o[d0][r] * sc, 0.f, 0, false) & 0xff); }
  __syncthreads();
#undef SLOAD
#undef SWRITE
#undef SWAIT
#undef RESC
}
#undef KSWZ
#undef KSWZ8
#undef SBAR
}
constexpr int NWAVES = 8;
constexpr int SEQ = 8192, DM = 2048, HD = 128, NEXP = 64, TOPK = 8, FE = 512;
constexpr int INC = 7168;
constexpr int PLD = INC + PROJ_PAD;
constexpr int C_QA = 0, C_KA = 1024, C_VA = 1280, C_QB = 1536, C_KB = 2560, C_VB = 2816, C_GA = 3072, C_GB = 5120;
constexpr float LN_EPS = 1e-5f, RMS_EPS = 1e-6f;
constexpr float ALPHA = 1.189207115002721f;
constexpr float ROUTED_SCALE = 2.5f;
constexpr int LCAP = 8192;
constexpr int NEXP1 = NEXP + 1;

constexpr size_t MiB = 1u << 20;
constexpr size_t WS_CTL = 0, CTL_ZERO_BYTES = 1 * MiB;
constexpr size_t WS_WGU = 1 * MiB;
constexpr size_t WS_WINT = WS_WGU + 260 * MiB;
constexpr size_t WS_XBF = WS_WINT + 28 * MiB;
constexpr size_t WS_PROJ = WS_XBF + 32 * MiB;
constexpr size_t WS_OA = WS_PROJ + 116 * MiB;
constexpr size_t WS_OB = WS_OA + 16 * MiB;
constexpr size_t WS_MRG = WS_OB + 16 * MiB;
constexpr size_t WS_WAT = WS_MRG + 32 * MiB;
constexpr size_t WS_WBT = WS_WAT + 4 * MiB;
constexpr size_t WS_WOT = WS_WBT + 4 * MiB;
constexpr size_t WS_DEAD_END = WS_WOT + 8 * MiB;
constexpr size_t WS_Y = WS_WGU;
constexpr size_t WS_WD = WS_DEAD_END;
constexpr size_t WS_WR = WS_WD + 130 * MiB;
constexpr size_t WS_H32 = WS_WR + 1 * MiB;
constexpr size_t WS_HBF = WS_H32 + 64 * MiB;
constexpr size_t WS_HID = WS_HBF + 32 * MiB;
constexpr size_t WS_PRE = WS_HID + 88 * MiB;
constexpr size_t WS_LTOK = WS_PRE + 64 * MiB;
constexpr size_t WS_LW = WS_LTOK + 3 * MiB;
constexpr size_t WS_ROUTE = WS_LW + 3 * MiB;
constexpr size_t WS_HF8 = WS_H32;
constexpr size_t WS_KF8 = WS_H32 + 16 * MiB;
constexpr size_t WS_END = WS_ROUTE + 1 * MiB;
static_assert(WS_Y + 352 * MiB <= WS_WD, "Y overlay");
static_assert((size_t)SEQ * PLD * 2 <= 116 * MiB, "proj slot");
static_assert(WS_END <= 1024 * MiB, "d_ws map must fit 1 GiB");
constexpr int CW_TMO = 0;
constexpr int CW_CNT = 64;
constexpr int CW_BAR = 4096;

constexpr int RING_OFF = 0, RING_BYTES = 131072;
constexpr int LDSCTL_OFF = RING_BYTES;
constexpr int MISC_OFF = LDSCTL_OFF;
constexpr int IDXL_OFF = LDSCTL_OFF + 256;
constexpr int TST_OFF = IDXL_OFF + 1024 + 2048;
constexpr int LDS_BYTES = 147456;
static_assert(TST_OFF + 512 <= LDS_BYTES, "LDS map");

#define GAS __attribute__((address_space(1)))
#define LAS __attribute__((address_space(3)))
typedef unsigned short bf16;
typedef unsigned v4u __attribute__((ext_vector_type(4)));
typedef unsigned v2u __attribute__((ext_vector_type(2)));
typedef float f32x4 __attribute__((ext_vector_type(4)));
typedef short bf16x8 __attribute__((ext_vector_type(8)));
#define RLX_AGENT __ATOMIC_RELAXED, __HIP_MEMORY_SCOPE_AGENT
#define LDS_WAIT() asm volatile("s_waitcnt lgkmcnt(0)" ::: "memory")
#define VM_WAIT() asm volatile("s_waitcnt vmcnt(0)" ::: "memory")
__device__ __forceinline__ unsigned f2bf(float f) { unsigned u = __builtin_bit_cast(unsigned, f); return (u + 0x7fffu + ((u >> 16) & 1u)) >> 16; }
__device__ __forceinline__ unsigned pk2(float lo, float hi) { return f2bf(lo) | (f2bf(hi) << 16); }
__device__ __forceinline__ float bf2f(unsigned short h) { return __uint_as_float((unsigned)h << 16); }

#ifndef XB_L1_ACQ
#define XB_L1_ACQ 1
#endif
#ifndef XB_EARLY_WB
#define XB_EARLY_WB 0
#endif
#define XB_TMO      128
#define XB_XCNT(j)  (256  + 64 * (j))
#define XB_XSUB(j)  (1280 + 64 * (j))
#define XB_XGEN(j)  (2304 + 64 * (j))
#define XB_TOP      3328
#define XB_TOPGEN   3392
#define XCD_BAR_WORDS 3456
#define XB_SPIN_CAP (1u << 20)
__device__ __forceinline__ unsigned xb_ld(unsigned* p)              { return __hip_atomic_load(p, __ATOMIC_RELAXED, __HIP_MEMORY_SCOPE_AGENT); }
__device__ __forceinline__ unsigned xb_add(unsigned* p, unsigned v) { return __hip_atomic_fetch_add(p, v, __ATOMIC_RELAXED, __HIP_MEMORY_SCOPE_AGENT); }
__device__ __forceinline__ unsigned xb_xcc_id() { return (unsigned)__builtin_amdgcn_s_getreg((3 << 11) | 20) & 0xFu; }
#define XB_SPIN(cond, bar) do { unsigned _sp = 0; while (cond) { __builtin_amdgcn_s_sleep(1); \
    if ((++_sp & 255u) == 0u) { if (xb_ld(&(bar)[XB_TMO])) break; if (_sp > XB_SPIN_CAP) { atomicAdd(&(bar)[XB_TMO], 1u); break; } } } } while (0)
struct XcdBarrier { unsigned* bar; unsigned x; volatile LAS unsigned* st; unsigned total; };
__device__ __forceinline__ XcdBarrier xcd_barrier_post(unsigned* bar, volatile LAS unsigned* st, unsigned total) {
    XcdBarrier b; b.bar = bar; b.x = xb_xcc_id(); b.st = st; b.total = total;
    if (threadIdx.x == 0) (void)xb_add(&bar[XB_XCNT(b.x)], 1u);
    return b;
}
__device__ __forceinline__ void xcd_barrier_complete(unsigned* bar, unsigned x, unsigned G, unsigned& nloc, unsigned& nx) {
    unsigned sum, cnt, mine, sp = 0u;
    for (;;) {
        sum = 0u; cnt = 0u; mine = 0u;
#pragma unroll
        for (unsigned j = 0; j < 16; ++j) { const unsigned c = xb_ld(&bar[XB_XCNT(j)]); sum += c; cnt += (c > 0u) ? 1u : 0u; mine = (j == x) ? c : mine; }
        if (sum == G) break;
        __builtin_amdgcn_s_sleep(1);
        if ((++sp & 255u) == 0u) { if (xb_ld(&bar[XB_TMO])) break; if (sp > XB_SPIN_CAP) { atomicAdd(&bar[XB_TMO], 1u); break; } }
    }
    nloc = mine > 0u ? mine : 1u; nx = cnt > 0u ? cnt : 1u;
}
__device__ __forceinline__ void xcd_barrier(const XcdBarrier& b) {
    asm volatile("s_waitcnt vmcnt(0)" ::: "memory");
    __syncthreads();
    if (threadIdx.x == 0) {
        unsigned* bar = b.bar;
        __builtin_amdgcn_s_waitcnt(0);
        unsigned nloc = b.st[0], nx = b.st[1];
        if (nloc == 0u) { xcd_barrier_complete(bar, b.x, b.total, nloc, nx); b.st[0] = nloc; b.st[1] = nx; }
        const unsigned old = xb_add(&bar[XB_XSUB(b.x)], 1u);
        const unsigned gen = old / nloc;
        if (old + 1u == (gen + 1u) * nloc) {
            __builtin_amdgcn_fence(__ATOMIC_RELEASE, "agent");
            asm volatile("s_waitcnt vmcnt(0)" ::: "memory");
            asm volatile("buffer_inv sc1" ::: "memory");
            const unsigned og = xb_add(&bar[XB_TOP], 1u);
            const unsigned tg = og / nx;
            if (og + 1u == (tg + 1u) * nx) xb_add(&bar[XB_TOPGEN], 1u);
            else XB_SPIN(xb_ld(&bar[XB_TOPGEN]) == tg, bar);
            asm volatile("s_waitcnt vmcnt(0)" ::: "memory");
            xb_add(&bar[XB_XGEN(b.x)], 1u);
            asm volatile("s_waitcnt vmcnt(0)" ::: "memory");
        } else {
            asm volatile("buffer_inv sc1" ::: "memory");
            XB_SPIN(xb_ld(&bar[XB_XGEN(b.x)]) == gen, bar);
            asm volatile("s_waitcnt vmcnt(0)" ::: "memory");
        }
    }
    __syncthreads();
}

__device__ __forceinline__ float wave_sum(float v) {
#pragma unroll
    for (int o = 1; o < 64; o <<= 1) v += __shfl_xor(v, o);
    return v;
}
__device__ __forceinline__ float sigmoidf_(float x) { return __builtin_amdgcn_rcpf(1.0f + __builtin_amdgcn_exp2f(-x * 1.4426950408889634f)); }

struct Args { const float* in[22]; float* out; unsigned char* ws; int ph_lo, ph_hi; };
struct Frame {
    LAS unsigned char* lds;
    volatile LAS unsigned* MISC;
    unsigned* ctl;
    int tid, lane, wave;
    int vcu, G;
    const float* in[22]; float* out; unsigned char* ws;
};

#ifndef G1_FP8
#define G1_FP8 1
#endif
#ifndef ATT_F8
#define ATT_F8 1
#endif
#ifndef P1_FP8
#define P1_FP8 1
#endif
struct TItem { const float* W; unsigned char* WT; int K, N, k0, n0, drow0, f8; };
constexpr float W8SCALE = 32.0f, H8SCALE = 8.0f, OA_SCALE = 16.0f, OB_SCALE = 64.0f, MG_SCALE = 32.0f;
__device__ __forceinline__ void titem_issue(const TItem& it, LAS unsigned char* buf, int lane) {
#pragma unroll
    for (int g = 0; g < 8; ++g) { const int k = 8 * g + (lane >> 3), pos = lane & 7;
        __builtin_amdgcn_global_load_lds((const unsigned*)(it.W + (size_t)(it.k0 + k) * it.N + it.n0 + 4 * (pos ^ g)), (LAS unsigned*)(buf + g * 1024), 16, 0, 0); }
}
__device__ __forceinline__ void titem_finish(const TItem& it, const LAS float* buf, int lane) {
    const int c = lane & 7;
#pragma unroll
    for (int j = 0; j < 4; ++j) { const int nn = (lane >> 3) + 8 * j; const LAS float* s = buf + (8 * c) * 32 + (((nn >> 2) ^ c) << 2) + (nn & 3);
        const size_t eo = (size_t)(it.drow0 + nn) * it.K + it.k0 + 8 * c;
        if (it.f8) { v2u o; int t = __builtin_amdgcn_cvt_pk_fp8_f32(s[0 * 32] * W8SCALE, s[1 * 32] * W8SCALE, 0, false); t = __builtin_amdgcn_cvt_pk_fp8_f32(s[2 * 32] * W8SCALE, s[3 * 32] * W8SCALE, t, true); o.x = (unsigned)t;
            t = __builtin_amdgcn_cvt_pk_fp8_f32(s[4 * 32] * W8SCALE, s[5 * 32] * W8SCALE, 0, false); t = __builtin_amdgcn_cvt_pk_fp8_f32(s[6 * 32] * W8SCALE, s[7 * 32] * W8SCALE, t, true); o.y = (unsigned)t;
            __builtin_nontemporal_store(o, (GAS v2u*)(it.WT + eo)); }
        else { v4u o; o.x = pg8::cvt_pk_bf16(s[0 * 32], s[1 * 32]); o.y = pg8::cvt_pk_bf16(s[2 * 32], s[3 * 32]); o.z = pg8::cvt_pk_bf16(s[4 * 32], s[5 * 32]); o.w = pg8::cvt_pk_bf16(s[6 * 32], s[7 * 32]);
            __builtin_nontemporal_store(o, (GAS v4u*)(it.WT + 2 * eo)); } }
}
constexpr int I_IN = (DM / 64) * (INC / 32);
constexpr int I_BR = (1024 / 64) * (DM / 32);
constexpr int I_WO = (DM / 64) * (DM / 32);
constexpr int I_GU = (DM / 64) * (FE / 32);
constexpr int I_DN = (FE / 64) * (DM / 32);
constexpr int NITEMS_E1 = 2 * I_BR + I_WO + NEXP1 * 2 * I_GU;
constexpr int NITEMS_E2 = NEXP1 * I_DN;
__device__ __forceinline__ void titem_plain(TItem& it, const float* W, int K, int N, void* WT, int item, int f8 = 0) {
    const int nblk = N / 32, kb = item / nblk, nb = item % nblk; it.W = W; it.WT = (unsigned char*)WT; it.K = K; it.N = N; it.k0 = 64 * kb; it.n0 = 32 * nb; it.drow0 = 32 * nb; it.f8 = f8;
}
template <int LIST>
__device__ __forceinline__ void titem_get(Frame& F, int r, TItem& it) {
    if constexpr (LIST == 0) { titem_plain(it, F.in[1], DM, INC, F.ws + WS_WINT, r, P1_FP8); }
    else if constexpr (LIST == 2) { const int e = r / I_DN; r -= e * I_DN;
        titem_plain(it, e < NEXP ? F.in[16] + (size_t)e * FE * DM : F.in[19], FE, DM, F.ws + WS_WD + (size_t)e * DM * FE, r, 1); }
    else {
        if (r < I_BR) { titem_plain(it, F.in[7], 1024, DM, F.ws + WS_WAT, r, 1); return; } r -= I_BR;
        if (r < I_BR) { titem_plain(it, F.in[8], 1024, DM, F.ws + WS_WBT, r, 1); return; } r -= I_BR;
        if (r < I_WO) { titem_plain(it, F.in[9], DM, DM, F.ws + WS_WOT, r, 1); return; } r -= I_WO;
        const int e = r / (2 * I_GU); r -= e * (2 * I_GU);
        const int half = r >= I_GU ? 1 : 0; r -= half * I_GU;
        const float* w = e < NEXP ? (half ? F.in[15] : F.in[14]) + (size_t)e * DM * FE : (half ? F.in[18] : F.in[17]);
        const int nblk = FE / 32, kb = r / nblk, nb = r % nblk, n0 = 32 * nb;
        it.W = w; it.WT = F.ws + WS_WGU + (size_t)e * 1024 * DM * (G1_FP8 ? 1 : 2); it.f8 = G1_FP8; it.K = DM; it.N = FE; it.k0 = 64 * kb; it.n0 = n0; it.drow0 = 256 * (n0 >> 7) + 128 * half + (n0 & 127);
    }
}
#ifndef CONV_D
#define CONV_D 4
#endif
__device__ __forceinline__ void titem_load(const TItem& it, f32x4 (&r)[8], int lane) {
#pragma unroll
    for (int g = 0; g < 8; ++g) r[g] = __builtin_nontemporal_load((const GAS f32x4*)(it.W + (size_t)(it.k0 + 8 * g + (lane >> 3)) * it.N + it.n0 + 4 * (lane & 7)));
}
__device__ __forceinline__ void titem_store(const TItem& it, const f32x4 (&r)[8], LAS float* buf, int lane) {
#pragma unroll
    for (int g = 0; g < 8; ++g) *(LAS f32x4*)(buf + (8 * g + (lane >> 3)) * 32 + (((lane & 7) ^ g) << 2)) = r[g];
    titem_finish(it, buf, lane);
}
template <int LISTE>
__device__ __forceinline__ void convert_items(Frame& F, int first, int step, int last) {
    LAS float* buf = (LAS float*)(F.lds + RING_OFF + F.wave * 8192);
    if (first >= last) return;
    const int n_my = (last - first + step - 1) / step;
    f32x4 r[CONV_D][8]; TItem it;
#pragma unroll
    for (int d = 0; d < CONV_D; ++d) if (d < n_my) { titem_get<LISTE>(F, first + d * step, it); titem_load(it, r[d], F.lane); }
    for (int base = 0; base < n_my; base += CONV_D) {
#pragma unroll
        for (int d = 0; d < CONV_D; ++d) { const int idx = base + d;
            if (idx < n_my) { titem_get<LISTE>(F, first + idx * step, it); titem_store(it, r[d], buf, F.lane);
                if (idx + CONV_D < n_my) { titem_get<LISTE>(F, first + (idx + CONV_D) * step, it); titem_load(it, r[d], F.lane); } } }
    }
}
#ifndef CONV_Q
#define CONV_Q 200
#endif
#ifndef P1_NCG
#define P1_NCG 23
#endif
constexpr int NCONV = 32, NCOMP = 256 - NCONV, NCONV1 = 8 * (32 - P1_NCG), NCOMP1 = 8 * P1_NCG, E_SPLIT = (NCONV1 * NWAVES * CONV_Q < NITEMS_E1) ? NCONV1 * NWAVES * CONV_Q : NITEMS_E1;
#ifndef CONV_Q2
#define CONV_Q2 100
#endif
#ifndef P1_QE2
#define P1_QE2 0
#endif
constexpr int E2_A = (NCONV1 * NWAVES * P1_QE2 < NITEMS_E2) ? NCONV1 * NWAVES * P1_QE2 : NITEMS_E2;
constexpr int E2_SPLIT = (E2_A + 32 * NWAVES * CONV_Q2 < NITEMS_E2) ? E2_A + 32 * NWAVES * CONV_Q2 : NITEMS_E2;
#ifndef CONV_G1
#define CONV_G1 1
#endif
__device__ __forceinline__ void p0_prologue(Frame& F, bool compute_only) {
    const int gw = (compute_only ? (F.vcu >> 5) * P1_NCG + (F.vcu & 31) : F.vcu) * NWAVES + F.wave, NGW = (compute_only ? NCOMP1 : F.G) * NWAVES;
    convert_items<0>(F, gw, NGW, I_IN);
    { const int gt = gw * 64 + F.lane, NT = NGW * 64; const GAS f32x4* xs = (const GAS f32x4*)F.in[0]; GAS v4u* xo = (GAS v4u*)(F.ws + WS_XBF);
      for (int i = gt; i < SEQ * DM / 8; i += 4 * NT) {
          f32x4 a[4], b[4];
#pragma unroll
          for (int u = 0; u < 4; ++u) if (i + u * NT < SEQ * DM / 8) { a[u] = __builtin_nontemporal_load(xs + 2 * (i + u * NT)); b[u] = __builtin_nontemporal_load(xs + 2 * (i + u * NT) + 1); }
#pragma unroll
          for (int u = 0; u < 4; ++u) if (i + u * NT < SEQ * DM / 8) {
              if (P1_FP8) { v2u o; int t = __builtin_amdgcn_cvt_pk_fp8_f32(a[u].x, a[u].y, 0, false); t = __builtin_amdgcn_cvt_pk_fp8_f32(a[u].z, a[u].w, t, true); o.x = (unsigned)t;
                  t = __builtin_amdgcn_cvt_pk_fp8_f32(b[u].x, b[u].y, 0, false); t = __builtin_amdgcn_cvt_pk_fp8_f32(b[u].z, b[u].w, t, true); o.y = (unsigned)t; ((GAS v2u*)xo)[i + u * NT] = o; }
              else { v4u o; o.x = pg8::cvt_pk_bf16(a[u].x, a[u].y); o.y = pg8::cvt_pk_bf16(a[u].z, a[u].w); o.z = pg8::cvt_pk_bf16(b[u].x, b[u].y); o.w = pg8::cvt_pk_bf16(b[u].z, b[u].w); xo[i + u * NT] = o; } } } }
    { const int gt = gw * 64 + F.lane, NT = NGW * 64; bf16* wr = (bf16*)(F.ws + WS_WR);
      for (int i = gt; i < NEXP * DM; i += NT) {
          const int j_ = i & 7, ln = (i >> 3) & 63, nt_ = (i >> 9) & 3, ks = i >> 11, q_ = ln >> 4, t_ = ln & 15;
          const int k = ks * 32 + (j_ < 4 ? 4 * q_ + j_ : 16 + 4 * q_ + j_ - 4), e = 16 * nt_ + t_;
          const float w = F.in[12][(size_t)k * NEXP + e]; const unsigned h = f2bf(w); const float lo = w - __uint_as_float(h << 16);
          wr[i] = (bf16)h; wr[NEXP * DM + i] = (bf16)f2bf(lo); } }
    { const int gt = gw * 64 + F.lane, NT = NGW * 64; int* lt = (int*)(F.ws + WS_LTOK); float* lw = (float*)(F.ws + WS_LW);
      for (int i = gt; i < NEXP1 * LCAP; i += NT) { const bool sh = i >= NEXP * LCAP; lt[i] = sh ? i - NEXP * LCAP : 0; lw[i] = sh ? 1.0f : 0.0f; } }
}

#ifndef WT_STORES
#define WT_STORES 0
#endif
__device__ __forceinline__ void st_wt8(void* p, v2u w) {
    if (WT_STORES) __hip_atomic_store((unsigned long long*)p, ((unsigned long long)w.y << 32) | w.x, __ATOMIC_RELAXED, __HIP_MEMORY_SCOPE_AGENT);
    else *(v2u*)p = w;
}
__device__ __forceinline__ v4u pair16(v2u a, v2u b) {
    auto sx = __builtin_amdgcn_permlane16_swap(a.x, b.x, false, false);
    auto sy = __builtin_amdgcn_permlane16_swap(a.y, b.y, false, false);
    return (v4u){sx[0], sy[0], sx[1], sy[1]};
}
struct DenseOrder {
    const char* A; const char* B; int nM, nN, nwg, G, c; size_t tstep;
    __device__ __forceinline__ void init(const void* A_, const void* B_, int M, int N, int K, int G_, int c_) { A = (const char*)A_; B = (const char*)B_; nM = M / 256; nN = N / 256; nwg = nM * nN; G = G_; c = c_; tstep = (size_t)256 * K * (P1_FP8 ? 1 : 2); }
    __device__ __forceinline__ bool next(int i, pg8::Unit& u) const {
#ifdef P1_DOUBLE
        const long L = (long)(i >> 1) * G + c; if (L >= nwg) return false;
#else
        const long L = (long)i * G + c; if (L >= nwg) return false;
#endif
        int wgid = (int)L; { const int q = nwg / 8, r = nwg % 8, xcd = wgid % 8, off = wgid / 8; wgid = (xcd < r ? xcd * (q + 1) : r * (q + 1) + (xcd - r) * q) + off; }
        const int nig = 8 * nN, gid = wgid / nig, fm = gid * 8, gsz = (nM - fm) < 8 ? (nM - fm) : 8;
        const int pm = fm + ((wgid % nig) % gsz), pn = (wgid % nig) / gsz;
        u.A = A + (size_t)pm * tstep; u.B = B + (size_t)pn * tstep; u.idx = nullptr; u.wts = nullptr; u.r0 = pm * 256; u.c0 = pn * 256; u.aux = 0; u.kind = 0; return true;
    }
};
struct BranchOrder {
    const char *OA, *OB, *WA, *WB; int vcu;
    __device__ __forceinline__ bool next(int i, pg8::Unit& u) const {
#ifdef P3_DOUBLE
        if (i >= 4) return false; i &= 1;
#else
        if (i >= 2) return false;
#endif
        const int pm = vcu >> 3, pn = vcu & 7; const size_t ts = (size_t)256 * 1024;
        u.A = (i ? OB : OA) + (size_t)pm * ts; u.B = (i ? WB : WA) + (size_t)pn * ts; u.idx = nullptr; u.wts = nullptr; u.r0 = pm * 256; u.c0 = pn * 256; u.aux = 0; u.kind = i; return true;
    }
};
struct OneTileOrder {
    const char *A, *B; int vcu; size_t ts;
    __device__ __forceinline__ bool next(int i, pg8::Unit& u) const {
#ifdef P4_DOUBLE
        if (i >= 2) return false;
#else
        if (i >= 1) return false;
#endif
        const int pm = vcu >> 3, pn = vcu & 7;
        u.A = A + (size_t)pm * ts; u.B = B + (size_t)pn * ts; u.idx = nullptr; u.wts = nullptr; u.r0 = pm * 256; u.c0 = pn * 256; u.aux = 0; u.kind = 0; return true;
    }
};
template <int NPN>
struct MoeOrder {
    const LAS int* tst; const char* A; const char* B; const int* ltok; const float* lwt; int vcu, G; size_t arow, bexp, bpn;
    bool gather;
    int l0, lend, nheavy;
    const unsigned* flag; int wait_gmt, need;
    mutable int ec = 0;
    __device__ __forceinline__ bool next(int i, pg8::Unit& u) const {
        const int T = tst[NEXP1]; const int end = lend < 0 ? T * NPN : lend;
        int L;
#ifdef G2_DOUBLE
        if (NPN == 8) i >>= 1;
#endif
        if (nheavy > 0) { const int NL = G - nheavy; if (vcu >= NL) L = 2 * NL + i * G + vcu; else L = i < 2 ? i * NL + vcu : 2 * NL + (i - 2) * G + vcu; }
        else L = l0 + i * G + vcu;
        if (L >= end) return false;
        const int gmt = L / NPN, pn = L % NPN; int e = ec; if (tst[e] > gmt) e = 0;
        while (e < NEXP && tst[e + 1] <= gmt) ++e;
        ec = e;
        const int mt = gmt - tst[e];
        if (need > 0 && gmt >= wait_gmt) {
            unsigned spins = 0; while (__hip_atomic_load(flag, __ATOMIC_RELAXED, __HIP_MEMORY_SCOPE_AGENT) < (unsigned)need && ++spins < (1u << 22)) __builtin_amdgcn_s_sleep(2);
            __builtin_amdgcn_fence(__ATOMIC_ACQUIRE, "agent"); asm volatile("s_waitcnt vmcnt(0)" ::: "memory"); }
        u.A = gather ? A : A + (size_t)gmt * 256 * arow; u.B = B + (size_t)e * bexp + (size_t)pn * bpn; u.idx = ltok + e * LCAP + mt * 256; u.wts = lwt + e * LCAP + mt * 256;
        u.r0 = gmt * 256; u.c0 = pn * 256; u.aux = e * LCAP + mt * 256; u.kind = 0; return true;
    }
};

constexpr float GSCALE = 256.0f;
typedef float f32x2v __attribute__((ext_vector_type(2)));
struct EpiProj {
    static constexpr bool PERM = true; static constexpr int NST = 8;
    bf16* O; const float* bgate;
    __device__ __forceinline__ bool operator()(const pg8::f32x4 (&acc)[2][2][4][2], const pg8::Unit& u, int wr, int wc, int fr, int fq, const LAS float* wl) const {
        const int row0 = u.r0 + wr * 64 + fr, col0 = u.c0 + wc * 32 + 8 * fq;
        constexpr float PS = P1_FP8 ? 1.0f / W8SCALE : 1.0f;
        if (u.c0 >= C_GA) {
            f32x4 bb[2][2];
#pragma unroll
            for (int bj = 0; bj < 2; ++bj) { bb[bj][0] = *(const f32x4*)(bgate + col0 + bj * 128 - C_GA); bb[bj][1] = *(const f32x4*)(bgate + col0 + bj * 128 - C_GA + 4); }
            const int odd = fq & 1; unsigned char* G = (unsigned char*)O + (size_t)C_GA * 2 + (col0 - 8 * odd - C_GA);
#pragma unroll
            for (int ai = 0; ai < 2; ++ai)
#pragma unroll
                for (int mp = 0; mp < 2; ++mp)
#pragma unroll
                    for (int bj = 0; bj < 2; ++bj) { v2u w[2];
#pragma unroll
                        for (int mm = 0; mm < 2; ++mm) { const int m = 2 * mp + mm; const f32x4 v0 = acc[ai][bj][m][0] * PS + bb[bj][0], v1 = acc[ai][bj][m][1] * PS + bb[bj][1];
                            int t = __builtin_amdgcn_cvt_pk_fp8_f32(GSCALE * sigmoidf_(v0[0]), GSCALE * sigmoidf_(v0[1]), 0, false); t = __builtin_amdgcn_cvt_pk_fp8_f32(GSCALE * sigmoidf_(v0[2]), GSCALE * sigmoidf_(v0[3]), t, true); w[mm].x = (unsigned)t;
                            t = __builtin_amdgcn_cvt_pk_fp8_f32(GSCALE * sigmoidf_(v1[0]), GSCALE * sigmoidf_(v1[1]), 0, false); t = __builtin_amdgcn_cvt_pk_fp8_f32(GSCALE * sigmoidf_(v1[2]), GSCALE * sigmoidf_(v1[3]), t, true); w[mm].y = (unsigned)t; }
                        *(v4u*)(G + (size_t)(row0 + ai * 128 + (2 * mp + odd) * 16) * (PLD * 2) + bj * 128) = pair16(w[0], w[1]); }
        } else {
#pragma unroll
            for (int ai = 0; ai < 2; ++ai)
#pragma unroll
                for (int m = 0; m < 4; ++m)
#pragma unroll
                    for (int bj = 0; bj < 2; ++bj) { const f32x4 v0 = acc[ai][bj][m][0] * PS, v1 = acc[ai][bj][m][1] * PS;
                        v4u w; w.x = pg8::cvt_pk_bf16(v0[0], v0[1]); w.y = pg8::cvt_pk_bf16(v0[2], v0[3]); w.z = pg8::cvt_pk_bf16(v1[0], v1[1]); w.w = pg8::cvt_pk_bf16(v1[2], v1[3]);
                        *(v4u*)(O + (size_t)(row0 + ai * 128 + m * 16) * PLD + col0 + bj * 128) = w; }
        }
        return false;
    }
};
struct EpiBranch {
    static constexpr bool PERM = true; static constexpr int NST = 0;
    const bf16* proj; unsigned char* O;
    __device__ __forceinline__ bool operator()(pg8::f32x4 (&acc)[2][2][4][2], const pg8::Unit& u, int wr, int wc, int fr, int fq, const LAS float* wl) const {
        const int row0 = u.r0 + wr * 64 + fr, col0 = u.c0 + wc * 32 + 8 * fq;
        const bool seg0 = u.kind == 0;
#pragma unroll
        for (int ai = 0; ai < 2; ++ai) {
            v2u gb[4][2], ga[4][2];
#pragma unroll
            for (int m = 0; m < 4; ++m)
#pragma unroll
                for (int bj = 0; bj < 2; ++bj) { const size_t r = (size_t)(row0 + ai * 128 + m * 16); const int c = col0 + bj * 128;
                    const unsigned char* gp = (const unsigned char*)proj + r * (PLD * 2) + (size_t)C_GA * 2 + c;
                    gb[m][bj] = *(const v2u*)(gp + (C_GB - C_GA)); ga[m][bj] = seg0 ? *(const v2u*)gp : (v2u){0u, 0u}; }
            __builtin_amdgcn_sched_barrier(0);
#pragma unroll
            for (int mp = 0; mp < 2; ++mp) {
                v2u wq[2][2];
#pragma unroll
                for (int mm = 0; mm < 2; ++mm)
#pragma unroll
                    for (int bj = 0; bj < 2; ++bj) { const int m = 2 * mp + mm;
                        const v2u gbv = gb[m][bj], gav = ga[m][bj];
                        const f32x2v g01 = __builtin_amdgcn_cvt_pk_f32_fp8((int)gbv.x, false), g23 = __builtin_amdgcn_cvt_pk_f32_fp8((int)gbv.x, true), g45 = __builtin_amdgcn_cvt_pk_f32_fp8((int)gbv.y, false), g67 = __builtin_amdgcn_cvt_pk_f32_fp8((int)gbv.y, true);
                        float g[8] = {g01[0], g01[1], g23[0], g23[1], g45[0], g45[1], g67[0], g67[1]};
                        if (seg0) {
                            const f32x2v a01 = __builtin_amdgcn_cvt_pk_f32_fp8((int)gav.x, false), a23 = __builtin_amdgcn_cvt_pk_f32_fp8((int)gav.x, true), a45 = __builtin_amdgcn_cvt_pk_f32_fp8((int)gav.y, false), a67 = __builtin_amdgcn_cvt_pk_f32_fp8((int)gav.y, true);
                            float a[8] = {a01[0], a01[1], a23[0], a23[1], a45[0], a45[1], a67[0], a67[1]};
#pragma unroll
                            for (int j = 0; j < 4; ++j) { acc[ai][bj][m][0][j] *= (OB_SCALE / OA_SCALE) * a[j] * __builtin_amdgcn_rcpf(fmaxf(g[j], 1e-30f)); acc[ai][bj][m][1][j] *= (OB_SCALE / OA_SCALE) * a[4 + j] * __builtin_amdgcn_rcpf(fmaxf(g[4 + j], 1e-30f)); }
                        } else {
                            const pg8::f32x4 v0 = acc[ai][bj][m][0], v1 = acc[ai][bj][m][1];
                            constexpr float S1 = MG_SCALE / (OB_SCALE * W8SCALE * GSCALE);
                            v2u w; int t = __builtin_amdgcn_cvt_pk_fp8_f32(v0[0] * g[0] * S1, v0[1] * g[1] * S1, 0, false); t = __builtin_amdgcn_cvt_pk_fp8_f32(v0[2] * g[2] * S1, v0[3] * g[3] * S1, t, true); w.x = (unsigned)t;
                            t = __builtin_amdgcn_cvt_pk_fp8_f32(v1[0] * g[4] * S1, v1[1] * g[5] * S1, 0, false); t = __builtin_amdgcn_cvt_pk_fp8_f32(v1[2] * g[6] * S1, v1[3] * g[7] * S1, t, true); w.y = (unsigned)t;
                            wq[mm][bj] = w;
                        }
                    }
                if (!seg0) { const int odd = fq & 1;
#pragma unroll
                    for (int bj = 0; bj < 2; ++bj) *(v4u*)(O + (size_t)(row0 + ai * 128 + (2 * mp + odd) * 16) * DM + col0 - 8 * odd + bj * 128) = pair16(wq[0][bj], wq[1][bj]); }
            }
            __builtin_amdgcn_sched_barrier(0);
        }
        return seg0;
    }
};
struct EpiMix {
    static constexpr bool PERM = true; static constexpr int NST = 16;
    bf16* O;
    __device__ __forceinline__ bool operator()(const pg8::f32x4 (&acc)[2][2][4][2], const pg8::Unit& u, int wr, int wc, int fr, int fq, const LAS float* wl) const {
        const int row0 = u.r0 + wr * 64 + fr, col0 = u.c0 + wc * 32 + 8 * fq;
#pragma unroll
        for (int ai = 0; ai < 2; ++ai)
#pragma unroll
            for (int m = 0; m < 4; ++m)
#pragma unroll
                for (int bj = 0; bj < 2; ++bj) { const pg8::f32x4 v0 = acc[ai][bj][m][0] * (1.0f / (MG_SCALE * W8SCALE)), v1 = acc[ai][bj][m][1] * (1.0f / (MG_SCALE * W8SCALE));
                    v4u w; w.x = pg8::cvt_pk_bf16(v0[0], v0[1]); w.y = pg8::cvt_pk_bf16(v0[2], v0[3]); w.z = pg8::cvt_pk_bf16(v1[0], v1[1]); w.w = pg8::cvt_pk_bf16(v1[2], v1[3]);
                    *(v4u*)(O + (size_t)(row0 + ai * 128 + m * 16) * DM + col0 + bj * 128) = w; }
        return false;
    }
};
struct EpiMoe1 {
    static constexpr bool PERM = true; static constexpr int NST = 4;
    unsigned char* H;
    __device__ __forceinline__ bool operator()(const pg8::f32x4 (&acc)[2][2][4][2], const pg8::Unit& u, int wr, int wc, int fr, int fq, const LAS float* wl) const {
        const int odd = fq & 1; const int row0 = u.r0 + wr * 64 + fr + odd * 16, col0 = (u.c0 >> 1) + wc * 32 + 8 * (fq - odd);
#pragma unroll
        for (int ai = 0; ai < 2; ++ai)
#pragma unroll
            for (int mp = 0; mp < 2; ++mp) { v2u w[2];
#pragma unroll
                for (int mm = 0; mm < 2; ++mm) { const int m = 2 * mp + mm; float h[8]; const float wt = wl[wr * 64 + fr + ai * 128 + m * 16] * H8SCALE;
#pragma unroll
                    for (int n = 0; n < 2; ++n)
#pragma unroll
                        for (int j = 0; j < 4; ++j) { const float g = acc[ai][0][m][n][j] * (G1_FP8 ? 1.0f / W8SCALE : 1.0f), up = acc[ai][1][m][n][j] * (G1_FP8 ? 1.0f / W8SCALE : 1.0f); h[4 * n + j] = __builtin_amdgcn_fmed3f(g * sigmoidf_(g) * up * wt, -448.0f, 448.0f); }
                    int t = __builtin_amdgcn_cvt_pk_fp8_f32(h[0], h[1], 0, false); t = __builtin_amdgcn_cvt_pk_fp8_f32(h[2], h[3], t, true); w[mm].x = (unsigned)t;
                    t = __builtin_amdgcn_cvt_pk_fp8_f32(h[4], h[5], 0, false); t = __builtin_amdgcn_cvt_pk_fp8_f32(h[6], h[7], t, true); w[mm].y = (unsigned)t; }
                *(v4u*)(H + (size_t)(row0 + ai * 128 + mp * 32) * FE + col0) = pair16(w[0], w[1]); }
        return false;
    }
};
constexpr float YSCALE = 16.0f;
struct EpiMoe2 {
    static constexpr bool PERM = true; static constexpr int NST = 8;
    unsigned char* Y;
    __device__ __forceinline__ bool operator()(const pg8::f32x4 (&acc)[2][2][4][2], const pg8::Unit& u, int wr, int wc, int fr, int fq, const LAS float* wl) const {
        const int odd = fq & 1; const int lr0 = wr * 64 + fr + odd * 16, col0 = u.c0 + wc * 32 + 8 * (fq - odd);
#pragma unroll
        for (int ai = 0; ai < 2; ++ai)
#pragma unroll
            for (int mp = 0; mp < 2; ++mp) { const int lr = lr0 + ai * 128 + mp * 32;
#pragma unroll
                for (int bj = 0; bj < 2; ++bj) { v2u w[2];
#pragma unroll
                    for (int mm = 0; mm < 2; ++mm) { pg8::f32x4 v0 = acc[ai][bj][2 * mp + mm][0] * (YSCALE / (W8SCALE * H8SCALE)), v1 = acc[ai][bj][2 * mp + mm][1] * (YSCALE / (W8SCALE * H8SCALE));
#pragma unroll
                        for (int j = 0; j < 4; ++j) { v0[j] = __builtin_amdgcn_fmed3f(v0[j], -448.0f, 448.0f); v1[j] = __builtin_amdgcn_fmed3f(v1[j], -448.0f, 448.0f); }
                        int t = __builtin_amdgcn_cvt_pk_fp8_f32(v0[0], v0[1], 0, false); t = __builtin_amdgcn_cvt_pk_fp8_f32(v0[2], v0[3], t, true); w[mm].x = (unsigned)t;
                        t = __builtin_amdgcn_cvt_pk_fp8_f32(v1[0], v1[1], 0, false); t = __builtin_amdgcn_cvt_pk_fp8_f32(v1[2], v1[3], t, true); w[mm].y = (unsigned)t; }
                    *(v4u*)(Y + (size_t)(u.r0 + lr) * DM + col0 + bj * 128) = pair16(w[0], w[1]); } }
        return false;
    }
};

__device__ __forceinline__ void p1b_qknorm(Frame& F) {
    const int gw = F.vcu * NWAVES + F.wave, NGW = F.G * NWAVES; const bf16* proj = (const bf16*)(F.ws + WS_PROJ);
    const int hf = F.lane >> 5, i = F.lane & 31;
    const float inv = __builtin_amdgcn_exp2f(-(float)(2 * i) * (1.0f / 64.0f) * 13.287712379549449f);
    const float gk0 = F.in[6][64 * hf + i], gk1 = F.in[6][64 * hf + 32 + i];
    for (int tok0 = gw; tok0 < SEQ; tok0 += 4 * NGW) {
        float x1[4][2], x2[4][2];
#pragma unroll
        for (int b = 0; b < 4; ++b) { const int tok = tok0 + b * NGW; const bf16* pq = proj + (size_t)(tok < SEQ ? tok : 0) * PLD + C_KB + 64 * hf + i;
#pragma unroll
            for (int hh = 0; hh < 2; ++hh) { x1[b][hh] = bf2f(pq[hh * HD]); x2[b][hh] = bf2f(pq[hh * HD + 32]); } }
        __builtin_amdgcn_sched_barrier(0);
#pragma unroll
        for (int b = 0; b < 4; ++b) { const int tok = tok0 + b * NGW;
            const float pos = (float)(hf == 0 ? (tok >> 6) : (tok & 63));
            const float rev = pos * inv * 0.15915494309189535f, fr = rev - floorf(rev);
            const float sn = __builtin_amdgcn_sinf(fr), cs = __builtin_amdgcn_cosf(fr);
#pragma unroll
            for (int hh = 0; hh < 2; ++hh) {
                const float ss = wave_sum(x1[b][hh] * x1[b][hh] + x2[b][hh] * x2[b][hh]);
                const float rs = 1.0f / sqrtf(ss * (1.0f / HD) + RMS_EPS);
                const float a = x1[b][hh] * rs * gk0, c = x2[b][hh] * rs * gk1;
                const float o1 = a * cs - c * sn, o2 = c * cs + a * sn;
                if (tok < SEQ) { unsigned char* kf = F.ws + WS_KF8 + (size_t)tok * 256 + hh * HD + 64 * hf + 32 * ((i >> 4) & 1) + (i & 15);
                    kf[0] = (unsigned char)(__builtin_amdgcn_cvt_pk_fp8_f32(o1, 0.f, 0, false) & 0xff); kf[16] = (unsigned char)(__builtin_amdgcn_cvt_pk_fp8_f32(o2, 0.f, 0, false) & 0xff); } } }
    }
}

__device__ __forceinline__ int t5_bucket(int rel) {
    const int n = rel < 0 ? -rel : rel; int b;
    if (n < 8) b = n; else if (n < 12) b = 8; else if (n < 16) b = 9; else if (n < 23) b = 10; else if (n < 32) b = 11; else if (n < 46) b = 12; else if (n < 64) b = 13; else if (n < 91) b = 14; else b = 15;
    return (rel > 0 ? 16 : 0) + b;
}
#ifndef ATT_PP
#define ATT_PP 1
#endif
#ifndef PROBE_ATT_KMASK
#define PROBE_ATT_KMASK (-1)
#endif
__device__ __forceinline__ void p3_dense_attention(Frame& F) {
    using abf = attn::bf16;
    char* lds = (char*)F.lds;
    const abf* proj = (const abf*)(F.ws + WS_PROJ);
    float gqm = fmaxf(fabsf(F.in[5][F.lane]), fabsf(F.in[5][F.lane + 64])), gkm = fmaxf(fabsf(F.in[6][F.lane]), fabsf(F.in[6][F.lane + 64]));
#pragma unroll
    for (int o = 1; o < 64; o <<= 1) { gqm = fmaxf(gqm, __shfl_xor(gqm, o)); gkm = fmaxf(gkm, __shfl_xor(gkm, o)); }
    const float sbound = 1.15f * 128.0f * gqm * gkm;
    for (int un = F.vcu; un < 256; un += F.G) {
        const int h = un >> 5, ub = un & 31, kvh = h >> 2;
        attn::attn_body<false, 1, true, true, true, -1, ATT_PP != 0>(proj + (size_t)(ub * 256) * PLD + C_QB + h * HD, proj + C_KB + kvh * HD, F.ws + WS_KF8 + kvh * HD, proj + C_VB + kvh * HD,
                               F.ws + WS_OB + (size_t)(ub * 256) * 1024 + h * HD, OB_SCALE, SEQ, lds, nullptr, 0, sbound, 0.f, F.in[5], ub * 256);
#ifdef PROBE_ATT2
        attn::attn_body<false, 1, true, true, true, PROBE_ATT_KMASK>(proj + (size_t)(ub * 256) * PLD + C_QB + h * HD, proj + C_KB + kvh * HD, F.ws + WS_KF8 + kvh * HD, proj + C_VB + kvh * HD,
                               F.ws + WS_MRG + (size_t)(ub * 256) * 1024 + h * HD, OB_SCALE, SEQ, lds, nullptr, 0, sbound, 0.f, F.in[5], ub * 256);
#endif
    }
}
__device__ __forceinline__ void win_attention(Frame& F, int first, int step) {
    using abf = attn::bf16;
    char* lds = (char*)F.lds;
    const abf* proj = (const abf*)(F.ws + WS_PROJ);
    for (int un = first; un < 256; un += step) {
        const int h = un >> 5, ub = un & 31, kvh = h >> 2;
        LAS float* tab = (LAS float*)(F.lds + attn::WIN_TAB);
        for (int e = F.tid; e < 1024; e += NWAVES * 64) { const int rel = e - 512; const int ar = rel < 0 ? -rel : rel;
            tab[e] = ar <= 128 ? F.in[4][t5_bucket(rel) * 8 + h] * (1.0f / attn::SCALE) : -1e30f; }
        __syncthreads();
        const int q0 = ub * 256; int kf = q0 - 128, ke = q0 + 384; if (kf < 0) kf = 0; if (ke > SEQ) ke = SEQ;
        const float sinkl = F.in[3][h] * (1.0f / attn::SCALE);
        attn::attn_body<true, 1, false, false>(proj + (size_t)q0 * PLD + C_QA + h * HD, proj + (size_t)kf * PLD + C_KA + kvh * HD, nullptr, proj + (size_t)kf * PLD + C_VA + kvh * HD,
                              F.ws + WS_OA + (size_t)q0 * 1024 + h * HD, OA_SCALE, ke - kf, lds, tab, kf - q0, sinkl, 1.0f);
    }
}

__device__ __forceinline__ void p5_ln_router(Frame& F, bool probe_rep = false) {
    typedef float f32x4v __attribute__((ext_vector_type(4)));
    const bf16* mixb = (const bf16*)(F.ws + WS_PRE); bf16* hbf = (bf16*)(F.ws + WS_HBF);
    const bf16* wrh = (const bf16*)(F.ws + WS_WR); const bf16* wrl = wrh + NEXP * DM;
    LAS float* red = (LAS float*)(F.lds);
    LAS float* part = (LAS float*)(F.lds + 4096);
    LAS int* cntl = (LAS int*)(F.lds + 4096 + 32768);
    LAS int* basel = cntl + 64;
    LAS int* rec_e = basel + 64;
    LAS int* rec_p = rec_e + 256;
    LAS float* rec_w = (LAS float*)(rec_p + 256);
    const int lane = F.lane, w = F.wave, gi = w >> 2, kq = w & 3, t = lane & 15, q = lane >> 4;
    for (int blk = F.vcu; blk < SEQ / 32; blk += F.G) {
        const int tok = blk * 32 + gi * 16 + t;
        if (F.tid < 64) cntl[F.tid] = 0;
        float s1 = 0.f, s2 = 0.f;
        const float* prow = F.in[0] + (size_t)tok * DM + kq * 512 + 4 * q; const bf16* mrow = mixb + (size_t)tok * DM + kq * 512 + 4 * q;
        f32x4v hv[16][2];
#pragma unroll
        for (int sg = 0; sg < 4; ++sg) {
            f32x4v xa[4][2]; v2u ma[4][2];
#pragma unroll
            for (int u = 0; u < 4; ++u) { const int s = 4 * sg + u; xa[u][0] = *(const f32x4v*)(prow + 32 * s); xa[u][1] = *(const f32x4v*)(prow + 32 * s + 16); ma[u][0] = *(const v2u*)(mrow + 32 * s); ma[u][1] = *(const v2u*)(mrow + 32 * s + 16); }
            __builtin_amdgcn_sched_barrier(0);
#pragma unroll
            for (int u = 0; u < 4; ++u) { const int s = 4 * sg + u; const v2u m0 = ma[u][0], m1 = ma[u][1];
                const f32x4v v0 = xa[u][0] * ALPHA + (f32x4v){pg8::bf_lo(m0.x), pg8::bf_hi(m0.x), pg8::bf_lo(m0.y), pg8::bf_hi(m0.y)}, v1 = xa[u][1] * ALPHA + (f32x4v){pg8::bf_lo(m1.x), pg8::bf_hi(m1.x), pg8::bf_lo(m1.y), pg8::bf_hi(m1.y)};
                hv[s][0] = v0; hv[s][1] = v1;
#pragma unroll
                for (int j = 0; j < 4; ++j) { s1 += v0[j] + v1[j]; s2 += v0[j] * v0[j] + v1[j] * v1[j]; } }
            __builtin_amdgcn_sched_barrier(0);
        }
        s1 += __shfl_xor(s1, 16); s1 += __shfl_xor(s1, 32); s2 += __shfl_xor(s2, 16); s2 += __shfl_xor(s2, 32);
        if (q == 0) { red[(w * 16 + t) * 2] = s1; red[(w * 16 + t) * 2 + 1] = s2; }
        __syncthreads();
        float m1 = 0.f, m2 = 0.f;
#pragma unroll
        for (int k = 0; k < 4; ++k) { m1 += red[((gi * 4 + k) * 16 + t) * 2]; m2 += red[((gi * 4 + k) * 16 + t) * 2 + 1]; }
        const float mean = m1 * (1.0f / DM); const float var = m2 * (1.0f / DM) - mean * mean; const float rstd = 1.0f / sqrtf(var + LN_EPS);
        f32x4v acc[4] = {};
        const float* gp = F.in[10] + kq * 512 + 4 * q; const float* bp = F.in[11] + kq * 512 + 4 * q;
        bf16* brow = hbf + (size_t)tok * DM + kq * 512 + 4 * q; unsigned char* frow = F.ws + WS_HF8 + (size_t)tok * DM + kq * 512 + 4 * q;
        struct P5Set { f32x4v g0, g1, b0, b1; bf16x8 Bh[4], Bl[4]; };
        P5Set A_; const unsigned lane8 = (unsigned)lane * 8u;
#define P5_LOAD(S, X) do { X.g0 = *(const f32x4v*)(gp + 32 * (S)); X.g1 = *(const f32x4v*)(gp + 32 * (S) + 16); X.b0 = *(const f32x4v*)(bp + 32 * (S)); X.b1 = *(const f32x4v*)(bp + 32 * (S) + 16); \
            { const bf16* wuh_ = wrh + (size_t)((kq * 16 + (S)) * 2048); const bf16* wul_ = wuh_ + NEXP * DM;     \
              asm volatile("" : "+s"(wuh_), "+s"(wul_));                                                         \
              _Pragma("unroll") for (int nt = 0; nt < 4; ++nt) { X.Bh[nt] = *(const bf16x8*)(wuh_ + nt * 512 + lane8); X.Bl[nt] = *(const bf16x8*)(wul_ + nt * 512 + lane8); } } } while (0)
#define P5_COMP(S, X) do { const f32x4v p0_ = hv[S][0], p1_ = hv[S][1]; \
            const f32x4v y0 = (p0_ - mean) * rstd * X.g0 + X.b0, y1 = (p1_ - mean) * rstd * X.g1 + X.b1; \
            v4u ah, al; ah.x = pg8::cvt_pk_bf16(y0[0], y0[1]); ah.y = pg8::cvt_pk_bf16(y0[2], y0[3]); ah.z = pg8::cvt_pk_bf16(y1[0], y1[1]); ah.w = pg8::cvt_pk_bf16(y1[2], y1[3]); \
            al.x = pg8::cvt_pk_bf16(y0[0] - pg8::bf_lo(ah.x), y0[1] - pg8::bf_hi(ah.x)); al.y = pg8::cvt_pk_bf16(y0[2] - pg8::bf_lo(ah.y), y0[3] - pg8::bf_hi(ah.y)); \
            al.z = pg8::cvt_pk_bf16(y1[0] - pg8::bf_lo(ah.z), y1[1] - pg8::bf_hi(ah.z)); al.w = pg8::cvt_pk_bf16(y1[2] - pg8::bf_lo(ah.w), y1[3] - pg8::bf_hi(ah.w)); \
            *(v2u*)(brow + 32 * (S)) = (v2u){ah.x, ah.y}; *(v2u*)(brow + 32 * (S) + 16) = (v2u){ah.z, ah.w}; \
            { int t0_ = __builtin_amdgcn_cvt_pk_fp8_f32(y0[0], y0[1], 0, false); t0_ = __builtin_amdgcn_cvt_pk_fp8_f32(y0[2], y0[3], t0_, true); \
              int t1_ = __builtin_amdgcn_cvt_pk_fp8_f32(y1[0], y1[1], 0, false); t1_ = __builtin_amdgcn_cvt_pk_fp8_f32(y1[2], y1[3], t1_, true); \
              *(int*)(frow + 32 * (S)) = t0_; *(int*)(frow + 32 * (S) + 16) = t1_; } \
            const bf16x8 Ah = __builtin_bit_cast(bf16x8, ah), Al = __builtin_bit_cast(bf16x8, al); \
            _Pragma("unroll") for (int nt = 0; nt < 4; ++nt) { acc[nt] = __builtin_amdgcn_mfma_f32_16x16x32_bf16(Ah, X.Bh[nt], acc[nt], 0, 0, 0); \
                acc[nt] = __builtin_amdgcn_mfma_f32_16x16x32_bf16(Al, X.Bh[nt], acc[nt], 0, 0, 0); acc[nt] = __builtin_amdgcn_mfma_f32_16x16x32_bf16(Ah, X.Bl[nt], acc[nt], 0, 0, 0); } } while (0)
#pragma unroll
        for (int s = 0; s < 16; ++s) {
            P5_LOAD(s, A_); __builtin_amdgcn_sched_barrier(0);
            P5_COMP(s, A_); __builtin_amdgcn_sched_barrier(0);
        }
#undef P5_LOAD
#undef P5_COMP
#pragma unroll
        for (int nt = 0; nt < 4; ++nt)
#pragma unroll
            for (int r = 0; r < 4; ++r) part[(w * 16 + 4 * q + r) * 64 + 16 * nt + t] = acc[nt][r];
        __syncthreads();
#ifdef PROBE_P5
        if (PROBE_P5 >= 2 && probe_rep) { __syncthreads(); continue; }
#endif
        const float rb = F.in[13][lane];
#pragma unroll 1
        for (int i = 0; i < 4; ++i) {
            const int tl = w * 4 + i, g2 = tl >> 4, tt = tl & 15;
            float logit = 0.f;
#pragma unroll
            for (int k = 0; k < 4; ++k) logit += part[((g2 * 4 + k) * 16 + tt) * 64 + lane];
            const float sc = 1.0f / (1.0f + expf(-logit));
            const float b = sc + rb;
            float mx = b; mx = fmaxf(mx, __shfl_xor(mx, 1)); mx = fmaxf(mx, __shfl_xor(mx, 2)); mx = fmaxf(mx, __shfl_xor(mx, 4));
            const unsigned long long bal = __ballot(b == mx); const unsigned gm = (unsigned)(bal >> (lane & ~7)) & 0xffu; const int first = __builtin_ctz(gm);
            float b2 = ((lane & 7) == first) ? -INFINITY : b; b2 = fmaxf(b2, __shfl_xor(b2, 1)); b2 = fmaxf(b2, __shfl_xor(b2, 2)); b2 = fmaxf(b2, __shfl_xor(b2, 4));
            const float gs = mx + b2; const int grp = lane >> 3; int gc = 0;
#pragma unroll
            for (int g3 = 0; g3 < 8; ++g3) { const float o = __uint_as_float(__builtin_amdgcn_readlane(__float_as_uint(gs), g3 * 8)); gc += (o > gs || (o == gs && g3 < grp)) ? 1 : 0; }
            const float mk = gc < 4 ? b : -INFINITY; int rank = 0;
#pragma unroll
            for (int j = 0; j < 64; ++j) { const float o = __uint_as_float(__builtin_amdgcn_readlane(__float_as_uint(mk), j)); rank += (o > mk || (o == mk && j < lane)) ? 1 : 0; }
            const bool sel = (gc < 4) && rank < 8;
            const float wsum = wave_sum(sel ? sc : 0.f);
            if (sel) { const int lp = atomicAdd((int*)(cntl + lane), 1); rec_e[tl * 8 + rank] = lane; rec_p[tl * 8 + rank] = lp; rec_w[tl * 8 + rank] = sc / wsum * ROUTED_SCALE; }
        }
        __syncthreads();
#ifdef PROBE_P5
        if (PROBE_P5 == 1 && probe_rep) { __syncthreads(); continue; }
#endif
        if (F.tid < 64) basel[F.tid] = (int)atomicAdd(F.ctl + CW_CNT + F.tid, (unsigned)cntl[F.tid]);
        __syncthreads();
        if (F.tid < 256) { const int tl = F.tid >> 3, e = rec_e[F.tid], pos = basel[e] + rec_p[F.tid]; const int token = blk * 32 + tl;
            ((int*)(F.ws + WS_LTOK))[e * LCAP + pos] = token; ((float*)(F.ws + WS_LW))[e * LCAP + pos] = rec_w[F.tid];
            int* rt = (int*)(F.ws + WS_ROUTE); rt[(token * 8 + (F.tid & 7)) * 2] = e; rt[(token * 8 + (F.tid & 7)) * 2 + 1] = pos; }
        __syncthreads();
    }
}

__device__ __forceinline__ void moe_build_tst(Frame& F) {
    LAS int* tst = (LAS int*)(F.lds + TST_OFF);
    if (F.tid == 0) { int acc = 0; for (int e = 0; e < NEXP1; ++e) { tst[e] = acc; const unsigned c = e < NEXP ? __hip_atomic_load(F.ctl + CW_CNT + e, RLX_AGENT) : (unsigned)SEQ; acc += (int)((c + 255u) >> 8); } tst[NEXP1] = acc; }
    __syncthreads();
}

__device__ __forceinline__ void p9_combine(Frame& F) {
    const LAS int* tst = (const LAS int*)(F.lds + TST_OFF);
    const int gw = F.vcu * NWAVES + F.wave, NGW = F.G * NWAVES; const int lane = F.lane;
    const unsigned char* Y = (const unsigned char*)(F.ws + WS_Y); const bf16* hbf = (const bf16*)(F.ws + WS_HBF); const int* rt = (const int*)(F.ws + WS_ROUTE);
    unsigned rows[9];
#define P9_ROWS(dst, tok_) do { _Pragma("unroll") for (int k = 0; k < 8; ++k) { const int e = rt[((tok_) * 8 + k) * 2], pos = rt[((tok_) * 8 + k) * 2 + 1]; dst[k] = (unsigned)(tst[e] * 256 + pos) * (DM / 8); } \
        dst[8] = (unsigned)(tst[NEXP] * 256 + (tok_)) * (DM / 8); } while (0)
    for (int tok = gw; tok < SEQ; tok += NGW) {
        P9_ROWS(rows, tok);
        float v[4][8]; float s1 = 0.f;
#pragma unroll
        for (int c = 0; c < 4; ++c) { const int col = 512 * c + 8 * lane;
            const v4u hv = __builtin_nontemporal_load((const v4u*)(hbf + (size_t)tok * DM + col));
            const f32x4 a = {pg8::bf_lo(hv.x), pg8::bf_hi(hv.x), pg8::bf_lo(hv.y), pg8::bf_hi(hv.y)}, b = {pg8::bf_lo(hv.z), pg8::bf_hi(hv.z), pg8::bf_lo(hv.w), pg8::bf_hi(hv.w)};
            float r[8] = {0.f, 0.f, 0.f, 0.f, 0.f, 0.f, 0.f, 0.f};
#pragma unroll
            for (int k = 0; k < 9; ++k) { const v2u y = __builtin_nontemporal_load((const v2u*)Y + (size_t)rows[k] + (col >> 3));
                const auto q0 = __builtin_amdgcn_cvt_pk_f32_fp8((int)y.x, false), q1 = __builtin_amdgcn_cvt_pk_f32_fp8((int)y.x, true), q2 = __builtin_amdgcn_cvt_pk_f32_fp8((int)y.y, false), q3 = __builtin_amdgcn_cvt_pk_f32_fp8((int)y.y, true);
                r[0] += q0[0]; r[1] += q0[1]; r[2] += q1[0]; r[3] += q1[1]; r[4] += q2[0]; r[5] += q2[1]; r[6] += q3[0]; r[7] += q3[1]; }
#pragma unroll
            for (int j = 0; j < 4; ++j) { v[c][j] = ALPHA * a[j] + r[j] * (1.0f / YSCALE); v[c][4 + j] = ALPHA * b[j] + r[4 + j] * (1.0f / YSCALE); }
#pragma unroll
            for (int j = 0; j < 8; ++j) s1 += v[c][j]; }
        const float mean = wave_sum(s1) * (1.0f / DM); float s2 = 0.f;
#pragma unroll
        for (int c = 0; c < 4; ++c)
#pragma unroll
            for (int j = 0; j < 8; ++j) { v[c][j] -= mean; s2 += v[c][j] * v[c][j]; }
        const float rstd = 1.0f / sqrtf(wave_sum(s2) * (1.0f / DM) + LN_EPS);
#pragma unroll
        for (int c = 0; c < 4; ++c) { const int col = 512 * c + 8 * lane;
            const f32x4 g0 = *(const f32x4*)(F.in[20] + col), g1 = *(const f32x4*)(F.in[20] + col + 4), b0 = *(const f32x4*)(F.in[21] + col), b1 = *(const f32x4*)(F.in[21] + col + 4);
            f32x4 o0, o1;
#pragma unroll
            for (int j = 0; j < 4; ++j) { o0[j] = v[c][j] * rstd * g0[j] + b0[j]; o1[j] = v[c][4 + j] * rstd * g1[j] + b1[j]; }
            __builtin_nontemporal_store(o0, (f32x4*)(F.out + (size_t)tok * DM + col)); __builtin_nontemporal_store(o1, (f32x4*)(F.out + (size_t)tok * DM + col + 4)); }
    }
#undef P9_ROWS
}

constexpr int NPHASES = 10;
#ifndef MK_ONE_LAUNCH
#define MK_ONE_LAUNCH 1
#endif
__global__ void __launch_bounds__(NWAVES * 64, 2) mega_fwd(Args args) {
    extern __shared__ __attribute__((aligned(16))) unsigned char lds[];
    Frame F;
    F.lds = (LAS unsigned char*)lds;
    F.MISC = (volatile LAS unsigned*)(F.lds + MISC_OFF);
    F.tid = threadIdx.x; F.lane = F.tid & 63; F.wave = __builtin_amdgcn_readfirstlane(F.tid >> 6);
    F.G = gridDim.x; { const int bx = blockIdx.x; F.vcu = (F.G % 8 == 0) ? (bx % 8) * (F.G / 8) + bx / 8 : bx; }
#pragma unroll
    for (int i = 0; i < 22; ++i) F.in[i] = args.in[i];
    F.out = args.out; F.ws = args.ws; F.ctl = (unsigned*)(args.ws + WS_CTL);
    for (int u = F.tid; u < (LDS_BYTES - LDSCTL_OFF) / 4; u += NWAVES * 64) ((LAS unsigned*)(F.lds + LDSCTL_OFF))[u] = 0u;
    __syncthreads();
    XcdBarrier bar; bar.bar = F.ctl + CW_BAR; bar.x = 0; bar.st = nullptr; bar.total = 0; XcdBarrier barB = bar;
    const bool conv1 = (F.G == 256) && (F.vcu & 31) >= P1_NCG;
    if (MK_ONE_LAUNCH) { bar = xcd_barrier_post(F.ctl + CW_BAR, F.MISC + 8, (unsigned)F.G); }
    const int lo = args.ph_lo, hi = args.ph_hi;
#ifndef PH_MASK
#define PH_MASK 0x3ff
#endif
#define IN(k) (((PH_MASK >> (k)) & 1) && lo <= (k) && (k) < hi)
#ifndef REP_MASK
#define REP_MASK 0
#endif
#define REP(k) for (int rep_ = 0; rep_ < 1 + ((REP_MASK >> (k)) & 1); ++rep_)
#ifndef BAR_REP
#define BAR_REP 1
#endif
#define SEAM(k) do { if (IN(k) && IN((k) + 1)) for (int br_ = 0; br_ < BAR_REP; ++br_) xcd_barrier(bar); } while (0)
    LAS int* idxl = (LAS int*)(F.lds + IDXL_OFF);
    const bool tst_needed = true;

    if (IN(0)) REP(0) { p0_prologue(F, false); } SEAM(0);
    if (IN(1)) REP(1) {
        const int grp = F.vcu >> 5, cin = F.vcu & 31;
        const bool conv = (F.G == 256) && cin >= P1_NCG;
        if (conv) { const int cw = (grp * (32 - P1_NCG) + (cin - P1_NCG)) * NWAVES + F.wave; convert_items<1>(F, cw, NCONV1 * NWAVES, E_SPLIT); convert_items<2>(F, cw, NCONV1 * NWAVES, E2_A); }
        else {
            DenseOrder S; if (F.G == 256) S.init(F.ws + WS_XBF, F.ws + WS_WINT, SEQ, INC, DM, NCOMP1, cin * 8 + grp); else S.init(F.ws + WS_XBF, F.ws + WS_WINT, SEQ, INC, DM, F.G, (int)blockIdx.x);
            EpiProj E{(bf16*)(F.ws + WS_PROJ), F.in[2]};
            pg8::gemm_phase<EpiProj, DenseOrder, true, false, P1_FP8 != 0>(F.lds + RING_OFF, idxl, DM, S, E);
        }
    } SEAM(1);
    if (IN(2)) {
        p1b_qknorm(F);
        if (F.G == 256) {
            if (E_SPLIT >= NITEMS_E1 && (CONV_G1 ? E2_SPLIT : E2_A) >= NITEMS_E2) win_attention(F, F.vcu, 256);
            else if (F.vcu & 1) win_attention(F, F.vcu >> 1, 128);
            else { const int cw = (F.vcu >> 1) * NWAVES + F.wave;
                convert_items<1>(F, E_SPLIT + cw, 128 * NWAVES, NITEMS_E1); convert_items<2>(F, (CONV_G1 ? E2_SPLIT : E2_A) + cw, 128 * NWAVES, NITEMS_E2); }
        } else { win_attention(F, F.vcu, F.G); convert_items<1>(F, F.vcu * NWAVES + F.wave, F.G * NWAVES, NITEMS_E1); convert_items<2>(F, F.vcu * NWAVES + F.wave, F.G * NWAVES, NITEMS_E2); }
    } SEAM(2);
    if (IN(3)) REP(3) { p3_dense_attention(F); } SEAM(3);
    if (IN(4)) REP(4) {
        BranchOrder S{(const char*)(F.ws + WS_OA), (const char*)(F.ws + WS_OB), (const char*)(F.ws + WS_WAT), (const char*)(F.ws + WS_WBT), F.vcu};
        EpiBranch E{(const bf16*)(F.ws + WS_PROJ), F.ws + WS_MRG};
        if (F.vcu < 256) pg8::gemm_phase<EpiBranch, BranchOrder, false, false, true>(F.lds + RING_OFF, idxl, 1024, S, E);
    } SEAM(4);
    if (IN(5)) REP(5) {
        OneTileOrder S{(const char*)(F.ws + WS_MRG), (const char*)(F.ws + WS_WOT), F.vcu, (size_t)256 * DM};
        EpiMix E{(bf16*)(F.ws + WS_PRE)};
        if (F.vcu < 256) pg8::gemm_phase<EpiMix, OneTileOrder, false, false, true>(F.lds + RING_OFF, idxl, DM, S, E);
    } SEAM(5);
    if (IN(6)) REP(6) { if (rep_) { xcd_barrier(bar);
#ifndef PROBE_P5
            if (blockIdx.x == 0 && F.tid < 64) __hip_atomic_store(F.ctl + CW_CNT + F.tid, 0u, RLX_AGENT);
#endif
            xcd_barrier(bar); } p5_ln_router(F, rep_ != 0); } SEAM(6);
    if (IN(7) || IN(8) || IN(9)) { if (tst_needed) moe_build_tst(F); }
#ifndef DEFER_MAX
#define DEFER_MAX 64
#endif
    int n_defer = 0, u1_end = -1;
    if (IN(7) || IN(8)) { const int T_ = ((const LAS int*)(F.lds + TST_OFF))[NEXP1]; const int r_ = (4 * T_) % 256;
        if (F.G == 256 && !CONV_G1 && 4 * T_ > 256 && r_ > 0 && r_ <= DEFER_MAX && (lo <= 7 && 8 < hi)) { n_defer = r_; u1_end = 4 * T_ - r_; } }
    if (IN(7)) REP(7) {
        const bool split = CONV_G1 && F.G == 256, conv = split && ((F.vcu & 7) == 7);
        if (conv) { convert_items<2>(F, E2_A + (F.vcu >> 3) * NWAVES + F.wave, NCONV * NWAVES, E2_SPLIT); }
        else {
        MoeOrder<4> S{(const LAS int*)(F.lds + TST_OFF), (const char*)(F.ws + (G1_FP8 ? WS_HF8 : WS_HBF)), (const char*)(F.ws + WS_WGU), (const int*)(F.ws + WS_LTOK), (const float*)(F.ws + WS_LW), split ? F.vcu - (F.vcu >> 3) : F.vcu, split ? NCOMP : F.G, 0, (size_t)1024 * DM * (G1_FP8 ? 1 : 2), (size_t)256 * DM * (G1_FP8 ? 1 : 2), true,
                      0, u1_end, 0, nullptr, 0, 0};
        EpiMoe1 E{F.ws + WS_HID};
        pg8::gemm_phase<EpiMoe1, MoeOrder<4>, true, true, G1_FP8 != 0>(F.lds + RING_OFF, idxl, DM, S, E);
        }
    } SEAM(7);
    if (IN(8)) REP(8) {
        unsigned* dflag = F.ctl + CW_CNT + 128;
        if (n_defer > 0 && F.vcu >= 256 - n_defer) {
            MoeOrder<4> S1{(const LAS int*)(F.lds + TST_OFF), (const char*)(F.ws + (G1_FP8 ? WS_HF8 : WS_HBF)), (const char*)(F.ws + WS_WGU), (const int*)(F.ws + WS_LTOK), (const float*)(F.ws + WS_LW), F.vcu - (256 - n_defer), 256, 0, (size_t)1024 * DM * (G1_FP8 ? 1 : 2), (size_t)256 * DM * (G1_FP8 ? 1 : 2), true,
                           u1_end, u1_end + n_defer, 0, nullptr, 0, 0};
            EpiMoe1 E1{F.ws + WS_HID};
            pg8::gemm_phase<EpiMoe1, MoeOrder<4>, true, true, G1_FP8 != 0>(F.lds + RING_OFF, idxl, DM, S1, E1);
            if (F.tid == 0) { __builtin_amdgcn_fence(__ATOMIC_RELEASE, "agent"); asm volatile("s_waitcnt vmcnt(0)" ::: "memory"); __hip_atomic_fetch_add(dflag, 1u, __ATOMIC_RELAXED, __HIP_MEMORY_SCOPE_AGENT); }
        }
        MoeOrder<8> S{(const LAS int*)(F.lds + TST_OFF), (const char*)(F.ws + WS_HID), (const char*)(F.ws + WS_WD), (const int*)(F.ws + WS_LTOK), (const float*)(F.ws + WS_LW), F.vcu, F.G, (size_t)FE, (size_t)DM * FE, (size_t)256 * FE, false,
                      0, -1, n_defer, dflag, n_defer > 0 ? u1_end / 4 : 0, n_defer};
#ifndef G2_ALIGN
#define G2_ALIGN true
#endif
        EpiMoe2 E{(unsigned char*)(F.ws + WS_Y)};
        pg8::gemm_phase<EpiMoe2, MoeOrder<8>, G2_ALIGN, false, true>(F.lds + RING_OFF, idxl, FE, S, E);
    } SEAM(8);
    if (IN(9)) REP(9) { p9_combine(F); }
#ifdef PROBE_T
    { const LAS int* tst_ = (const LAS int*)(F.lds + TST_OFF); if (tst_[NEXP1] > PROBE_T && blockIdx.x == 0 && F.tid == 0) F.out[0] = __builtin_nanf(""); }
#endif
#undef IN
#undef SEAM
}

extern "C" void kernel_launch(void* const* d_in, const int* in_sizes, int n_in, void* d_out, int out_size, void* d_ws, size_t ws_size, hipStream_t stream) {
    static int grid = 0;
    if (grid == 0) {
        if (n_in != 22 || out_size != SEQ * DM || ws_size < WS_END) { fprintf(stderr, "kernel_launch: unexpected shapes (n_in %d, out %d, ws %zu < %zu); nothing launched\n", n_in, out_size, ws_size, (size_t)WS_END); grid = -1; return; }
        int dev = 0, cus = 0, per_cu = 0;
        if (hipGetDevice(&dev) != hipSuccess || hipDeviceGetAttribute(&cus, hipDeviceAttributeMultiprocessorCount, dev) != hipSuccess) { grid = -1; return; }
        if (hipFuncSetAttribute((const void*)mega_fwd, hipFuncAttributeMaxDynamicSharedMemorySize, LDS_BYTES) != hipSuccess) { fprintf(stderr, "kernel_launch: hipFuncSetAttribute failed\n"); grid = -1; return; }
        if (hipOccupancyMaxActiveBlocksPerMultiprocessor(&per_cu, (const void*)mega_fwd, NWAVES * 64, LDS_BYTES) != hipSuccess || per_cu < 1) { fprintf(stderr, "kernel_launch: occupancy query says %d blocks per CU; nothing launched\n", per_cu); (void)hipGetLastError(); grid = -1; return; }
        grid = cus;
        if (grid > 256) grid = 256;
    }
    if (grid < 0) return;
    (void)hipMemsetAsync((char*)d_ws + WS_CTL, 0, CTL_ZERO_BYTES, stream);
    Args a{};
    for (int i = 0; i < 22; ++i) a.in[i] = (const float*)d_in[i];
    a.out = (float*)d_out; a.ws = (unsigned char*)d_ws;
#if MK_ONE_LAUNCH
    a.ph_lo = 0; a.ph_hi = NPHASES;
    hipLaunchKernelGGL(mega_fwd, dim3(grid), dim3(NWAVES * 64), LDS_BYTES, stream, a);
#else
    for (int p = 0; p < NPHASES; ++p) { a.ph_lo = p; a.ph_hi = p + 1; hipLaunchKernelGGL(mega_fwd, dim3(grid), dim3(NWAVES * 64), LDS_BYTES, stream, a); }
#endif
    const hipError_t le = hipPeekAtLastError();
    if (le != hipSuccess) fprintf(stderr, "kernel_launch: launch failed: %s\n", hipGetErrorName(le));
}
```

```cpp
#define P1_NCG 13
#define CONV_Q 59
#define P1_QE2 28
#define CONV_G1 0
#include <hip/hip_runtime.h>
#include <hip/hip_bf16.h>
#include <cstdio>
#include <cstdint>
#include <cmath>
namespace pg8 {
#define PG8_LAS __attribute__((address_space(3)))
typedef unsigned short bf16_t;
typedef short bf16x8 __attribute__((ext_vector_type(8)));
typedef float f32x4 __attribute__((ext_vector_type(4)));
typedef unsigned u32x4 __attribute__((ext_vector_type(4)));
typedef int v4i_t __attribute__((ext_vector_type(4)));
typedef int v8i_t __attribute__((ext_vector_type(8)));
constexpr int BM = 256, BK = 64, HALF = 128, HTB = HALF * BK * 2  , STAGE_BYTES = 8 * HTB;

__host__ __device__ __forceinline__ int lds_byte(int r, int c) { const int st = (r >> 4) * 2 + (c >> 5), rr = r & 15, cc = c & 31, ob = rr * 64 + cc * 2; return st * 1024 + (ob ^ (((ob >> 9) & 1) << 5)); }
__host__ __device__ __forceinline__ void stage_rc(int b, int& R, int& C) { const int st = b / 1024, sb = b % 1024, swz = sb ^ (((sb >> 9) & 1) << 5); R = (st >> 1) * 16 + swz / 64; C = (st & 1) * 32 + (swz % 64) / 2; }
__host__ __device__ __forceinline__ int perm32(int rho) { const int n = rho >> 4, i = rho & 15; return 8 * (i >> 2) + 4 * n + (i & 3); }

struct Unit { const char* A; const char* B; const int* idx; const float* wts; int r0, c0, aux, kind; };

typedef float f32x2_t __attribute__((ext_vector_type(2))); typedef __bf16 bf16x2_t __attribute__((ext_vector_type(2)));
__device__ __forceinline__ unsigned cvt_pk_bf16(float lo, float hi) { f32x2_t v = {lo, hi}; bf16x2_t b = __builtin_convertvector(v, bf16x2_t); return __builtin_bit_cast(unsigned, b); }
__device__ __forceinline__ float bf_lo(unsigned w) { return __uint_as_float(w << 16); }
__device__ __forceinline__ float bf_hi(unsigned w) { return __uint_as_float(w & 0xffff0000u); }

template <class Epi, class Sched, bool ALIGN_EPI, bool GATHER, bool FP8 = false>
__device__ __forceinline__ void gemm_phase(PG8_LAS unsigned char* lds, PG8_LAS int* idxl, const int K, const Sched& S, const Epi& E) {
    PG8_LAS float* wl = (PG8_LAS float*)(idxl + 256);
    const int tid = threadIdx.x, wid = __builtin_amdgcn_readfirstlane(tid >> 6), lane = tid & 63, wr = wid >> 2, wc = wid & 3, fr = lane & 15, fq = lane >> 4;
    const int KB = FP8 ? K : 2 * K;
    const int nt = KB / 128;
    const size_t kstep = (size_t)(BK * 2);
    const size_t hstep = (size_t)HALF * KB;
    unsigned voffA0[2], voffA1[2], voffB[2];
#pragma unroll
    for (int i = 0; i < 2; ++i) { int R, C; stage_rc(tid * 16 + i * 8192, R, C); const int Rb = Epi::PERM ? ((R & ~31) + perm32(R & 31)) : R;
        voffA0[i] = (unsigned)(R * KB + C * 2); voffA1[i] = voffA0[i] + (unsigned)hstep; voffB[i] = (unsigned)(Rb * KB + C * 2); }
    const unsigned ldsw = (unsigned)wid * 1024u;
    const int aoff = FP8 ? lds_byte(wr * 64 + fr, (fq >> 1) * 32 + (fq & 1) * 16) : lds_byte(wr * 64 + fr, fq * 8), boff = FP8 ? lds_byte(wc * 32 + fr, (fq >> 1) * 32 + (fq & 1) * 16) : lds_byte(wc * 32 + fr, fq * 8);
#define PG8_SA(b, h) (((b) * 2 + (h)) * HTB)
#define PG8_SB(b, h) ((4 + (b) * 2 + (h)) * HTB)
#define PG8_STAGE(bufoff, gbase, voff) do { _Pragma("unroll") for (int _i = 0; _i < 2; ++_i) \
        __builtin_amdgcn_global_load_lds((const unsigned*)((const char*)(gbase) + (voff)[_i]), (PG8_LAS unsigned*)(lds + (bufoff) + ldsw + _i * 8192), 16, 0, 0); } while (0)
#define PG8_LD8(addr) __builtin_shufflevector(*(const PG8_LAS v4i_t*)(addr), *(const PG8_LAS v4i_t*)((addr) + 16), 0, 1, 2, 3, 4, 5, 6, 7)
#define PG8_LDA(dst, b, h) do { if constexpr (FP8) { _Pragma("unroll") for (int m = 0; m < 4; ++m) dst##8[m] = PG8_LD8(lds + PG8_SA(b, h) + aoff + m * 2048); } \
        else { _Pragma("unroll") for (int m = 0; m < 4; ++m) _Pragma("unroll") for (int k = 0; k < 2; ++k) dst[m][k] = *(const PG8_LAS bf16x8*)(lds + PG8_SA(b, h) + aoff + m * 2048 + k * 1024); } } while (0)
#define PG8_LDB(dst, b, h) do { if constexpr (FP8) { _Pragma("unroll") for (int n = 0; n < 2; ++n) dst##8[n] = PG8_LD8(lds + PG8_SB(b, h) + boff + n * 2048); } \
        else { _Pragma("unroll") for (int n = 0; n < 2; ++n) _Pragma("unroll") for (int k = 0; k < 2; ++k) dst[n][k] = *(const PG8_LAS bf16x8*)(lds + PG8_SB(b, h) + boff + n * 2048 + k * 1024); } } while (0)
#define PG8_MMA(ai, bj, At, Bt) do { __builtin_amdgcn_s_setprio(1); _Pragma("unroll") for (int m = 0; m < 4; ++m) _Pragma("unroll") for (int n = 0; n < 2; ++n) { \
        if constexpr (FP8) asm volatile("v_mfma_scale_f32_16x16x128_f8f6f4 %0, %1, %2, %0, %3, %3 op_sel_hi:[0,0,0]" : "+v"(acc[ai][bj][m][n]) : "v"(Bt##8[n]), "v"(At##8[m]), "v"(one_scale)); \
        else { _Pragma("unroll") for (int k = 0; k < 2; ++k) acc[ai][bj][m][n] = __builtin_amdgcn_mfma_f32_16x16x32_bf16(Bt[n][k], At[m][k], acc[ai][bj][m][n], 0, 0, 0); } } __builtin_amdgcn_s_setprio(0); } while (0)
#define PG8_WAIT_V(n) asm volatile("s_waitcnt vmcnt(" #n ")" ::: "memory")
#define PG8_WAIT_L(n) asm volatile("s_waitcnt lgkmcnt(" #n ")" ::: "memory")
#define PG8_WAIT_VN(n) asm volatile("s_waitcnt vmcnt(%0)" :: "n"(n) : "memory")
#define PG8_WAIT_VR(sel) do { if constexpr (Epi::NST > 0) { int _sg; asm volatile("v_readfirstlane_b32 %0, %1\n\ts_nop 0\n\ts_cmp_lg_u32 %0, 0\n\ts_cbranch_scc1 1f\n\ts_waitcnt vmcnt(8)\n\ts_branch 2f\n1:\n\ts_waitcnt vmcnt(%2)\n2:" \
            : "=&s"(_sg) : "v"(sel), "n"(8 + Epi::NST) : "memory", "scc"); } \
        else asm volatile("s_waitcnt vmcnt(8)" ::: "memory"); } while (0)
#define PG8_BAR __builtin_amdgcn_s_barrier()
#define PG8_SCHED __builtin_amdgcn_sched_barrier(0)
#define PG8_GOFF(src) do { _Pragma("unroll") for (int _i = 0; _i < 2; ++_i) { int R_, C_; stage_rc(tid * 16 + _i * 8192, R_, C_); \
        voffA0[_i] = (unsigned)((src)[R_] * KB + C_ * 2); voffA1[_i] = (unsigned)((src)[R_ + HALF] * KB + C_ * 2); } } while (0)
    Unit cur, nxt; int ui = 0;
    if (!S.next(0, cur)) return;
    f32x4 acc[2][2][4][2];
#pragma unroll
    for (int a = 0; a < 2; ++a)
#pragma unroll
        for (int b = 0; b < 2; ++b)
#pragma unroll
            for (int m = 0; m < 4; ++m)
#pragma unroll
                for (int n = 0; n < 2; ++n) acc[a][b][m][n] = (f32x4){0.f, 0.f, 0.f, 0.f};
    bf16x8 At[4][2], B0[2][2], B1[2][2];
    v8i_t At8[4], B08[2], B18[2];
    int one_scale = 0x7f7f7f7f; asm volatile("" : "+v"(one_scale));
    const char* cA = cur.A; const char* cB = cur.B;
    if constexpr (GATHER) { PG8_GOFF(cur.idx); if (tid >= 256) wl[tid - 256] = cur.wts[tid - 256]; }
    PG8_STAGE(PG8_SB(0, 0), cB, voffB); PG8_STAGE(PG8_SB(0, 1), cB + hstep, voffB); PG8_STAGE(PG8_SA(0, 0), cA, voffA0); PG8_STAGE(PG8_SA(0, 1), cA, voffA1);
    if (wr == 1) PG8_BAR;
    PG8_WAIT_V(2); PG8_BAR;
    PG8_STAGE(PG8_SB(1, 0), cB + kstep, voffB); PG8_STAGE(PG8_SA(1, 0), cA + kstep, voffA0); PG8_STAGE(PG8_SB(1, 1), cB + hstep + kstep, voffB);
    PG8_WAIT_V(6); PG8_BAR;
    for (;;) {
        const bool has_next = S.next(ui + 1, nxt);
        const char* nA = has_next ? nxt.A : cA; const char* nB = has_next ? nxt.B : cB;
        if constexpr (GATHER) { if (has_next && tid < 256) {
            __builtin_amdgcn_global_load_lds((const unsigned*)(nxt.idx + tid), (PG8_LAS unsigned*)((PG8_LAS unsigned char*)idxl + wid * 256), 4, 0, 0); }
          if (has_next && tid >= 256) {
            __builtin_amdgcn_global_load_lds((const unsigned*)(nxt.wts + (tid - 256)), (PG8_LAS unsigned*)((PG8_LAS unsigned char*)(wl + ((ui + 1) & 1) * 256) + (wid - 4) * 256), 4, 0, 0); } }
#pragma unroll 1
        for (int t = 0; t < nt; t += 2) {
            const bool last = (t == nt - 2);
            const char* a1 = cA + (size_t)(t + 1) * kstep;
            const char* a2 = last ? nA : cA + (size_t)(t + 2) * kstep; const char* b2 = last ? nB : cB + (size_t)(t + 2) * kstep;
            const char* a3 = a2 + kstep; const char* b3 = b2 + kstep;
            const int rlx = (t == 0 && ui > 0) ? 1 : 0;
            PG8_LDB(B0, 0, 0); PG8_LDB(B1, 0, 1); PG8_SCHED; PG8_LDA(At, 0, 0); PG8_STAGE(PG8_SA(1, 1), a1, voffA1);
            if constexpr (GATHER) { if (last && has_next) { PG8_GOFF(idxl); } }
            PG8_WAIT_VR(rlx); PG8_WAIT_L(0); PG8_BAR; PG8_MMA(0, 0, At, B0); PG8_MMA(0, 1, At, B1); PG8_BAR; PG8_SCHED;
            PG8_LDA(At, 0, 1); PG8_STAGE(PG8_SB(0, 0), b2, voffB); PG8_STAGE(PG8_SB(0, 1), b2 + hstep, voffB); PG8_STAGE(PG8_SA(0, 0), a2, voffA0);
            PG8_WAIT_VR(rlx); PG8_WAIT_L(0); PG8_BAR; PG8_MMA(1, 0, At, B0); PG8_MMA(1, 1, At, B1); PG8_BAR; PG8_SCHED;
            PG8_LDB(B0, 1, 0); PG8_LDB(B1, 1, 1); PG8_SCHED; PG8_LDA(At, 1, 0); PG8_STAGE(PG8_SA(0, 1), a2, voffA1);
            PG8_WAIT_V(8); PG8_WAIT_L(0); PG8_BAR; PG8_MMA(0, 0, At, B0); PG8_MMA(0, 1, At, B1); PG8_BAR; PG8_SCHED;
            PG8_LDA(At, 1, 1); PG8_STAGE(PG8_SB(1, 0), b3, voffB); PG8_STAGE(PG8_SB(1, 1), b3 + hstep, voffB); PG8_STAGE(PG8_SA(1, 0), a3, voffA0);
            PG8_WAIT_V(8); PG8_WAIT_L(0); PG8_BAR; PG8_MMA(1, 0, At, B0); PG8_MMA(1, 1, At, B1); PG8_BAR; PG8_SCHED;
        }
        if constexpr (ALIGN_EPI) { if (wr == 0) PG8_BAR; }
        if constexpr (FP8) asm volatile("s_nop 15\n\ts_nop 15" ::: "memory");
        const bool keep = E(acc, cur, wr, wc, fr, fq, wl + (ui & 1) * 256);
        if (!has_next) break;
        if (!keep) {
#pragma unroll
        for (int a = 0; a < 2; ++a)
#pragma unroll
            for (int b = 0; b < 2; ++b)
#pragma unroll
                for (int m = 0; m < 4; ++m)
#pragma unroll
                    for (int n = 0; n < 2; ++n) acc[a][b][m][n] = (f32x4){0.f, 0.f, 0.f, 0.f};
        }
        cur = nxt; cA = nA; cB = nB; ++ui;
        if constexpr (ALIGN_EPI) { if (wr == 1) PG8_BAR; }
    }
    PG8_WAIT_V(0);
    if constexpr (!ALIGN_EPI) { if (wr == 0) PG8_BAR; }
    PG8_BAR;
#undef PG8_SA
#undef PG8_SB
#undef PG8_STAGE
#undef PG8_LDA
#undef PG8_LDB
#undef PG8_MMA
#undef PG8_LD8
#undef PG8_WAIT_V
#undef PG8_WAIT_L
#undef PG8_WAIT_VN
#undef PG8_WAIT_VR
#undef PG8_BAR
#undef PG8_SCHED
#undef PG8_GOFF
}
}
namespace attn {
using bf16 = __hip_bfloat16;
constexpr int   D = 128, NW = 8, QBLK = 32, KVBLK = 64;
constexpr float SCALE = 0.088388347648318440f;
constexpr float THR = 8.f;
constexpr float LOG2E = 1.4426950408889634f;
#ifndef PROJ_PAD
#define PROJ_PAD 64
#endif
constexpr int LDQ = 7168 + PROJ_PAD, LDK = 7168 + PROJ_PAD, LDO = 1024;
constexpr size_t SHM_V = KVBLK * D * 2, SHM_K = KVBLK * D * 2, SHM_ATTN = 2 * SHM_V + 2 * SHM_K + NW * 64 * 4;
constexpr int WIN_TAB = (int)SHM_ATTN;

using bf16x8 = __attribute__((ext_vector_type(8))) short;
using s16x4  = __attribute__((ext_vector_type(4))) short;
using f32x16 = __attribute__((ext_vector_type(16))) float;
using u32x4  = __attribute__((ext_vector_type(4))) unsigned;
using f32x4_a = __attribute__((ext_vector_type(4))) float;
#define KSWZ(row, colB) ((row) * 256 + ((colB) ^ (((row) & 7) << 4)))
#define SBAR() __builtin_amdgcn_sched_barrier(0)
__device__ __forceinline__ int crow(int r, int hi) { return (r & 3) + 8 * (r >> 2) + 4 * hi; }
__device__ __forceinline__ unsigned cvtpk(float lo, float hi) { return pg8::cvt_pk_bf16(lo, hi); }
template <bool FIXM, bool PRE = false>
__device__ __forceinline__ void partialSM(f32x16& p0, f32x16& p1, float& m_reg, float& mn, float& alpha) {
  constexpr float C = SCALE * LOG2E;
  if constexpr (PRE) {
    mn = m_reg; alpha = 1.f;
    for (int r = 0; r < 16; ++r) p0[r] = __builtin_amdgcn_exp2f(p0[r]);
    return;
  }
  if constexpr (FIXM) {
    mn = m_reg; alpha = 1.f; float mnC = -m_reg * C; asm volatile("" : "+v"(mnC));
    typedef float f32x2_p __attribute__((ext_vector_type(2))); const f32x2_p c2 = {C, C}, m2 = {mnC, mnC};
#pragma unroll
    for (int r = 0; r < 16; r += 2) { f32x2_p a = {p0[r], p0[r + 1]}, b = {p1[r], p1[r + 1]}; a = __builtin_elementwise_fma(a, c2, m2); b = __builtin_elementwise_fma(b, c2, m2); p0[r] = a[0]; p0[r + 1] = a[1]; p1[r] = b[0]; p1[r + 1] = b[1]; }
    for (int r = 0; r < 16; ++r) p0[r] = __builtin_amdgcn_exp2f(p0[r]);
    return;
  }
  float pmax = p0[0]; for (int r = 1; r < 16; ++r) pmax = fmaxf(pmax, p0[r]); for (int r = 0; r < 16; ++r) pmax = fmaxf(pmax, p1[r]);
  { auto rr = __builtin_amdgcn_permlane32_swap(__float_as_uint(pmax), __float_as_uint(pmax), false, false);
    pmax = fmaxf(__uint_as_float(rr[0]), __uint_as_float(rr[1])); }
  if (__builtin_expect(__all(pmax - m_reg <= THR / SCALE), 1)) { mn = m_reg; alpha = 1.f; }
  else { mn = fmaxf(m_reg, pmax); alpha = __builtin_amdgcn_exp2f((m_reg - mn) * C); m_reg = mn; }
  float mnC = -mn * C;
  for (int r = 0; r < 16; ++r) p0[r] = fmaf(p0[r], C, mnC); for (int r = 0; r < 16; ++r) p1[r] = fmaf(p1[r], C, mnC);
  for (int r = 0; r < 16; ++r) p0[r] = __builtin_amdgcn_exp2f(p0[r]);
}
__device__ __forceinline__ void finishSM(f32x16& p0, f32x16& p1, float alpha, float& l_reg, bf16x8& pa0, bf16x8& pa1, bf16x8& pa2, bf16x8& pa3) {
  for (int r = 0; r < 16; ++r) p1[r] = __builtin_amdgcn_exp2f(p1[r]);
  float ps = 0; for (int r = 0; r < 16; ++r) ps += p0[r]; for (int r = 0; r < 16; ++r) ps += p1[r];
  { auto rr = __builtin_amdgcn_permlane32_swap(__float_as_uint(ps), __float_as_uint(ps), false, false);
    ps = __uint_as_float(rr[0]) + __uint_as_float(rr[1]); }
  l_reg = l_reg * alpha + ps;
#define PK4(P, BASE, OUT) do { unsigned a0 = cvtpk(P[BASE + 0], P[BASE + 1]), a1 = cvtpk(P[BASE + 2], P[BASE + 3]);   \
    unsigned b0 = cvtpk(P[BASE + 4], P[BASE + 5]), b1 = cvtpk(P[BASE + 6], P[BASE + 7]);                              \
    auto r0 = __builtin_amdgcn_permlane32_swap(a0, b0, false, false); auto r1 = __builtin_amdgcn_permlane32_swap(a1, b1, false, false); \
    u32x4 w = {r0[0], r1[0], r0[1], r1[1]}; OUT = *reinterpret_cast<bf16x8*>(&w); } while (0)
  PK4(p0, 0, pa0); PK4(p0, 8, pa1); PK4(p1, 0, pa2); PK4(p1, 8, pa3);
#undef PK4
}
#define KSWZ8(row, colB) ((row) * 128 + ((colB) ^ (((row) & 7) << 4)))
typedef int v8i_a __attribute__((ext_vector_type(8))); typedef int v4i_a __attribute__((ext_vector_type(4)));
template <bool WIN, bool F8, bool PRE = false>
__device__ __forceinline__ void qkt(f32x16& p0, f32x16& p1, const bf16* Ks, const bf16x8* qr, const v8i_a* q8, int r32, int hi, const __attribute__((address_space(3))) float* tb, const f32x16* cinit = nullptr) {
  if constexpr (F8 && PRE) {
    int one = 0x7f7f7f7f, sc3 = 0x7c7c7c7c; asm volatile("" : "+v"(one), "+v"(sc3));
#pragma unroll
    for (int s = 0; s < 2; ++s) { const int cb = 64 * s + 32 * hi;
      const char* ka = (const char*)Ks + KSWZ8(r32, cb); const char* kb = (const char*)Ks + KSWZ8(32 + r32, cb);
      const v8i_a k0 = __builtin_shufflevector(*reinterpret_cast<const v4i_a*>(ka), *reinterpret_cast<const v4i_a*>((const char*)Ks + KSWZ8(r32, cb + 16)), 0, 1, 2, 3, 4, 5, 6, 7);
      const v8i_a k1 = __builtin_shufflevector(*reinterpret_cast<const v4i_a*>(kb), *reinterpret_cast<const v4i_a*>((const char*)Ks + KSWZ8(32 + r32, cb + 16)), 0, 1, 2, 3, 4, 5, 6, 7);
      if (s == 0) {
        asm volatile("s_nop 1\n\tv_mfma_scale_f32_32x32x64_f8f6f4 %0, %1, %2, %3, %4, %5 op_sel_hi:[0,0,0]" : "=&v"(p0) : "v"(k0), "v"(q8[s]), "v"(*cinit), "v"(one), "v"(sc3));
        asm volatile("v_mfma_scale_f32_32x32x64_f8f6f4 %0, %1, %2, %3, %4, %5 op_sel_hi:[0,0,0]" : "=&v"(p1) : "v"(k1), "v"(q8[s]), "v"(*cinit), "v"(one), "v"(sc3));
      } else {
        asm volatile("v_mfma_scale_f32_32x32x64_f8f6f4 %0, %1, %2, %0, %3, %4 op_sel_hi:[0,0,0]" : "+v"(p0) : "v"(k0), "v"(q8[s]), "v"(one), "v"(sc3));
        asm volatile("v_mfma_scale_f32_32x32x64_f8f6f4 %0, %1, %2, %0, %3, %4 op_sel_hi:[0,0,0]" : "+v"(p1) : "v"(k1), "v"(q8[s]), "v"(one), "v"(sc3)); } }
    asm volatile("s_nop 15\n\ts_nop 15" : "+v"(p0), "+v"(p1));
    return;
  }
  if constexpr (F8) {
    int one = 0x7f7f7f7f; asm volatile("" : "+v"(one));
#pragma unroll
    for (int s = 0; s < 2; ++s) { const int cb = 64 * s + 32 * hi;
      const char* ka = (const char*)Ks + KSWZ8(r32, cb); const char* kb = (const char*)Ks + KSWZ8(32 + r32, cb);
      const v8i_a k0 = __builtin_shufflevector(*reinterpret_cast<const v4i_a*>(ka), *reinterpret_cast<const v4i_a*>((const char*)Ks + KSWZ8(r32, cb + 16)), 0, 1, 2, 3, 4, 5, 6, 7);
      const v8i_a k1 = __builtin_shufflevector(*reinterpret_cast<const v4i_a*>(kb), *reinterpret_cast<const v4i_a*>((const char*)Ks + KSWZ8(32 + r32, cb + 16)), 0, 1, 2, 3, 4, 5, 6, 7);
      if (s == 0) {
        asm volatile("s_nop 1\n\tv_mfma_scale_f32_32x32x64_f8f6f4 %0, %1, %2, 0, %3, %3 op_sel_hi:[0,0,0]" : "=&v"(p0) : "v"(k0), "v"(q8[s]), "v"(one));
        asm volatile("v_mfma_scale_f32_32x32x64_f8f6f4 %0, %1, %2, 0, %3, %3 op_sel_hi:[0,0,0]" : "=&v"(p1) : "v"(k1), "v"(q8[s]), "v"(one));
      } else {
        asm volatile("v_mfma_scale_f32_32x32x64_f8f6f4 %0, %1, %2, %0, %3, %3 op_sel_hi:[0,0,0]" : "+v"(p0) : "v"(k0), "v"(q8[s]), "v"(one));
        asm volatile("v_mfma_scale_f32_32x32x64_f8f6f4 %0, %1, %2, %0, %3, %3 op_sel_hi:[0,0,0]" : "+v"(p1) : "v"(k1), "v"(q8[s]), "v"(one)); } }
    asm volatile("s_nop 15\n\ts_nop 15" : "+v"(p0), "+v"(p1));
    return;
  }
  if constexpr (WIN) {
#pragma unroll
    for (int r = 0; r < 16; ++r) { p0[r] = tb[(r & 3) + 8 * (r >> 2)]; p1[r] = tb[32 + (r & 3) + 8 * (r >> 2)]; }
  } else { p0 = f32x16{}; p1 = f32x16{}; }
  for (int d0 = 0; d0 < 8; ++d0) { int cb = (d0 * 16 + hi * 8) * 2;
    bf16x8 b0 = *reinterpret_cast<const bf16x8*>((const char*)Ks + KSWZ(r32, cb));
    bf16x8 b1 = *reinterpret_cast<const bf16x8*>((const char*)Ks + KSWZ(32 + r32, cb));
    p0 = __builtin_amdgcn_mfma_f32_32x32x16_bf16(b0, qr[d0], p0, 0, 0, 0);
    p1 = __builtin_amdgcn_mfma_f32_32x32x16_bf16(b1, qr[d0], p1, 0, 0, 0); }
}
__device__ __forceinline__ int v_st(int k, int c) { const int kk = (k & ~0xC) | ((k & 4) << 1) | ((k & 8) >> 1); return ((kk >> 3) * 4 + (c >> 5)) * 512 + ((kk & 7) * 32 + (c & 31)) * 2; }
__device__ __forceinline__ int v_rd_base(int lane) { return ((lane & 3) << 3) | (((lane >> 2) & 3) << 6) | (((lane >> 4) & 1) << 5) | (((lane >> 5) & 1) << 8); }
constexpr int v_rd_off(int d0, int ks, int half) { return d0 * 512 + ks * 4096 + half * 2048; }
template <int OFF> __device__ __forceinline__ s16x4 tr_read(int vb) {
  s16x4 r; asm volatile("ds_read_b64_tr_b16 %0, %1 offset:%2" : "=&v"(r) : "v"(vb), "i"(OFF) : "memory"); return r;
}
template <int D0> __device__ __forceinline__ void pv_one(f32x16& od, int vb, bf16x8 pa0, bf16x8 pa1, bf16x8 pa2, bf16x8 pa3) {
  const s16x4 l0 = tr_read<v_rd_off(D0, 0, 0)>(vb), h0 = tr_read<v_rd_off(D0, 0, 1)>(vb), l1 = tr_read<v_rd_off(D0, 1, 0)>(vb), h1 = tr_read<v_rd_off(D0, 1, 1)>(vb);
  const s16x4 l2 = tr_read<v_rd_off(D0, 2, 0)>(vb), h2 = tr_read<v_rd_off(D0, 2, 1)>(vb), l3 = tr_read<v_rd_off(D0, 3, 0)>(vb), h3 = tr_read<v_rd_off(D0, 3, 1)>(vb);
  asm volatile("s_waitcnt lgkmcnt(0)" ::: "memory"); SBAR();
#define PK(L, H) (bf16x8){L[0], L[1], L[2], L[3], H[0], H[1], H[2], H[3]}
  od = __builtin_amdgcn_mfma_f32_32x32x16_bf16(pa0, PK(l0, h0), od, 0, 0, 0);
  od = __builtin_amdgcn_mfma_f32_32x32x16_bf16(pa1, PK(l1, h1), od, 0, 0, 0);
  od = __builtin_amdgcn_mfma_f32_32x32x16_bf16(pa2, PK(l2, h2), od, 0, 0, 0);
  od = __builtin_amdgcn_mfma_f32_32x32x16_bf16(pa3, PK(l3, h3), od, 0, 0, 0);
#undef PK
}
__device__ __forceinline__ void pv_d0(f32x16* o, int vb, bf16x8 pa0, bf16x8 pa1, bf16x8 pa2, bf16x8 pa3) {
  pv_one<0>(o[0], vb, pa0, pa1, pa2, pa3); pv_one<1>(o[1], vb, pa0, pa1, pa2, pa3); pv_one<2>(o[2], vb, pa0, pa1, pa2, pa3); pv_one<3>(o[3], vb, pa0, pa1, pa2, pa3);
}

template <bool WIN, int SDEPTH, bool F8, bool FIXM, bool QN = false, int kmask = -1, bool PP = false>
__device__ __forceinline__ void attn_body(const bf16* __restrict__ Qb, const bf16* __restrict__ Kh, const unsigned char* __restrict__ Kh8, const bf16* __restrict__ Vh,
                                          unsigned char* __restrict__ Ob, float oscale, int seq, char* lds, const __attribute__((address_space(3))) float* tab, int relbase, float m0, float l0,
                                          const float* __restrict__ gq = nullptr, int qpos0 = 0) {
  int tid_ = threadIdx.x; asm volatile("" : "+v"(tid_));
  const int tid = tid_, wid = tid >> 6, lane = tid & 63, r32 = lane & 31, hi = lane >> 5;
  bf16* V_lds = (bf16*)lds; bf16* K_lds = (bf16*)(lds + 2 * SHM_V);
  float* ws = (float*)(lds + 2 * SHM_V + 2 * SHM_K) + wid * 64; float* li_l = ws; float* al_l = ws + 32;
  float m_reg = m0, l_reg = l0; f32x16 o[4]; bf16x8 qr[8];
  const bf16* Qw = Qb + (long)(wid * QBLK + r32) * LDQ + hi * 8;
  v8i_a q8[2];
  if constexpr (F8 && QN) {
    const bf16* Qr = Qb + (long)(wid * QBLK + r32) * LDQ + hi * 16;
    u32x4 raw[2][2][2];
#pragma unroll
    for (int s = 0; s < 2; ++s)
#pragma unroll
      for (int pt = 0; pt < 2; ++pt)
#pragma unroll
        for (int c = 0; c < 2; ++c) raw[s][pt][c] = *reinterpret_cast<const u32x4*>(Qr + 64 * s + 32 * pt + 8 * c);
#define QLO(w_) __uint_as_float((w_) << 16)
#define QHI(w_) __uint_as_float((w_) & 0xffff0000u)
    float ss = 0.f;
#pragma unroll
    for (int s = 0; s < 2; ++s)
#pragma unroll
      for (int pt = 0; pt < 2; ++pt)
#pragma unroll
        for (int c = 0; c < 2; ++c) { const u32x4 v = raw[s][pt][c];
          ss = fmaf(QLO(v.x), QLO(v.x), ss); ss = fmaf(QHI(v.x), QHI(v.x), ss); ss = fmaf(QLO(v.y), QLO(v.y), ss); ss = fmaf(QHI(v.y), QHI(v.y), ss);
          ss = fmaf(QLO(v.z), QLO(v.z), ss); ss = fmaf(QHI(v.z), QHI(v.z), ss); ss = fmaf(QLO(v.w), QLO(v.w), ss); ss = fmaf(QHI(v.w), QHI(v.w), ss); }
    { auto rr = __builtin_amdgcn_permlane32_swap(__float_as_uint(ss), __float_as_uint(ss), false, false); ss = __uint_as_float(rr[0]) + __uint_as_float(rr[1]); }
    const float rs = 1.0f / sqrtf(ss * (1.0f / D) + 1e-6f);
    constexpr float qsc = PP ? 8.0f * SCALE * LOG2E : 1.0f;
    const int tok = qpos0 + wid * QBLK + r32;
#pragma unroll
    for (int s = 0; s < 2; ++s) { int w[8]; const float pos = (float)(s == 0 ? (tok >> 6) : (tok & 63));
#pragma unroll
      for (int c = 0; c < 2; ++c) {
        const u32x4 va = raw[s][0][c], vb = raw[s][1][c];
        const float xa[8] = {QLO(va.x), QHI(va.x), QLO(va.y), QHI(va.y), QLO(va.z), QHI(va.z), QLO(va.w), QHI(va.w)}, xb[8] = {QLO(vb.x), QHI(vb.x), QLO(vb.y), QHI(vb.y), QLO(vb.z), QHI(vb.z), QLO(vb.w), QHI(vb.w)};
        float o1[8], o2[8];
#pragma unroll
        for (int u4 = 0; u4 < 2; ++u4) { const f32x4_a g1 = *reinterpret_cast<const f32x4_a*>(gq + 64 * s + 16 * hi + 8 * c + 4 * u4), g2 = *reinterpret_cast<const f32x4_a*>(gq + 64 * s + 32 + 16 * hi + 8 * c + 4 * u4);
#pragma unroll
          for (int u = 0; u < 4; ++u) { const int t = 4 * u4 + u; const float inv = __builtin_amdgcn_exp2f(-(float)(2 * (16 * hi + 8 * c + t)) * (1.0f / 64.0f) * 13.287712379549449f);
            const float rev = pos * inv * 0.15915494309189535f, fr = rev - floorf(rev); const float sn = __builtin_amdgcn_sinf(fr), cs = __builtin_amdgcn_cosf(fr);
            const float a = xa[t] * rs * g1[u], b = xb[t] * rs * g2[u]; o1[t] = (a * cs - b * sn) * qsc; o2[t] = (b * cs + a * sn) * qsc; } }
        int t0 = __builtin_amdgcn_cvt_pk_fp8_f32(o1[0], o1[1], 0, false); t0 = __builtin_amdgcn_cvt_pk_fp8_f32(o1[2], o1[3], t0, true); w[2 * c] = t0;
        t0 = __builtin_amdgcn_cvt_pk_fp8_f32(o1[4], o1[5], 0, false); t0 = __builtin_amdgcn_cvt_pk_fp8_f32(o1[6], o1[7], t0, true); w[2 * c + 1] = t0;
        t0 = __builtin_amdgcn_cvt_pk_fp8_f32(o2[0], o2[1], 0, false); t0 = __builtin_amdgcn_cvt_pk_fp8_f32(o2[2], o2[3], t0, true); w[4 + 2 * c] = t0;
        t0 = __builtin_amdgcn_cvt_pk_fp8_f32(o2[4], o2[5], 0, false); t0 = __builtin_amdgcn_cvt_pk_fp8_f32(o2[6], o2[7], t0, true); w[4 + 2 * c + 1] = t0; }
      q8[s] = (v8i_a){w[0], w[1], w[2], w[3], w[4], w[5], w[6], w[7]}; }
#undef QLO
#undef QHI
  } else if constexpr (F8) {
    const bf16* Qr = Qb + (long)(wid * QBLK + r32) * LDQ + hi * 32;
#pragma unroll
    for (int s = 0; s < 2; ++s) { int w[8];
#pragma unroll
      for (int c = 0; c < 4; ++c) { const u32x4 v = *reinterpret_cast<const u32x4*>(Qr + 64 * s + 8 * c);
        int t = __builtin_amdgcn_cvt_pk_fp8_f32(__uint_as_float(v.x << 16), __uint_as_float(v.x & 0xffff0000u), 0, false); t = __builtin_amdgcn_cvt_pk_fp8_f32(__uint_as_float(v.y << 16), __uint_as_float(v.y & 0xffff0000u), t, true); w[2 * c] = t;
        t = __builtin_amdgcn_cvt_pk_fp8_f32(__uint_as_float(v.z << 16), __uint_as_float(v.z & 0xffff0000u), 0, false); t = __builtin_amdgcn_cvt_pk_fp8_f32(__uint_as_float(v.w << 16), __uint_as_float(v.w & 0xffff0000u), t, true); w[2 * c + 1] = t; }
      q8[s] = (v8i_a){w[0], w[1], w[2], w[3], w[4], w[5], w[6], w[7]}; }
  } else {
#pragma unroll
    for (int d0 = 0; d0 < 8; ++d0) qr[d0] = *reinterpret_cast<const bf16x8*>(Qw + d0 * 16);
  }
#pragma unroll
  for (int d = 0; d < 4; ++d) { float z_; asm volatile("v_mov_b32 %0, 0" : "=v"(z_));
#pragma unroll
    for (int r = 0; r < 16; ++r) o[d][r] = z_; }
  const int sr = tid >> 4, sc = (tid & 15) * 8, vst0 = v_st(sr, sc), vst1 = v_st(32 + sr, sc);
  const int vb0 = (int)(uintptr_t)V_lds + v_rd_base(lane);
  const __attribute__((address_space(3))) float* tb0 = tab + (relbase - (wid * QBLK + r32) + 512 + 4 * hi);
  struct { bf16x8 vs0, vs1, ks0, ks1; } sr_[SDEPTH];
#define SLOAD(i, k0) do { sr_[i].vs0 = *reinterpret_cast<const bf16x8*>(&Vh[(long)(((k0) & kmask) + sr) * LDK + sc]); sr_[i].vs1 = *reinterpret_cast<const bf16x8*>(&Vh[(long)(((k0) & kmask) + 32 + sr) * LDK + sc]); \
    if constexpr (F8) { sr_[i].ks0 = *reinterpret_cast<const bf16x8*>(&Kh8[(long)(((k0) & kmask) + (tid >> 3)) * 256 + (tid & 7) * 16]); } \
    else { sr_[i].ks0 = *reinterpret_cast<const bf16x8*>(&Kh[(long)(((k0) & kmask) + sr) * LDK + sc]); sr_[i].ks1 = *reinterpret_cast<const bf16x8*>(&Kh[(long)(((k0) & kmask) + 32 + sr) * LDK + sc]); } } while (0)
#define SWRITE(b, i) do { *(bf16x8*)((char*)V_lds + (b) * SHM_V + vst0) = sr_[i].vs0;          \
    *(bf16x8*)((char*)V_lds + (b) * SHM_V + vst1) = sr_[i].vs1; int kc = sc * 2;               \
    if constexpr (F8) { *(bf16x8*)((char*)K_lds + (b) * SHM_K + KSWZ8(tid >> 3, (tid & 7) * 16)) = sr_[i].ks0; } \
    else { *(bf16x8*)((char*)K_lds + (b) * SHM_K + KSWZ(sr, kc)) = sr_[i].ks0;                       \
    *(bf16x8*)((char*)K_lds + (b) * SHM_K + KSWZ(32 + sr, kc)) = sr_[i].ks1; } } while (0)
#define SWAIT() do { if constexpr (SDEPTH == 2) asm volatile("s_waitcnt vmcnt(4)" ::: "memory"); else asm volatile("s_waitcnt vmcnt(0)" ::: "memory"); } while (0)
#define RESC(a) do { if (!FIXM && __any((a) < 1.f)) { if (hi == 0) al_l[r32] = (a); asm volatile("s_waitcnt lgkmcnt(0)" ::: "memory"); \
    for (int d = 0; d < 4; ++d) for (int r = 0; r < 16; ++r) o[d][r] *= al_l[crow(r, hi)]; } } while (0)
  f32x16 pA0, pA1, pB0, pB1; float mnA, mnB, alA, alB; bf16x8 pa0, pa1, pa2, pa3; const int NT = seq / KVBLK;
  if constexpr (PP) {
    static_assert(!PP || (F8 && FIXM && !WIN), "ping-pong path: dense fp8 fixed-reference attention only");
    constexpr int NS = 4, KSLOT = KVBLK * D, VSLOT = KVBLK * D * 2, KRING = NS * VSLOT;
    typedef __attribute__((address_space(3))) unsigned lds_u32;
    const int widu = __builtin_amdgcn_readfirstlane(wid), grp = widu >> 2;
    li_l = (float*)(lds + KRING + NS * KSLOT) + widu * 64; al_l = li_l + 32;
    const __attribute__((address_space(3))) unsigned char* ldsb = (const __attribute__((address_space(3))) unsigned char*)(unsigned)(uintptr_t)lds;
    const int krow = widu * 8 + (lane >> 3);
    const unsigned kofs = (unsigned)(krow * 256 + (((lane & 7) ^ (krow & 7)) << 4));
    unsigned vofs[2];
#pragma unroll
    for (int i = 0; i < 2; ++i) { const int blk = (widu * 2 + i) * 2 + (lane >> 5), kk = (blk >> 2) * 8 + ((lane & 31) >> 2), k = (kk & ~0xC) | ((kk & 4) << 1) | ((kk & 8) >> 1);
      vofs[i] = (unsigned)((k * LDK + (blk & 3) * 32 + 8 * (lane & 3)) * 2); }
#define DMAK(t) do { const int t_ = (t) < NT ? (t) : NT - 1; const unsigned char* kb_ = Kh8 + (long)t_ * (KVBLK * 256); asm volatile("" : "+s"(kb_)); \
      __builtin_amdgcn_global_load_lds((const unsigned*)(kb_ + kofs), (lds_u32*)(ldsb + KRING + ((t) & (NS - 1)) * KSLOT + widu * 1024), 16, 0, 0); } while (0)
#define DMAV(t) do { const int t_ = (t) < NT ? (t) : NT - 1; const unsigned char* vb_ = (const unsigned char*)(Vh + (long)t_ * (KVBLK * LDK)); asm volatile("" : "+s"(vb_)); _Pragma("unroll") for (int i_ = 0; i_ < 2; ++i_) \
      __builtin_amdgcn_global_load_lds((const unsigned*)(vb_ + vofs[i_]), (lds_u32*)(ldsb + ((t) & (NS - 1)) * VSLOT + (widu * 2 + i_) * 1024), 16, 0, 0); } while (0)
#define PBAR() do { asm volatile("s_waitcnt lgkmcnt(0)" ::: "memory"); __builtin_amdgcn_s_barrier(); } while (0)
#define PEND() do { asm volatile("s_waitcnt vmcnt(6)" ::: "memory"); PBAR(); } while (0)
#define KSL(t) ((bf16*)(lds + KRING + ((t) & (NS - 1)) * KSLOT))
#define VSL(t) (vb0 + ((t) & (NS - 1)) * VSLOT)
    DMAK(0); DMAV(0); DMAK(1); DMAV(1); DMAK(2); DMAK(3); DMAV(2);
    asm volatile("s_waitcnt vmcnt(0)" ::: "memory"); PBAR();
    f32x16 cinit; { float nm_ = -m0 * (SCALE * LOG2E); asm volatile("" : "+v"(nm_));
#pragma unroll
      for (int r = 0; r < 16; ++r) cinit[r] = nm_; }
    qkt<WIN, F8, true>(pA0, pA1, KSL(0), qr, q8, r32, hi, tb0, &cinit); partialSM<FIXM, true>(pA0, pA1, m_reg, mnA, alA);
    PBAR();
    if (grp == 1) PBAR();
#pragma unroll 1
    for (int t = 1; t < NT; ++t) {
      SBAR(); DMAK(t + 3); SBAR();
      finishSM(pA0, pA1, alA, l_reg, pa0, pa1, pa2, pa3); SBAR();
      qkt<WIN, F8, true>(pA0, pA1, KSL(t), qr, q8, r32, hi, tb0, &cinit); SBAR();
      PEND();
      SBAR(); DMAV(t + 2); SBAR();
      pv_d0(o, VSL(t - 1), pa0, pa1, pa2, pa3); partialSM<FIXM, true>(pA0, pA1, m_reg, mnA, alA); SBAR();
      PEND();
    }
    if (grp == 0) PBAR();
    finishSM(pA0, pA1, alA, l_reg, pa0, pa1, pa2, pa3); SBAR();
    pv_d0(o, VSL(NT - 1), pa0, pa1, pa2, pa3);
    asm volatile("s_waitcnt vmcnt(0)" ::: "memory");
#undef DMAK
#undef DMAV
#undef PBAR
#undef PEND
#undef KSL
#undef VSL
  } else {
  constexpr int SE = 0, SO = SDEPTH - 1;
  SLOAD(SE, 0); asm volatile("s_waitcnt vmcnt(0)" ::: "memory"); SWRITE(0, SE); __syncthreads();
  qkt<WIN, F8>(pA0, pA1, K_lds, qr, q8, r32, hi, tb0); partialSM<FIXM>(pA0, pA1, m_reg, mnA, alA);
  SLOAD(SO, KVBLK); if constexpr (SDEPTH == 2) { if (2 < NT) SLOAD(SE, 2 * KVBLK); }
  SWAIT(); SWRITE(1, SO); __syncthreads();
  for (int j = 1; j + 1 < NT; j += 2) {
    SBAR(); qkt<WIN, F8>(pB0, pB1, (bf16*)((char*)K_lds + SHM_K), qr, q8, r32, hi, tb0 + 64 * j);
    finishSM(pA0, pA1, alA, l_reg, pa0, pa1, pa2, pa3); SBAR();
    SLOAD(SO, (j + SDEPTH) * KVBLK); SBAR();
    pv_d0(o, vb0, pa0, pa1, pa2, pa3); partialSM<FIXM>(pB0, pB1, m_reg, mnB, alB);
    __syncthreads(); SWAIT(); SWRITE(0, SE);
    RESC(alB); __syncthreads();
    SBAR(); qkt<WIN, F8>(pA0, pA1, K_lds, qr, q8, r32, hi, tb0 + 64 * (j + 1));
    finishSM(pB0, pB1, alB, l_reg, pa0, pa1, pa2, pa3); SBAR();
    if (SDEPTH == 1 || j + 3 < NT) SLOAD(SE, (j + 1 + SDEPTH) * KVBLK); SBAR();
    pv_d0(o, vb0 + (int)SHM_V, pa0, pa1, pa2, pa3); partialSM<FIXM>(pA0, pA1, m_reg, mnA, alA);
    __syncthreads(); SWAIT(); SWRITE(1, SO);
    RESC(alA); __syncthreads();
  }
  SBAR(); qkt<WIN, F8>(pB0, pB1, (bf16*)((char*)K_lds + SHM_K), qr, q8, r32, hi, tb0 + 64 * (NT - 1));
  finishSM(pA0, pA1, alA, l_reg, pa0, pa1, pa2, pa3); SBAR();
  pv_d0(o, vb0, pa0, pa1, pa2, pa3); partialSM<FIXM>(pB0, pB1, m_reg, mnB, alB);
  __syncthreads(); RESC(alB);
  finishSM(pB0, pB1, alB, l_reg, pa0, pa1, pa2, pa3); SBAR();
  pv_d0(o, vb0 + (int)SHM_V, pa0, pa1, pa2, pa3);
  }
  if (hi == 0) li_l[r32] = l_reg; asm volatile("s_waitcnt lgkmcnt(0)" ::: "memory");
  float rli[16];
#pragma unroll
  for (int r = 0; r < 16; ++r) rli[r] = __builtin_amdgcn_rcpf(li_l[crow(r, hi)]);
  unsigned char* Ow = Ob + (long)(wid * QBLK) * LDO;
#pragma unroll
  for (int r = 0; r < 16; ++r) { int orow = crow(r, hi); const float sc = rli[r] * oscale;
    for (int d0 = 0; d0 < 4; ++d0) Ow[(long)orow * LDO + d0 * 32 + r32] = (unsigned char)(__builtin_amdgcn_cvt_pk_fp8_f32(o[d0][r] * sc, 0.f, 0, false) & 0xff); }
  __syncthreads();
#undef SLOAD
#undef SWRITE
#undef SWAIT
#undef RESC
}
#undef KSWZ
#undef KSWZ8
#undef SBAR
}
constexpr int NWAVES = 8;
constexpr int SEQ = 8192, DM = 2048, HD = 128, NEXP = 64, TOPK = 8, FE = 512;
constexpr int INC = 7168;
constexpr int PLD = INC + PROJ_PAD;
constexpr int C_QA = 0, C_KA = 1024, C_VA = 1280, C_QB = 1536, C_KB = 2560, C_VB = 2816, C_GA = 3072, C_GB = 5120;
constexpr float LN_EPS = 1e-5f, RMS_EPS = 1e-6f;
constexpr float ALPHA = 1.189207115002721f;
constexpr float ROUTED_SCALE = 2.5f;
constexpr int LCAP = 8192;
constexpr int NEXP1 = NEXP + 1;

constexpr size_t MiB = 1u << 20;
constexpr size_t WS_CTL = 0, CTL_ZERO_BYTES = 1 * MiB;
constexpr size_t WS_WGU = 1 * MiB;
constexpr size_t WS_WINT = WS_WGU + 260 * MiB;
constexpr size_t WS_XBF = WS_WINT + 28 * MiB;
constexpr size_t WS_PROJ = WS_XBF + 32 * MiB;
constexpr size_t WS_OA = WS_PROJ + 116 * MiB;
constexpr size_t WS_OB = WS_OA + 16 * MiB;
constexpr size_t WS_MRG = WS_OB + 16 * MiB;
constexpr size_t WS_WAT = WS_MRG + 32 * MiB;
constexpr size_t WS_WBT = WS_WAT + 4 * MiB;
constexpr size_t WS_WOT = WS_WBT + 4 * MiB;
constexpr size_t WS_DEAD_END = WS_WOT + 8 * MiB;
constexpr size_t WS_Y = WS_WGU;
constexpr size_t WS_WD = WS_DEAD_END;
constexpr size_t WS_WR = WS_WD + 130 * MiB;
constexpr size_t WS_H32 = WS_WR + 1 * MiB;
constexpr size_t WS_HBF = WS_H32 + 64 * MiB;
constexpr size_t WS_HID = WS_HBF + 32 * MiB;
constexpr size_t WS_PRE = WS_HID + 88 * MiB;
constexpr size_t WS_LTOK = WS_PRE + 64 * MiB;
constexpr size_t WS_LW = WS_LTOK + 3 * MiB;
constexpr size_t WS_ROUTE = WS_LW + 3 * MiB;
constexpr size_t WS_HF8 = WS_H32;
constexpr size_t WS_KF8 = WS_H32 + 16 * MiB;
constexpr size_t WS_END = WS_ROUTE + 1 * MiB;
static_assert(WS_Y + 352 * MiB <= WS_WD, "Y overlay");
static_assert((size_t)SEQ * PLD * 2 <= 116 * MiB, "proj slot");
static_assert(WS_END <= 1024 * MiB, "d_ws map must fit 1 GiB");
constexpr int CW_TMO = 0;
constexpr int CW_CNT = 64;
constexpr int CW_BAR = 4096;

constexpr int RING_OFF = 0, RING_BYTES = 131072;
constexpr int LDSCTL_OFF = RING_BYTES;
constexpr int MISC_OFF = LDSCTL_OFF;
constexpr int IDXL_OFF = LDSCTL_OFF + 256;
constexpr int TST_OFF = IDXL_OFF + 1024 + 2048;
constexpr int LDS_BYTES = 147456;
static_assert(TST_OFF + 512 <= LDS_BYTES, "LDS map");

#define GAS __attribute__((address_space(1)))
#define LAS __attribute__((address_space(3)))
typedef unsigned short bf16;
typedef unsigned v4u __attribute__((ext_vector_type(4)));
typedef unsigned v2u __attribute__((ext_vector_type(2)));
typedef float f32x4 __attribute__((ext_vector_type(4)));
typedef short bf16x8 __attribute__((ext_vector_type(8)));
#define RLX_AGENT __ATOMIC_RELAXED, __HIP_MEMORY_SCOPE_AGENT
#define LDS_WAIT() asm volatile("s_waitcnt lgkmcnt(0)" ::: "memory")
#define VM_WAIT() asm volatile("s_waitcnt vmcnt(0)" ::: "memory")
__device__ __forceinline__ unsigned f2bf(float f) { unsigned u = __builtin_bit_cast(unsigned, f); return (u + 0x7fffu + ((u >> 16) & 1u)) >> 16; }
__device__ __forceinline__ unsigned pk2(float lo, float hi) { return f2bf(lo) | (f2bf(hi) << 16); }
__device__ __forceinline__ float bf2f(unsigned short h) { return __uint_as_float((unsigned)h << 16); }

#ifndef XB_L1_ACQ
#define XB_L1_ACQ 1
#endif
#ifndef XB_EARLY_WB
#define XB_EARLY_WB 0
#endif
#define XB_TMO      128
#define XB_XCNT(j)  (256  + 64 * (j))
#define XB_XSUB(j)  (1280 + 64 * (j))
#define XB_XGEN(j)  (2304 + 64 * (j))
#define XB_TOP      3328
#define XB_TOPGEN   3392
#define XCD_BAR_WORDS 3456
#define XB_SPIN_CAP (1u << 20)
__device__ __forceinline__ unsigned xb_ld(unsigned* p)              { return __hip_atomic_load(p, __ATOMIC_RELAXED, __HIP_MEMORY_SCOPE_AGENT); }
__device__ __forceinline__ unsigned xb_add(unsigned* p, unsigned v) { return __hip_atomic_fetch_add(p, v, __ATOMIC_RELAXED, __HIP_MEMORY_SCOPE_AGENT); }
__device__ __forceinline__ unsigned xb_xcc_id() { return (unsigned)__builtin_amdgcn_s_getreg((3 << 11) | 20) & 0xFu; }
#define XB_SPIN(cond, bar) do { unsigned _sp = 0; while (cond) { __builtin_amdgcn_s_sleep(1); \
    if ((++_sp & 255u) == 0u) { if (xb_ld(&(bar)[XB_TMO])) break; if (_sp > XB_SPIN_CAP) { atomicAdd(&(bar)[XB_TMO], 1u); break; } } } } while (0)
struct XcdBarrier { unsigned* bar; unsigned x; volatile LAS unsigned* st; unsigned total; };
__device__ __forceinline__ XcdBarrier xcd_barrier_post(unsigned* bar, volatile LAS unsigned* st, unsigned total) {
    XcdBarrier b; b.bar = bar; b.x = xb_xcc_id(); b.st = st; b.total = total;
    if (threadIdx.x == 0) (void)xb_add(&bar[XB_XCNT(b.x)], 1u);
    return b;
}
__device__ __forceinline__ void xcd_barrier_complete(unsigned* bar, unsigned x, unsigned G, unsigned& nloc, unsigned& nx) {
    unsigned sum, cnt, mine, sp = 0u;
    for (;;) {
        sum = 0u; cnt = 0u; mine = 0u;
#pragma unroll
        for (unsigned j = 0; j < 16; ++j) { const unsigned c = xb_ld(&bar[XB_XCNT(j)]); sum += c; cnt += (c > 0u) ? 1u : 0u; mine = (j == x) ? c : mine; }
        if (sum == G) break;
        __builtin_amdgcn_s_sleep(1);
        if ((++sp & 255u) == 0u) { if (xb_ld(&bar[XB_TMO])) break; if (sp > XB_SPIN_CAP) { atomicAdd(&bar[XB_TMO], 1u); break; } }
    }
    nloc = mine > 0u ? mine : 1u; nx = cnt > 0u ? cnt : 1u;
}
__device__ __forceinline__ void xcd_barrier(const XcdBarrier& b) {
    asm volatile("s_waitcnt vmcnt(0)" ::: "memory");
    __syncthreads();
    if (threadIdx.x == 0) {
        unsigned* bar = b.bar;
        __builtin_amdgcn_s_waitcnt(0);
        unsigned nloc = b.st[0], nx = b.st[1];
        if (nloc == 0u) { xcd_barrier_complete(bar, b.x, b.total, nloc, nx); b.st[0] = nloc; b.st[1] = nx; }
        const unsigned old = xb_add(&bar[XB_XSUB(b.x)], 1u);
        const unsigned gen = old / nloc;
        if (old + 1u == (gen + 1u) * nloc) {
            __builtin_amdgcn_fence(__ATOMIC_RELEASE, "agent");
            asm volatile("s_waitcnt vmcnt(0)" ::: "memory");
            asm volatile("buffer_inv sc1" ::: "memory");
            const unsigned og = xb_add(&bar[XB_TOP], 1u);
            const unsigned tg = og / nx;
            if (og + 1u == (tg + 1u) * nx) xb_add(&bar[XB_TOPGEN], 1u);
            else XB_SPIN(xb_ld(&bar[XB_TOPGEN]) == tg, bar);
            asm volatile("s_waitcnt vmcnt(0)" ::: "memory");
            xb_add(&bar[XB_XGEN(b.x)], 1u);
            asm volatile("s_waitcnt vmcnt(0)" ::: "memory");
        } else {
            asm volatile("buffer_inv sc1" ::: "memory");
            XB_SPIN(xb_ld(&bar[XB_XGEN(b.x)]) == gen, bar);
            asm volatile("s_waitcnt vmcnt(0)" ::: "memory");
        }
    }
    __syncthreads();
}

constexpr int GB_ID = 1024, GB_CTR = 1536;
__device__ __forceinline__ void group_barrier(unsigned* ctl, int vcu, int seam) {
    asm volatile("s_waitcnt vmcnt(0)" ::: "memory");
    __syncthreads();
    if (threadIdx.x == 0) {
        unsigned* c = ctl + GB_CTR + 2 * (vcu >> 3) + seam;
        (void)xb_add(c, 1u);
        asm volatile("buffer_inv sc1" ::: "memory");
        unsigned sp = 0; while (xb_ld(c) < 8u) { __builtin_amdgcn_s_sleep(1); if (++sp > XB_SPIN_CAP) break; }
        asm volatile("s_waitcnt vmcnt(0)" ::: "memory");
    }
    __syncthreads();
}
__device__ __forceinline__ float wave_sum(float v) {
#pragma unroll
    for (int o = 1; o < 64; o <<= 1) v += __shfl_xor(v, o);
    return v;
}
__device__ __forceinline__ float sigmoidf_(float x) { return __builtin_amdgcn_rcpf(1.0f + __builtin_amdgcn_exp2f(-x * 1.4426950408889634f)); }

struct Args { const float* in[22]; float* out; unsigned char* ws; int ph_lo, ph_hi; };
struct Frame {
    LAS unsigned char* lds;
    volatile LAS unsigned* MISC;
    unsigned* ctl;
    int tid, lane, wave;
    int vcu, G;
    const float* in[22]; float* out; unsigned char* ws;
};

#ifndef G1_FP8
#define G1_FP8 1
#endif
#ifndef ATT_F8
#define ATT_F8 1
#endif
#ifndef P1_FP8
#define P1_FP8 1
#endif
struct TItem { const float* W; unsigned char* WT; int K, N, k0, n0, drow0, f8; };
constexpr float W8SCALE = 32.0f, H8SCALE = 8.0f, OA_SCALE = 16.0f, OB_SCALE = 64.0f, MG_SCALE = 32.0f;
__device__ __forceinline__ void titem_issue(const TItem& it, LAS unsigned char* buf, int lane) {
#pragma unroll
    for (int g = 0; g < 8; ++g) { const int k = 8 * g + (lane >> 3), pos = lane & 7;
        __builtin_amdgcn_global_load_lds((const unsigned*)(it.W + (size_t)(it.k0 + k) * it.N + it.n0 + 4 * (pos ^ g)), (LAS unsigned*)(buf + g * 1024), 16, 0, 0); }
}
__device__ __forceinline__ void titem_finish(const TItem& it, const LAS float* buf, int lane) {
    const int c = lane & 7;
#pragma unroll
    for (int j = 0; j < 4; ++j) { const int nn = (lane >> 3) + 8 * j; const LAS float* s = buf + (8 * c) * 32 + (((nn >> 2) ^ c) << 2) + (nn & 3);
        const size_t eo = (size_t)(it.drow0 + nn) * it.K + it.k0 + 8 * c;
        if (it.f8) { v2u o; int t = __builtin_amdgcn_cvt_pk_fp8_f32(s[0 * 32] * W8SCALE, s[1 * 32] * W8SCALE, 0, false); t = __builtin_amdgcn_cvt_pk_fp8_f32(s[2 * 32] * W8SCALE, s[3 * 32] * W8SCALE, t, true); o.x = (unsigned)t;
            t = __builtin_amdgcn_cvt_pk_fp8_f32(s[4 * 32] * W8SCALE, s[5 * 32] * W8SCALE, 0, false); t = __builtin_amdgcn_cvt_pk_fp8_f32(s[6 * 32] * W8SCALE, s[7 * 32] * W8SCALE, t, true); o.y = (unsigned)t;
            __builtin_nontemporal_store(o, (GAS v2u*)(it.WT + eo)); }
        else { v4u o; o.x = pg8::cvt_pk_bf16(s[0 * 32], s[1 * 32]); o.y = pg8::cvt_pk_bf16(s[2 * 32], s[3 * 32]); o.z = pg8::cvt_pk_bf16(s[4 * 32], s[5 * 32]); o.w = pg8::cvt_pk_bf16(s[6 * 32], s[7 * 32]);
            __builtin_nontemporal_store(o, (GAS v4u*)(it.WT + 2 * eo)); } }
}
constexpr int I_IN = (DM / 64) * (INC / 32);
constexpr int I_BR = (1024 / 64) * (DM / 32);
constexpr int I_WO = (DM / 64) * (DM / 32);
constexpr int I_GU = (DM / 64) * (FE / 32);
constexpr int I_DN = (FE / 64) * (DM / 32);
constexpr int NITEMS_E1 = 2 * I_BR + I_WO + NEXP1 * 2 * I_GU;
constexpr int NITEMS_E2 = NEXP1 * I_DN;
__device__ __forceinline__ void titem_plain(TItem& it, const float* W, int K, int N, void* WT, int item, int f8 = 0) {
    const int nblk = N / 32, kb = item / nblk, nb = item % nblk; it.W = W; it.WT = (unsigned char*)WT; it.K = K; it.N = N; it.k0 = 64 * kb; it.n0 = 32 * nb; it.drow0 = 32 * nb; it.f8 = f8;
}
template <int LIST>
__device__ __forceinline__ void titem_get(Frame& F, int r, TItem& it) {
    if constexpr (LIST == 0) { titem_plain(it, F.in[1], DM, INC, F.ws + WS_WINT, r, P1_FP8); }
    else if constexpr (LIST == 2) { const int e = r / I_DN; r -= e * I_DN;
        titem_plain(it, e < NEXP ? F.in[16] + (size_t)e * FE * DM : F.in[19], FE, DM, F.ws + WS_WD + (size_t)e * DM * FE, r, 1); }
    else {
        if (r < I_BR) { titem_plain(it, F.in[7], 1024, DM, F.ws + WS_WAT, r, 1); return; } r -= I_BR;
        if (r < I_BR) { titem_plain(it, F.in[8], 1024, DM, F.ws + WS_WBT, r, 1); return; } r -= I_BR;
        if (r < I_WO) { titem_plain(it, F.in[9], DM, DM, F.ws + WS_WOT, r, 1); return; } r -= I_WO;
        const int e = r / (2 * I_GU); r -= e * (2 * I_GU);
        const int half = r >= I_GU ? 1 : 0; r -= half * I_GU;
        const float* w = e < NEXP ? (half ? F.in[15] : F.in[14]) + (size_t)e * DM * FE : (half ? F.in[18] : F.in[17]);
        const int nblk = FE / 32, kb = r / nblk, nb = r % nblk, n0 = 32 * nb;
        it.W = w; it.WT = F.ws + WS_WGU + (size_t)e * 1024 * DM * (G1_FP8 ? 1 : 2); it.f8 = G1_FP8; it.K = DM; it.N = FE; it.k0 = 64 * kb; it.n0 = n0; it.drow0 = 256 * (n0 >> 7) + 128 * half + (n0 & 127);
    }
}
#ifndef CONV_D
#define CONV_D 4
#endif
__device__ __forceinline__ void titem_load(const TItem& it, f32x4 (&r)[8], int lane) {
#pragma unroll
    for (int g = 0; g < 8; ++g) r[g] = __builtin_nontemporal_load((const GAS f32x4*)(it.W + (size_t)(it.k0 + 8 * g + (lane >> 3)) * it.N + it.n0 + 4 * (lane & 7)));
}
__device__ __forceinline__ void titem_store(const TItem& it, const f32x4 (&r)[8], LAS float* buf, int lane) {
#pragma unroll
    for (int g = 0; g < 8; ++g) *(LAS f32x4*)(buf + (8 * g + (lane >> 3)) * 32 + (((lane & 7) ^ g) << 2)) = r[g];
    titem_finish(it, buf, lane);
}
template <int LISTE>
__device__ __forceinline__ void convert_items(Frame& F, int first, int step, int last) {
    LAS float* buf = (LAS float*)(F.lds + RING_OFF + F.wave * 8192);
    if (first >= last) return;
    const int n_my = (last - first + step - 1) / step;
    f32x4 r[CONV_D][8]; TItem it;
#pragma unroll
    for (int d = 0; d < CONV_D; ++d) if (d < n_my) { titem_get<LISTE>(F, first + d * step, it); titem_load(it, r[d], F.lane); }
    for (int base = 0; base < n_my; base += CONV_D) {
#pragma unroll
        for (int d = 0; d < CONV_D; ++d) { const int idx = base + d;
            if (idx < n_my) { titem_get<LISTE>(F, first + idx * step, it); titem_store(it, r[d], buf, F.lane);
                if (idx + CONV_D < n_my) { titem_get<LISTE>(F, first + (idx + CONV_D) * step, it); titem_load(it, r[d], F.lane); } } }
    }
}
#ifndef CONV_Q
#define CONV_Q 200
#endif
#ifndef P1_NCG
#define P1_NCG 23
#endif
constexpr int NCONV = 32, NCOMP = 256 - NCONV, NCONV1 = 8 * (32 - P1_NCG), NCOMP1 = 8 * P1_NCG, E_SPLIT = (NCONV1 * NWAVES * CONV_Q < NITEMS_E1) ? NCONV1 * NWAVES * CONV_Q : NITEMS_E1;
#ifndef CONV_Q2
#define CONV_Q2 100
#endif
#ifndef P1_QE2
#define P1_QE2 0
#endif
constexpr int E2_A = (NCONV1 * NWAVES * P1_QE2 < NITEMS_E2) ? NCONV1 * NWAVES * P1_QE2 : NITEMS_E2;
constexpr int E2_SPLIT = (E2_A + 32 * NWAVES * CONV_Q2 < NITEMS_E2) ? E2_A + 32 * NWAVES * CONV_Q2 : NITEMS_E2;
#ifndef CONV_G1
#define CONV_G1 1
#endif
__device__ __forceinline__ void p0_prologue(Frame& F, bool compute_only) {
    const int gw = (compute_only ? (F.vcu >> 5) * P1_NCG + (F.vcu & 31) : F.vcu) * NWAVES + F.wave, NGW = (compute_only ? NCOMP1 : F.G) * NWAVES;
    convert_items<0>(F, gw, NGW, I_IN);
    { const int gt = gw * 64 + F.lane, NT = NGW * 64; const GAS f32x4* xs = (const GAS f32x4*)F.in[0]; GAS v4u* xo = (GAS v4u*)(F.ws + WS_XBF);
      for (int i = gt; i < SEQ * DM / 8; i += 4 * NT) {
          f32x4 a[4], b[4];
#pragma unroll
          for (int u = 0; u < 4; ++u) if (i + u * NT < SEQ * DM / 8) { a[u] = __builtin_nontemporal_load(xs + 2 * (i + u * NT)); b[u] = __builtin_nontemporal_load(xs + 2 * (i + u * NT) + 1); }
#pragma unroll
          for (int u = 0; u < 4; ++u) if (i + u * NT < SEQ * DM / 8) {
              if (P1_FP8) { v2u o; int t = __builtin_amdgcn_cvt_pk_fp8_f32(a[u].x, a[u].y, 0, false); t = __builtin_amdgcn_cvt_pk_fp8_f32(a[u].z, a[u].w, t, true); o.x = (unsigned)t;
                  t = __builtin_amdgcn_cvt_pk_fp8_f32(b[u].x, b[u].y, 0, false); t = __builtin_amdgcn_cvt_pk_fp8_f32(b[u].z, b[u].w, t, true); o.y = (unsigned)t; ((GAS v2u*)xo)[i + u * NT] = o; }
              else { v4u o; o.x = pg8::cvt_pk_bf16(a[u].x, a[u].y); o.y = pg8::cvt_pk_bf16(a[u].z, a[u].w); o.z = pg8::cvt_pk_bf16(b[u].x, b[u].y); o.w = pg8::cvt_pk_bf16(b[u].z, b[u].w); xo[i + u * NT] = o; } } } }
    { const int gt = gw * 64 + F.lane, NT = NGW * 64; bf16* wr = (bf16*)(F.ws + WS_WR);
      for (int i = gt; i < NEXP * DM; i += NT) {
          const int j_ = i & 7, ln = (i >> 3) & 63, nt_ = (i >> 9) & 3, ks = i >> 11, q_ = ln >> 4, t_ = ln & 15;
          const int k = ks * 32 + (j_ < 4 ? 4 * q_ + j_ : 16 + 4 * q_ + j_ - 4), e = 16 * nt_ + t_;
          const float w = F.in[12][(size_t)k * NEXP + e]; const unsigned h = f2bf(w); const float lo = w - __uint_as_float(h << 16);
          wr[i] = (bf16)h; wr[NEXP * DM + i] = (bf16)f2bf(lo); } }
    { const int gt = gw * 64 + F.lane, NT = NGW * 64; int* lt = (int*)(F.ws + WS_LTOK); float* lw = (float*)(F.ws + WS_LW);
      for (int i = gt; i < NEXP1 * LCAP; i += NT) { const bool sh = i >= NEXP * LCAP; lt[i] = sh ? i - NEXP * LCAP : 0; lw[i] = sh ? 1.0f : 0.0f; } }
}

#ifndef WT_STORES
#define WT_STORES 0
#endif
__device__ __forceinline__ void st_wt8(void* p, v2u w) {
    if (WT_STORES) __hip_atomic_store((unsigned long long*)p, ((unsigned long long)w.y << 32) | w.x, __ATOMIC_RELAXED, __HIP_MEMORY_SCOPE_AGENT);
    else *(v2u*)p = w;
}
__device__ __forceinline__ v4u pair16(v2u a, v2u b) {
    auto sx = __builtin_amdgcn_permlane16_swap(a.x, b.x, false, false);
    auto sy = __builtin_amdgcn_permlane16_swap(a.y, b.y, false, false);
    return (v4u){sx[0], sy[0], sx[1], sy[1]};
}
struct DenseOrder {
    const char* A; const char* B; int nM, nN, nwg, G, c; size_t tstep;
    __device__ __forceinline__ void init(const void* A_, const void* B_, int M, int N, int K, int G_, int c_) { A = (const char*)A_; B = (const char*)B_; nM = M / 256; nN = N / 256; nwg = nM * nN; G = G_; c = c_; tstep = (size_t)256 * K * (P1_FP8 ? 1 : 2); }
    __device__ __forceinline__ bool next(int i, pg8::Unit& u) const {
#ifdef P1_DOUBLE
        const long L = (long)(i >> 1) * G + c; if (L >= nwg) return false;
#else
        const long L = (long)i * G + c; if (L >= nwg) return false;
#endif
        int wgid = (int)L; { const int q = nwg / 8, r = nwg % 8, xcd = wgid % 8, off = wgid / 8; wgid = (xcd < r ? xcd * (q + 1) : r * (q + 1) + (xcd - r) * q) + off; }
        const int nig = 8 * nN, gid = wgid / nig, fm = gid * 8, gsz = (nM - fm) < 8 ? (nM - fm) : 8;
        const int pm = fm + ((wgid % nig) % gsz), pn = (wgid % nig) / gsz;
        u.A = A + (size_t)pm * tstep; u.B = B + (size_t)pn * tstep; u.idx = nullptr; u.wts = nullptr; u.r0 = pm * 256; u.c0 = pn * 256; u.aux = 0; u.kind = 0; return true;
    }
};
struct BranchOrder {
    const char *OA, *OB, *WA, *WB; int vcu;
    __device__ __forceinline__ bool next(int i, pg8::Unit& u) const {
#ifdef P3_DOUBLE
        if (i >= 4) return false; i &= 1;
#else
        if (i >= 2) return false;
#endif
        const int pm = vcu >> 3, pn = vcu & 7; const size_t ts = (size_t)256 * 1024;
        u.A = (i ? OB : OA) + (size_t)pm * ts; u.B = (i ? WB : WA) + (size_t)pn * ts; u.idx = nullptr; u.wts = nullptr; u.r0 = pm * 256; u.c0 = pn * 256; u.aux = 0; u.kind = i; return true;
    }
};
struct OneTileOrder {
    const char *A, *B; int vcu; size_t ts;
    __device__ __forceinline__ bool next(int i, pg8::Unit& u) const {
#ifdef P4_DOUBLE
        if (i >= 2) return false;
#else
        if (i >= 1) return false;
#endif
        const int pm = vcu >> 3, pn = vcu & 7;
        u.A = A + (size_t)pm * ts; u.B = B + (size_t)pn * ts; u.idx = nullptr; u.wts = nullptr; u.r0 = pm * 256; u.c0 = pn * 256; u.aux = 0; u.kind = 0; return true;
    }
};
template <int NPN>
struct MoeOrder {
    const LAS int* tst; const char* A; const char* B; const int* ltok; const float* lwt; int vcu, G; size_t arow, bexp, bpn;
    bool gather;
    int l0, lend, nheavy;
    const unsigned* flag; int wait_gmt, need;
    mutable int ec = 0;
    __device__ __forceinline__ bool next(int i, pg8::Unit& u) const {
        const int T = tst[NEXP1]; const int end = lend < 0 ? T * NPN : lend;
        int L;
#ifdef G2_DOUBLE
        if (NPN == 8) i >>= 1;
#endif
        if (nheavy > 0) { const int NL = G - nheavy; if (vcu >= NL) L = 2 * NL + i * G + vcu; else L = i < 2 ? i * NL + vcu : 2 * NL + (i - 2) * G + vcu; }
        else L = l0 + i * G + vcu;
        if (L >= end) return false;
        const int gmt = L / NPN, pn = L % NPN; int e = ec; if (tst[e] > gmt) e = 0;
        while (e < NEXP && tst[e + 1] <= gmt) ++e;
        ec = e;
        const int mt = gmt - tst[e];
        if (need > 0 && gmt >= wait_gmt) {
            unsigned spins = 0; while (__hip_atomic_load(flag, __ATOMIC_RELAXED, __HIP_MEMORY_SCOPE_AGENT) < (unsigned)need && ++spins < (1u << 22)) __builtin_amdgcn_s_sleep(2);
            __builtin_amdgcn_fence(__ATOMIC_ACQUIRE, "agent"); asm volatile("s_waitcnt vmcnt(0)" ::: "memory"); }
        u.A = gather ? A : A + (size_t)gmt * 256 * arow; u.B = B + (size_t)e * bexp + (size_t)pn * bpn; u.idx = ltok + e * LCAP + mt * 256; u.wts = lwt + e * LCAP + mt * 256;
        u.r0 = gmt * 256; u.c0 = pn * 256; u.aux = e * LCAP + mt * 256; u.kind = 0; return true;
    }
};

constexpr float GSCALE = 256.0f;
typedef float f32x2v __attribute__((ext_vector_type(2)));
struct EpiProj {
    static constexpr bool PERM = true; static constexpr int NST = 8;
    bf16* O; const float* bgate;
    __device__ __forceinline__ bool operator()(const pg8::f32x4 (&acc)[2][2][4][2], const pg8::Unit& u, int wr, int wc, int fr, int fq, const LAS float* wl) const {
        const int row0 = u.r0 + wr * 64 + fr, col0 = u.c0 + wc * 32 + 8 * fq;
        constexpr float PS = P1_FP8 ? 1.0f / W8SCALE : 1.0f;
        if (u.c0 >= C_GA) {
            f32x4 bb[2][2];
#pragma unroll
            for (int bj = 0; bj < 2; ++bj) { bb[bj][0] = *(const f32x4*)(bgate + col0 + bj * 128 - C_GA); bb[bj][1] = *(const f32x4*)(bgate + col0 + bj * 128 - C_GA + 4); }
            const int odd = fq & 1; unsigned char* G = (unsigned char*)O + (size_t)C_GA * 2 + (col0 - 8 * odd - C_GA);
#pragma unroll
            for (int ai = 0; ai < 2; ++ai)
#pragma unroll
                for (int mp = 0; mp < 2; ++mp)
#pragma unroll
                    for (int bj = 0; bj < 2; ++bj) { v2u w[2];
#pragma unroll
                        for (int mm = 0; mm < 2; ++mm) { const int m = 2 * mp + mm; const f32x4 v0 = acc[ai][bj][m][0] * PS + bb[bj][0], v1 = acc[ai][bj][m][1] * PS + bb[bj][1];
                            int t = __builtin_amdgcn_cvt_pk_fp8_f32(GSCALE * sigmoidf_(v0[0]), GSCALE * sigmoidf_(v0[1]), 0, false); t = __builtin_amdgcn_cvt_pk_fp8_f32(GSCALE * sigmoidf_(v0[2]), GSCALE * sigmoidf_(v0[3]), t, true); w[mm].x = (unsigned)t;
                            t = __builtin_amdgcn_cvt_pk_fp8_f32(GSCALE * sigmoidf_(v1[0]), GSCALE * sigmoidf_(v1[1]), 0, false); t = __builtin_amdgcn_cvt_pk_fp8_f32(GSCALE * sigmoidf_(v1[2]), GSCALE * sigmoidf_(v1[3]), t, true); w[mm].y = (unsigned)t; }
                        *(v4u*)(G + (size_t)(row0 + ai * 128 + (2 * mp + odd) * 16) * (PLD * 2) + bj * 128) = pair16(w[0], w[1]); }
        } else {
#pragma unroll
            for (int ai = 0; ai < 2; ++ai)
#pragma unroll
                for (int m = 0; m < 4; ++m)
#pragma unroll
                    for (int bj = 0; bj < 2; ++bj) { const f32x4 v0 = acc[ai][bj][m][0] * PS, v1 = acc[ai][bj][m][1] * PS;
                        v4u w; w.x = pg8::cvt_pk_bf16(v0[0], v0[1]); w.y = pg8::cvt_pk_bf16(v0[2], v0[3]); w.z = pg8::cvt_pk_bf16(v1[0], v1[1]); w.w = pg8::cvt_pk_bf16(v1[2], v1[3]);
                        *(v4u*)(O + (size_t)(row0 + ai * 128 + m * 16) * PLD + col0 + bj * 128) = w; }
        }
        return false;
    }
};
struct EpiBranch {
    static constexpr bool PERM = true; static constexpr int NST = 0;
    const bf16* proj; unsigned char* O;
    __device__ __forceinline__ bool operator()(pg8::f32x4 (&acc)[2][2][4][2], const pg8::Unit& u, int wr, int wc, int fr, int fq, const LAS float* wl) const {
        const int row0 = u.r0 + wr * 64 + fr, col0 = u.c0 + wc * 32 + 8 * fq;
        const bool seg0 = u.kind == 0;
#pragma unroll
        for (int ai = 0; ai < 2; ++ai) {
            v2u gb[4][2], ga[4][2];
#pragma unroll
            for (int m = 0; m < 4; ++m)
#pragma unroll
                for (int bj = 0; bj < 2; ++bj) { const size_t r = (size_t)(row0 + ai * 128 + m * 16); const int c = col0 + bj * 128;
                    const unsigned char* gp = (const unsigned char*)proj + r * (PLD * 2) + (size_t)C_GA * 2 + c;
                    gb[m][bj] = *(const v2u*)(gp + (C_GB - C_GA)); ga[m][bj] = seg0 ? *(const v2u*)gp : (v2u){0u, 0u}; }
            __builtin_amdgcn_sched_barrier(0);
#pragma unroll
            for (int mp = 0; mp < 2; ++mp) {
                v2u wq[2][2];
#pragma unroll
                for (int mm = 0; mm < 2; ++mm)
#pragma unroll
                    for (int bj = 0; bj < 2; ++bj) { const int m = 2 * mp + mm;
                        const v2u gbv = gb[m][bj], gav = ga[m][bj];
                        const f32x2v g01 = __builtin_amdgcn_cvt_pk_f32_fp8((int)gbv.x, false), g23 = __builtin_amdgcn_cvt_pk_f32_fp8((int)gbv.x, true), g45 = __builtin_amdgcn_cvt_pk_f32_fp8((int)gbv.y, false), g67 = __builtin_amdgcn_cvt_pk_f32_fp8((int)gbv.y, true);
                        float g[8] = {g01[0], g01[1], g23[0], g23[1], g45[0], g45[1], g67[0], g67[1]};
                        if (seg0) {
                            const f32x2v a01 = __builtin_amdgcn_cvt_pk_f32_fp8((int)gav.x, false), a23 = __builtin_amdgcn_cvt_pk_f32_fp8((int)gav.x, true), a45 = __builtin_amdgcn_cvt_pk_f32_fp8((int)gav.y, false), a67 = __builtin_amdgcn_cvt_pk_f32_fp8((int)gav.y, true);
                            float a[8] = {a01[0], a01[1], a23[0], a23[1], a45[0], a45[1], a67[0], a67[1]};
#pragma unroll
                            for (int j = 0; j < 4; ++j) { acc[ai][bj][m][0][j] *= (OB_SCALE / OA_SCALE) * a[j] * __builtin_amdgcn_rcpf(fmaxf(g[j], 1e-30f)); acc[ai][bj][m][1][j] *= (OB_SCALE / OA_SCALE) * a[4 + j] * __builtin_amdgcn_rcpf(fmaxf(g[4 + j], 1e-30f)); }
                        } else {
                            const pg8::f32x4 v0 = acc[ai][bj][m][0], v1 = acc[ai][bj][m][1];
                            constexpr float S1 = MG_SCALE / (OB_SCALE * W8SCALE * GSCALE);
                            v2u w; int t = __builtin_amdgcn_cvt_pk_fp8_f32(v0[0] * g[0] * S1, v0[1] * g[1] * S1, 0, false); t = __builtin_amdgcn_cvt_pk_fp8_f32(v0[2] * g[2] * S1, v0[3] * g[3] * S1, t, true); w.x = (unsigned)t;
                            t = __builtin_amdgcn_cvt_pk_fp8_f32(v1[0] * g[4] * S1, v1[1] * g[5] * S1, 0, false); t = __builtin_amdgcn_cvt_pk_fp8_f32(v1[2] * g[6] * S1, v1[3] * g[7] * S1, t, true); w.y = (unsigned)t;
                            wq[mm][bj] = w;
                        }
                    }
                if (!seg0) { const int odd = fq & 1;
#pragma unroll
                    for (int bj = 0; bj < 2; ++bj) *(v4u*)(O + (size_t)(row0 + ai * 128 + (2 * mp + odd) * 16) * DM + col0 - 8 * odd + bj * 128) = pair16(wq[0][bj], wq[1][bj]); }
            }
            __builtin_amdgcn_sched_barrier(0);
        }
        return seg0;
    }
};
struct EpiMix {
    static constexpr bool PERM = true; static constexpr int NST = 16;
    bf16* O;
    __device__ __forceinline__ bool operator()(const pg8::f32x4 (&acc)[2][2][4][2], const pg8::Unit& u, int wr, int wc, int fr, int fq, const LAS float* wl) const {
        const int row0 = u.r0 + wr * 64 + fr, col0 = u.c0 + wc * 32 + 8 * fq;
#pragma unroll
        for (int ai = 0; ai < 2; ++ai)
#pragma unroll
            for (int m = 0; m < 4; ++m)
#pragma unroll
                for (int bj = 0; bj < 2; ++bj) { const pg8::f32x4 v0 = acc[ai][bj][m][0] * (1.0f / (MG_SCALE * W8SCALE)), v1 = acc[ai][bj][m][1] * (1.0f / (MG_SCALE * W8SCALE));
                    v4u w; w.x = pg8::cvt_pk_bf16(v0[0], v0[1]); w.y = pg8::cvt_pk_bf16(v0[2], v0[3]); w.z = pg8::cvt_pk_bf16(v1[0], v1[1]); w.w = pg8::cvt_pk_bf16(v1[2], v1[3]);
                    *(v4u*)(O + (size_t)(row0 + ai * 128 + m * 16) * DM + col0 + bj * 128) = w; }
        return false;
    }
};
struct EpiMoe1 {
    static constexpr bool PERM = true; static constexpr int NST = 4;
    unsigned char* H;
    __device__ __forceinline__ bool operator()(const pg8::f32x4 (&acc)[2][2][4][2], const pg8::Unit& u, int wr, int wc, int fr, int fq, const LAS float* wl) const {
        const int odd = fq & 1; const int row0 = u.r0 + wr * 64 + fr + odd * 16, col0 = (u.c0 >> 1) + wc * 32 + 8 * (fq - odd);
#pragma unroll
        for (int ai = 0; ai < 2; ++ai)
#pragma unroll
            for (int mp = 0; mp < 2; ++mp) { v2u w[2];
#pragma unroll
                for (int mm = 0; mm < 2; ++mm) { const int m = 2 * mp + mm; float h[8]; const float wt = wl[wr * 64 + fr + ai * 128 + m * 16] * H8SCALE;
#pragma unroll
                    for (int n = 0; n < 2; ++n)
#pragma unroll
                        for (int j = 0; j < 4; ++j) { const float g = acc[ai][0][m][n][j] * (G1_FP8 ? 1.0f / W8SCALE : 1.0f), up = acc[ai][1][m][n][j] * (G1_FP8 ? 1.0f / W8SCALE : 1.0f); h[4 * n + j] = __builtin_amdgcn_fmed3f(g * sigmoidf_(g) * up * wt, -448.0f, 448.0f); }
                    int t = __builtin_amdgcn_cvt_pk_fp8_f32(h[0], h[1], 0, false); t = __builtin_amdgcn_cvt_pk_fp8_f32(h[2], h[3], t, true); w[mm].x = (unsigned)t;
                    t = __builtin_amdgcn_cvt_pk_fp8_f32(h[4], h[5], 0, false); t = __builtin_amdgcn_cvt_pk_fp8_f32(h[6], h[7], t, true); w[mm].y = (unsigned)t; }
                *(v4u*)(H + (size_t)(row0 + ai * 128 + mp * 32) * FE + col0) = pair16(w[0], w[1]); }
        return false;
    }
};
constexpr float YSCALE = 16.0f;
struct EpiMoe2 {
    static constexpr bool PERM = true; static constexpr int NST = 8;
    unsigned char* Y;
    __device__ __forceinline__ bool operator()(const pg8::f32x4 (&acc)[2][2][4][2], const pg8::Unit& u, int wr, int wc, int fr, int fq, const LAS float* wl) const {
        const int odd = fq & 1; const int lr0 = wr * 64 + fr + odd * 16, col0 = u.c0 + wc * 32 + 8 * (fq - odd);
#pragma unroll
        for (int ai = 0; ai < 2; ++ai)
#pragma unroll
            for (int mp = 0; mp < 2; ++mp) { const int lr = lr0 + ai * 128 + mp * 32;
#pragma unroll
                for (int bj = 0; bj < 2; ++bj) { v2u w[2];
#pragma unroll
                    for (int mm = 0; mm < 2; ++mm) { pg8::f32x4 v0 = acc[ai][bj][2 * mp + mm][0] * (YSCALE / (W8SCALE * H8SCALE)), v1 = acc[ai][bj][2 * mp + mm][1] * (YSCALE / (W8SCALE * H8SCALE));
#pragma unroll
                        for (int j = 0; j < 4; ++j) { v0[j] = __builtin_amdgcn_fmed3f(v0[j], -448.0f, 448.0f); v1[j] = __builtin_amdgcn_fmed3f(v1[j], -448.0f, 448.0f); }
                        int t = __builtin_amdgcn_cvt_pk_fp8_f32(v0[0], v0[1], 0, false); t = __builtin_amdgcn_cvt_pk_fp8_f32(v0[2], v0[3], t, true); w[mm].x = (unsigned)t;
                        t = __builtin_amdgcn_cvt_pk_fp8_f32(v1[0], v1[1], 0, false); t = __builtin_amdgcn_cvt_pk_fp8_f32(v1[2], v1[3], t, true); w[mm].y = (unsigned)t; }
                    *(v4u*)(Y + (size_t)(u.r0 + lr) * DM + col0 + bj * 128) = pair16(w[0], w[1]); } }
        return false;
    }
};

__device__ __forceinline__ void p1b_qknorm(Frame& F) {
    const int gw = F.vcu * NWAVES + F.wave, NGW = F.G * NWAVES; const bf16* proj = (const bf16*)(F.ws + WS_PROJ);
    const int hf = F.lane >> 5, i = F.lane & 31;
    const float inv = __builtin_amdgcn_exp2f(-(float)(2 * i) * (1.0f / 64.0f) * 13.287712379549449f);
    const float gk0 = F.in[6][64 * hf + i], gk1 = F.in[6][64 * hf + 32 + i];
    for (int tok0 = gw; tok0 < SEQ; tok0 += 4 * NGW) {
        float x1[4][2], x2[4][2];
#pragma unroll
        for (int b = 0; b < 4; ++b) { const int tok = tok0 + b * NGW; const bf16* pq = proj + (size_t)(tok < SEQ ? tok : 0) * PLD + C_KB + 64 * hf + i;
#pragma unroll
            for (int hh = 0; hh < 2; ++hh) { x1[b][hh] = bf2f(pq[hh * HD]); x2[b][hh] = bf2f(pq[hh * HD + 32]); } }
        __builtin_amdgcn_sched_barrier(0);
#pragma unroll
        for (int b = 0; b < 4; ++b) { const int tok = tok0 + b * NGW;
            const float pos = (float)(hf == 0 ? (tok >> 6) : (tok & 63));
            const float rev = pos * inv * 0.15915494309189535f, fr = rev - floorf(rev);
            const float sn = __builtin_amdgcn_sinf(fr), cs = __builtin_amdgcn_cosf(fr);
#pragma unroll
            for (int hh = 0; hh < 2; ++hh) {
                const float ss = wave_sum(x1[b][hh] * x1[b][hh] + x2[b][hh] * x2[b][hh]);
                const float rs = 1.0f / sqrtf(ss * (1.0f / HD) + RMS_EPS);
                const float a = x1[b][hh] * rs * gk0, c = x2[b][hh] * rs * gk1;
                const float o1 = a * cs - c * sn, o2 = c * cs + a * sn;
                if (tok < SEQ) { unsigned char* kf = F.ws + WS_KF8 + (size_t)tok * 256 + hh * HD + 64 * hf + 32 * ((i >> 4) & 1) + (i & 15);
                    kf[0] = (unsigned char)(__builtin_amdgcn_cvt_pk_fp8_f32(o1, 0.f, 0, false) & 0xff); kf[16] = (unsigned char)(__builtin_amdgcn_cvt_pk_fp8_f32(o2, 0.f, 0, false) & 0xff); } } }
    }
}

__device__ __forceinline__ int t5_bucket(int rel) {
    const int n = rel < 0 ? -rel : rel; int b;
    if (n < 8) b = n; else if (n < 12) b = 8; else if (n < 16) b = 9; else if (n < 23) b = 10; else if (n < 32) b = 11; else if (n < 46) b = 12; else if (n < 64) b = 13; else if (n < 91) b = 14; else b = 15;
    return (rel > 0 ? 16 : 0) + b;
}
#ifndef ATT_PP
#define ATT_PP 1
#endif
#ifndef PROBE_ATT_KMASK
#define PROBE_ATT_KMASK (-1)
#endif
__device__ __forceinline__ void p3_dense_attention(Frame& F) {
    using abf = attn::bf16;
    char* lds = (char*)F.lds;
    const abf* proj = (const abf*)(F.ws + WS_PROJ);
    float gqm = fmaxf(fabsf(F.in[5][F.lane]), fabsf(F.in[5][F.lane + 64])), gkm = fmaxf(fabsf(F.in[6][F.lane]), fabsf(F.in[6][F.lane + 64]));
#pragma unroll
    for (int o = 1; o < 64; o <<= 1) { gqm = fmaxf(gqm, __shfl_xor(gqm, o)); gkm = fmaxf(gkm, __shfl_xor(gkm, o)); }
    const float sbound = 1.15f * 128.0f * gqm * gkm;
    for (int un = F.vcu; un < 256; un += F.G) {
        const int h = un >> 5, ub = un & 31, kvh = h >> 2;
        attn::attn_body<false, 1, true, true, true, -1, ATT_PP != 0>(proj + (size_t)(ub * 256) * PLD + C_QB + h * HD, proj + C_KB + kvh * HD, F.ws + WS_KF8 + kvh * HD, proj + C_VB + kvh * HD,
                               F.ws + WS_OB + (size_t)(ub * 256) * 1024 + h * HD, OB_SCALE, SEQ, lds, nullptr, 0, sbound, 0.f, F.in[5], ub * 256);
#ifdef PROBE_ATT2
        attn::attn_body<false, 1, true, true, true, PROBE_ATT_KMASK>(proj + (size_t)(ub * 256) * PLD + C_QB + h * HD, proj + C_KB + kvh * HD, F.ws + WS_KF8 + kvh * HD, proj + C_VB + kvh * HD,
                               F.ws + WS_MRG + (size_t)(ub * 256) * 1024 + h * HD, OB_SCALE, SEQ, lds, nullptr, 0, sbound, 0.f, F.in[5], ub * 256);
#endif
    }
}
__device__ __forceinline__ void win_attention(Frame& F, int first, int step) {
    using abf = attn::bf16;
    char* lds = (char*)F.lds;
    const abf* proj = (const abf*)(F.ws + WS_PROJ);
    for (int un = first; un < 256; un += step) {
        const int h = un >> 5, ub = un & 31, kvh = h >> 2;
        LAS float* tab = (LAS float*)(F.lds + attn::WIN_TAB);
        for (int e = F.tid; e < 1024; e += NWAVES * 64) { const int rel = e - 512; const int ar = rel < 0 ? -rel : rel;
            tab[e] = ar <= 128 ? F.in[4][t5_bucket(rel) * 8 + h] * (1.0f / attn::SCALE) : -1e30f; }
        __syncthreads();
        const int q0 = ub * 256; int kf = q0 - 128, ke = q0 + 384; if (kf < 0) kf = 0; if (ke > SEQ) ke = SEQ;
        const float sinkl = F.in[3][h] * (1.0f / attn::SCALE);
        attn::attn_body<true, 1, false, false>(proj + (size_t)q0 * PLD + C_QA + h * HD, proj + (size_t)kf * PLD + C_KA + kvh * HD, nullptr, proj + (size_t)kf * PLD + C_VA + kvh * HD,
                              F.ws + WS_OA + (size_t)q0 * 1024 + h * HD, OA_SCALE, ke - kf, lds, tab, kf - q0, sinkl, 1.0f);
    }
}

__device__ __forceinline__ void p5_ln_router(Frame& F, bool probe_rep = false) {
    typedef float f32x4v __attribute__((ext_vector_type(4)));
    const bf16* mixb = (const bf16*)(F.ws + WS_PRE); bf16* hbf = (bf16*)(F.ws + WS_HBF);
    const bf16* wrh = (const bf16*)(F.ws + WS_WR); const bf16* wrl = wrh + NEXP * DM;
    LAS float* red = (LAS float*)(F.lds);
    LAS float* part = (LAS float*)(F.lds + 4096);
    LAS int* cntl = (LAS int*)(F.lds + 4096 + 32768);
    LAS int* basel = cntl + 64;
    LAS int* rec_e = basel + 64;
    LAS int* rec_p = rec_e + 256;
    LAS float* rec_w = (LAS float*)(rec_p + 256);
    const int lane = F.lane, w = F.wave, gi = w >> 2, kq = w & 3, t = lane & 15, q = lane >> 4;
    for (int blk = F.vcu; blk < SEQ / 32; blk += F.G) {
        const int tok = blk * 32 + gi * 16 + t;
        if (F.tid < 64) cntl[F.tid] = 0;
        float s1 = 0.f, s2 = 0.f;
        const float* prow = F.in[0] + (size_t)tok * DM + kq * 512 + 4 * q; const bf16* mrow = mixb + (size_t)tok * DM + kq * 512 + 4 * q;
        f32x4v hv[16][2];
#pragma unroll
        for (int sg = 0; sg < 4; ++sg) {
            f32x4v xa[4][2]; v2u ma[4][2];
#pragma unroll
            for (int u = 0; u < 4; ++u) { const int s = 4 * sg + u; xa[u][0] = *(const f32x4v*)(prow + 32 * s); xa[u][1] = *(const f32x4v*)(prow + 32 * s + 16); ma[u][0] = *(const v2u*)(mrow + 32 * s); ma[u][1] = *(const v2u*)(mrow + 32 * s + 16); }
            __builtin_amdgcn_sched_barrier(0);
#pragma unroll
            for (int u = 0; u < 4; ++u) { const int s = 4 * sg + u; const v2u m0 = ma[u][0], m1 = ma[u][1];
                const f32x4v v0 = xa[u][0] * ALPHA + (f32x4v){pg8::bf_lo(m0.x), pg8::bf_hi(m0.x), pg8::bf_lo(m0.y), pg8::bf_hi(m0.y)}, v1 = xa[u][1] * ALPHA + (f32x4v){pg8::bf_lo(m1.x), pg8::bf_hi(m1.x), pg8::bf_lo(m1.y), pg8::bf_hi(m1.y)};
                hv[s][0] = v0; hv[s][1] = v1;
#pragma unroll
                for (int j = 0; j < 4; ++j) { s1 += v0[j] + v1[j]; s2 += v0[j] * v0[j] + v1[j] * v1[j]; } }
            __builtin_amdgcn_sched_barrier(0);
        }
        s1 += __shfl_xor(s1, 16); s1 += __shfl_xor(s1, 32); s2 += __shfl_xor(s2, 16); s2 += __shfl_xor(s2, 32);
        if (q == 0) { red[(w * 16 + t) * 2] = s1; red[(w * 16 + t) * 2 + 1] = s2; }
        __syncthreads();
        float m1 = 0.f, m2 = 0.f;
#pragma unroll
        for (int k = 0; k < 4; ++k) { m1 += red[((gi * 4 + k) * 16 + t) * 2]; m2 += red[((gi * 4 + k) * 16 + t) * 2 + 1]; }
        const float mean = m1 * (1.0f / DM); const float var = m2 * (1.0f / DM) - mean * mean; const float rstd = 1.0f / sqrtf(var + LN_EPS);
        f32x4v acc[4] = {};
        const float* gp = F.in[10] + kq * 512 + 4 * q; const float* bp = F.in[11] + kq * 512 + 4 * q;
        bf16* brow = hbf + (size_t)tok * DM + kq * 512 + 4 * q; unsigned char* frow = F.ws + WS_HF8 + (size_t)tok * DM + kq * 512 + 4 * q;
        struct P5Set { f32x4v g0, g1, b0, b1; bf16x8 Bh[4], Bl[4]; };
        P5Set A_; const unsigned lane8 = (unsigned)lane * 8u;
#define P5_LOAD(S, X) do { X.g0 = *(const f32x4v*)(gp + 32 * (S)); X.g1 = *(const f32x4v*)(gp + 32 * (S) + 16); X.b0 = *(const f32x4v*)(bp + 32 * (S)); X.b1 = *(const f32x4v*)(bp + 32 * (S) + 16); \
            { const bf16* wuh_ = wrh + (size_t)((kq * 16 + (S)) * 2048); const bf16* wul_ = wuh_ + NEXP * DM;     \
              asm volatile("" : "+s"(wuh_), "+s"(wul_));                                                         \
              _Pragma("unroll") for (int nt = 0; nt < 4; ++nt) { X.Bh[nt] = *(const bf16x8*)(wuh_ + nt * 512 + lane8); X.Bl[nt] = *(const bf16x8*)(wul_ + nt * 512 + lane8); } } } while (0)
#define P5_COMP(S, X) do { const f32x4v p0_ = hv[S][0], p1_ = hv[S][1]; \
            const f32x4v y0 = (p0_ - mean) * rstd * X.g0 + X.b0, y1 = (p1_ - mean) * rstd * X.g1 + X.b1; \
            v4u ah, al; ah.x = pg8::cvt_pk_bf16(y0[0], y0[1]); ah.y = pg8::cvt_pk_bf16(y0[2], y0[3]); ah.z = pg8::cvt_pk_bf16(y1[0], y1[1]); ah.w = pg8::cvt_pk_bf16(y1[2], y1[3]); \
            al.x = pg8::cvt_pk_bf16(y0[0] - pg8::bf_lo(ah.x), y0[1] - pg8::bf_hi(ah.x)); al.y = pg8::cvt_pk_bf16(y0[2] - pg8::bf_lo(ah.y), y0[3] - pg8::bf_hi(ah.y)); \
            al.z = pg8::cvt_pk_bf16(y1[0] - pg8::bf_lo(ah.z), y1[1] - pg8::bf_hi(ah.z)); al.w = pg8::cvt_pk_bf16(y1[2] - pg8::bf_lo(ah.w), y1[3] - pg8::bf_hi(ah.w)); \
            *(v2u*)(brow + 32 * (S)) = (v2u){ah.x, ah.y}; *(v2u*)(brow + 32 * (S) + 16) = (v2u){ah.z, ah.w}; \
            { int t0_ = __builtin_amdgcn_cvt_pk_fp8_f32(y0[0], y0[1], 0, false); t0_ = __builtin_amdgcn_cvt_pk_fp8_f32(y0[2], y0[3], t0_, true); \
              int t1_ = __builtin_amdgcn_cvt_pk_fp8_f32(y1[0], y1[1], 0, false); t1_ = __builtin_amdgcn_cvt_pk_fp8_f32(y1[2], y1[3], t1_, true); \
              *(int*)(frow + 32 * (S)) = t0_; *(int*)(frow + 32 * (S) + 16) = t1_; } \
            const bf16x8 Ah = __builtin_bit_cast(bf16x8, ah), Al = __builtin_bit_cast(bf16x8, al); \
            _Pragma("unroll") for (int nt = 0; nt < 4; ++nt) { acc[nt] = __builtin_amdgcn_mfma_f32_16x16x32_bf16(Ah, X.Bh[nt], acc[nt], 0, 0, 0); \
                acc[nt] = __builtin_amdgcn_mfma_f32_16x16x32_bf16(Al, X.Bh[nt], acc[nt], 0, 0, 0); acc[nt] = __builtin_amdgcn_mfma_f32_16x16x32_bf16(Ah, X.Bl[nt], acc[nt], 0, 0, 0); } } while (0)
#pragma unroll
        for (int s = 0; s < 16; ++s) {
            P5_LOAD(s, A_); __builtin_amdgcn_sched_barrier(0);
            P5_COMP(s, A_); __builtin_amdgcn_sched_barrier(0);
        }
#undef P5_LOAD
#undef P5_COMP
#pragma unroll
        for (int nt = 0; nt < 4; ++nt)
#pragma unroll
            for (int r = 0; r < 4; ++r) part[(w * 16 + 4 * q + r) * 64 + 16 * nt + t] = acc[nt][r];
        __syncthreads();
#ifdef PROBE_P5
        if (PROBE_P5 >= 2 && probe_rep) { __syncthreads(); continue; }
#endif
        const float rb = F.in[13][lane];
#pragma unroll 1
        for (int i = 0; i < 4; ++i) {
            const int tl = w * 4 + i, g2 = tl >> 4, tt = tl & 15;
            float logit = 0.f;
#pragma unroll
            for (int k = 0; k < 4; ++k) logit += part[((g2 * 4 + k) * 16 + tt) * 64 + lane];
            const float sc = 1.0f / (1.0f + expf(-logit));
            const float b = sc + rb;
            float mx = b; mx = fmaxf(mx, __shfl_xor(mx, 1)); mx = fmaxf(mx, __shfl_xor(mx, 2)); mx = fmaxf(mx, __shfl_xor(mx, 4));
            const unsigned long long bal = __ballot(b == mx); const unsigned gm = (unsigned)(bal >> (lane & ~7)) & 0xffu; const int first = __builtin_ctz(gm);
            float b2 = ((lane & 7) == first) ? -INFINITY : b; b2 = fmaxf(b2, __shfl_xor(b2, 1)); b2 = fmaxf(b2, __shfl_xor(b2, 2)); b2 = fmaxf(b2, __shfl_xor(b2, 4));
            const float gs = mx + b2; const int grp = lane >> 3; int gc = 0;
#pragma unroll
            for (int g3 = 0; g3 < 8; ++g3) { const float o = __uint_as_float(__builtin_amdgcn_readlane(__float_as_uint(gs), g3 * 8)); gc += (o > gs || (o == gs && g3 < grp)) ? 1 : 0; }
            const float mk = gc < 4 ? b : -INFINITY; int rank = 0;
#pragma unroll
            for (int j = 0; j < 64; ++j) { const float o = __uint_as_float(__builtin_amdgcn_readlane(__float_as_uint(mk), j)); rank += (o > mk || (o == mk && j < lane)) ? 1 : 0; }
            const bool sel = (gc < 4) && rank < 8;
            const float wsum = wave_sum(sel ? sc : 0.f);
            if (sel) { const int lp = atomicAdd((int*)(cntl + lane), 1); rec_e[tl * 8 + rank] = lane; rec_p[tl * 8 + rank] = lp; rec_w[tl * 8 + rank] = sc / wsum * ROUTED_SCALE; }
        }
        __syncthreads();
#ifdef PROBE_P5
        if (PROBE_P5 == 1 && probe_rep) { __syncthreads(); continue; }
#endif
        if (F.tid < 64) basel[F.tid] = (int)atomicAdd(F.ctl + CW_CNT + F.tid, (unsigned)cntl[F.tid]);
        __syncthreads();
        if (F.tid < 256) { const int tl = F.tid >> 3, e = rec_e[F.tid], pos = basel[e] + rec_p[F.tid]; const int token = blk * 32 + tl;
            ((int*)(F.ws + WS_LTOK))[e * LCAP + pos] = token; ((float*)(F.ws + WS_LW))[e * LCAP + pos] = rec_w[F.tid];
            int* rt = (int*)(F.ws + WS_ROUTE); rt[(token * 8 + (F.tid & 7)) * 2] = e; rt[(token * 8 + (F.tid & 7)) * 2 + 1] = pos; }
        __syncthreads();
    }
}

__device__ __forceinline__ void moe_build_tst(Frame& F) {
    LAS int* tst = (LAS int*)(F.lds + TST_OFF);
    if (F.tid == 0) { int acc = 0; for (int e = 0; e < NEXP1; ++e) { tst[e] = acc; const unsigned c = e < NEXP ? __hip_atomic_load(F.ctl + CW_CNT + e, RLX_AGENT) : (unsigned)SEQ; acc += (int)((c + 255u) >> 8); } tst[NEXP1] = acc; }
    __syncthreads();
}

__device__ __forceinline__ void p9_combine(Frame& F) {
    const LAS int* tst = (const LAS int*)(F.lds + TST_OFF);
    const int gw = F.vcu * NWAVES + F.wave, NGW = F.G * NWAVES; const int lane = F.lane;
    const unsigned char* Y = (const unsigned char*)(F.ws + WS_Y); const bf16* hbf = (const bf16*)(F.ws + WS_HBF); const int* rt = (const int*)(F.ws + WS_ROUTE);
    unsigned rows[9];
#define P9_ROWS(dst, tok_) do { _Pragma("unroll") for (int k = 0; k < 8; ++k) { const int e = rt[((tok_) * 8 + k) * 2], pos = rt[((tok_) * 8 + k) * 2 + 1]; dst[k] = (unsigned)(tst[e] * 256 + pos) * (DM / 8); } \
        dst[8] = (unsigned)(tst[NEXP] * 256 + (tok_)) * (DM / 8); } while (0)
    for (int tok = gw; tok < SEQ; tok += NGW) {
        P9_ROWS(rows, tok);
        float v[4][8]; float s1 = 0.f;
#pragma unroll
        for (int c = 0; c < 4; ++c) { const int col = 512 * c + 8 * lane;
            const v4u hv = __builtin_nontemporal_load((const v4u*)(hbf + (size_t)tok * DM + col));
            const f32x4 a = {pg8::bf_lo(hv.x), pg8::bf_hi(hv.x), pg8::bf_lo(hv.y), pg8::bf_hi(hv.y)}, b = {pg8::bf_lo(hv.z), pg8::bf_hi(hv.z), pg8::bf_lo(hv.w), pg8::bf_hi(hv.w)};
            float r[8] = {0.f, 0.f, 0.f, 0.f, 0.f, 0.f, 0.f, 0.f};
#pragma unroll
            for (int k = 0; k < 9; ++k) { const v2u y = __builtin_nontemporal_load((const v2u*)Y + (size_t)rows[k] + (col >> 3));
                const auto q0 = __builtin_amdgcn_cvt_pk_f32_fp8((int)y.x, false), q1 = __builtin_amdgcn_cvt_pk_f32_fp8((int)y.x, true), q2 = __builtin_amdgcn_cvt_pk_f32_fp8((int)y.y, false), q3 = __builtin_amdgcn_cvt_pk_f32_fp8((int)y.y, true);
                r[0] += q0[0]; r[1] += q0[1]; r[2] += q1[0]; r[3] += q1[1]; r[4] += q2[0]; r[5] += q2[1]; r[6] += q3[0]; r[7] += q3[1]; }
#pragma unroll
            for (int j = 0; j < 4; ++j) { v[c][j] = ALPHA * a[j] + r[j] * (1.0f / YSCALE); v[c][4 + j] = ALPHA * b[j] + r[4 + j] * (1.0f / YSCALE); }
#pragma unroll
            for (int j = 0; j < 8; ++j) s1 += v[c][j]; }
        const float mean = wave_sum(s1) * (1.0f / DM); float s2 = 0.f;
#pragma unroll
        for (int c = 0; c < 4; ++c)
#pragma unroll
            for (int j = 0; j < 8; ++j) { v[c][j] -= mean; s2 += v[c][j] * v[c][j]; }
        const float rstd = 1.0f / sqrtf(wave_sum(s2) * (1.0f / DM) + LN_EPS);
#pragma unroll
        for (int c = 0; c < 4; ++c) { const int col = 512 * c + 8 * lane;
            const f32x4 g0 = *(const f32x4*)(F.in[20] + col), g1 = *(const f32x4*)(F.in[20] + col + 4), b0 = *(const f32x4*)(F.in[21] + col), b1 = *(const f32x4*)(F.in[21] + col + 4);
            f32x4 o0, o1;
#pragma unroll
            for (int j = 0; j < 4; ++j) { o0[j] = v[c][j] * rstd * g0[j] + b0[j]; o1[j] = v[c][4 + j] * rstd * g1[j] + b1[j]; }
            __builtin_nontemporal_store(o0, (f32x4*)(F.out + (size_t)tok * DM + col)); __builtin_nontemporal_store(o1, (f32x4*)(F.out + (size_t)tok * DM + col + 4)); }
    }
#undef P9_ROWS
}

constexpr int NPHASES = 10;
#ifndef GROUP_SEAMS
#define GROUP_SEAMS 1
#endif
#ifndef MK_ONE_LAUNCH
#define MK_ONE_LAUNCH 1
#endif
__global__ void __launch_bounds__(NWAVES * 64, 2) mega_fwd(Args args) {
    extern __shared__ __attribute__((aligned(16))) unsigned char lds[];
    Frame F;
    F.lds = (LAS unsigned char*)lds;
    F.MISC = (volatile LAS unsigned*)(F.lds + MISC_OFF);
    F.tid = threadIdx.x; F.lane = F.tid & 63; F.wave = __builtin_amdgcn_readfirstlane(F.tid >> 6);
    F.G = gridDim.x; { const int bx = blockIdx.x; F.vcu = (F.G % 8 == 0) ? (bx % 8) * (F.G / 8) + bx / 8 : bx; }
#pragma unroll
    for (int i = 0; i < 22; ++i) F.in[i] = args.in[i];
    F.out = args.out; F.ws = args.ws; F.ctl = (unsigned*)(args.ws + WS_CTL);
    for (int u = F.tid; u < (LDS_BYTES - LDSCTL_OFF) / 4; u += NWAVES * 64) ((LAS unsigned*)(F.lds + LDSCTL_OFF))[u] = 0u;
    __syncthreads();
    XcdBarrier bar; bar.bar = F.ctl + CW_BAR; bar.x = 0; bar.st = nullptr; bar.total = 0; XcdBarrier barB = bar;
    const bool conv1 = (F.G == 256) && (F.vcu & 31) >= P1_NCG;
    if (MK_ONE_LAUNCH) { bar = xcd_barrier_post(F.ctl + CW_BAR, F.MISC + 8, (unsigned)F.G); }
    if (MK_ONE_LAUNCH && F.tid == 0) __hip_atomic_store(F.ctl + GB_ID + F.vcu, xb_xcc_id() + 1u, RLX_AGENT);
    const int lo = args.ph_lo, hi = args.ph_hi;
#ifndef PH_MASK
#define PH_MASK 0x3ff
#endif
#define IN(k) (((PH_MASK >> (k)) & 1) && lo <= (k) && (k) < hi)
#ifndef REP_MASK
#define REP_MASK 0
#endif
#define REP(k) for (int rep_ = 0; rep_ < 1 + ((REP_MASK >> (k)) & 1); ++rep_)
#ifndef BAR_REP
#define BAR_REP 1
#endif
#define SEAM(k) do { if (IN(k) && IN((k) + 1)) for (int br_ = 0; br_ < BAR_REP; ++br_) xcd_barrier(bar); } while (0)
    LAS int* idxl = (LAS int*)(F.lds + IDXL_OFF);
    const bool tst_needed = true;

    if (IN(0)) REP(0) { p0_prologue(F, false); } SEAM(0);
    bool gb_ok = false;
    if (GROUP_SEAMS && MK_ONE_LAUNCH && F.G == 256 && IN(0) && IN(1)) {
        int okl = 1;
        if (F.tid < 256) { const unsigned id = __hip_atomic_load(F.ctl + GB_ID + F.tid, RLX_AGENT); const unsigned id0 = (unsigned)__shfl((int)id, F.lane & ~7); okl = (id != 0u && id == id0) ? 1 : 0; }
        const int okb = __syncthreads_and(okl);
        gb_ok = okb != 0;
    }
    if (IN(1)) REP(1) {
        const int grp = F.vcu >> 5, cin = F.vcu & 31;
        const bool conv = (F.G == 256) && cin >= P1_NCG;
        if (conv) { const int cw = (grp * (32 - P1_NCG) + (cin - P1_NCG)) * NWAVES + F.wave; convert_items<1>(F, cw, NCONV1 * NWAVES, E_SPLIT); convert_items<2>(F, cw, NCONV1 * NWAVES, E2_A); }
        else {
            DenseOrder S; if (F.G == 256) S.init(F.ws + WS_XBF, F.ws + WS_WINT, SEQ, INC, DM, NCOMP1, cin * 8 + grp); else S.init(F.ws + WS_XBF, F.ws + WS_WINT, SEQ, INC, DM, F.G, (int)blockIdx.x);
            EpiProj E{(bf16*)(F.ws + WS_PROJ), F.in[2]};
            pg8::gemm_phase<EpiProj, DenseOrder, true, false, P1_FP8 != 0>(F.lds + RING_OFF, idxl, DM, S, E);
        }
    } SEAM(1);
    if (IN(2)) {
        p1b_qknorm(F);
        if (F.G == 256) {
            if (E_SPLIT >= NITEMS_E1 && (CONV_G1 ? E2_SPLIT : E2_A) >= NITEMS_E2) win_attention(F, F.vcu, 256);
            else if (F.vcu & 1) win_attention(F, F.vcu >> 1, 128);
            else { const int cw = (F.vcu >> 1) * NWAVES + F.wave;
                convert_items<1>(F, E_SPLIT + cw, 128 * NWAVES, NITEMS_E1); convert_items<2>(F, (CONV_G1 ? E2_SPLIT : E2_A) + cw, 128 * NWAVES, NITEMS_E2); }
        } else { win_attention(F, F.vcu, F.G); convert_items<1>(F, F.vcu * NWAVES + F.wave, F.G * NWAVES, NITEMS_E1); convert_items<2>(F, F.vcu * NWAVES + F.wave, F.G * NWAVES, NITEMS_E2); }
    } SEAM(2);
    if (IN(3)) REP(3) { p3_dense_attention(F); } SEAM(3);
    if (IN(4)) REP(4) {
        BranchOrder S{(const char*)(F.ws + WS_OA), (const char*)(F.ws + WS_OB), (const char*)(F.ws + WS_WAT), (const char*)(F.ws + WS_WBT), F.vcu};
        EpiBranch E{(const bf16*)(F.ws + WS_PROJ), F.ws + WS_MRG};
        if (F.vcu < 256) pg8::gemm_phase<EpiBranch, BranchOrder, false, false, true>(F.lds + RING_OFF, idxl, 1024, S, E);
    } if (gb_ok && IN(4) && IN(5)) group_barrier(F.ctl, F.vcu, 0); else SEAM(4);
    if (IN(5)) REP(5) {
        OneTileOrder S{(const char*)(F.ws + WS_MRG), (const char*)(F.ws + WS_WOT), F.vcu, (size_t)256 * DM};
        EpiMix E{(bf16*)(F.ws + WS_PRE)};
        if (F.vcu < 256) pg8::gemm_phase<EpiMix, OneTileOrder, false, false, true>(F.lds + RING_OFF, idxl, DM, S, E);
    } if (gb_ok && IN(5) && IN(6)) group_barrier(F.ctl, F.vcu, 1); else SEAM(5);
    if (IN(6)) REP(6) { if (rep_) { xcd_barrier(bar);
#ifndef PROBE_P5
            if (blockIdx.x == 0 && F.tid < 64) __hip_atomic_store(F.ctl + CW_CNT + F.tid, 0u, RLX_AGENT);
#endif
            xcd_barrier(bar); } p5_ln_router(F, rep_ != 0); } SEAM(6);
    if (IN(7) || IN(8) || IN(9)) { if (tst_needed) moe_build_tst(F); }
#ifndef DEFER_MAX
#define DEFER_MAX 64
#endif
    int n_defer = 0, u1_end = -1;
    if (IN(7) || IN(8)) { const int T_ = ((const LAS int*)(F.lds + TST_OFF))[NEXP1]; const int r_ = (4 * T_) % 256;
        if (F.G == 256 && !CONV_G1 && 4 * T_ > 256 && r_ > 0 && r_ <= DEFER_MAX && (lo <= 7 && 8 < hi)) { n_defer = r_; u1_end = 4 * T_ - r_; } }
    if (IN(7)) REP(7) {
        const bool split = CONV_G1 && F.G == 256, conv = split && ((F.vcu & 7) == 7);
        if (conv) { convert_items<2>(F, E2_A + (F.vcu >> 3) * NWAVES + F.wave, NCONV * NWAVES, E2_SPLIT); }
        else {
        MoeOrder<4> S{(const LAS int*)(F.lds + TST_OFF), (const char*)(F.ws + (G1_FP8 ? WS_HF8 : WS_HBF)), (const char*)(F.ws + WS_WGU), (const int*)(F.ws + WS_LTOK), (const float*)(F.ws + WS_LW), split ? F.vcu - (F.vcu >> 3) : F.vcu, split ? NCOMP : F.G, 0, (size_t)1024 * DM * (G1_FP8 ? 1 : 2), (size_t)256 * DM * (G1_FP8 ? 1 : 2), true,
                      0, u1_end, 0, nullptr, 0, 0};
        EpiMoe1 E{F.ws + WS_HID};
        pg8::gemm_phase<EpiMoe1, MoeOrder<4>, true, true, G1_FP8 != 0>(F.lds + RING_OFF, idxl, DM, S, E);
        }
    } SEAM(7);
    if (IN(8)) REP(8) {
        unsigned* dflag = F.ctl + CW_CNT + 128;
        if (n_defer > 0 && F.vcu >= 256 - n_defer) {
            MoeOrder<4> S1{(const LAS int*)(F.lds + TST_OFF), (const char*)(F.ws + (G1_FP8 ? WS_HF8 : WS_HBF)), (const char*)(F.ws + WS_WGU), (const int*)(F.ws + WS_LTOK), (const float*)(F.ws + WS_LW), F.vcu - (256 - n_defer), 256, 0, (size_t)1024 * DM * (G1_FP8 ? 1 : 2), (size_t)256 * DM * (G1_FP8 ? 1 : 2), true,
                           u1_end, u1_end + n_defer, 0, nullptr, 0, 0};
            EpiMoe1 E1{F.ws + WS_HID};
            pg8::gemm_phase<EpiMoe1, MoeOrder<4>, true, true, G1_FP8 != 0>(F.lds + RING_OFF, idxl, DM, S1, E1);
            if (F.tid == 0) { __builtin_amdgcn_fence(__ATOMIC_RELEASE, "agent"); asm volatile("s_waitcnt vmcnt(0)" ::: "memory"); __hip_atomic_fetch_add(dflag, 1u, __ATOMIC_RELAXED, __HIP_MEMORY_SCOPE_AGENT); }
        }
        MoeOrder<8> S{(const LAS int*)(F.lds + TST_OFF), (const char*)(F.ws + WS_HID), (const char*)(F.ws + WS_WD), (const int*)(F.ws + WS_LTOK), (const float*)(F.ws + WS_LW), F.vcu, F.G, (size_t)FE, (size_t)DM * FE, (size_t)256 * FE, false,
                      0, -1, n_defer, dflag, n_defer > 0 ? u1_end / 4 : 0, n_defer};
#ifndef G2_ALIGN
#define G2_ALIGN true
#endif
        EpiMoe2 E{(unsigned char*)(F.ws + WS_Y)};
        pg8::gemm_phase<EpiMoe2, MoeOrder<8>, G2_ALIGN, false, true>(F.lds + RING_OFF, idxl, FE, S, E);
    } SEAM(8);
    if (IN(9)) REP(9) { p9_combine(F); }
#ifdef PROBE_T
    { const LAS int* tst_ = (const LAS int*)(F.lds + TST_OFF); if (tst_[NEXP1] > PROBE_T && blockIdx.x == 0 && F.tid == 0) F.out[0] = __builtin_nanf(""); }
#endif
#undef IN
#undef SEAM
}

extern "C" void kernel_launch(void* const* d_in, const int* in_sizes, int n_in, void* d_out, int out_size, void* d_ws, size_t ws_size, hipStream_t stream) {
    static int grid = 0;
    if (grid == 0) {
        if (n_in != 22 || out_size != SEQ * DM || ws_size < WS_END) { fprintf(stderr, "kernel_launch: unexpected shapes (n_in %d, out %d, ws %zu < %zu); nothing launched\n", n_in, out_size, ws_size, (size_t)WS_END); grid = -1; return; }
        int dev = 0, cus = 0, per_cu = 0;
        if (hipGetDevice(&dev) != hipSuccess || hipDeviceGetAttribute(&cus, hipDeviceAttributeMultiprocessorCount, dev) != hipSuccess) { grid = -1; return; }
        if (hipFuncSetAttribute((const void*)mega_fwd, hipFuncAttributeMaxDynamicSharedMemorySize, LDS_BYTES) != hipSuccess) { fprintf(stderr, "kernel_launch: hipFuncSetAttribute failed\n"); grid = -1; return; }
        if (hipOccupancyMaxActiveBlocksPerMultiprocessor(&per_cu, (const void*)mega_fwd, NWAVES * 64, LDS_BYTES) != hipSuccess || per_cu < 1) { fprintf(stderr, "kernel_launch: occupancy query says %d blocks per CU; nothing launched\n", per_cu); (void)hipGetLastError(); grid = -1; return; }
        grid = cus;
        if (grid > 256) grid = 256;
    }
    if (grid < 0) return;
    (void)hipMemsetAsync((char*)d_ws + WS_CTL, 0, CTL_ZERO_BYTES, stream);
    Args a{};
    for (int i = 0; i < 22; ++i) a.in[i] = (const float*)d_in[i];
    a.out = (float*)d_out; a.ws = (unsigned char*)d_ws;
#if MK_ONE_LAUNCH
    a.ph_lo = 0; a.ph_hi = NPHASES;
    hipLaunchKernelGGL(mega_fwd, dim3(grid), dim3(NWAVES * 64), LDS_BYTES, stream, a);
#else
    for (int p = 0; p < NPHASES; ++p) { a.ph_lo = p; a.ph_hi = p + 1; hipLaunchKernelGGL(mega_fwd, dim3(grid), dim3(NWAVES * 64), LDS_BYTES, stream, a); }
#endif
    const hipError_t le = hipPeekAtLastError();
    if (le != hipSuccess) fprintf(stderr, "kernel_launch: launch failed: %s\n", hipGetErrorName(le));
}
```

```cpp
#define P1_NCG 13
#define CONV_Q 59
#define P1_QE2 28
#define CONV_G1 0
#include <hip/hip_runtime.h>
#include <hip/hip_bf16.h>
#include <cstdio>
#include <cstdint>
#include <cmath>
namespace pg8 {
#define PG8_LAS __attribute__((address_space(3)))
typedef unsigned short bf16_t;
typedef short bf16x8 __attribute__((ext_vector_type(8)));
typedef float f32x4 __attribute__((ext_vector_type(4)));
typedef unsigned u32x4 __attribute__((ext_vector_type(4)));
typedef int v4i_t __attribute__((ext_vector_type(4)));
typedef int v8i_t __attribute__((ext_vector_type(8)));
constexpr int BM = 256, BK = 64, HALF = 128, HTB = HALF * BK * 2  , STAGE_BYTES = 8 * HTB;

__host__ __device__ __forceinline__ int lds_byte(int r, int c) { const int st = (r >> 4) * 2 + (c >> 5), rr = r & 15, cc = c & 31, ob = rr * 64 + cc * 2; return st * 1024 + (ob ^ (((ob >> 9) & 1) << 5)); }
__host__ __device__ __forceinline__ void stage_rc(int b, int& R, int& C) { const int st = b / 1024, sb = b % 1024, swz = sb ^ (((sb >> 9) & 1) << 5); R = (st >> 1) * 16 + swz / 64; C = (st & 1) * 32 + (swz % 64) / 2; }
__host__ __device__ __forceinline__ int perm32(int rho) { const int n = rho >> 4, i = rho & 15; return 8 * (i >> 2) + 4 * n + (i & 3); }

struct Unit { const char* A; const char* B; const int* idx; const float* wts; int r0, c0, aux, kind; };

typedef float f32x2_t __attribute__((ext_vector_type(2))); typedef __bf16 bf16x2_t __attribute__((ext_vector_type(2)));
__device__ __forceinline__ unsigned cvt_pk_bf16(float lo, float hi) { f32x2_t v = {lo, hi}; bf16x2_t b = __builtin_convertvector(v, bf16x2_t); return __builtin_bit_cast(unsigned, b); }
__device__ __forceinline__ float bf_lo(unsigned w) { return __uint_as_float(w << 16); }
__device__ __forceinline__ float bf_hi(unsigned w) { return __uint_as_float(w & 0xffff0000u); }

template <class Epi, class Sched, bool ALIGN_EPI, bool GATHER, bool FP8 = false>
__device__ __forceinline__ void gemm_phase(PG8_LAS unsigned char* lds, PG8_LAS int* idxl, const int K, const Sched& S, const Epi& E) {
    PG8_LAS float* wl = (PG8_LAS float*)(idxl + 256);
    const int tid = threadIdx.x, wid = __builtin_amdgcn_readfirstlane(tid >> 6), lane = tid & 63, wr = wid >> 2, wc = wid & 3, fr = lane & 15, fq = lane >> 4;
    const int KB = FP8 ? K : 2 * K;
    const int nt = KB / 128;
    const size_t kstep = (size_t)(BK * 2);
    const size_t hstep = (size_t)HALF * KB;
    unsigned voffA0[2], voffA1[2], voffB[2];
#pragma unroll
    for (int i = 0; i < 2; ++i) { int R, C; stage_rc(tid * 16 + i * 8192, R, C); const int Rb = Epi::PERM ? ((R & ~31) + perm32(R & 31)) : R;
        voffA0[i] = (unsigned)(R * KB + C * 2); voffA1[i] = voffA0[i] + (unsigned)hstep; voffB[i] = (unsigned)(Rb * KB + C * 2); }
    const unsigned ldsw = (unsigned)wid * 1024u;
    const int aoff = FP8 ? lds_byte(wr * 64 + fr, (fq >> 1) * 32 + (fq & 1) * 16) : lds_byte(wr * 64 + fr, fq * 8), boff = FP8 ? lds_byte(wc * 32 + fr, (fq >> 1) * 32 + (fq & 1) * 16) : lds_byte(wc * 32 + fr, fq * 8);
#define PG8_SA(b, h) (((b) * 2 + (h)) * HTB)
#define PG8_SB(b, h) ((4 + (b) * 2 + (h)) * HTB)
#define PG8_STAGE(bufoff, gbase, voff) do { _Pragma("unroll") for (int _i = 0; _i < 2; ++_i) \
        __builtin_amdgcn_global_load_lds((const unsigned*)((const char*)(gbase) + (voff)[_i]), (PG8_LAS unsigned*)(lds + (bufoff) + ldsw + _i * 8192), 16, 0, 0); } while (0)
#define PG8_LD8(addr) __builtin_shufflevector(*(const PG8_LAS v4i_t*)(addr), *(const PG8_LAS v4i_t*)((addr) + 16), 0, 1, 2, 3, 4, 5, 6, 7)
#define PG8_LDA(dst, b, h) do { if constexpr (FP8) { _Pragma("unroll") for (int m = 0; m < 4; ++m) dst##8[m] = PG8_LD8(lds + PG8_SA(b, h) + aoff + m * 2048); } \
        else { _Pragma("unroll") for (int m = 0; m < 4; ++m) _Pragma("unroll") for (int k = 0; k < 2; ++k) dst[m][k] = *(const PG8_LAS bf16x8*)(lds + PG8_SA(b, h) + aoff + m * 2048 + k * 1024); } } while (0)
#define PG8_LDB(dst, b, h) do { if constexpr (FP8) { _Pragma("unroll") for (int n = 0; n < 2; ++n) dst##8[n] = PG8_LD8(lds + PG8_SB(b, h) + boff + n * 2048); } \
        else { _Pragma("unroll") for (int n = 0; n < 2; ++n) _Pragma("unroll") for (int k = 0; k < 2; ++k) dst[n][k] = *(const PG8_LAS bf16x8*)(lds + PG8_SB(b, h) + boff + n * 2048 + k * 1024); } } while (0)
#define PG8_MMA(ai, bj, At, Bt) do { __builtin_amdgcn_s_setprio(1); _Pragma("unroll") for (int m = 0; m < 4; ++m) _Pragma("unroll") for (int n = 0; n < 2; ++n) { \
        if constexpr (FP8) asm volatile("v_mfma_scale_f32_16x16x128_f8f6f4 %0, %1, %2, %0, %3, %3 op_sel_hi:[0,0,0]" : "+v"(acc[ai][bj][m][n]) : "v"(Bt##8[n]), "v"(At##8[m]), "v"(one_scale)); \
        else { _Pragma("unroll") for (int k = 0; k < 2; ++k) acc[ai][bj][m][n] = __builtin_amdgcn_mfma_f32_16x16x32_bf16(Bt[n][k], At[m][k], acc[ai][bj][m][n], 0, 0, 0); } } __builtin_amdgcn_s_setprio(0); } while (0)
#define PG8_WAIT_V(n) asm volatile("s_waitcnt vmcnt(" #n ")" ::: "memory")
#define PG8_WAIT_L(n) asm volatile("s_waitcnt lgkmcnt(" #n ")" ::: "memory")
#define PG8_WAIT_VN(n) asm volatile("s_waitcnt vmcnt(%0)" :: "n"(n) : "memory")
#define PG8_WAIT_VR(sel) do { if constexpr (Epi::NST > 0) { int _sg; asm volatile("v_readfirstlane_b32 %0, %1\n\ts_nop 0\n\ts_cmp_lg_u32 %0, 0\n\ts_cbranch_scc1 1f\n\ts_waitcnt vmcnt(8)\n\ts_branch 2f\n1:\n\ts_waitcnt vmcnt(%2)\n2:" \
            : "=&s"(_sg) : "v"(sel), "n"(8 + Epi::NST) : "memory", "scc"); } \
        else asm volatile("s_waitcnt vmcnt(8)" ::: "memory"); } while (0)
#define PG8_BAR __builtin_amdgcn_s_barrier()
#define PG8_SCHED __builtin_amdgcn_sched_barrier(0)
#define PG8_GOFF(src) do { _Pragma("unroll") for (int _i = 0; _i < 2; ++_i) { int R_, C_; stage_rc(tid * 16 + _i * 8192, R_, C_); \
        voffA0[_i] = (unsigned)((src)[R_] * KB + C_ * 2); voffA1[_i] = (unsigned)((src)[R_ + HALF] * KB + C_ * 2); } } while (0)
    Unit cur, nxt; int ui = 0;
    if (!S.next(0, cur)) return;
    f32x4 acc[2][2][4][2];
#pragma unroll
    for (int a = 0; a < 2; ++a)
#pragma unroll
        for (int b = 0; b < 2; ++b)
#pragma unroll
            for (int m = 0; m < 4; ++m)
#pragma unroll
                for (int n = 0; n < 2; ++n) acc[a][b][m][n] = (f32x4){0.f, 0.f, 0.f, 0.f};
    bf16x8 At[4][2], B0[2][2], B1[2][2];
    v8i_t At8[4], B08[2], B18[2];
    int one_scale = 0x7f7f7f7f; asm volatile("" : "+v"(one_scale));
    const char* cA = cur.A; const char* cB = cur.B;
    if constexpr (GATHER) { PG8_GOFF(cur.idx); if (tid >= 256) wl[tid - 256] = cur.wts[tid - 256]; }
    PG8_STAGE(PG8_SB(0, 0), cB, voffB); PG8_STAGE(PG8_SB(0, 1), cB + hstep, voffB); PG8_STAGE(PG8_SA(0, 0), cA, voffA0); PG8_STAGE(PG8_SA(0, 1), cA, voffA1);
    if (wr == 1) PG8_BAR;
    PG8_WAIT_V(2); PG8_BAR;
    PG8_STAGE(PG8_SB(1, 0), cB + kstep, voffB); PG8_STAGE(PG8_SA(1, 0), cA + kstep, voffA0); PG8_STAGE(PG8_SB(1, 1), cB + hstep + kstep, voffB);
    PG8_WAIT_V(6); PG8_BAR;
    for (;;) {
        const bool has_next = S.next(ui + 1, nxt);
        const char* nA = has_next ? nxt.A : cA; const char* nB = has_next ? nxt.B : cB;
        if constexpr (GATHER) { if (has_next && tid < 256) {
            __builtin_amdgcn_global_load_lds((const unsigned*)(nxt.idx + tid), (PG8_LAS unsigned*)((PG8_LAS unsigned char*)idxl + wid * 256), 4, 0, 0); }
          if (has_next && tid >= 256) {
            __builtin_amdgcn_global_load_lds((const unsigned*)(nxt.wts + (tid - 256)), (PG8_LAS unsigned*)((PG8_LAS unsigned char*)(wl + ((ui + 1) & 1) * 256) + (wid - 4) * 256), 4, 0, 0); } }
#pragma unroll 1
        for (int t = 0; t < nt; t += 2) {
            const bool last = (t == nt - 2);
            const char* a1 = cA + (size_t)(t + 1) * kstep;
            const char* a2 = last ? nA : cA + (size_t)(t + 2) * kstep; const char* b2 = last ? nB : cB + (size_t)(t + 2) * kstep;
            const char* a3 = a2 + kstep; const char* b3 = b2 + kstep;
            const int rlx = (t == 0 && ui > 0) ? 1 : 0;
            PG8_LDB(B0, 0, 0); PG8_LDB(B1, 0, 1); PG8_SCHED; PG8_LDA(At, 0, 0); PG8_STAGE(PG8_SA(1, 1), a1, voffA1);
            if constexpr (GATHER) { if (last && has_next) { PG8_GOFF(idxl); } }
            PG8_WAIT_VR(rlx); PG8_WAIT_L(0); PG8_BAR; PG8_MMA(0, 0, At, B0); PG8_MMA(0, 1, At, B1); PG8_BAR; PG8_SCHED;
            PG8_LDA(At, 0, 1); PG8_STAGE(PG8_SB(0, 0), b2, voffB); PG8_STAGE(PG8_SB(0, 1), b2 + hstep, voffB); PG8_STAGE(PG8_SA(0, 0), a2, voffA0);
            PG8_WAIT_VR(rlx); PG8_WAIT_L(0); PG8_BAR; PG8_MMA(1, 0, At, B0); PG8_MMA(1, 1, At, B1); PG8_BAR; PG8_SCHED;
            PG8_LDB(B0, 1, 0); PG8_LDB(B1, 1, 1); PG8_SCHED; PG8_LDA(At, 1, 0); PG8_STAGE(PG8_SA(0, 1), a2, voffA1);
            PG8_WAIT_V(8); PG8_WAIT_L(0); PG8_BAR; PG8_MMA(0, 0, At, B0); PG8_MMA(0, 1, At, B1); PG8_BAR; PG8_SCHED;
            PG8_LDA(At, 1, 1); PG8_STAGE(PG8_SB(1, 0), b3, voffB); PG8_STAGE(PG8_SB(1, 1), b3 + hstep, voffB); PG8_STAGE(PG8_SA(1, 0), a3, voffA0);
            PG8_WAIT_V(8); PG8_WAIT_L(0); PG8_BAR; PG8_MMA(1, 0, At, B0); PG8_MMA(1, 1, At, B1); PG8_BAR; PG8_SCHED;
        }
        if constexpr (ALIGN_EPI) { if (wr == 0) PG8_BAR; }
        if constexpr (FP8) asm volatile("s_nop 15\n\ts_nop 15" ::: "memory");
        const bool keep = E(acc, cur, wr, wc, fr, fq, wl + (ui & 1) * 256);
        if (!has_next) break;
        if (!keep) {
#pragma unroll
        for (int a = 0; a < 2; ++a)
#pragma unroll
            for (int b = 0; b < 2; ++b)
#pragma unroll
                for (int m = 0; m < 4; ++m)
#pragma unroll
                    for (int n = 0; n < 2; ++n) acc[a][b][m][n] = (f32x4){0.f, 0.f, 0.f, 0.f};
        }
        cur = nxt; cA = nA; cB = nB; ++ui;
        if constexpr (ALIGN_EPI) { if (wr == 1) PG8_BAR; }
    }
    PG8_WAIT_V(0);
    if constexpr (!ALIGN_EPI) { if (wr == 0) PG8_BAR; }
    PG8_BAR;
#undef PG8_SA
#undef PG8_SB
#undef PG8_STAGE
#undef PG8_LDA
#undef PG8_LDB
#undef PG8_MMA
#undef PG8_LD8
#undef PG8_WAIT_V
#undef PG8_WAIT_L
#undef PG8_WAIT_VN
#undef PG8_WAIT_VR
#undef PG8_BAR
#undef PG8_SCHED
#undef PG8_GOFF
}
}
namespace attn {
using bf16 = __hip_bfloat16;
constexpr int   D = 128, NW = 8, QBLK = 32, KVBLK = 64;
constexpr float SCALE = 0.088388347648318440f;
constexpr float THR = 8.f;
constexpr float LOG2E = 1.4426950408889634f;
#ifndef PROJ_PAD
#define PROJ_PAD 64
#endif
constexpr int LDQ = 7168 + PROJ_PAD, LDK = 7168 + PROJ_PAD, LDO = 1024;
constexpr size_t SHM_V = KVBLK * D * 2, SHM_K = KVBLK * D * 2, SHM_ATTN = 2 * SHM_V + 2 * SHM_K + NW * 64 * 4;
constexpr int WIN_TAB = (int)SHM_ATTN;

using bf16x8 = __attribute__((ext_vector_type(8))) short;
using s16x4  = __attribute__((ext_vector_type(4))) short;
using f32x16 = __attribute__((ext_vector_type(16))) float;
using u32x4  = __attribute__((ext_vector_type(4))) unsigned;
using f32x4_a = __attribute__((ext_vector_type(4))) float;
#define KSWZ(row, colB) ((row) * 256 + ((colB) ^ (((row) & 7) << 4)))
#define SBAR() __builtin_amdgcn_sched_barrier(0)
__device__ __forceinline__ int crow(int r, int hi) { return (r & 3) + 8 * (r >> 2) + 4 * hi; }
__device__ __forceinline__ unsigned cvtpk(float lo, float hi) { return pg8::cvt_pk_bf16(lo, hi); }
template <bool FIXM, bool PRE = false>
__device__ __forceinline__ void partialSM(f32x16& p0, f32x16& p1, float& m_reg, float& mn, float& alpha) {
  constexpr float C = SCALE * LOG2E;
  if constexpr (PRE) {
    mn = m_reg; alpha = 1.f;
    for (int r = 0; r < 16; ++r) p0[r] = __builtin_amdgcn_exp2f(p0[r]);
    return;
  }
  if constexpr (FIXM) {
    mn = m_reg; alpha = 1.f; float mnC = -m_reg * C; asm volatile("" : "+v"(mnC));
    typedef float f32x2_p __attribute__((ext_vector_type(2))); const f32x2_p c2 = {C, C}, m2 = {mnC, mnC};
#pragma unroll
    for (int r = 0; r < 16; r += 2) { f32x2_p a = {p0[r], p0[r + 1]}, b = {p1[r], p1[r + 1]}; a = __builtin_elementwise_fma(a, c2, m2); b = __builtin_elementwise_fma(b, c2, m2); p0[r] = a[0]; p0[r + 1] = a[1]; p1[r] = b[0]; p1[r + 1] = b[1]; }
    for (int r = 0; r < 16; ++r) p0[r] = __builtin_amdgcn_exp2f(p0[r]);
    return;
  }
  float pmax = p0[0]; for (int r = 1; r < 16; ++r) pmax = fmaxf(pmax, p0[r]); for (int r = 0; r < 16; ++r) pmax = fmaxf(pmax, p1[r]);
  { auto rr = __builtin_amdgcn_permlane32_swap(__float_as_uint(pmax), __float_as_uint(pmax), false, false);
    pmax = fmaxf(__uint_as_float(rr[0]), __uint_as_float(rr[1])); }
  if (__builtin_expect(__all(pmax - m_reg <= THR / SCALE), 1)) { mn = m_reg; alpha = 1.f; }
  else { mn = fmaxf(m_reg, pmax); alpha = __builtin_amdgcn_exp2f((m_reg - mn) * C); m_reg = mn; }
  float mnC = -mn * C;
  for (int r = 0; r < 16; ++r) p0[r] = fmaf(p0[r], C, mnC); for (int r = 0; r < 16; ++r) p1[r] = fmaf(p1[r], C, mnC);
  for (int r = 0; r < 16; ++r) p0[r] = __builtin_amdgcn_exp2f(p0[r]);
}
__device__ __forceinline__ void finishSM(f32x16& p0, f32x16& p1, float alpha, float& l_reg, bf16x8& pa0, bf16x8& pa1, bf16x8& pa2, bf16x8& pa3) {
  for (int r = 0; r < 16; ++r) p1[r] = __builtin_amdgcn_exp2f(p1[r]);
  float ps = 0; for (int r = 0; r < 16; ++r) ps += p0[r]; for (int r = 0; r < 16; ++r) ps += p1[r];
  { auto rr = __builtin_amdgcn_permlane32_swap(__float_as_uint(ps), __float_as_uint(ps), false, false);
    ps = __uint_as_float(rr[0]) + __uint_as_float(rr[1]); }
  l_reg = l_reg * alpha + ps;
#define PK4(P, BASE, OUT) do { unsigned a0 = cvtpk(P[BASE + 0], P[BASE + 1]), a1 = cvtpk(P[BASE + 2], P[BASE + 3]);   \
    unsigned b0 = cvtpk(P[BASE + 4], P[BASE + 5]), b1 = cvtpk(P[BASE + 6], P[BASE + 7]);                              \
    auto r0 = __builtin_amdgcn_permlane32_swap(a0, b0, false, false); auto r1 = __builtin_amdgcn_permlane32_swap(a1, b1, false, false); \
    u32x4 w = {r0[0], r1[0], r0[1], r1[1]}; OUT = *reinterpret_cast<bf16x8*>(&w); } while (0)
  PK4(p0, 0, pa0); PK4(p0, 8, pa1); PK4(p1, 0, pa2); PK4(p1, 8, pa3);
#undef PK4
}
#define KSWZ8(row, colB) ((row) * 128 + ((colB) ^ (((row) & 7) << 4)))
typedef int v8i_a __attribute__((ext_vector_type(8))); typedef int v4i_a __attribute__((ext_vector_type(4)));
template <bool WIN, bool F8, bool PRE = false>
__device__ __forceinline__ void qkt(f32x16& p0, f32x16& p1, const bf16* Ks, const bf16x8* qr, const v8i_a* q8, int r32, int hi, const __attribute__((address_space(3))) float* tb, const f32x16* cinit = nullptr) {
  if constexpr (F8 && PRE) {
    int one = 0x7f7f7f7f, sc3 = 0x7c7c7c7c; asm volatile("" : "+v"(one), "+v"(sc3));
#pragma unroll
    for (int s = 0; s < 2; ++s) { const int cb = 64 * s + 32 * hi;
      const char* ka = (const char*)Ks + KSWZ8(r32, cb); const char* kb = (const char*)Ks + KSWZ8(32 + r32, cb);
      const v8i_a k0 = __builtin_shufflevector(*reinterpret_cast<const v4i_a*>(ka), *reinterpret_cast<const v4i_a*>((const char*)Ks + KSWZ8(r32, cb + 16)), 0, 1, 2, 3, 4, 5, 6, 7);
      const v8i_a k1 = __builtin_shufflevector(*reinterpret_cast<const v4i_a*>(kb), *reinterpret_cast<const v4i_a*>((const char*)Ks + KSWZ8(32 + r32, cb + 16)), 0, 1, 2, 3, 4, 5, 6, 7);
      if (s == 0) {
        asm volatile("s_nop 1\n\tv_mfma_scale_f32_32x32x64_f8f6f4 %0, %1, %2, %3, %4, %5 op_sel_hi:[0,0,0]" : "=&v"(p0) : "v"(k0), "v"(q8[s]), "v"(*cinit), "v"(one), "v"(sc3));
        asm volatile("v_mfma_scale_f32_32x32x64_f8f6f4 %0, %1, %2, %3, %4, %5 op_sel_hi:[0,0,0]" : "=&v"(p1) : "v"(k1), "v"(q8[s]), "v"(*cinit), "v"(one), "v"(sc3));
      } else {
        asm volatile("v_mfma_scale_f32_32x32x64_f8f6f4 %0, %1, %2, %0, %3, %4 op_sel_hi:[0,0,0]" : "+v"(p0) : "v"(k0), "v"(q8[s]), "v"(one), "v"(sc3));
        asm volatile("v_mfma_scale_f32_32x32x64_f8f6f4 %0, %1, %2, %0, %3, %4 op_sel_hi:[0,0,0]" : "+v"(p1) : "v"(k1), "v"(q8[s]), "v"(one), "v"(sc3)); } }
    asm volatile("s_nop 15\n\ts_nop 15" : "+v"(p0), "+v"(p1));
    return;
  }
  if constexpr (F8) {
    int one = 0x7f7f7f7f; asm volatile("" : "+v"(one));
#pragma unroll
    for (int s = 0; s < 2; ++s) { const int cb = 64 * s + 32 * hi;
      const char* ka = (const char*)Ks + KSWZ8(r32, cb); const char* kb = (const char*)Ks + KSWZ8(32 + r32, cb);
      const v8i_a k0 = __builtin_shufflevector(*reinterpret_cast<const v4i_a*>(ka), *reinterpret_cast<const v4i_a*>((const char*)Ks + KSWZ8(r32, cb + 16)), 0, 1, 2, 3, 4, 5, 6, 7);
      const v8i_a k1 = __builtin_shufflevector(*reinterpret_cast<const v4i_a*>(kb), *reinterpret_cast<const v4i_a*>((const char*)Ks + KSWZ8(32 + r32, cb + 16)), 0, 1, 2, 3, 4, 5, 6, 7);
      if (s == 0) {
        asm volatile("s_nop 1\n\tv_mfma_scale_f32_32x32x64_f8f6f4 %0, %1, %2, 0, %3, %3 op_sel_hi:[0,0,0]" : "=&v"(p0) : "v"(k0), "v"(q8[s]), "v"(one));
        asm volatile("v_mfma_scale_f32_32x32x64_f8f6f4 %0, %1, %2, 0, %3, %3 op_sel_hi:[0,0,0]" : "=&v"(p1) : "v"(k1), "v"(q8[s]), "v"(one));
      } else {
        asm volatile("v_mfma_scale_f32_32x32x64_f8f6f4 %0, %1, %2, %0, %3, %3 op_sel_hi:[0,0,0]" : "+v"(p0) : "v"(k0), "v"(q8[s]), "v"(one));
        asm volatile("v_mfma_scale_f32_32x32x64_f8f6f4 %0, %1, %2, %0, %3, %3 op_sel_hi:[0,0,0]" : "+v"(p1) : "v"(k1), "v"(q8[s]), "v"(one)); } }
    asm volatile("s_nop 15\n\ts_nop 15" : "+v"(p0), "+v"(p1));
    return;
  }
  if constexpr (WIN) {
#pragma unroll
    for (int r = 0; r < 16; ++r) { p0[r] = tb[(r & 3) + 8 * (r >> 2)]; p1[r] = tb[32 + (r & 3) + 8 * (r >> 2)]; }
  } else { p0 = f32x16{}; p1 = f32x16{}; }
  for (int d0 = 0; d0 < 8; ++d0) { int cb = (d0 * 16 + hi * 8) * 2;
    bf16x8 b0 = *reinterpret_cast<const bf16x8*>((const char*)Ks + KSWZ(r32, cb));
    bf16x8 b1 = *reinterpret_cast<const bf16x8*>((const char*)Ks + KSWZ(32 + r32, cb));
    p0 = __builtin_amdgcn_mfma_f32_32x32x16_bf16(b0, qr[d0], p0, 0, 0, 0);
    p1 = __builtin_amdgcn_mfma_f32_32x32x16_bf16(b1, qr[d0], p1, 0, 0, 0); }
}
__device__ __forceinline__ int v_st(int k, int c) { const int kk = (k & ~0xC) | ((k & 4) << 1) | ((k & 8) >> 1); return ((kk >> 3) * 4 + (c >> 5)) * 512 + ((kk & 7) * 32 + (c & 31)) * 2; }
__device__ __forceinline__ int v_rd_base(int lane) { return ((lane & 3) << 3) | (((lane >> 2) & 3) << 6) | (((lane >> 4) & 1) << 5) | (((lane >> 5) & 1) << 8); }
constexpr int v_rd_off(int d0, int ks, int half) { return d0 * 512 + ks * 4096 + half * 2048; }
template <int OFF> __device__ __forceinline__ s16x4 tr_read(int vb) {
  s16x4 r; asm volatile("ds_read_b64_tr_b16 %0, %1 offset:%2" : "=&v"(r) : "v"(vb), "i"(OFF) : "memory"); return r;
}
template <int D0> __device__ __forceinline__ void pv_one(f32x16& od, int vb, bf16x8 pa0, bf16x8 pa1, bf16x8 pa2, bf16x8 pa3) {
  const s16x4 l0 = tr_read<v_rd_off(D0, 0, 0)>(vb), h0 = tr_read<v_rd_off(D0, 0, 1)>(vb), l1 = tr_read<v_rd_off(D0, 1, 0)>(vb), h1 = tr_read<v_rd_off(D0, 1, 1)>(vb);
  const s16x4 l2 = tr_read<v_rd_off(D0, 2, 0)>(vb), h2 = tr_read<v_rd_off(D0, 2, 1)>(vb), l3 = tr_read<v_rd_off(D0, 3, 0)>(vb), h3 = tr_read<v_rd_off(D0, 3, 1)>(vb);
  asm volatile("s_waitcnt lgkmcnt(0)" ::: "memory"); SBAR();
#define PK(L, H) (bf16x8){L[0], L[1], L[2], L[3], H[0], H[1], H[2], H[3]}
  od = __builtin_amdgcn_mfma_f32_32x32x16_bf16(pa0, PK(l0, h0), od, 0, 0, 0);
  od = __builtin_amdgcn_mfma_f32_32x32x16_bf16(pa1, PK(l1, h1), od, 0, 0, 0);
  od = __builtin_amdgcn_mfma_f32_32x32x16_bf16(pa2, PK(l2, h2), od, 0, 0, 0);
  od = __builtin_amdgcn_mfma_f32_32x32x16_bf16(pa3, PK(l3, h3), od, 0, 0, 0);
#undef PK
}
__device__ __forceinline__ void pv_d0(f32x16* o, int vb, bf16x8 pa0, bf16x8 pa1, bf16x8 pa2, bf16x8 pa3) {
  pv_one<0>(o[0], vb, pa0, pa1, pa2, pa3); pv_one<1>(o[1], vb, pa0, pa1, pa2, pa3); pv_one<2>(o[2], vb, pa0, pa1, pa2, pa3); pv_one<3>(o[3], vb, pa0, pa1, pa2, pa3);
}

template <bool WIN, int SDEPTH, bool F8, bool FIXM, bool QN = false, int kmask = -1, bool PP = false, bool WRES = false>
__device__ __forceinline__ void attn_body(const bf16* __restrict__ Qb, const bf16* __restrict__ Kh, const unsigned char* __restrict__ Kh8, const bf16* __restrict__ Vh,
                                          unsigned char* __restrict__ Ob, float oscale, int seq, char* lds, const __attribute__((address_space(3))) float* tab, int relbase, float m0, float l0,
                                          const float* __restrict__ gq = nullptr, int qpos0 = 0) {
  int tid_ = threadIdx.x; asm volatile("" : "+v"(tid_));
  const int tid = tid_, wid = tid >> 6, lane = tid & 63, r32 = lane & 31, hi = lane >> 5;
  bf16* V_lds = (bf16*)lds; bf16* K_lds = (bf16*)(lds + 2 * SHM_V);
  float* ws = (float*)(lds + 2 * SHM_V + 2 * SHM_K) + wid * 64; float* li_l = ws; float* al_l = ws + 32;
  float m_reg = m0, l_reg = l0; f32x16 o[4]; bf16x8 qr[8];
  const bf16* Qw = Qb + (long)(wid * QBLK + r32) * LDQ + hi * 8;
  v8i_a q8[2];
  if constexpr (F8 && QN) {
    const bf16* Qr = Qb + (long)(wid * QBLK + r32) * LDQ + hi * 16;
    u32x4 raw[2][2][2];
#pragma unroll
    for (int s = 0; s < 2; ++s)
#pragma unroll
      for (int pt = 0; pt < 2; ++pt)
#pragma unroll
        for (int c = 0; c < 2; ++c) raw[s][pt][c] = *reinterpret_cast<const u32x4*>(Qr + 64 * s + 32 * pt + 8 * c);
#define QLO(w_) __uint_as_float((w_) << 16)
#define QHI(w_) __uint_as_float((w_) & 0xffff0000u)
    float ss = 0.f;
#pragma unroll
    for (int s = 0; s < 2; ++s)
#pragma unroll
      for (int pt = 0; pt < 2; ++pt)
#pragma unroll
        for (int c = 0; c < 2; ++c) { const u32x4 v = raw[s][pt][c];
          ss = fmaf(QLO(v.x), QLO(v.x), ss); ss = fmaf(QHI(v.x), QHI(v.x), ss); ss = fmaf(QLO(v.y), QLO(v.y), ss); ss = fmaf(QHI(v.y), QHI(v.y), ss);
          ss = fmaf(QLO(v.z), QLO(v.z), ss); ss = fmaf(QHI(v.z), QHI(v.z), ss); ss = fmaf(QLO(v.w), QLO(v.w), ss); ss = fmaf(QHI(v.w), QHI(v.w), ss); }
    { auto rr = __builtin_amdgcn_permlane32_swap(__float_as_uint(ss), __float_as_uint(ss), false, false); ss = __uint_as_float(rr[0]) + __uint_as_float(rr[1]); }
    const float rs = 1.0f / sqrtf(ss * (1.0f / D) + 1e-6f);
    constexpr float qsc = PP ? 8.0f * SCALE * LOG2E : 1.0f;
    const int tok = qpos0 + wid * QBLK + r32;
#pragma unroll
    for (int s = 0; s < 2; ++s) { int w[8]; const float pos = (float)(s == 0 ? (tok >> 6) : (tok & 63));
#pragma unroll
      for (int c = 0; c < 2; ++c) {
        const u32x4 va = raw[s][0][c], vb = raw[s][1][c];
        const float xa[8] = {QLO(va.x), QHI(va.x), QLO(va.y), QHI(va.y), QLO(va.z), QHI(va.z), QLO(va.w), QHI(va.w)}, xb[8] = {QLO(vb.x), QHI(vb.x), QLO(vb.y), QHI(vb.y), QLO(vb.z), QHI(vb.z), QLO(vb.w), QHI(vb.w)};
        float o1[8], o2[8];
#pragma unroll
        for (int u4 = 0; u4 < 2; ++u4) { const f32x4_a g1 = *reinterpret_cast<const f32x4_a*>(gq + 64 * s + 16 * hi + 8 * c + 4 * u4), g2 = *reinterpret_cast<const f32x4_a*>(gq + 64 * s + 32 + 16 * hi + 8 * c + 4 * u4);
#pragma unroll
          for (int u = 0; u < 4; ++u) { const int t = 4 * u4 + u; const float inv = __builtin_amdgcn_exp2f(-(float)(2 * (16 * hi + 8 * c + t)) * (1.0f / 64.0f) * 13.287712379549449f);
            const float rev = pos * inv * 0.15915494309189535f, fr = rev - floorf(rev); const float sn = __builtin_amdgcn_sinf(fr), cs = __builtin_amdgcn_cosf(fr);
            const float a = xa[t] * rs * g1[u], b = xb[t] * rs * g2[u]; o1[t] = (a * cs - b * sn) * qsc; o2[t] = (b * cs + a * sn) * qsc; } }
        int t0 = __builtin_amdgcn_cvt_pk_fp8_f32(o1[0], o1[1], 0, false); t0 = __builtin_amdgcn_cvt_pk_fp8_f32(o1[2], o1[3], t0, true); w[2 * c] = t0;
        t0 = __builtin_amdgcn_cvt_pk_fp8_f32(o1[4], o1[5], 0, false); t0 = __builtin_amdgcn_cvt_pk_fp8_f32(o1[6], o1[7], t0, true); w[2 * c + 1] = t0;
        t0 = __builtin_amdgcn_cvt_pk_fp8_f32(o2[0], o2[1], 0, false); t0 = __builtin_amdgcn_cvt_pk_fp8_f32(o2[2], o2[3], t0, true); w[4 + 2 * c] = t0;
        t0 = __builtin_amdgcn_cvt_pk_fp8_f32(o2[4], o2[5], 0, false); t0 = __builtin_amdgcn_cvt_pk_fp8_f32(o2[6], o2[7], t0, true); w[4 + 2 * c + 1] = t0; }
      q8[s] = (v8i_a){w[0], w[1], w[2], w[3], w[4], w[5], w[6], w[7]}; }
#undef QLO
#undef QHI
  } else if constexpr (F8) {
    const bf16* Qr = Qb + (long)(wid * QBLK + r32) * LDQ + hi * 32;
#pragma unroll
    for (int s = 0; s < 2; ++s) { int w[8];
#pragma unroll
      for (int c = 0; c < 4; ++c) { const u32x4 v = *reinterpret_cast<const u32x4*>(Qr + 64 * s + 8 * c);
        int t = __builtin_amdgcn_cvt_pk_fp8_f32(__uint_as_float(v.x << 16), __uint_as_float(v.x & 0xffff0000u), 0, false); t = __builtin_amdgcn_cvt_pk_fp8_f32(__uint_as_float(v.y << 16), __uint_as_float(v.y & 0xffff0000u), t, true); w[2 * c] = t;
        t = __builtin_amdgcn_cvt_pk_fp8_f32(__uint_as_float(v.z << 16), __uint_as_float(v.z & 0xffff0000u), 0, false); t = __builtin_amdgcn_cvt_pk_fp8_f32(__uint_as_float(v.w << 16), __uint_as_float(v.w & 0xffff0000u), t, true); w[2 * c + 1] = t; }
      q8[s] = (v8i_a){w[0], w[1], w[2], w[3], w[4], w[5], w[6], w[7]}; }
  } else {
#pragma unroll
    for (int d0 = 0; d0 < 8; ++d0) qr[d0] = *reinterpret_cast<const bf16x8*>(Qw + d0 * 16);
  }
#pragma unroll
  for (int d = 0; d < 4; ++d) { float z_; asm volatile("v_mov_b32 %0, 0" : "=v"(z_));
#pragma unroll
    for (int r = 0; r < 16; ++r) o[d][r] = z_; }
  const int sr = tid >> 4, sc = (tid & 15) * 8, vst0 = v_st(sr, sc), vst1 = v_st(32 + sr, sc);
  const int vb0 = (int)(uintptr_t)V_lds + v_rd_base(lane);
  const __attribute__((address_space(3))) float* tb0 = tab + (relbase - (wid * QBLK + r32) + 512 + 4 * hi);
  struct { bf16x8 vs0, vs1, ks0, ks1; } sr_[SDEPTH];
#define SLOAD(i, k0) do { sr_[i].vs0 = *reinterpret_cast<const bf16x8*>(&Vh[(long)(((k0) & kmask) + sr) * LDK + sc]); sr_[i].vs1 = *reinterpret_cast<const bf16x8*>(&Vh[(long)(((k0) & kmask) + 32 + sr) * LDK + sc]); \
    if constexpr (F8) { sr_[i].ks0 = *reinterpret_cast<const bf16x8*>(&Kh8[(long)(((k0) & kmask) + (tid >> 3)) * 256 + (tid & 7) * 16]); } \
    else { sr_[i].ks0 = *reinterpret_cast<const bf16x8*>(&Kh[(long)(((k0) & kmask) + sr) * LDK + sc]); sr_[i].ks1 = *reinterpret_cast<const bf16x8*>(&Kh[(long)(((k0) & kmask) + 32 + sr) * LDK + sc]); } } while (0)
#define SWRITE(b, i) do { *(bf16x8*)((char*)V_lds + (b) * SHM_V + vst0) = sr_[i].vs0;          \
    *(bf16x8*)((char*)V_lds + (b) * SHM_V + vst1) = sr_[i].vs1; int kc = sc * 2;               \
    if constexpr (F8) { *(bf16x8*)((char*)K_lds + (b) * SHM_K + KSWZ8(tid >> 3, (tid & 7) * 16)) = sr_[i].ks0; } \
    else { *(bf16x8*)((char*)K_lds + (b) * SHM_K + KSWZ(sr, kc)) = sr_[i].ks0;                       \
    *(bf16x8*)((char*)K_lds + (b) * SHM_K + KSWZ(32 + sr, kc)) = sr_[i].ks1; } } while (0)
#define SWAIT() do { if constexpr (SDEPTH == 2) asm volatile("s_waitcnt vmcnt(4)" ::: "memory"); else asm volatile("s_waitcnt vmcnt(0)" ::: "memory"); } while (0)
#define RESC(a) do { if (!FIXM && __any((a) < 1.f)) { if (hi == 0) al_l[r32] = (a); asm volatile("s_waitcnt lgkmcnt(0)" ::: "memory"); \
    for (int d = 0; d < 4; ++d) for (int r = 0; r < 16; ++r) o[d][r] *= al_l[crow(r, hi)]; } } while (0)
  f32x16 pA0, pA1, pB0, pB1; float mnA, mnB, alA, alB; bf16x8 pa0, pa1, pa2, pa3; const int NT = seq / KVBLK;
  if constexpr (WRES) {
    static_assert(!WRES || (WIN && !F8 && !FIXM && !PP), "window-resident path: the bf16 banded attention only");
    typedef __attribute__((address_space(3))) unsigned lds_u32;
    typedef __attribute__((address_space(3))) unsigned char lds_u8;
    constexpr int KST = 0, VST = 65536, TILEB = KVBLK * D * 2, TABO = 131072 + 512, SCRO = TABO + 4096;
    const int widu = __builtin_amdgcn_readfirstlane(wid);
    lds_u8* ldsb = (lds_u8*)(unsigned)(uintptr_t)lds;
    li_l = (float*)(lds + SCRO) + widu * 64; al_l = li_l + 32;
    __attribute__((address_space(3))) float* tabw = (__attribute__((address_space(3))) float*)(ldsb + TABO);
    unsigned kofs[2], vofs[2];
#pragma unroll
    for (int i = 0; i < 2; ++i) { const int row = 4 * (widu * 2 + i) + (lane >> 4), c = (lane & 15) ^ (row & 7); kofs[i] = (unsigned)((row * LDK + c * 8) * 2);
      const int blk = (widu * 2 + i) * 2 + (lane >> 5), kk = (blk >> 2) * 8 + ((lane & 31) >> 2), k = (kk & ~0xC) | ((kk & 4) << 1) | ((kk & 8) >> 1);
      vofs[i] = (unsigned)((k * LDK + (blk & 3) * 32 + 8 * (lane & 3)) * 2); }
#define WDMA(slot, tile) do { const unsigned char* kb_ = (const unsigned char*)(Kh + (long)(tile) * (KVBLK * LDK)); const unsigned char* vb_ = (const unsigned char*)(Vh + (long)(tile) * (KVBLK * LDK)); \
      asm volatile("" : "+s"(kb_), "+s"(vb_)); _Pragma("unroll") for (int i_ = 0; i_ < 2; ++i_) { \
        __builtin_amdgcn_global_load_lds((const unsigned*)(kb_ + kofs[i_]), (lds_u32*)(ldsb + KST + (slot) * TILEB + (widu * 2 + i_) * 1024), 16, 0, 0); \
        __builtin_amdgcn_global_load_lds((const unsigned*)(vb_ + vofs[i_]), (lds_u32*)(ldsb + VST + (slot) * TILEB + (widu * 2 + i_) * 1024), 16, 0, 0); } } while (0)
#pragma unroll
    for (int sl = 0; sl < 4; ++sl) if (sl < NT) WDMA(sl, sl);
    for (int e = tid; e < 1024; e += NW * 64) { const int rel = e - 512, n = rel < 0 ? -rel : rel; int b;
      if (n < 8) b = n; else if (n < 12) b = 8; else if (n < 16) b = 9; else if (n < 23) b = 10; else if (n < 32) b = 11; else if (n < 46) b = 12; else if (n < 64) b = 13; else if (n < 91) b = 14; else b = 15;
      tabw[e] = n <= 128 ? gq[((rel > 0 ? 16 : 0) + b) * 8] * (1.0f / SCALE) : -1e30f; }
    asm volatile("s_waitcnt vmcnt(0) lgkmcnt(0)" ::: "memory"); __syncthreads();
    const __attribute__((address_space(3))) float* tbw0 = tabw + (relbase - (wid * QBLK + r32) + 512 + 4 * hi);
    const int qlo = widu * QBLK, qhi = qlo + QBLK - 1;
#pragma unroll 1
    for (int st = 0; st < 2; ++st) {
#pragma unroll 1
      for (int jj = 0; jj < 4; ++jj) { const int j = st * 4 + jj; const int r0 = relbase + KVBLK * j;
        if (j < NT && r0 <= qhi + 128 && r0 + KVBLK - 1 >= qlo - 128) {
          qkt<WIN, F8>(pA0, pA1, (bf16*)(lds + KST + jj * TILEB), qr, q8, r32, hi, tbw0 + KVBLK * j);
          partialSM<FIXM>(pA0, pA1, m_reg, mnA, alA); finishSM(pA0, pA1, alA, l_reg, pa0, pa1, pa2, pa3); RESC(alA);
          pv_d0(o, (int)(uintptr_t)(lds + VST + jj * TILEB) + v_rd_base(lane), pa0, pa1, pa2, pa3); } }
      if (st == 0 && NT > 4) { __syncthreads();
#pragma unroll
        for (int sl = 0; sl < 4; ++sl) if (4 + sl < NT) WDMA(sl, 4 + sl);
        asm volatile("s_waitcnt vmcnt(0)" ::: "memory"); __syncthreads(); }
      else if (st == 0) break;
    }
#undef WDMA
  } else if constexpr (PP) {
    static_assert(!PP || (F8 && FIXM && !WIN), "ping-pong path: dense fp8 fixed-reference attention only");
    constexpr int NS = 4, KSLOT = KVBLK * D, VSLOT = KVBLK * D * 2, KRING = NS * VSLOT;
    typedef __attribute__((address_space(3))) unsigned lds_u32;
    const int widu = __builtin_amdgcn_readfirstlane(wid), grp = widu >> 2;
    li_l = (float*)(lds + KRING + NS * KSLOT) + widu * 64; al_l = li_l + 32;
    const __attribute__((address_space(3))) unsigned char* ldsb = (const __attribute__((address_space(3))) unsigned char*)(unsigned)(uintptr_t)lds;
    const int krow = widu * 8 + (lane >> 3);
    const unsigned kofs = (unsigned)(krow * 256 + (((lane & 7) ^ (krow & 7)) << 4));
    unsigned vofs[2];
#pragma unroll
    for (int i = 0; i < 2; ++i) { const int blk = (widu * 2 + i) * 2 + (lane >> 5), kk = (blk >> 2) * 8 + ((lane & 31) >> 2), k = (kk & ~0xC) | ((kk & 4) << 1) | ((kk & 8) >> 1);
      vofs[i] = (unsigned)((k * LDK + (blk & 3) * 32 + 8 * (lane & 3)) * 2); }
#define DMAK(t) do { const int t_ = (t) < NT ? (t) : NT - 1; const unsigned char* kb_ = Kh8 + (long)t_ * (KVBLK * 256); asm volatile("" : "+s"(kb_)); \
      __builtin_amdgcn_global_load_lds((const unsigned*)(kb_ + kofs), (lds_u32*)(ldsb + KRING + ((t) & (NS - 1)) * KSLOT + widu * 1024), 16, 0, 0); } while (0)
#define DMAV(t) do { const int t_ = (t) < NT ? (t) : NT - 1; const unsigned char* vb_ = (const unsigned char*)(Vh + (long)t_ * (KVBLK * LDK)); asm volatile("" : "+s"(vb_)); _Pragma("unroll") for (int i_ = 0; i_ < 2; ++i_) \
      __builtin_amdgcn_global_load_lds((const unsigned*)(vb_ + vofs[i_]), (lds_u32*)(ldsb + ((t) & (NS - 1)) * VSLOT + (widu * 2 + i_) * 1024), 16, 0, 0); } while (0)
#define PBAR() do { asm volatile("s_waitcnt lgkmcnt(0)" ::: "memory"); __builtin_amdgcn_s_barrier(); } while (0)
#define PEND() do { asm volatile("s_waitcnt vmcnt(6)" ::: "memory"); PBAR(); } while (0)
#define KSL(t) ((bf16*)(lds + KRING + ((t) & (NS - 1)) * KSLOT))
#define VSL(t) (vb0 + ((t) & (NS - 1)) * VSLOT)
    DMAK(0); DMAV(0); DMAK(1); DMAV(1); DMAK(2); DMAK(3); DMAV(2);
    asm volatile("s_waitcnt vmcnt(0)" ::: "memory"); PBAR();
    f32x16 cinit; { float nm_ = -m0 * (SCALE * LOG2E); asm volatile("" : "+v"(nm_));
#pragma unroll
      for (int r = 0; r < 16; ++r) cinit[r] = nm_; }
    qkt<WIN, F8, true>(pA0, pA1, KSL(0), qr, q8, r32, hi, tb0, &cinit); partialSM<FIXM, true>(pA0, pA1, m_reg, mnA, alA);
    PBAR();
    if (grp == 1) PBAR();
#pragma unroll 1
    for (int t = 1; t < NT; ++t) {
      SBAR(); DMAK(t + 3); SBAR();
      finishSM(pA0, pA1, alA, l_reg, pa0, pa1, pa2, pa3); SBAR();
      qkt<WIN, F8, true>(pA0, pA1, KSL(t), qr, q8, r32, hi, tb0, &cinit); SBAR();
      PEND();
      SBAR(); DMAV(t + 2); SBAR();
      pv_d0(o, VSL(t - 1), pa0, pa1, pa2, pa3); partialSM<FIXM, true>(pA0, pA1, m_reg, mnA, alA); SBAR();
      PEND();
    }
    if (grp == 0) PBAR();
    finishSM(pA0, pA1, alA, l_reg, pa0, pa1, pa2, pa3); SBAR();
    pv_d0(o, VSL(NT - 1), pa0, pa1, pa2, pa3);
    asm volatile("s_waitcnt vmcnt(0)" ::: "memory");
#undef DMAK
#undef DMAV
#undef PBAR
#undef PEND
#undef KSL
#undef VSL
  } else {
  constexpr int SE = 0, SO = SDEPTH - 1;
  SLOAD(SE, 0); asm volatile("s_waitcnt vmcnt(0)" ::: "memory"); SWRITE(0, SE); __syncthreads();
  qkt<WIN, F8>(pA0, pA1, K_lds, qr, q8, r32, hi, tb0); partialSM<FIXM>(pA0, pA1, m_reg, mnA, alA);
  SLOAD(SO, KVBLK); if constexpr (SDEPTH == 2) { if (2 < NT) SLOAD(SE, 2 * KVBLK); }
  SWAIT(); SWRITE(1, SO); __syncthreads();
  for (int j = 1; j + 1 < NT; j += 2) {
    SBAR(); qkt<WIN, F8>(pB0, pB1, (bf16*)((char*)K_lds + SHM_K), qr, q8, r32, hi, tb0 + 64 * j);
    finishSM(pA0, pA1, alA, l_reg, pa0, pa1, pa2, pa3); SBAR();
    SLOAD(SO, (j + SDEPTH) * KVBLK); SBAR();
    pv_d0(o, vb0, pa0, pa1, pa2, pa3); partialSM<FIXM>(pB0, pB1, m_reg, mnB, alB);
    __syncthreads(); SWAIT(); SWRITE(0, SE);
    RESC(alB); __syncthreads();
    SBAR(); qkt<WIN, F8>(pA0, pA1, K_lds, qr, q8, r32, hi, tb0 + 64 * (j + 1));
    finishSM(pB0, pB1, alB, l_reg, pa0, pa1, pa2, pa3); SBAR();
    if (SDEPTH == 1 || j + 3 < NT) SLOAD(SE, (j + 1 + SDEPTH) * KVBLK); SBAR();
    pv_d0(o, vb0 + (int)SHM_V, pa0, pa1, pa2, pa3); partialSM<FIXM>(pA0, pA1, m_reg, mnA, alA);
    __syncthreads(); SWAIT(); SWRITE(1, SO);
    RESC(alA); __syncthreads();
  }
  SBAR(); qkt<WIN, F8>(pB0, pB1, (bf16*)((char*)K_lds + SHM_K), qr, q8, r32, hi, tb0 + 64 * (NT - 1));
  finishSM(pA0, pA1, alA, l_reg, pa0, pa1, pa2, pa3); SBAR();
  pv_d0(o, vb0, pa0, pa1, pa2, pa3); partialSM<FIXM>(pB0, pB1, m_reg, mnB, alB);
  __syncthreads(); RESC(alB);
  finishSM(pB0, pB1, alB, l_reg, pa0, pa1, pa2, pa3); SBAR();
  pv_d0(o, vb0 + (int)SHM_V, pa0, pa1, pa2, pa3);
  }
  if (hi == 0) li_l[r32] = l_reg; asm volatile("s_waitcnt lgkmcnt(0)" ::: "memory");
  float rli[16];
#pragma unroll
  for (int r = 0; r < 16; ++r) rli[r] = __builtin_amdgcn_rcpf(li_l[crow(r, hi)]);
  unsigned char* Ow = Ob + (long)(wid * QBLK) * LDO;
#pragma unroll
  for (int r = 0; r < 16; ++r) { int orow = crow(r, hi); const float sc = rli[r] * oscale;
    for (int d0 = 0; d0 < 4; ++d0) Ow[(long)orow * LDO + d0 * 32 + r32] = (unsigned char)(__builtin_amdgcn_cvt_pk_fp8_f32(o[d0][r] * sc, 0.f, 0, false) & 0xff); }
  __syncthreads();
#undef SLOAD
#undef SWRITE
#undef SWAIT
#undef RESC
}
#undef KSWZ
#undef KSWZ8
#undef SBAR
}
constexpr int NWAVES = 8;
constexpr int SEQ = 8192, DM = 2048, HD = 128, NEXP = 64, TOPK = 8, FE = 512;
constexpr int INC = 7168;
constexpr int PLD = INC + PROJ_PAD;
constexpr int C_QA = 0, C_KA = 1024, C_VA = 1280, C_QB = 1536, C_KB = 2560, C_VB = 2816, C_GA = 3072, C_GB = 5120;
constexpr float LN_EPS = 1e-5f, RMS_EPS = 1e-6f;
constexpr float ALPHA = 1.189207115002721f;
constexpr float ROUTED_SCALE = 2.5f;
constexpr int LCAP = 8192;
constexpr int NEXP1 = NEXP + 1;

constexpr size_t MiB = 1u << 20;
constexpr size_t WS_CTL = 0, CTL_ZERO_BYTES = 1 * MiB;
constexpr size_t WS_WGU = 1 * MiB;
constexpr size_t WS_WINT = WS_WGU + 260 * MiB;
constexpr size_t WS_XBF = WS_WINT + 28 * MiB;
constexpr size_t WS_PROJ = WS_XBF + 32 * MiB;
constexpr size_t WS_OA = WS_PROJ + 116 * MiB;
constexpr size_t WS_OB = WS_OA + 16 * MiB;
constexpr size_t WS_MRG = WS_OB + 16 * MiB;
constexpr size_t WS_WAT = WS_MRG + 32 * MiB;
constexpr size_t WS_WBT = WS_WAT + 4 * MiB;
constexpr size_t WS_WOT = WS_WBT + 4 * MiB;
constexpr size_t WS_DEAD_END = WS_WOT + 8 * MiB;
constexpr size_t WS_Y = WS_WGU;
constexpr size_t WS_WD = WS_DEAD_END;
constexpr size_t WS_WR = WS_WD + 130 * MiB;
constexpr size_t WS_H32 = WS_WR + 1 * MiB;
constexpr size_t WS_HBF = WS_H32 + 64 * MiB;
constexpr size_t WS_HID = WS_HBF + 32 * MiB;
constexpr size_t WS_PRE = WS_HID + 88 * MiB;
constexpr size_t WS_LTOK = WS_PRE + 64 * MiB;
constexpr size_t WS_LW = WS_LTOK + 3 * MiB;
constexpr size_t WS_ROUTE = WS_LW + 3 * MiB;
constexpr size_t WS_HF8 = WS_H32;
constexpr size_t WS_KF8 = WS_H32 + 16 * MiB;
constexpr size_t WS_END = WS_ROUTE + 1 * MiB;
static_assert(WS_Y + 352 * MiB <= WS_WD, "Y overlay");
static_assert((size_t)SEQ * PLD * 2 <= 116 * MiB, "proj slot");
static_assert(WS_END <= 1024 * MiB, "d_ws map must fit 1 GiB");
constexpr int CW_TMO = 0;
constexpr int CW_CNT = 64;
constexpr int CW_BAR = 4096;

constexpr int RING_OFF = 0, RING_BYTES = 131072;
constexpr int LDSCTL_OFF = RING_BYTES;
constexpr int MISC_OFF = LDSCTL_OFF;
constexpr int IDXL_OFF = LDSCTL_OFF + 256;
constexpr int TST_OFF = IDXL_OFF + 1024 + 2048;
constexpr int LDS_BYTES = 147456;
static_assert(TST_OFF + 512 <= LDS_BYTES, "LDS map");

#define GAS __attribute__((address_space(1)))
#define LAS __attribute__((address_space(3)))
typedef unsigned short bf16;
typedef unsigned v4u __attribute__((ext_vector_type(4)));
typedef unsigned v2u __attribute__((ext_vector_type(2)));
typedef float f32x4 __attribute__((ext_vector_type(4)));
typedef short bf16x8 __attribute__((ext_vector_type(8)));
#define RLX_AGENT __ATOMIC_RELAXED, __HIP_MEMORY_SCOPE_AGENT
#define LDS_WAIT() asm volatile("s_waitcnt lgkmcnt(0)" ::: "memory")
#define VM_WAIT() asm volatile("s_waitcnt vmcnt(0)" ::: "memory")
__device__ __forceinline__ unsigned f2bf(float f) { unsigned u = __builtin_bit_cast(unsigned, f); return (u + 0x7fffu + ((u >> 16) & 1u)) >> 16; }
__device__ __forceinline__ unsigned pk2(float lo, float hi) { return f2bf(lo) | (f2bf(hi) << 16); }
__device__ __forceinline__ float bf2f(unsigned short h) { return __uint_as_float((unsigned)h << 16); }

#ifndef XB_L1_ACQ
#define XB_L1_ACQ 1
#endif
#ifndef XB_EARLY_WB
#define XB_EARLY_WB 0
#endif
#define XB_TMO      128
#define XB_XCNT(j)  (256  + 64 * (j))
#define XB_XSUB(j)  (1280 + 64 * (j))
#define XB_XGEN(j)  (2304 + 64 * (j))
#define XB_TOP      3328
#define XB_TOPGEN   3392
#define XCD_BAR_WORDS 3456
#define XB_SPIN_CAP (1u << 20)
__device__ __forceinline__ unsigned xb_ld(unsigned* p)              { return __hip_atomic_load(p, __ATOMIC_RELAXED, __HIP_MEMORY_SCOPE_AGENT); }
__device__ __forceinline__ unsigned xb_add(unsigned* p, unsigned v) { return __hip_atomic_fetch_add(p, v, __ATOMIC_RELAXED, __HIP_MEMORY_SCOPE_AGENT); }
__device__ __forceinline__ unsigned xb_xcc_id() { return (unsigned)__builtin_amdgcn_s_getreg((3 << 11) | 20) & 0xFu; }
#define XB_SPIN(cond, bar) do { unsigned _sp = 0; while (cond) { __builtin_amdgcn_s_sleep(1); \
    if ((++_sp & 255u) == 0u) { if (xb_ld(&(bar)[XB_TMO])) break; if (_sp > XB_SPIN_CAP) { atomicAdd(&(bar)[XB_TMO], 1u); break; } } } } while (0)
struct XcdBarrier { unsigned* bar; unsigned x; volatile LAS unsigned* st; unsigned total; };
__device__ __forceinline__ XcdBarrier xcd_barrier_post(unsigned* bar, volatile LAS unsigned* st, unsigned total) {
    XcdBarrier b; b.bar = bar; b.x = xb_xcc_id(); b.st = st; b.total = total;
    if (threadIdx.x == 0) (void)xb_add(&bar[XB_XCNT(b.x)], 1u);
    return b;
}
__device__ __forceinline__ void xcd_barrier_complete(unsigned* bar, unsigned x, unsigned G, unsigned& nloc, unsigned& nx) {
    unsigned sum, cnt, mine, sp = 0u;
    for (;;) {
        sum = 0u; cnt = 0u; mine = 0u;
#pragma unroll
        for (unsigned j = 0; j < 16; ++j) { const unsigned c = xb_ld(&bar[XB_XCNT(j)]); sum += c; cnt += (c > 0u) ? 1u : 0u; mine = (j == x) ? c : mine; }
        if (sum == G) break;
        __builtin_amdgcn_s_sleep(1);
        if ((++sp & 255u) == 0u) { if (xb_ld(&bar[XB_TMO])) break; if (sp > XB_SPIN_CAP) { atomicAdd(&bar[XB_TMO], 1u); break; } }
    }
    nloc = mine > 0u ? mine : 1u; nx = cnt > 0u ? cnt : 1u;
}
__device__ __forceinline__ void xcd_barrier(const XcdBarrier& b) {
    asm volatile("s_waitcnt vmcnt(0)" ::: "memory");
    __syncthreads();
    if (threadIdx.x == 0) {
        unsigned* bar = b.bar;
        __builtin_amdgcn_s_waitcnt(0);
        unsigned nloc = b.st[0], nx = b.st[1];
        if (nloc == 0u) { xcd_barrier_complete(bar, b.x, b.total, nloc, nx); b.st[0] = nloc; b.st[1] = nx; }
        const unsigned old = xb_add(&bar[XB_XSUB(b.x)], 1u);
        const unsigned gen = old / nloc;
        if (old + 1u == (gen + 1u) * nloc) {
            __builtin_amdgcn_fence(__ATOMIC_RELEASE, "agent");
            asm volatile("s_waitcnt vmcnt(0)" ::: "memory");
            asm volatile("buffer_inv sc1" ::: "memory");
            const unsigned og = xb_add(&bar[XB_TOP], 1u);
            const unsigned tg = og / nx;
            if (og + 1u == (tg + 1u) * nx) xb_add(&bar[XB_TOPGEN], 1u);
            else XB_SPIN(xb_ld(&bar[XB_TOPGEN]) == tg, bar);
            asm volatile("s_waitcnt vmcnt(0)" ::: "memory");
            xb_add(&bar[XB_XGEN(b.x)], 1u);
            asm volatile("s_waitcnt vmcnt(0)" ::: "memory");
        } else {
            asm volatile("buffer_inv sc1" ::: "memory");
            XB_SPIN(xb_ld(&bar[XB_XGEN(b.x)]) == gen, bar);
            asm volatile("s_waitcnt vmcnt(0)" ::: "memory");
        }
    }
    __syncthreads();
}

__device__ __forceinline__ float wave_sum(float v) {
#pragma unroll
    for (int o = 1; o < 64; o <<= 1) v += __shfl_xor(v, o);
    return v;
}
__device__ __forceinline__ float sigmoidf_(float x) { return __builtin_amdgcn_rcpf(1.0f + __builtin_amdgcn_exp2f(-x * 1.4426950408889634f)); }

struct Args { const float* in[22]; float* out; unsigned char* ws; int ph_lo, ph_hi; };
struct Frame {
    LAS unsigned char* lds;
    volatile LAS unsigned* MISC;
    unsigned* ctl;
    int tid, lane, wave;
    int vcu, G;
    const float* in[22]; float* out; unsigned char* ws;
};

#ifndef G1_FP8
#define G1_FP8 1
#endif
#ifndef ATT_F8
#define ATT_F8 1
#endif
#ifndef P1_FP8
#define P1_FP8 1
#endif
struct TItem { const float* W; unsigned char* WT; int K, N, k0, n0, drow0, f8; };
constexpr float W8SCALE = 32.0f, H8SCALE = 8.0f, OA_SCALE = 16.0f, OB_SCALE = 64.0f, MG_SCALE = 32.0f;
__device__ __forceinline__ void titem_issue(const TItem& it, LAS unsigned char* buf, int lane) {
#pragma unroll
    for (int g = 0; g < 8; ++g) { const int k = 8 * g + (lane >> 3), pos = lane & 7;
        __builtin_amdgcn_global_load_lds((const unsigned*)(it.W + (size_t)(it.k0 + k) * it.N + it.n0 + 4 * (pos ^ g)), (LAS unsigned*)(buf + g * 1024), 16, 0, 0); }
}
__device__ __forceinline__ void titem_finish(const TItem& it, const LAS float* buf, int lane) {
    const int c = lane & 7;
#pragma unroll
    for (int j = 0; j < 4; ++j) { const int nn = (lane >> 3) + 8 * j; const LAS float* s = buf + (8 * c) * 32 + (((nn >> 2) ^ c) << 2) + (nn & 3);
        const size_t eo = (size_t)(it.drow0 + nn) * it.K + it.k0 + 8 * c;
        if (it.f8) { v2u o; int t = __builtin_amdgcn_cvt_pk_fp8_f32(s[0 * 32] * W8SCALE, s[1 * 32] * W8SCALE, 0, false); t = __builtin_amdgcn_cvt_pk_fp8_f32(s[2 * 32] * W8SCALE, s[3 * 32] * W8SCALE, t, true); o.x = (unsigned)t;
            t = __builtin_amdgcn_cvt_pk_fp8_f32(s[4 * 32] * W8SCALE, s[5 * 32] * W8SCALE, 0, false); t = __builtin_amdgcn_cvt_pk_fp8_f32(s[6 * 32] * W8SCALE, s[7 * 32] * W8SCALE, t, true); o.y = (unsigned)t;
            __builtin_nontemporal_store(o, (GAS v2u*)(it.WT + eo)); }
        else { v4u o; o.x = pg8::cvt_pk_bf16(s[0 * 32], s[1 * 32]); o.y = pg8::cvt_pk_bf16(s[2 * 32], s[3 * 32]); o.z = pg8::cvt_pk_bf16(s[4 * 32], s[5 * 32]); o.w = pg8::cvt_pk_bf16(s[6 * 32], s[7 * 32]);
            __builtin_nontemporal_store(o, (GAS v4u*)(it.WT + 2 * eo)); } }
}
constexpr int I_IN = (DM / 64) * (INC / 32);
constexpr int I_BR = (1024 / 64) * (DM / 32);
constexpr int I_WO = (DM / 64) * (DM / 32);
constexpr int I_GU = (DM / 64) * (FE / 32);
constexpr int I_DN = (FE / 64) * (DM / 32);
constexpr int NITEMS_E1 = 2 * I_BR + I_WO + NEXP1 * 2 * I_GU;
constexpr int NITEMS_E2 = NEXP1 * I_DN;
__device__ __forceinline__ void titem_plain(TItem& it, const float* W, int K, int N, void* WT, int item, int f8 = 0) {
    const int nblk = N / 32, kb = item / nblk, nb = item % nblk; it.W = W; it.WT = (unsigned char*)WT; it.K = K; it.N = N; it.k0 = 64 * kb; it.n0 = 32 * nb; it.drow0 = 32 * nb; it.f8 = f8;
}
template <int LIST>
__device__ __forceinline__ void titem_get(Frame& F, int r, TItem& it) {
    if constexpr (LIST == 0) { titem_plain(it, F.in[1], DM, INC, F.ws + WS_WINT, r, P1_FP8); }
    else if constexpr (LIST == 2) { const int e = r / I_DN; r -= e * I_DN;
        titem_plain(it, e < NEXP ? F.in[16] + (size_t)e * FE * DM : F.in[19], FE, DM, F.ws + WS_WD + (size_t)e * DM * FE, r, 1); }
    else {
        if (r < I_BR) { titem_plain(it, F.in[7], 1024, DM, F.ws + WS_WAT, r, 1); return; } r -= I_BR;
        if (r < I_BR) { titem_plain(it, F.in[8], 1024, DM, F.ws + WS_WBT, r, 1); return; } r -= I_BR;
        if (r < I_WO) { titem_plain(it, F.in[9], DM, DM, F.ws + WS_WOT, r, 1); return; } r -= I_WO;
        const int e = r / (2 * I_GU); r -= e * (2 * I_GU);
        const int half = r >= I_GU ? 1 : 0; r -= half * I_GU;
        const float* w = e < NEXP ? (half ? F.in[15] : F.in[14]) + (size_t)e * DM * FE : (half ? F.in[18] : F.in[17]);
        const int nblk = FE / 32, kb = r / nblk, nb = r % nblk, n0 = 32 * nb;
        it.W = w; it.WT = F.ws + WS_WGU + (size_t)e * 1024 * DM * (G1_FP8 ? 1 : 2); it.f8 = G1_FP8; it.K = DM; it.N = FE; it.k0 = 64 * kb; it.n0 = n0; it.drow0 = 256 * (n0 >> 7) + 128 * half + (n0 & 127);
    }
}
#ifndef CONV_D
#define CONV_D 4
#endif
__device__ __forceinline__ void titem_load(const TItem& it, f32x4 (&r)[8], int lane) {
#pragma unroll
    for (int g = 0; g < 8; ++g) r[g] = __builtin_nontemporal_load((const GAS f32x4*)(it.W + (size_t)(it.k0 + 8 * g + (lane >> 3)) * it.N + it.n0 + 4 * (lane & 7)));
}
__device__ __forceinline__ void titem_store(const TItem& it, const f32x4 (&r)[8], LAS float* buf, int lane) {
#pragma unroll
    for (int g = 0; g < 8; ++g) *(LAS f32x4*)(buf + (8 * g + (lane >> 3)) * 32 + (((lane & 7) ^ g) << 2)) = r[g];
    titem_finish(it, buf, lane);
}
template <int LISTE>
__device__ __forceinline__ void convert_items(Frame& F, int first, int step, int last) {
    LAS float* buf = (LAS float*)(F.lds + RING_OFF + F.wave * 8192);
    if (first >= last) return;
    const int n_my = (last - first + step - 1) / step;
    f32x4 r[CONV_D][8]; TItem it;
#pragma unroll
    for (int d = 0; d < CONV_D; ++d) if (d < n_my) { titem_get<LISTE>(F, first + d * step, it); titem_load(it, r[d], F.lane); }
    for (int base = 0; base < n_my; base += CONV_D) {
#pragma unroll
        for (int d = 0; d < CONV_D; ++d) { const int idx = base + d;
            if (idx < n_my) { titem_get<LISTE>(F, first + idx * step, it); titem_store(it, r[d], buf, F.lane);
                if (idx + CONV_D < n_my) { titem_get<LISTE>(F, first + (idx + CONV_D) * step, it); titem_load(it, r[d], F.lane); } } }
    }
}
#ifndef CONV_Q
#define CONV_Q 200
#endif
#ifndef P1_NCG
#define P1_NCG 23
#endif
constexpr int NCONV = 32, NCOMP = 256 - NCONV, NCONV1 = 8 * (32 - P1_NCG), NCOMP1 = 8 * P1_NCG, E_SPLIT = (NCONV1 * NWAVES * CONV_Q < NITEMS_E1) ? NCONV1 * NWAVES * CONV_Q : NITEMS_E1;
#ifndef CONV_Q2
#define CONV_Q2 100
#endif
#ifndef P1_QE2
#define P1_QE2 0
#endif
constexpr int E2_A = (NCONV1 * NWAVES * P1_QE2 < NITEMS_E2) ? NCONV1 * NWAVES * P1_QE2 : NITEMS_E2;
constexpr int E2_SPLIT = (E2_A + 32 * NWAVES * CONV_Q2 < NITEMS_E2) ? E2_A + 32 * NWAVES * CONV_Q2 : NITEMS_E2;
#ifndef CONV_G1
#define CONV_G1 1
#endif
__device__ __forceinline__ void p0_prologue(Frame& F, bool compute_only) {
    const int gw = (compute_only ? (F.vcu >> 5) * P1_NCG + (F.vcu & 31) : F.vcu) * NWAVES + F.wave, NGW = (compute_only ? NCOMP1 : F.G) * NWAVES;
    convert_items<0>(F, gw, NGW, I_IN);
    { const int gt = gw * 64 + F.lane, NT = NGW * 64; const GAS f32x4* xs = (const GAS f32x4*)F.in[0]; GAS v4u* xo = (GAS v4u*)(F.ws + WS_XBF);
      for (int i = gt; i < SEQ * DM / 8; i += 4 * NT) {
          f32x4 a[4], b[4];
#pragma unroll
          for (int u = 0; u < 4; ++u) if (i + u * NT < SEQ * DM / 8) { a[u] = __builtin_nontemporal_load(xs + 2 * (i + u * NT)); b[u] = __builtin_nontemporal_load(xs + 2 * (i + u * NT) + 1); }
#pragma unroll
          for (int u = 0; u < 4; ++u) if (i + u * NT < SEQ * DM / 8) {
              if (P1_FP8) { v2u o; int t = __builtin_amdgcn_cvt_pk_fp8_f32(a[u].x, a[u].y, 0, false); t = __builtin_amdgcn_cvt_pk_fp8_f32(a[u].z, a[u].w, t, true); o.x = (unsigned)t;
                  t = __builtin_amdgcn_cvt_pk_fp8_f32(b[u].x, b[u].y, 0, false); t = __builtin_amdgcn_cvt_pk_fp8_f32(b[u].z, b[u].w, t, true); o.y = (unsigned)t; ((GAS v2u*)xo)[i + u * NT] = o; }
              else { v4u o; o.x = pg8::cvt_pk_bf16(a[u].x, a[u].y); o.y = pg8::cvt_pk_bf16(a[u].z, a[u].w); o.z = pg8::cvt_pk_bf16(b[u].x, b[u].y); o.w = pg8::cvt_pk_bf16(b[u].z, b[u].w); xo[i + u * NT] = o; } } } }
    { const int gt = gw * 64 + F.lane, NT = NGW * 64; bf16* wr = (bf16*)(F.ws + WS_WR);
      for (int i = gt; i < NEXP * DM; i += NT) {
          const int j_ = i & 7, ln = (i >> 3) & 63, nt_ = (i >> 9) & 3, ks = i >> 11, q_ = ln >> 4, t_ = ln & 15;
          const int k = ks * 32 + (j_ < 4 ? 4 * q_ + j_ : 16 + 4 * q_ + j_ - 4), e = 16 * nt_ + t_;
          const float w = F.in[12][(size_t)k * NEXP + e]; const unsigned h = f2bf(w); const float lo = w - __uint_as_float(h << 16);
          wr[i] = (bf16)h; wr[NEXP * DM + i] = (bf16)f2bf(lo); } }
    { const int gt = gw * 64 + F.lane, NT = NGW * 64; int* lt = (int*)(F.ws + WS_LTOK); float* lw = (float*)(F.ws + WS_LW);
      for (int i = gt; i < NEXP1 * LCAP; i += NT) { const bool sh = i >= NEXP * LCAP; lt[i] = sh ? i - NEXP * LCAP : 0; lw[i] = sh ? 1.0f : 0.0f; } }
}

#ifndef WT_STORES
#define WT_STORES 0
#endif
__device__ __forceinline__ void st_wt8(void* p, v2u w) {
    if (WT_STORES) __hip_atomic_store((unsigned long long*)p, ((unsigned long long)w.y << 32) | w.x, __ATOMIC_RELAXED, __HIP_MEMORY_SCOPE_AGENT);
    else *(v2u*)p = w;
}
__device__ __forceinline__ v4u pair16(v2u a, v2u b) {
    auto sx = __builtin_amdgcn_permlane16_swap(a.x, b.x, false, false);
    auto sy = __builtin_amdgcn_permlane16_swap(a.y, b.y, false, false);
    return (v4u){sx[0], sy[0], sx[1], sy[1]};
}
struct DenseOrder {
    const char* A; const char* B; int nM, nN, nwg, G, c; size_t tstep;
    __device__ __forceinline__ void init(const void* A_, const void* B_, int M, int N, int K, int G_, int c_) { A = (const char*)A_; B = (const char*)B_; nM = M / 256; nN = N / 256; nwg = nM * nN; G = G_; c = c_; tstep = (size_t)256 * K * (P1_FP8 ? 1 : 2); }
    __device__ __forceinline__ bool next(int i, pg8::Unit& u) const {
#ifdef P1_DOUBLE
        const long L = (long)(i >> 1) * G + c; if (L >= nwg) return false;
#else
        const long L = (long)i * G + c; if (L >= nwg) return false;
#endif
        int wgid = (int)L; { const int q = nwg / 8, r = nwg % 8, xcd = wgid % 8, off = wgid / 8; wgid = (xcd < r ? xcd * (q + 1) : r * (q + 1) + (xcd - r) * q) + off; }
        const int nig = 8 * nN, gid = wgid / nig, fm = gid * 8, gsz = (nM - fm) < 8 ? (nM - fm) : 8;
        const int pm = fm + ((wgid % nig) % gsz), pn = (wgid % nig) / gsz;
        u.A = A + (size_t)pm * tstep; u.B = B + (size_t)pn * tstep; u.idx = nullptr; u.wts = nullptr; u.r0 = pm * 256; u.c0 = pn * 256; u.aux = 0; u.kind = 0; return true;
    }
};
struct BranchOrder {
    const char *OA, *OB, *WA, *WB; int vcu;
    __device__ __forceinline__ bool next(int i, pg8::Unit& u) const {
#ifdef P3_DOUBLE
        if (i >= 4) return false; i &= 1;
#else
        if (i >= 2) return false;
#endif
        const int pm = vcu >> 3, pn = vcu & 7; const size_t ts = (size_t)256 * 1024;
        u.A = (i ? OB : OA) + (size_t)pm * ts; u.B = (i ? WB : WA) + (size_t)pn * ts; u.idx = nullptr; u.wts = nullptr; u.r0 = pm * 256; u.c0 = pn * 256; u.aux = 0; u.kind = i; return true;
    }
};
struct OneTileOrder {
    const char *A, *B; int vcu; size_t ts;
    __device__ __forceinline__ bool next(int i, pg8::Unit& u) const {
#ifdef P4_DOUBLE
        if (i >= 2) return false;
#else
        if (i >= 1) return false;
#endif
        const int pm = vcu >> 3, pn = vcu & 7;
        u.A = A + (size_t)pm * ts; u.B = B + (size_t)pn * ts; u.idx = nullptr; u.wts = nullptr; u.r0 = pm * 256; u.c0 = pn * 256; u.aux = 0; u.kind = 0; return true;
    }
};
template <int NPN>
struct MoeOrder {
    const LAS int* tst; const char* A; const char* B; const int* ltok; const float* lwt; int vcu, G; size_t arow, bexp, bpn;
    bool gather;
    int l0, lend, nheavy;
    const unsigned* flag; int wait_gmt, need;
    mutable int ec = 0;
    __device__ __forceinline__ bool next(int i, pg8::Unit& u) const {
        const int T = tst[NEXP1]; const int end = lend < 0 ? T * NPN : lend;
        int L;
#ifdef G2_DOUBLE
        if (NPN == 8) i >>= 1;
#endif
        if (nheavy > 0) { const int NL = G - nheavy; if (vcu >= NL) L = 2 * NL + i * G + vcu; else L = i < 2 ? i * NL + vcu : 2 * NL + (i - 2) * G + vcu; }
        else L = l0 + i * G + vcu;
        if (L >= end) return false;
        const int gmt = L / NPN, pn = L % NPN; int e = ec; if (tst[e] > gmt) e = 0;
        while (e < NEXP && tst[e + 1] <= gmt) ++e;
        ec = e;
        const int mt = gmt - tst[e];
        if (need > 0 && gmt >= wait_gmt) {
            unsigned spins = 0; while (__hip_atomic_load(flag, __ATOMIC_RELAXED, __HIP_MEMORY_SCOPE_AGENT) < (unsigned)need && ++spins < (1u << 22)) __builtin_amdgcn_s_sleep(2);
            __builtin_amdgcn_fence(__ATOMIC_ACQUIRE, "agent"); asm volatile("s_waitcnt vmcnt(0)" ::: "memory"); }
        u.A = gather ? A : A + (size_t)gmt * 256 * arow; u.B = B + (size_t)e * bexp + (size_t)pn * bpn; u.idx = ltok + e * LCAP + mt * 256; u.wts = lwt + e * LCAP + mt * 256;
        u.r0 = gmt * 256; u.c0 = pn * 256; u.aux = e * LCAP + mt * 256; u.kind = 0; return true;
    }
};

constexpr float GSCALE = 256.0f;
typedef float f32x2v __attribute__((ext_vector_type(2)));
struct EpiProj {
    static constexpr bool PERM = true; static constexpr int NST = 8;
    bf16* O; const float* bgate;
    __device__ __forceinline__ bool operator()(const pg8::f32x4 (&acc)[2][2][4][2], const pg8::Unit& u, int wr, int wc, int fr, int fq, const LAS float* wl) const {
        const int row0 = u.r0 + wr * 64 + fr, col0 = u.c0 + wc * 32 + 8 * fq;
        constexpr float PS = P1_FP8 ? 1.0f / W8SCALE : 1.0f;
        if (u.c0 >= C_GA) {
            f32x4 bb[2][2];
#pragma unroll
            for (int bj = 0; bj < 2; ++bj) { bb[bj][0] = *(const f32x4*)(bgate + col0 + bj * 128 - C_GA); bb[bj][1] = *(const f32x4*)(bgate + col0 + bj * 128 - C_GA + 4); }
            const int odd = fq & 1; unsigned char* G = (unsigned char*)O + (size_t)C_GA * 2 + (col0 - 8 * odd - C_GA);
#pragma unroll
            for (int ai = 0; ai < 2; ++ai)
#pragma unroll
                for (int mp = 0; mp < 2; ++mp)
#pragma unroll
                    for (int bj = 0; bj < 2; ++bj) { v2u w[2];
#pragma unroll
                        for (int mm = 0; mm < 2; ++mm) { const int m = 2 * mp + mm; const f32x4 v0 = acc[ai][bj][m][0] * PS + bb[bj][0], v1 = acc[ai][bj][m][1] * PS + bb[bj][1];
                            int t = __builtin_amdgcn_cvt_pk_fp8_f32(GSCALE * sigmoidf_(v0[0]), GSCALE * sigmoidf_(v0[1]), 0, false); t = __builtin_amdgcn_cvt_pk_fp8_f32(GSCALE * sigmoidf_(v0[2]), GSCALE * sigmoidf_(v0[3]), t, true); w[mm].x = (unsigned)t;
                            t = __builtin_amdgcn_cvt_pk_fp8_f32(GSCALE * sigmoidf_(v1[0]), GSCALE * sigmoidf_(v1[1]), 0, false); t = __builtin_amdgcn_cvt_pk_fp8_f32(GSCALE * sigmoidf_(v1[2]), GSCALE * sigmoidf_(v1[3]), t, true); w[mm].y = (unsigned)t; }
                        *(v4u*)(G + (size_t)(row0 + ai * 128 + (2 * mp + odd) * 16) * (PLD * 2) + bj * 128) = pair16(w[0], w[1]); }
        } else {
#pragma unroll
            for (int ai = 0; ai < 2; ++ai)
#pragma unroll
                for (int m = 0; m < 4; ++m)
#pragma unroll
                    for (int bj = 0; bj < 2; ++bj) { const f32x4 v0 = acc[ai][bj][m][0] * PS, v1 = acc[ai][bj][m][1] * PS;
                        v4u w; w.x = pg8::cvt_pk_bf16(v0[0], v0[1]); w.y = pg8::cvt_pk_bf16(v0[2], v0[3]); w.z = pg8::cvt_pk_bf16(v1[0], v1[1]); w.w = pg8::cvt_pk_bf16(v1[2], v1[3]);
                        *(v4u*)(O + (size_t)(row0 + ai * 128 + m * 16) * PLD + col0 + bj * 128) = w; }
        }
        return false;
    }
};
struct EpiBranch {
    static constexpr bool PERM = true; static constexpr int NST = 0;
    const bf16* proj; unsigned char* O;
    __device__ __forceinline__ bool operator()(pg8::f32x4 (&acc)[2][2][4][2], const pg8::Unit& u, int wr, int wc, int fr, int fq, const LAS float* wl) const {
        const int row0 = u.r0 + wr * 64 + fr, col0 = u.c0 + wc * 32 + 8 * fq;
        const bool seg0 = u.kind == 0;
#pragma unroll
        for (int ai = 0; ai < 2; ++ai) {
            v2u gb[4][2], ga[4][2];
#pragma unroll
            for (int m = 0; m < 4; ++m)
#pragma unroll
                for (int bj = 0; bj < 2; ++bj) { const size_t r = (size_t)(row0 + ai * 128 + m * 16); const int c = col0 + bj * 128;
                    const unsigned char* gp = (const unsigned char*)proj + r * (PLD * 2) + (size_t)C_GA * 2 + c;
                    gb[m][bj] = *(const v2u*)(gp + (C_GB - C_GA)); ga[m][bj] = seg0 ? *(const v2u*)gp : (v2u){0u, 0u}; }
            __builtin_amdgcn_sched_barrier(0);
#pragma unroll
            for (int mp = 0; mp < 2; ++mp) {
                v2u wq[2][2];
#pragma unroll
                for (int mm = 0; mm < 2; ++mm)
#pragma unroll
                    for (int bj = 0; bj < 2; ++bj) { const int m = 2 * mp + mm;
                        const v2u gbv = gb[m][bj], gav = ga[m][bj];
                        const f32x2v g01 = __builtin_amdgcn_cvt_pk_f32_fp8((int)gbv.x, false), g23 = __builtin_amdgcn_cvt_pk_f32_fp8((int)gbv.x, true), g45 = __builtin_amdgcn_cvt_pk_f32_fp8((int)gbv.y, false), g67 = __builtin_amdgcn_cvt_pk_f32_fp8((int)gbv.y, true);
                        float g[8] = {g01[0], g01[1], g23[0], g23[1], g45[0], g45[1], g67[0], g67[1]};
                        if (seg0) {
                            const f32x2v a01 = __builtin_amdgcn_cvt_pk_f32_fp8((int)gav.x, false), a23 = __builtin_amdgcn_cvt_pk_f32_fp8((int)gav.x, true), a45 = __builtin_amdgcn_cvt_pk_f32_fp8((int)gav.y, false), a67 = __builtin_amdgcn_cvt_pk_f32_fp8((int)gav.y, true);
                            float a[8] = {a01[0], a01[1], a23[0], a23[1], a45[0], a45[1], a67[0], a67[1]};
#pragma unroll
                            for (int j = 0; j < 4; ++j) { acc[ai][bj][m][0][j] *= (OB_SCALE / OA_SCALE) * a[j] * __builtin_amdgcn_rcpf(fmaxf(g[j], 1e-30f)); acc[ai][bj][m][1][j] *= (OB_SCALE / OA_SCALE) * a[4 + j] * __builtin_amdgcn_rcpf(fmaxf(g[4 + j], 1e-30f)); }
                        } else {
                            const pg8::f32x4 v0 = acc[ai][bj][m][0], v1 = acc[ai][bj][m][1];
                            constexpr float S1 = MG_SCALE / (OB_SCALE * W8SCALE * GSCALE);
                            v2u w; int t = __builtin_amdgcn_cvt_pk_fp8_f32(v0[0] * g[0] * S1, v0[1] * g[1] * S1, 0, false); t = __builtin_amdgcn_cvt_pk_fp8_f32(v0[2] * g[2] * S1, v0[3] * g[3] * S1, t, true); w.x = (unsigned)t;
                            t = __builtin_amdgcn_cvt_pk_fp8_f32(v1[0] * g[4] * S1, v1[1] * g[5] * S1, 0, false); t = __builtin_amdgcn_cvt_pk_fp8_f32(v1[2] * g[6] * S1, v1[3] * g[7] * S1, t, true); w.y = (unsigned)t;
                            wq[mm][bj] = w;
                        }
                    }
                if (!seg0) { const int odd = fq & 1;
#pragma unroll
                    for (int bj = 0; bj < 2; ++bj) *(v4u*)(O + (size_t)(row0 + ai * 128 + (2 * mp + odd) * 16) * DM + col0 - 8 * odd + bj * 128) = pair16(wq[0][bj], wq[1][bj]); }
            }
            __builtin_amdgcn_sched_barrier(0);
        }
        return seg0;
    }
};
struct EpiMix {
    static constexpr bool PERM = true; static constexpr int NST = 16;
    bf16* O;
    __device__ __forceinline__ bool operator()(const pg8::f32x4 (&acc)[2][2][4][2], const pg8::Unit& u, int wr, int wc, int fr, int fq, const LAS float* wl) const {
        const int row0 = u.r0 + wr * 64 + fr, col0 = u.c0 + wc * 32 + 8 * fq;
#pragma unroll
        for (int ai = 0; ai < 2; ++ai)
#pragma unroll
            for (int m = 0; m < 4; ++m)
#pragma unroll
                for (int bj = 0; bj < 2; ++bj) { const pg8::f32x4 v0 = acc[ai][bj][m][0] * (1.0f / (MG_SCALE * W8SCALE)), v1 = acc[ai][bj][m][1] * (1.0f / (MG_SCALE * W8SCALE));
                    v4u w; w.x = pg8::cvt_pk_bf16(v0[0], v0[1]); w.y = pg8::cvt_pk_bf16(v0[2], v0[3]); w.z = pg8::cvt_pk_bf16(v1[0], v1[1]); w.w = pg8::cvt_pk_bf16(v1[2], v1[3]);
                    *(v4u*)(O + (size_t)(row0 + ai * 128 + m * 16) * DM + col0 + bj * 128) = w; }
        return false;
    }
};
struct EpiMoe1 {
    static constexpr bool PERM = true; static constexpr int NST = 4;
    unsigned char* H;
    __device__ __forceinline__ bool operator()(const pg8::f32x4 (&acc)[2][2][4][2], const pg8::Unit& u, int wr, int wc, int fr, int fq, const LAS float* wl) const {
        const int odd = fq & 1; const int row0 = u.r0 + wr * 64 + fr + odd * 16, col0 = (u.c0 >> 1) + wc * 32 + 8 * (fq - odd);
#pragma unroll
        for (int ai = 0; ai < 2; ++ai)
#pragma unroll
            for (int mp = 0; mp < 2; ++mp) { v2u w[2];
#pragma unroll
                for (int mm = 0; mm < 2; ++mm) { const int m = 2 * mp + mm; float h[8]; const float wt = wl[wr * 64 + fr + ai * 128 + m * 16] * H8SCALE;
#pragma unroll
                    for (int n = 0; n < 2; ++n)
#pragma unroll
                        for (int j = 0; j < 4; ++j) { const float g = acc[ai][0][m][n][j] * (G1_FP8 ? 1.0f / W8SCALE : 1.0f), up = acc[ai][1][m][n][j] * (G1_FP8 ? 1.0f / W8SCALE : 1.0f); h[4 * n + j] = __builtin_amdgcn_fmed3f(g * sigmoidf_(g) * up * wt, -448.0f, 448.0f); }
                    int t = __builtin_amdgcn_cvt_pk_fp8_f32(h[0], h[1], 0, false); t = __builtin_amdgcn_cvt_pk_fp8_f32(h[2], h[3], t, true); w[mm].x = (unsigned)t;
                    t = __builtin_amdgcn_cvt_pk_fp8_f32(h[4], h[5], 0, false); t = __builtin_amdgcn_cvt_pk_fp8_f32(h[6], h[7], t, true); w[mm].y = (unsigned)t; }
                *(v4u*)(H + (size_t)(row0 + ai * 128 + mp * 32) * FE + col0) = pair16(w[0], w[1]); }
        return false;
    }
};
constexpr float YSCALE = 16.0f;
struct EpiMoe2 {
    static constexpr bool PERM = true; static constexpr int NST = 8;
    unsigned char* Y;
    __device__ __forceinline__ bool operator()(const pg8::f32x4 (&acc)[2][2][4][2], const pg8::Unit& u, int wr, int wc, int fr, int fq, const LAS float* wl) const {
        const int odd = fq & 1; const int lr0 = wr * 64 + fr + odd * 16, col0 = u.c0 + wc * 32 + 8 * (fq - odd);
#pragma unroll
        for (int ai = 0; ai < 2; ++ai)
#pragma unroll
            for (int mp = 0; mp < 2; ++mp) { const int lr = lr0 + ai * 128 + mp * 32;
#pragma unroll
                for (int bj = 0; bj < 2; ++bj) { v2u w[2];
#pragma unroll
                    for (int mm = 0; mm < 2; ++mm) { pg8::f32x4 v0 = acc[ai][bj][2 * mp + mm][0] * (YSCALE / (W8SCALE * H8SCALE)), v1 = acc[ai][bj][2 * mp + mm][1] * (YSCALE / (W8SCALE * H8SCALE));
#pragma unroll
                        for (int j = 0; j < 4; ++j) { v0[j] = __builtin_amdgcn_fmed3f(v0[j], -448.0f, 448.0f); v1[j] = __builtin_amdgcn_fmed3f(v1[j], -448.0f, 448.0f); }
                        int t = __builtin_amdgcn_cvt_pk_fp8_f32(v0[0], v0[1], 0, false); t = __builtin_amdgcn_cvt_pk_fp8_f32(v0[2], v0[3], t, true); w[mm].x = (unsigned)t;
                        t = __builtin_amdgcn_cvt_pk_fp8_f32(v1[0], v1[1], 0, false); t = __builtin_amdgcn_cvt_pk_fp8_f32(v1[2], v1[3], t, true); w[mm].y = (unsigned)t; }
                    *(v4u*)(Y + (size_t)(u.r0 + lr) * DM + col0 + bj * 128) = pair16(w[0], w[1]); } }
        return false;
    }
};

__device__ __forceinline__ void p1b_qknorm(Frame& F) {
    const int gw = F.vcu * NWAVES + F.wave, NGW = F.G * NWAVES; const bf16* proj = (const bf16*)(F.ws + WS_PROJ);
    const int hf = F.lane >> 5, i = F.lane & 31;
    const float inv = __builtin_amdgcn_exp2f(-(float)(2 * i) * (1.0f / 64.0f) * 13.287712379549449f);
    const float gk0 = F.in[6][64 * hf + i], gk1 = F.in[6][64 * hf + 32 + i];
    for (int tok0 = gw; tok0 < SEQ; tok0 += 4 * NGW) {
        float x1[4][2], x2[4][2];
#pragma unroll
        for (int b = 0; b < 4; ++b) { const int tok = tok0 + b * NGW; const bf16* pq = proj + (size_t)(tok < SEQ ? tok : 0) * PLD + C_KB + 64 * hf + i;
#pragma unroll
            for (int hh = 0; hh < 2; ++hh) { x1[b][hh] = bf2f(pq[hh * HD]); x2[b][hh] = bf2f(pq[hh * HD + 32]); } }
        __builtin_amdgcn_sched_barrier(0);
#pragma unroll
        for (int b = 0; b < 4; ++b) { const int tok = tok0 + b * NGW;
            const float pos = (float)(hf == 0 ? (tok >> 6) : (tok & 63));
            const float rev = pos * inv * 0.15915494309189535f, fr = rev - floorf(rev);
            const float sn = __builtin_amdgcn_sinf(fr), cs = __builtin_amdgcn_cosf(fr);
#pragma unroll
            for (int hh = 0; hh < 2; ++hh) {
                const float ss = wave_sum(x1[b][hh] * x1[b][hh] + x2[b][hh] * x2[b][hh]);
                const float rs = 1.0f / sqrtf(ss * (1.0f / HD) + RMS_EPS);
                const float a = x1[b][hh] * rs * gk0, c = x2[b][hh] * rs * gk1;
                const float o1 = a * cs - c * sn, o2 = c * cs + a * sn;
                if (tok < SEQ) { unsigned char* kf = F.ws + WS_KF8 + (size_t)tok * 256 + hh * HD + 64 * hf + 32 * ((i >> 4) & 1) + (i & 15);
                    kf[0] = (unsigned char)(__builtin_amdgcn_cvt_pk_fp8_f32(o1, 0.f, 0, false) & 0xff); kf[16] = (unsigned char)(__builtin_amdgcn_cvt_pk_fp8_f32(o2, 0.f, 0, false) & 0xff); } } }
    }
}

__device__ __forceinline__ int t5_bucket(int rel) {
    const int n = rel < 0 ? -rel : rel; int b;
    if (n < 8) b = n; else if (n < 12) b = 8; else if (n < 16) b = 9; else if (n < 23) b = 10; else if (n < 32) b = 11; else if (n < 46) b = 12; else if (n < 64) b = 13; else if (n < 91) b = 14; else b = 15;
    return (rel > 0 ? 16 : 0) + b;
}
#ifndef ATT_PP
#define ATT_PP 1
#endif
#ifndef WIN_RES
#define WIN_RES 1
#endif
#ifndef PROBE_ATT_KMASK
#define PROBE_ATT_KMASK (-1)
#endif
__device__ __forceinline__ void p3_dense_attention(Frame& F) {
    using abf = attn::bf16;
    char* lds = (char*)F.lds;
    const abf* proj = (const abf*)(F.ws + WS_PROJ);
    float gqm = fmaxf(fabsf(F.in[5][F.lane]), fabsf(F.in[5][F.lane + 64])), gkm = fmaxf(fabsf(F.in[6][F.lane]), fabsf(F.in[6][F.lane + 64]));
#pragma unroll
    for (int o = 1; o < 64; o <<= 1) { gqm = fmaxf(gqm, __shfl_xor(gqm, o)); gkm = fmaxf(gkm, __shfl_xor(gkm, o)); }
    const float sbound = 1.15f * 128.0f * gqm * gkm;
    for (int un = F.vcu; un < 256; un += F.G) {
        const int h = un >> 5, ub = un & 31, kvh = h >> 2;
        attn::attn_body<false, 1, true, true, true, -1, ATT_PP != 0>(proj + (size_t)(ub * 256) * PLD + C_QB + h * HD, proj + C_KB + kvh * HD, F.ws + WS_KF8 + kvh * HD, proj + C_VB + kvh * HD,
                               F.ws + WS_OB + (size_t)(ub * 256) * 1024 + h * HD, OB_SCALE, SEQ, lds, nullptr, 0, sbound, 0.f, F.in[5], ub * 256);
#ifdef PROBE_ATT2
        attn::attn_body<false, 1, true, true, true, PROBE_ATT_KMASK>(proj + (size_t)(ub * 256) * PLD + C_QB + h * HD, proj + C_KB + kvh * HD, F.ws + WS_KF8 + kvh * HD, proj + C_VB + kvh * HD,
                               F.ws + WS_MRG + (size_t)(ub * 256) * 1024 + h * HD, OB_SCALE, SEQ, lds, nullptr, 0, sbound, 0.f, F.in[5], ub * 256);
#endif
    }
}
__device__ __forceinline__ void win_attention(Frame& F, int first, int step) {
    using abf = attn::bf16;
    char* lds = (char*)F.lds;
    const abf* proj = (const abf*)(F.ws + WS_PROJ);
    for (int un = first; un < 256; un += step) {
        const int h = un >> 5, ub = un & 31, kvh = h >> 2;
        const int q0 = ub * 256; int kf = q0 - 128, ke = q0 + 384; if (kf < 0) kf = 0; if (ke > SEQ) ke = SEQ;
        const float sinkl = F.in[3][h] * (1.0f / attn::SCALE);
#if WIN_RES
        attn::attn_body<true, 1, false, false, false, -1, false, true>(proj + (size_t)q0 * PLD + C_QA + h * HD, proj + (size_t)kf * PLD + C_KA + kvh * HD, nullptr, proj + (size_t)kf * PLD + C_VA + kvh * HD,
                              F.ws + WS_OA + (size_t)q0 * 1024 + h * HD, OA_SCALE, ke - kf, lds, nullptr, kf - q0, sinkl, 1.0f, F.in[4] + h, 0);
#else
        LAS float* tab = (LAS float*)(F.lds + attn::WIN_TAB);
        for (int e = F.tid; e < 1024; e += NWAVES * 64) { const int rel = e - 512; const int ar = rel < 0 ? -rel : rel;
            tab[e] = ar <= 128 ? F.in[4][t5_bucket(rel) * 8 + h] * (1.0f / attn::SCALE) : -1e30f; }
        __syncthreads();
        attn::attn_body<true, 1, false, false>(proj + (size_t)q0 * PLD + C_QA + h * HD, proj + (size_t)kf * PLD + C_KA + kvh * HD, nullptr, proj + (size_t)kf * PLD + C_VA + kvh * HD,
                              F.ws + WS_OA + (size_t)q0 * 1024 + h * HD, OA_SCALE, ke - kf, lds, tab, kf - q0, sinkl, 1.0f);
#endif
    }
}

__device__ __forceinline__ void p5_ln_router(Frame& F, bool probe_rep = false) {
    typedef float f32x4v __attribute__((ext_vector_type(4)));
    const bf16* mixb = (const bf16*)(F.ws + WS_PRE); bf16* hbf = (bf16*)(F.ws + WS_HBF);
    const bf16* wrh = (const bf16*)(F.ws + WS_WR); const bf16* wrl = wrh + NEXP * DM;
    LAS float* red = (LAS float*)(F.lds);
    LAS float* part = (LAS float*)(F.lds + 4096);
    LAS int* cntl = (LAS int*)(F.lds + 4096 + 32768);
    LAS int* basel = cntl + 64;
    LAS int* rec_e = basel + 64;
    LAS int* rec_p = rec_e + 256;
    LAS float* rec_w = (LAS float*)(rec_p + 256);
    const int lane = F.lane, w = F.wave, gi = w >> 2, kq = w & 3, t = lane & 15, q = lane >> 4;
    for (int blk = F.vcu; blk < SEQ / 32; blk += F.G) {
        const int tok = blk * 32 + gi * 16 + t;
        if (F.tid < 64) cntl[F.tid] = 0;
        float s1 = 0.f, s2 = 0.f;
        const float* prow = F.in[0] + (size_t)tok * DM + kq * 512 + 4 * q; const bf16* mrow = mixb + (size_t)tok * DM + kq * 512 + 4 * q;
        f32x4v hv[16][2];
#pragma unroll
        for (int sg = 0; sg < 4; ++sg) {
            f32x4v xa[4][2]; v2u ma[4][2];
#pragma unroll
            for (int u = 0; u < 4; ++u) { const int s = 4 * sg + u; xa[u][0] = *(const f32x4v*)(prow + 32 * s); xa[u][1] = *(const f32x4v*)(prow + 32 * s + 16); ma[u][0] = *(const v2u*)(mrow + 32 * s); ma[u][1] = *(const v2u*)(mrow + 32 * s + 16); }
            __builtin_amdgcn_sched_barrier(0);
#pragma unroll
            for (int u = 0; u < 4; ++u) { const int s = 4 * sg + u; const v2u m0 = ma[u][0], m1 = ma[u][1];
                const f32x4v v0 = xa[u][0] * ALPHA + (f32x4v){pg8::bf_lo(m0.x), pg8::bf_hi(m0.x), pg8::bf_lo(m0.y), pg8::bf_hi(m0.y)}, v1 = xa[u][1] * ALPHA + (f32x4v){pg8::bf_lo(m1.x), pg8::bf_hi(m1.x), pg8::bf_lo(m1.y), pg8::bf_hi(m1.y)};
                hv[s][0] = v0; hv[s][1] = v1;
#pragma unroll
                for (int j = 0; j < 4; ++j) { s1 += v0[j] + v1[j]; s2 += v0[j] * v0[j] + v1[j] * v1[j]; } }
            __builtin_amdgcn_sched_barrier(0);
        }
        s1 += __shfl_xor(s1, 16); s1 += __shfl_xor(s1, 32); s2 += __shfl_xor(s2, 16); s2 += __shfl_xor(s2, 32);
        if (q == 0) { red[(w * 16 + t) * 2] = s1; red[(w * 16 + t) * 2 + 1] = s2; }
        __syncthreads();
        float m1 = 0.f, m2 = 0.f;
#pragma unroll
        for (int k = 0; k < 4; ++k) { m1 += red[((gi * 4 + k) * 16 + t) * 2]; m2 += red[((gi * 4 + k) * 16 + t) * 2 + 1]; }
        const float mean = m1 * (1.0f / DM); const float var = m2 * (1.0f / DM) - mean * mean; const float rstd = 1.0f / sqrtf(var + LN_EPS);
        f32x4v acc[4] = {};
        const float* gp = F.in[10] + kq * 512 + 4 * q; const float* bp = F.in[11] + kq * 512 + 4 * q;
        bf16* brow = hbf + (size_t)tok * DM + kq * 512 + 4 * q; unsigned char* frow = F.ws + WS_HF8 + (size_t)tok * DM + kq * 512 + 4 * q;
        struct P5Set { f32x4v g0, g1, b0, b1; bf16x8 Bh[4], Bl[4]; };
        P5Set A_; const unsigned lane8 = (unsigned)lane * 8u;
#define P5_LOAD(S, X) do { X.g0 = *(const f32x4v*)(gp + 32 * (S)); X.g1 = *(const f32x4v*)(gp + 32 * (S) + 16); X.b0 = *(const f32x4v*)(bp + 32 * (S)); X.b1 = *(const f32x4v*)(bp + 32 * (S) + 16); \
            { const bf16* wuh_ = wrh + (size_t)((kq * 16 + (S)) * 2048); const bf16* wul_ = wuh_ + NEXP * DM;     \
              asm volatile("" : "+s"(wuh_), "+s"(wul_));                                                         \
              _Pragma("unroll") for (int nt = 0; nt < 4; ++nt) { X.Bh[nt] = *(const bf16x8*)(wuh_ + nt * 512 + lane8); X.Bl[nt] = *(const bf16x8*)(wul_ + nt * 512 + lane8); } } } while (0)
#define P5_COMP(S, X) do { const f32x4v p0_ = hv[S][0], p1_ = hv[S][1]; \
            const f32x4v y0 = (p0_ - mean) * rstd * X.g0 + X.b0, y1 = (p1_ - mean) * rstd * X.g1 + X.b1; \
            v4u ah, al; ah.x = pg8::cvt_pk_bf16(y0[0], y0[1]); ah.y = pg8::cvt_pk_bf16(y0[2], y0[3]); ah.z = pg8::cvt_pk_bf16(y1[0], y1[1]); ah.w = pg8::cvt_pk_bf16(y1[2], y1[3]); \
            al.x = pg8::cvt_pk_bf16(y0[0] - pg8::bf_lo(ah.x), y0[1] - pg8::bf_hi(ah.x)); al.y = pg8::cvt_pk_bf16(y0[2] - pg8::bf_lo(ah.y), y0[3] - pg8::bf_hi(ah.y)); \
            al.z = pg8::cvt_pk_bf16(y1[0] - pg8::bf_lo(ah.z), y1[1] - pg8::bf_hi(ah.z)); al.w = pg8::cvt_pk_bf16(y1[2] - pg8::bf_lo(ah.w), y1[3] - pg8::bf_hi(ah.w)); \
            *(v2u*)(brow + 32 * (S)) = (v2u){ah.x, ah.y}; *(v2u*)(brow + 32 * (S) + 16) = (v2u){ah.z, ah.w}; \
            { int t0_ = __builtin_amdgcn_cvt_pk_fp8_f32(y0[0], y0[1], 0, false); t0_ = __builtin_amdgcn_cvt_pk_fp8_f32(y0[2], y0[3], t0_, true); \
              int t1_ = __builtin_amdgcn_cvt_pk_fp8_f32(y1[0], y1[1], 0, false); t1_ = __builtin_amdgcn_cvt_pk_fp8_f32(y1[2], y1[3], t1_, true); \
              *(int*)(frow + 32 * (S)) = t0_; *(int*)(frow + 32 * (S) + 16) = t1_; } \
            const bf16x8 Ah = __builtin_bit_cast(bf16x8, ah), Al = __builtin_bit_cast(bf16x8, al); \
            _Pragma("unroll") for (int nt = 0; nt < 4; ++nt) { acc[nt] = __builtin_amdgcn_mfma_f32_16x16x32_bf16(Ah, X.Bh[nt], acc[nt], 0, 0, 0); \
                acc[nt] = __builtin_amdgcn_mfma_f32_16x16x32_bf16(Al, X.Bh[nt], acc[nt], 0, 0, 0); acc[nt] = __builtin_amdgcn_mfma_f32_16x16x32_bf16(Ah, X.Bl[nt], acc[nt], 0, 0, 0); } } while (0)
#pragma unroll
        for (int s = 0; s < 16; ++s) {
            P5_LOAD(s, A_); __builtin_amdgcn_sched_barrier(0);
            P5_COMP(s, A_); __builtin_amdgcn_sched_barrier(0);
        }
#undef P5_LOAD
#undef P5_COMP
#pragma unroll
        for (int nt = 0; nt < 4; ++nt)
#pragma unroll
            for (int r = 0; r < 4; ++r) part[(w * 16 + 4 * q + r) * 64 + 16 * nt + t] = acc[nt][r];
        __syncthreads();
#ifdef PROBE_P5
        if (PROBE_P5 >= 2 && probe_rep) { __syncthreads(); continue; }
#endif
        const float rb = F.in[13][lane];
#pragma unroll 1
        for (int i = 0; i < 4; ++i) {
            const int tl = w * 4 + i, g2 = tl >> 4, tt = tl & 15;
            float logit = 0.f;
#pragma unroll
            for (int k = 0; k < 4; ++k) logit += part[((g2 * 4 + k) * 16 + tt) * 64 + lane];
            const float sc = 1.0f / (1.0f + expf(-logit));
            const float b = sc + rb;
            float mx = b; mx = fmaxf(mx, __shfl_xor(mx, 1)); mx = fmaxf(mx, __shfl_xor(mx, 2)); mx = fmaxf(mx, __shfl_xor(mx, 4));
            const unsigned long long bal = __ballot(b == mx); const unsigned gm = (unsigned)(bal >> (lane & ~7)) & 0xffu; const int first = __builtin_ctz(gm);
            float b2 = ((lane & 7) == first) ? -INFINITY : b; b2 = fmaxf(b2, __shfl_xor(b2, 1)); b2 = fmaxf(b2, __shfl_xor(b2, 2)); b2 = fmaxf(b2, __shfl_xor(b2, 4));
            const float gs = mx + b2; const int grp = lane >> 3; int gc = 0;
#pragma unroll
            for (int g3 = 0; g3 < 8; ++g3) { const float o = __uint_as_float(__builtin_amdgcn_readlane(__float_as_uint(gs), g3 * 8)); gc += (o > gs || (o == gs && g3 < grp)) ? 1 : 0; }
            const float mk = gc < 4 ? b : -INFINITY; int rank = 0;
#pragma unroll
            for (int j = 0; j < 64; ++j) { const float o = __uint_as_float(__builtin_amdgcn_readlane(__float_as_uint(mk), j)); rank += (o > mk || (o == mk && j < lane)) ? 1 : 0; }
            const bool sel = (gc < 4) && rank < 8;
            const float wsum = wave_sum(sel ? sc : 0.f);
            if (sel) { const int lp = atomicAdd((int*)(cntl + lane), 1); rec_e[tl * 8 + rank] = lane; rec_p[tl * 8 + rank] = lp; rec_w[tl * 8 + rank] = sc / wsum * ROUTED_SCALE; }
        }
        __syncthreads();
#ifdef PROBE_P5
        if (PROBE_P5 == 1 && probe_rep) { __syncthreads(); continue; }
#endif
        if (F.tid < 64) basel[F.tid] = (int)atomicAdd(F.ctl + CW_CNT + F.tid, (unsigned)cntl[F.tid]);
        __syncthreads();
        if (F.tid < 256) { const int tl = F.tid >> 3, e = rec_e[F.tid], pos = basel[e] + rec_p[F.tid]; const int token = blk * 32 + tl;
            ((int*)(F.ws + WS_LTOK))[e * LCAP + pos] = token; ((float*)(F.ws + WS_LW))[e * LCAP + pos] = rec_w[F.tid];
            int* rt = (int*)(F.ws + WS_ROUTE); rt[(token * 8 + (F.tid & 7)) * 2] = e; rt[(token * 8 + (F.tid & 7)) * 2 + 1] = pos; }
        __syncthreads();
    }
}

__device__ __forceinline__ void moe_build_tst(Frame& F) {
    LAS int* tst = (LAS int*)(F.lds + TST_OFF);
    if (F.tid == 0) { int acc = 0; for (int e = 0; e < NEXP1; ++e) { tst[e] = acc; const unsigned c = e < NEXP ? __hip_atomic_load(F.ctl + CW_CNT + e, RLX_AGENT) : (unsigned)SEQ; acc += (int)((c + 255u) >> 8); } tst[NEXP1] = acc; }
    __syncthreads();
}

__device__ __forceinline__ void p9_combine(Frame& F) {
    const LAS int* tst = (const LAS int*)(F.lds + TST_OFF);
    const int gw = F.vcu * NWAVES + F.wave, NGW = F.G * NWAVES; const int lane = F.lane;
    const unsigned char* Y = (const unsigned char*)(F.ws + WS_Y); const bf16* hbf = (const bf16*)(F.ws + WS_HBF); const int* rt = (const int*)(F.ws + WS_ROUTE);
    unsigned rows[9];
#define P9_ROWS(dst, tok_) do { _Pragma("unroll") for (int k = 0; k < 8; ++k) { const int e = rt[((tok_) * 8 + k) * 2], pos = rt[((tok_) * 8 + k) * 2 + 1]; dst[k] = (unsigned)(tst[e] * 256 + pos) * (DM / 8); } \
        dst[8] = (unsigned)(tst[NEXP] * 256 + (tok_)) * (DM / 8); } while (0)
    for (int tok = gw; tok < SEQ; tok += NGW) {
        P9_ROWS(rows, tok);
        float v[4][8]; float s1 = 0.f;
#pragma unroll
        for (int c = 0; c < 4; ++c) { const int col = 512 * c + 8 * lane;
            const v4u hv = __builtin_nontemporal_load((const v4u*)(hbf + (size_t)tok * DM + col));
            const f32x4 a = {pg8::bf_lo(hv.x), pg8::bf_hi(hv.x), pg8::bf_lo(hv.y), pg8::bf_hi(hv.y)}, b = {pg8::bf_lo(hv.z), pg8::bf_hi(hv.z), pg8::bf_lo(hv.w), pg8::bf_hi(hv.w)};
            float r[8] = {0.f, 0.f, 0.f, 0.f, 0.f, 0.f, 0.f, 0.f};
#pragma unroll
            for (int k = 0; k < 9; ++k) { const v2u y = __builtin_nontemporal_load((const v2u*)Y + (size_t)rows[k] + (col >> 3));
                const auto q0 = __builtin_amdgcn_cvt_pk_f32_fp8((int)y.x, false), q1 = __builtin_amdgcn_cvt_pk_f32_fp8((int)y.x, true), q2 = __builtin_amdgcn_cvt_pk_f32_fp8((int)y.y, false), q3 = __builtin_amdgcn_cvt_pk_f32_fp8((int)y.y, true);
                r[0] += q0[0]; r[1] += q0[1]; r[2] += q1[0]; r[3] += q1[1]; r[4] += q2[0]; r[5] += q2[1]; r[6] += q3[0]; r[7] += q3[1]; }
#pragma unroll
            for (int j = 0; j < 4; ++j) { v[c][j] = ALPHA * a[j] + r[j] * (1.0f / YSCALE); v[c][4 + j] = ALPHA * b[j] + r[4 + j] * (1.0f / YSCALE); }
#pragma unroll
            for (int j = 0; j < 8; ++j) s1 += v[c][j]; }
        const float mean = wave_sum(s1) * (1.0f / DM); float s2 = 0.f;
#pragma unroll
        for (int c = 0; c < 4; ++c)
#pragma unroll
            for (int j = 0; j < 8; ++j) { v[c][j] -= mean; s2 += v[c][j] * v[c][j]; }
        const float rstd = 1.0f / sqrtf(wave_sum(s2) * (1.0f / DM) + LN_EPS);
#pragma unroll
        for (int c = 0; c < 4; ++c) { const int col = 512 * c + 8 * lane;
            const f32x4 g0 = *(const f32x4*)(F.in[20] + col), g1 = *(const f32x4*)(F.in[20] + col + 4), b0 = *(const f32x4*)(F.in[21] + col), b1 = *(const f32x4*)(F.in[21] + col + 4);
            f32x4 o0, o1;
#pragma unroll
            for (int j = 0; j < 4; ++j) { o0[j] = v[c][j] * rstd * g0[j] + b0[j]; o1[j] = v[c][4 + j] * rstd * g1[j] + b1[j]; }
            __builtin_nontemporal_store(o0, (f32x4*)(F.out + (size_t)tok * DM + col)); __builtin_nontemporal_store(o1, (f32x4*)(F.out + (size_t)tok * DM + col + 4)); }
    }
#undef P9_ROWS
}

constexpr int NPHASES = 10;
#ifndef MK_ONE_LAUNCH
#define MK_ONE_LAUNCH 1
#endif
__global__ void __launch_bounds__(NWAVES * 64, 2) mega_fwd(Args args) {
    extern __shared__ __attribute__((aligned(16))) unsigned char lds[];
    Frame F;
    F.lds = (LAS unsigned char*)lds;
    F.MISC = (volatile LAS unsigned*)(F.lds + MISC_OFF);
    F.tid = threadIdx.x; F.lane = F.tid & 63; F.wave = __builtin_amdgcn_readfirstlane(F.tid >> 6);
    F.G = gridDim.x; { const int bx = blockIdx.x; F.vcu = (F.G % 8 == 0) ? (bx % 8) * (F.G / 8) + bx / 8 : bx; }
#pragma unroll
    for (int i = 0; i < 22; ++i) F.in[i] = args.in[i];
    F.out = args.out; F.ws = args.ws; F.ctl = (unsigned*)(args.ws + WS_CTL);
    for (int u = F.tid; u < (LDS_BYTES - LDSCTL_OFF) / 4; u += NWAVES * 64) ((LAS unsigned*)(F.lds + LDSCTL_OFF))[u] = 0u;
    __syncthreads();
    XcdBarrier bar; bar.bar = F.ctl + CW_BAR; bar.x = 0; bar.st = nullptr; bar.total = 0; XcdBarrier barB = bar;
    const bool conv1 = (F.G == 256) && (F.vcu & 31) >= P1_NCG;
    if (MK_ONE_LAUNCH) { bar = xcd_barrier_post(F.ctl + CW_BAR, F.MISC + 8, (unsigned)F.G); }
    const int lo = args.ph_lo, hi = args.ph_hi;
#ifndef PH_MASK
#define PH_MASK 0x3ff
#endif
#define IN(k) (((PH_MASK >> (k)) & 1) && lo <= (k) && (k) < hi)
#ifndef REP_MASK
#define REP_MASK 0
#endif
#define REP(k) for (int rep_ = 0; rep_ < 1 + ((REP_MASK >> (k)) & 1); ++rep_)
#ifndef BAR_REP
#define BAR_REP 1
#endif
#define SEAM(k) do { if (IN(k) && IN((k) + 1)) for (int br_ = 0; br_ < BAR_REP; ++br_) xcd_barrier(bar); } while (0)
    LAS int* idxl = (LAS int*)(F.lds + IDXL_OFF);
    const bool tst_needed = true;

    if (IN(0)) REP(0) { p0_prologue(F, false); } SEAM(0);
    if (IN(1)) REP(1) {
        const int grp = F.vcu >> 5, cin = F.vcu & 31;
        const bool conv = (F.G == 256) && cin >= P1_NCG;
        if (conv) { const int cw = (grp * (32 - P1_NCG) + (cin - P1_NCG)) * NWAVES + F.wave; convert_items<1>(F, cw, NCONV1 * NWAVES, E_SPLIT); convert_items<2>(F, cw, NCONV1 * NWAVES, E2_A); }
        else {
            DenseOrder S; if (F.G == 256) S.init(F.ws + WS_XBF, F.ws + WS_WINT, SEQ, INC, DM, NCOMP1, cin * 8 + grp); else S.init(F.ws + WS_XBF, F.ws + WS_WINT, SEQ, INC, DM, F.G, (int)blockIdx.x);
            EpiProj E{(bf16*)(F.ws + WS_PROJ), F.in[2]};
            pg8::gemm_phase<EpiProj, DenseOrder, true, false, P1_FP8 != 0>(F.lds + RING_OFF, idxl, DM, S, E);
        }
    } SEAM(1);
    if (IN(2)) {
        p1b_qknorm(F);
        if (F.G == 256) {
            if (E_SPLIT >= NITEMS_E1 && (CONV_G1 ? E2_SPLIT : E2_A) >= NITEMS_E2) win_attention(F, F.vcu, 256);
            else if (F.vcu & 1) win_attention(F, F.vcu >> 1, 128);
            else { const int cw = (F.vcu >> 1) * NWAVES + F.wave;
                convert_items<1>(F, E_SPLIT + cw, 128 * NWAVES, NITEMS_E1); convert_items<2>(F, (CONV_G1 ? E2_SPLIT : E2_A) + cw, 128 * NWAVES, NITEMS_E2); }
        } else { win_attention(F, F.vcu, F.G); convert_items<1>(F, F.vcu * NWAVES + F.wave, F.G * NWAVES, NITEMS_E1); convert_items<2>(F, F.vcu * NWAVES + F.wave, F.G * NWAVES, NITEMS_E2); }
    } SEAM(2);
    if (IN(3)) REP(3) { p3_dense_attention(F); } SEAM(3);
    if (IN(4)) REP(4) {
        BranchOrder S{(const char*)(F.ws + WS_OA), (const char*)(F.ws + WS_OB), (const char*)(F.ws + WS_WAT), (const char*)(F.ws + WS_WBT), F.vcu};
        EpiBranch E{(const bf16*)(F.ws + WS_PROJ), F.ws + WS_MRG};
        if (F.vcu < 256) pg8::gemm_phase<EpiBranch, BranchOrder, false, false, true>(F.lds + RING_OFF, idxl, 1024, S, E);
    } SEAM(4);
    if (IN(5)) REP(5) {
        OneTileOrder S{(const char*)(F.ws + WS_MRG), (const char*)(F.ws + WS_WOT), F.vcu, (size_t)256 * DM};
        EpiMix E{(bf16*)(F.ws + WS_PRE)};
        if (F.vcu < 256) pg8::gemm_phase<EpiMix, OneTileOrder, false, false, true>(F.lds + RING_OFF, idxl, DM, S, E);
    } SEAM(5);
    if (IN(6)) REP(6) { if (rep_) { xcd_barrier(bar);
#ifndef PROBE_P5
            if (blockIdx.x == 0 && F.tid < 64) __hip_atomic_store(F.ctl + CW_CNT + F.tid, 0u, RLX_AGENT);
#endif
            xcd_barrier(bar); } p5_ln_router(F, rep_ != 0); } SEAM(6);
    if (IN(7) || IN(8) || IN(9)) { if (tst_needed) moe_build_tst(F); }
#ifndef DEFER_MAX
#define DEFER_MAX 64
#endif
    int n_defer = 0, u1_end = -1;
    if (IN(7) || IN(8)) { const int T_ = ((const LAS int*)(F.lds + TST_OFF))[NEXP1]; const int r_ = (4 * T_) % 256;
        if (F.G == 256 && !CONV_G1 && 4 * T_ > 256 && r_ > 0 && r_ <= DEFER_MAX && (lo <= 7 && 8 < hi)) { n_defer = r_; u1_end = 4 * T_ - r_; } }
    if (IN(7)) REP(7) {
        const bool split = CONV_G1 && F.G == 256, conv = split && ((F.vcu & 7) == 7);
        if (conv) { convert_items<2>(F, E2_A + (F.vcu >> 3) * NWAVES + F.wave, NCONV * NWAVES, E2_SPLIT); }
        else {
        MoeOrder<4> S{(const LAS int*)(F.lds + TST_OFF), (const char*)(F.ws + (G1_FP8 ? WS_HF8 : WS_HBF)), (const char*)(F.ws + WS_WGU), (const int*)(F.ws + WS_LTOK), (const float*)(F.ws + WS_LW), split ? F.vcu - (F.vcu >> 3) : F.vcu, split ? NCOMP : F.G, 0, (size_t)1024 * DM * (G1_FP8 ? 1 : 2), (size_t)256 * DM * (G1_FP8 ? 1 : 2), true,
                      0, u1_end, 0, nullptr, 0, 0};
        EpiMoe1 E{F.ws + WS_HID};
        pg8::gemm_phase<EpiMoe1, MoeOrder<4>, true, true, G1_FP8 != 0>(F.lds + RING_OFF, idxl, DM, S, E);
        }
    } SEAM(7);
    if (IN(8)) REP(8) {
        unsigned* dflag = F.ctl + CW_CNT + 128;
        if (n_defer > 0 && F.vcu >= 256 - n_defer) {
            MoeOrder<4> S1{(const LAS int*)(F.lds + TST_OFF), (const char*)(F.ws + (G1_FP8 ? WS_HF8 : WS_HBF)), (const char*)(F.ws + WS_WGU), (const int*)(F.ws + WS_LTOK), (const float*)(F.ws + WS_LW), F.vcu - (256 - n_defer), 256, 0, (size_t)1024 * DM * (G1_FP8 ? 1 : 2), (size_t)256 * DM * (G1_FP8 ? 1 : 2), true,
                           u1_end, u1_end + n_defer, 0, nullptr, 0, 0};
            EpiMoe1 E1{F.ws + WS_HID};
            pg8::gemm_phase<EpiMoe1, MoeOrder<4>, true, true, G1_FP8 != 0>(F.lds + RING_OFF, idxl, DM, S1, E1);
            if (F.tid == 0) { __builtin_amdgcn_fence(__ATOMIC_RELEASE, "agent"); asm volatile("s_waitcnt vmcnt(0)" ::: "memory"); __hip_atomic_fetch_add(dflag, 1u, __ATOMIC_RELAXED, __HIP_MEMORY_SCOPE_AGENT); }
        }
        MoeOrder<8> S{(const LAS int*)(F.lds + TST_OFF), (const char*)(F.ws + WS_HID), (const char*)(F.ws + WS_WD), (const int*)(F.ws + WS_LTOK), (const float*)(F.ws + WS_LW), F.vcu, F.G, (size_t)FE, (size_t)DM * FE, (size_t)256 * FE, false,
                      0, -1, n_defer, dflag, n_defer > 0 ? u1_end / 4 : 0, n_defer};
#ifndef G2_ALIGN
#define G2_ALIGN true
#endif
        EpiMoe2 E{(unsigned char*)(F.ws + WS_Y)};
        pg8::gemm_phase<EpiMoe2, MoeOrder<8>, G2_ALIGN, false, true>(F.lds + RING_OFF, idxl, FE, S, E);
    } SEAM(8);
    if (IN(9)) REP(9) { p9_combine(F); }
#ifdef PROBE_T
    { const LAS int* tst_ = (const LAS int*)(F.lds + TST_OFF); if (tst_[NEXP1] > PROBE_T && blockIdx.x == 0 && F.tid == 0) F.out[0] = __builtin_nanf(""); }
#endif
#undef IN
#undef SEAM
}

extern "C" void kernel_launch(void* const* d_in, const int* in_sizes, int n_in, void* d_out, int out_size, void* d_ws, size_t ws_size, hipStream_t stream) {
    static int grid = 0;
    if (grid == 0) {
        if (n_in != 22 || out_size != SEQ * DM || ws_size < WS_END) { fprintf(stderr, "kernel_launch: unexpected shapes (n_in %d, out %d, ws %zu < %zu); nothing launched\n", n_in, out_size, ws_size, (size_t)WS_END); grid = -1; return; }
        int dev = 0, cus = 0, per_cu = 0;
        if (hipGetDevice(&dev) != hipSuccess || hipDeviceGetAttribute(&cus, hipDeviceAttributeMultiprocessorCount, dev) != hipSuccess) { grid = -1; return; }
        if (hipFuncSetAttribute((const void*)mega_fwd, hipFuncAttributeMaxDynamicSharedMemorySize, LDS_BYTES) != hipSuccess) { fprintf(stderr, "kernel_launch: hipFuncSetAttribute failed\n"); grid = -1; return; }
        if (hipOccupancyMaxActiveBlocksPerMultiprocessor(&per_cu, (const void*)mega_fwd, NWAVES * 64, LDS_BYTES) != hipSuccess || per_cu < 1) { fprintf(stderr, "kernel_launch: occupancy query says %d blocks per CU; nothing launched\n", per_cu); (void)hipGetLastError(); grid = -1; return; }
        grid = cus;
        if (grid > 256) grid = 256;
    }
    if (grid < 0) return;
    (void)hipMemsetAsync((char*)d_ws + WS_CTL, 0, CTL_ZERO_BYTES, stream);
    Args a{};
    for (int i = 0; i < 22; ++i) a.in[i] = (const float*)d_in[i];
    a.out = (float*)d_out; a.ws = (unsigned char*)d_ws;
#if MK_ONE_LAUNCH
    a.ph_lo = 0; a.ph_hi = NPHASES;
    hipLaunchKernelGGL(mega_fwd, dim3(grid), dim3(NWAVES * 64), LDS_BYTES, stream, a);
#else
    for (int p = 0; p < NPHASES; ++p) { a.ph_lo = p; a.ph_hi = p + 1; hipLaunchKernelGGL(mega_fwd, dim3(grid), dim3(NWAVES * 64), LDS_BYTES, stream, a); }
#endif
    const hipError_t le = hipPeekAtLastError();
    if (le != hipSuccess) fprintf(stderr, "kernel_launch: launch failed: %s\n", hipGetErrorName(le));
}
```

```cpp
#define P1_NCG 23
#define CONV_Q 58
#define P1_QA 14
#define P1_QB 3
#define P1_QE2 0
#define CONV_G1 0
#define P6_PREG 2
#include <hip/hip_runtime.h>
#include <hip/hip_bf16.h>
#include <cstdio>
#include <cstdint>
#include <cmath>
namespace pg8 {
#define PG8_LAS __attribute__((address_space(3)))
typedef unsigned short bf16_t;
typedef short bf16x8 __attribute__((ext_vector_type(8)));
typedef float f32x4 __attribute__((ext_vector_type(4)));
typedef unsigned u32x4 __attribute__((ext_vector_type(4)));
typedef int v4i_t __attribute__((ext_vector_type(4)));
typedef int v8i_t __attribute__((ext_vector_type(8)));
constexpr int BM = 256, BK = 64, HALF = 128, HTB = HALF * BK * 2  , STAGE_BYTES = 8 * HTB;

__host__ __device__ __forceinline__ int lds_byte(int r, int c) { const int st = (r >> 4) * 2 + (c >> 5), rr = r & 15, cc = c & 31, ob = rr * 64 + cc * 2; return st * 1024 + (ob ^ (((ob >> 9) & 1) << 5)); }
__host__ __device__ __forceinline__ void stage_rc(int b, int& R, int& C) { const int st = b / 1024, sb = b % 1024, swz = sb ^ (((sb >> 9) & 1) << 5); R = (st >> 1) * 16 + swz / 64; C = (st & 1) * 32 + (swz % 64) / 2; }
__host__ __device__ __forceinline__ int perm32(int rho) { const int n = rho >> 4, i = rho & 15; return 8 * (i >> 2) + 4 * n + (i & 3); }

struct Unit { const char* A; const char* B; const int* idx; const float* wts; int r0, c0, aux, kind; };

typedef float f32x2_t __attribute__((ext_vector_type(2))); typedef __bf16 bf16x2_t __attribute__((ext_vector_type(2)));
__device__ __forceinline__ unsigned cvt_pk_bf16(float lo, float hi) { f32x2_t v = {lo, hi}; bf16x2_t b = __builtin_convertvector(v, bf16x2_t); return __builtin_bit_cast(unsigned, b); }
__device__ __forceinline__ float bf_lo(unsigned w) { return __uint_as_float(w << 16); }
__device__ __forceinline__ float bf_hi(unsigned w) { return __uint_as_float(w & 0xffff0000u); }

template <class Epi, class Sched, bool ALIGN_EPI, bool GATHER, bool FP8 = false>
__device__ __forceinline__ void gemm_phase(PG8_LAS unsigned char* lds, PG8_LAS int* idxl, const int K, const Sched& S, const Epi& E) {
    PG8_LAS float* wl = (PG8_LAS float*)(idxl + 256);
    const int tid = threadIdx.x, wid = __builtin_amdgcn_readfirstlane(tid >> 6), lane = tid & 63, wr = wid >> 2, wc = wid & 3, fr = lane & 15, fq = lane >> 4;
    const int KB = FP8 ? K : 2 * K;
    const int nt = KB / 128;
    const size_t kstep = (size_t)(BK * 2);
    const size_t hstep = (size_t)HALF * KB;
    unsigned voffA0[2], voffA1[2], voffB[2];
#pragma unroll
    for (int i = 0; i < 2; ++i) { int R, C; stage_rc(tid * 16 + i * 8192, R, C); const int Rb = Epi::PERM ? ((R & ~31) + perm32(R & 31)) : R;
        voffA0[i] = (unsigned)(R * KB + C * 2); voffA1[i] = voffA0[i] + (unsigned)hstep; voffB[i] = (unsigned)(Rb * KB + C * 2); }
    const unsigned ldsw = (unsigned)wid * 1024u;
    const int aoff = FP8 ? lds_byte(wr * 64 + fr, (fq >> 1) * 32 + (fq & 1) * 16) : lds_byte(wr * 64 + fr, fq * 8), boff = FP8 ? lds_byte(wc * 32 + fr, (fq >> 1) * 32 + (fq & 1) * 16) : lds_byte(wc * 32 + fr, fq * 8);
#define PG8_SA(b, h) (((b) * 2 + (h)) * HTB)
#define PG8_SB(b, h) ((4 + (b) * 2 + (h)) * HTB)
#define PG8_STAGE(bufoff, gbase, voff) do { _Pragma("unroll") for (int _i = 0; _i < 2; ++_i) \
        __builtin_amdgcn_global_load_lds((const unsigned*)((const char*)(gbase) + (voff)[_i]), (PG8_LAS unsigned*)(lds + (bufoff) + ldsw + _i * 8192), 16, 0, 0); } while (0)
#define PG8_LD8(addr) __builtin_shufflevector(*(const PG8_LAS v4i_t*)(addr), *(const PG8_LAS v4i_t*)((addr) + 16), 0, 1, 2, 3, 4, 5, 6, 7)
#define PG8_LDA(dst, b, h) do { if constexpr (FP8) { _Pragma("unroll") for (int m = 0; m < 4; ++m) dst##8[m] = PG8_LD8(lds + PG8_SA(b, h) + aoff + m * 2048); } \
        else { _Pragma("unroll") for (int m = 0; m < 4; ++m) _Pragma("unroll") for (int k = 0; k < 2; ++k) dst[m][k] = *(const PG8_LAS bf16x8*)(lds + PG8_SA(b, h) + aoff + m * 2048 + k * 1024); } } while (0)
#define PG8_LDB(dst, b, h) do { if constexpr (FP8) { _Pragma("unroll") for (int n = 0; n < 2; ++n) dst##8[n] = PG8_LD8(lds + PG8_SB(b, h) + boff + n * 2048); } \
        else { _Pragma("unroll") for (int n = 0; n < 2; ++n) _Pragma("unroll") for (int k = 0; k < 2; ++k) dst[n][k] = *(const PG8_LAS bf16x8*)(lds + PG8_SB(b, h) + boff + n * 2048 + k * 1024); } } while (0)
#define PG8_MMA(ai, bj, At, Bt) do { __builtin_amdgcn_s_setprio(1); _Pragma("unroll") for (int m = 0; m < 4; ++m) _Pragma("unroll") for (int n = 0; n < 2; ++n) { \
        if constexpr (FP8) asm volatile("v_mfma_scale_f32_16x16x128_f8f6f4 %0, %1, %2, %0, %3, %4 op_sel_hi:[0,0,0]" : "+v"(acc[ai][bj][m][n]) : "v"(Bt##8[n]), "v"(At##8[m]), "v"(one_scale), "v"(epi_scale)); \
        else { _Pragma("unroll") for (int k = 0; k < 2; ++k) acc[ai][bj][m][n] = __builtin_amdgcn_mfma_f32_16x16x32_bf16(Bt[n][k], At[m][k], acc[ai][bj][m][n], 0, 0, 0); } } __builtin_amdgcn_s_setprio(0); } while (0)
#define PG8_WAIT_V(n) asm volatile("s_waitcnt vmcnt(" #n ")" ::: "memory")
#define PG8_WAIT_L(n) asm volatile("s_waitcnt lgkmcnt(" #n ")" ::: "memory")
#define PG8_WAIT_VN(n) asm volatile("s_waitcnt vmcnt(%0)" :: "n"(n) : "memory")
#define PG8_WAIT_VR(sel) do { if constexpr (Epi::NST > 0) { int _sg; asm volatile("v_readfirstlane_b32 %0, %1\n\ts_nop 0\n\ts_cmp_lg_u32 %0, 0\n\ts_cbranch_scc1 1f\n\ts_waitcnt vmcnt(8)\n\ts_branch 2f\n1:\n\ts_waitcnt vmcnt(%2)\n2:" \
            : "=&s"(_sg) : "v"(sel), "n"(8 + Epi::NST) : "memory", "scc"); } \
        else asm volatile("s_waitcnt vmcnt(8)" ::: "memory"); } while (0)
#define PG8_BAR __builtin_amdgcn_s_barrier()
#define PG8_SCHED __builtin_amdgcn_sched_barrier(0)
#define PG8_GOFF(src) do { _Pragma("unroll") for (int _i = 0; _i < 2; ++_i) { int R_, C_; stage_rc(tid * 16 + _i * 8192, R_, C_); \
        voffA0[_i] = (unsigned)((src)[R_] * KB + C_ * 2); voffA1[_i] = (unsigned)((src)[R_ + HALF] * KB + C_ * 2); } } while (0)
    Unit cur, nxt; int ui = 0;
    if (!S.next(0, cur)) return;
    f32x4 acc[2][2][4][2];
#pragma unroll
    for (int a = 0; a < 2; ++a)
#pragma unroll
        for (int b = 0; b < 2; ++b)
#pragma unroll
            for (int m = 0; m < 4; ++m)
#pragma unroll
                for (int n = 0; n < 2; ++n) acc[a][b][m][n] = (f32x4){0.f, 0.f, 0.f, 0.f};
    bf16x8 At[4][2], B0[2][2], B1[2][2];
    v8i_t At8[4], B08[2], B18[2];
    int epi_scale = Epi::MSCALE; asm volatile("" : "+v"(epi_scale));
    int one_scale = 0x7f7f7f7f; asm volatile("" : "+v"(one_scale));
    const char* cA = cur.A; const char* cB = cur.B;
    if constexpr (GATHER) { PG8_GOFF(cur.idx); if (tid >= 256) wl[tid - 256] = cur.wts[tid - 256]; }
    PG8_STAGE(PG8_SB(0, 0), cB, voffB); PG8_STAGE(PG8_SB(0, 1), cB + hstep, voffB); PG8_STAGE(PG8_SA(0, 0), cA, voffA0); PG8_STAGE(PG8_SA(0, 1), cA, voffA1);
    if (wr == 1) PG8_BAR;
    PG8_WAIT_V(2); PG8_BAR;
    PG8_STAGE(PG8_SB(1, 0), cB + kstep, voffB); PG8_STAGE(PG8_SA(1, 0), cA + kstep, voffA0); PG8_STAGE(PG8_SB(1, 1), cB + hstep + kstep, voffB);
    PG8_WAIT_V(6); PG8_BAR;
    for (;;) {
        const bool has_next = S.next(ui + 1, nxt);
        const char* nA = has_next ? nxt.A : cA; const char* nB = has_next ? nxt.B : cB;
        if constexpr (GATHER) { if (has_next && tid < 256) {
            __builtin_amdgcn_global_load_lds((const unsigned*)(nxt.idx + tid), (PG8_LAS unsigned*)((PG8_LAS unsigned char*)idxl + wid * 256), 4, 0, 0); }
          if (has_next && tid >= 256) {
            __builtin_amdgcn_global_load_lds((const unsigned*)(nxt.wts + (tid - 256)), (PG8_LAS unsigned*)((PG8_LAS unsigned char*)(wl + ((ui + 1) & 1) * 256) + (wid - 4) * 256), 4, 0, 0); } }
#pragma unroll 1
        for (int t = 0; t < nt; t += 2) {
            const bool last = (t == nt - 2);
            const char* a1 = cA + (size_t)(t + 1) * kstep;
            const char* a2 = last ? nA : cA + (size_t)(t + 2) * kstep; const char* b2 = last ? nB : cB + (size_t)(t + 2) * kstep;
            const char* a3 = a2 + kstep; const char* b3 = b2 + kstep;
            const int rlx = (t == 0 && ui > 0) ? 1 : 0;
            PG8_LDB(B0, 0, 0); PG8_LDB(B1, 0, 1); PG8_SCHED; PG8_LDA(At, 0, 0); PG8_STAGE(PG8_SA(1, 1), a1, voffA1);
            if constexpr (GATHER) { if (last && has_next) { PG8_GOFF(idxl); } }
            PG8_WAIT_VR(rlx); PG8_WAIT_L(0); PG8_BAR; PG8_MMA(0, 0, At, B0); PG8_MMA(0, 1, At, B1); PG8_BAR; PG8_SCHED;
            PG8_LDA(At, 0, 1); PG8_STAGE(PG8_SB(0, 0), b2, voffB); PG8_STAGE(PG8_SB(0, 1), b2 + hstep, voffB); PG8_STAGE(PG8_SA(0, 0), a2, voffA0);
            PG8_WAIT_VR(rlx); PG8_WAIT_L(0); PG8_BAR; PG8_MMA(1, 0, At, B0); PG8_MMA(1, 1, At, B1); PG8_BAR; PG8_SCHED;
            PG8_LDB(B0, 1, 0); PG8_LDB(B1, 1, 1); PG8_SCHED; PG8_LDA(At, 1, 0); PG8_STAGE(PG8_SA(0, 1), a2, voffA1);
            PG8_WAIT_V(8); PG8_WAIT_L(0); PG8_BAR; PG8_MMA(0, 0, At, B0); PG8_MMA(0, 1, At, B1); PG8_BAR; PG8_SCHED;
            PG8_LDA(At, 1, 1); PG8_STAGE(PG8_SB(1, 0), b3, voffB); PG8_STAGE(PG8_SB(1, 1), b3 + hstep, voffB); PG8_STAGE(PG8_SA(1, 0), a3, voffA0);
            PG8_WAIT_V(8); PG8_WAIT_L(0); PG8_BAR; PG8_MMA(1, 0, At, B0); PG8_MMA(1, 1, At, B1); PG8_BAR; PG8_SCHED;
        }
        if constexpr (ALIGN_EPI) { if (wr == 0) PG8_BAR; }
        if constexpr (FP8) asm volatile("s_nop 15\n\ts_nop 15" ::: "memory");
        const bool keep = E(acc, cur, wr, wc, fr, fq, wl + (ui & 1) * 256);
        if (!has_next) break;
        if (!keep) {
#pragma unroll
        for (int a = 0; a < 2; ++a)
#pragma unroll
            for (int b = 0; b < 2; ++b)
#pragma unroll
                for (int m = 0; m < 4; ++m)
#pragma unroll
                    for (int n = 0; n < 2; ++n) acc[a][b][m][n] = (f32x4){0.f, 0.f, 0.f, 0.f};
        }
        cur = nxt; cA = nA; cB = nB; ++ui;
        if constexpr (ALIGN_EPI) { if (wr == 1) PG8_BAR; }
    }
    PG8_WAIT_V(0);
    if constexpr (!ALIGN_EPI) { if (wr == 0) PG8_BAR; }
    PG8_BAR;
#undef PG8_SA
#undef PG8_SB
#undef PG8_STAGE
#undef PG8_LDA
#undef PG8_LDB
#undef PG8_MMA
#undef PG8_LD8
#undef PG8_WAIT_V
#undef PG8_WAIT_L
#undef PG8_WAIT_VN
#undef PG8_WAIT_VR
#undef PG8_BAR
#undef PG8_SCHED
#undef PG8_GOFF
}
}
namespace attn {
using bf16 = __hip_bfloat16;
constexpr int   D = 128, NW = 8, QBLK = 32, KVBLK = 64;
constexpr float SCALE = 0.088388347648318440f;
constexpr float THR = 8.f;
constexpr float LOG2E = 1.4426950408889634f;
#ifndef PROJ_PAD
#define PROJ_PAD 64
#endif
constexpr int LDQ = 7168 + PROJ_PAD, LDK = 7168 + PROJ_PAD, LDO = 1024;
constexpr size_t SHM_V = KVBLK * D * 2, SHM_K = KVBLK * D * 2, SHM_ATTN = 2 * SHM_V + 2 * SHM_K + NW * 64 * 4;
constexpr int WIN_TAB = (int)SHM_ATTN;

using bf16x8 = __attribute__((ext_vector_type(8))) short;
using s16x4  = __attribute__((ext_vector_type(4))) short;
using f32x16 = __attribute__((ext_vector_type(16))) float;
using u32x4  = __attribute__((ext_vector_type(4))) unsigned;
using f32x4_a = __attribute__((ext_vector_type(4))) float;
#define KSWZ(row, colB) ((row) * 256 + ((colB) ^ (((row) & 7) << 4)))
#define SBAR() __builtin_amdgcn_sched_barrier(0)
__device__ __forceinline__ int crow(int r, int hi) { return (r & 3) + 8 * (r >> 2) + 4 * hi; }
__device__ __forceinline__ unsigned cvtpk(float lo, float hi) { return pg8::cvt_pk_bf16(lo, hi); }
template <bool FIXM, bool PRE = false>
__device__ __forceinline__ void partialSM(f32x16& p0, f32x16& p1, float& m_reg, float& mn, float& alpha) {
  constexpr float C = SCALE * LOG2E;
  if constexpr (PRE) {
    mn = m_reg; alpha = 1.f;
    for (int r = 0; r < 16; ++r) p0[r] = __builtin_amdgcn_exp2f(p0[r]);
    return;
  }
  if constexpr (FIXM) {
    mn = m_reg; alpha = 1.f; float mnC = -m_reg * C; asm volatile("" : "+v"(mnC));
    typedef float f32x2_p __attribute__((ext_vector_type(2))); const f32x2_p c2 = {C, C}, m2 = {mnC, mnC};
#pragma unroll
    for (int r = 0; r < 16; r += 2) { f32x2_p a = {p0[r], p0[r + 1]}, b = {p1[r], p1[r + 1]}; a = __builtin_elementwise_fma(a, c2, m2); b = __builtin_elementwise_fma(b, c2, m2); p0[r] = a[0]; p0[r + 1] = a[1]; p1[r] = b[0]; p1[r + 1] = b[1]; }
    for (int r = 0; r < 16; ++r) p0[r] = __builtin_amdgcn_exp2f(p0[r]);
    return;
  }
  float pmax = p0[0]; for (int r = 1; r < 16; ++r) pmax = fmaxf(pmax, p0[r]); for (int r = 0; r < 16; ++r) pmax = fmaxf(pmax, p1[r]);
  { auto rr = __builtin_amdgcn_permlane32_swap(__float_as_uint(pmax), __float_as_uint(pmax), false, false);
    pmax = fmaxf(__uint_as_float(rr[0]), __uint_as_float(rr[1])); }
  if (__builtin_expect(__all(pmax - m_reg <= THR / SCALE), 1)) { mn = m_reg; alpha = 1.f; }
  else { mn = fmaxf(m_reg, pmax); alpha = __builtin_amdgcn_exp2f((m_reg - mn) * C); m_reg = mn; }
  float mnC = -mn * C;
  for (int r = 0; r < 16; ++r) p0[r] = fmaf(p0[r], C, mnC); for (int r = 0; r < 16; ++r) p1[r] = fmaf(p1[r], C, mnC);
  for (int r = 0; r < 16; ++r) p0[r] = __builtin_amdgcn_exp2f(p0[r]);
}
__device__ __forceinline__ void finishSM(f32x16& p0, f32x16& p1, float alpha, float& l_reg, bf16x8& pa0, bf16x8& pa1, bf16x8& pa2, bf16x8& pa3) {
  for (int r = 0; r < 16; ++r) p1[r] = __builtin_amdgcn_exp2f(p1[r]);
  float ps = 0; for (int r = 0; r < 16; ++r) ps += p0[r]; for (int r = 0; r < 16; ++r) ps += p1[r];
  { auto rr = __builtin_amdgcn_permlane32_swap(__float_as_uint(ps), __float_as_uint(ps), false, false);
    ps = __uint_as_float(rr[0]) + __uint_as_float(rr[1]); }
  l_reg = l_reg * alpha + ps;
#define PK4(P, BASE, OUT) do { unsigned a0 = cvtpk(P[BASE + 0], P[BASE + 1]), a1 = cvtpk(P[BASE + 2], P[BASE + 3]);   \
    unsigned b0 = cvtpk(P[BASE + 4], P[BASE + 5]), b1 = cvtpk(P[BASE + 6], P[BASE + 7]);                              \
    auto r0 = __builtin_amdgcn_permlane32_swap(a0, b0, false, false); auto r1 = __builtin_amdgcn_permlane32_swap(a1, b1, false, false); \
    u32x4 w = {r0[0], r1[0], r0[1], r1[1]}; OUT = *reinterpret_cast<bf16x8*>(&w); } while (0)
  PK4(p0, 0, pa0); PK4(p0, 8, pa1); PK4(p1, 0, pa2); PK4(p1, 8, pa3);
#undef PK4
}
#define KSWZ8(row, colB) ((row) * 128 + ((colB) ^ (((row) & 7) << 4)))
typedef int v8i_a __attribute__((ext_vector_type(8))); typedef int v4i_a __attribute__((ext_vector_type(4)));
template <bool WIN, bool F8, bool PRE = false>
__device__ __forceinline__ void qkt(f32x16& p0, f32x16& p1, const bf16* Ks, const bf16x8* qr, const v8i_a* q8, int r32, int hi, const __attribute__((address_space(3))) float* tb, const f32x16* cinit = nullptr) {
  if constexpr (F8 && PRE) {
    int one = 0x7f7f7f7f, sc3 = 0x7c7c7c7c; asm volatile("" : "+v"(one), "+v"(sc3));
#pragma unroll
    for (int s = 0; s < 2; ++s) { const int cb = 64 * s + 32 * hi;
      const char* ka = (const char*)Ks + KSWZ8(r32, cb); const char* kb = (const char*)Ks + KSWZ8(32 + r32, cb);
      const v8i_a k0 = __builtin_shufflevector(*reinterpret_cast<const v4i_a*>(ka), *reinterpret_cast<const v4i_a*>((const char*)Ks + KSWZ8(r32, cb + 16)), 0, 1, 2, 3, 4, 5, 6, 7);
      const v8i_a k1 = __builtin_shufflevector(*reinterpret_cast<const v4i_a*>(kb), *reinterpret_cast<const v4i_a*>((const char*)Ks + KSWZ8(32 + r32, cb + 16)), 0, 1, 2, 3, 4, 5, 6, 7);
      if (s == 0) {
        asm volatile("s_nop 1\n\tv_mfma_scale_f32_32x32x64_f8f6f4 %0, %1, %2, %3, %4, %5 op_sel_hi:[0,0,0]" : "=&v"(p0) : "v"(k0), "v"(q8[s]), "v"(*cinit), "v"(one), "v"(sc3));
        asm volatile("v_mfma_scale_f32_32x32x64_f8f6f4 %0, %1, %2, %3, %4, %5 op_sel_hi:[0,0,0]" : "=&v"(p1) : "v"(k1), "v"(q8[s]), "v"(*cinit), "v"(one), "v"(sc3));
      } else {
        asm volatile("v_mfma_scale_f32_32x32x64_f8f6f4 %0, %1, %2, %0, %3, %4 op_sel_hi:[0,0,0]" : "+v"(p0) : "v"(k0), "v"(q8[s]), "v"(one), "v"(sc3));
        asm volatile("v_mfma_scale_f32_32x32x64_f8f6f4 %0, %1, %2, %0, %3, %4 op_sel_hi:[0,0,0]" : "+v"(p1) : "v"(k1), "v"(q8[s]), "v"(one), "v"(sc3)); } }
    asm volatile("s_nop 15\n\ts_nop 15" : "+v"(p0), "+v"(p1));
    return;
  }
  if constexpr (F8) {
    int one = 0x7f7f7f7f; asm volatile("" : "+v"(one));
#pragma unroll
    for (int s = 0; s < 2; ++s) { const int cb = 64 * s + 32 * hi;
      const char* ka = (const char*)Ks + KSWZ8(r32, cb); const char* kb = (const char*)Ks + KSWZ8(32 + r32, cb);
      const v8i_a k0 = __builtin_shufflevector(*reinterpret_cast<const v4i_a*>(ka), *reinterpret_cast<const v4i_a*>((const char*)Ks + KSWZ8(r32, cb + 16)), 0, 1, 2, 3, 4, 5, 6, 7);
      const v8i_a k1 = __builtin_shufflevector(*reinterpret_cast<const v4i_a*>(kb), *reinterpret_cast<const v4i_a*>((const char*)Ks + KSWZ8(32 + r32, cb + 16)), 0, 1, 2, 3, 4, 5, 6, 7);
      if (s == 0) {
        asm volatile("s_nop 1\n\tv_mfma_scale_f32_32x32x64_f8f6f4 %0, %1, %2, 0, %3, %3 op_sel_hi:[0,0,0]" : "=&v"(p0) : "v"(k0), "v"(q8[s]), "v"(one));
        asm volatile("v_mfma_scale_f32_32x32x64_f8f6f4 %0, %1, %2, 0, %3, %3 op_sel_hi:[0,0,0]" : "=&v"(p1) : "v"(k1), "v"(q8[s]), "v"(one));
      } else {
        asm volatile("v_mfma_scale_f32_32x32x64_f8f6f4 %0, %1, %2, %0, %3, %3 op_sel_hi:[0,0,0]" : "+v"(p0) : "v"(k0), "v"(q8[s]), "v"(one));
        asm volatile("v_mfma_scale_f32_32x32x64_f8f6f4 %0, %1, %2, %0, %3, %3 op_sel_hi:[0,0,0]" : "+v"(p1) : "v"(k1), "v"(q8[s]), "v"(one)); } }
    asm volatile("s_nop 15\n\ts_nop 15" : "+v"(p0), "+v"(p1));
    return;
  }
  if constexpr (WIN) {
#pragma unroll
    for (int r = 0; r < 16; ++r) { p0[r] = tb[(r & 3) + 8 * (r >> 2)]; p1[r] = tb[32 + (r & 3) + 8 * (r >> 2)]; }
  } else { p0 = f32x16{}; p1 = f32x16{}; }
  for (int d0 = 0; d0 < 8; ++d0) { int cb = (d0 * 16 + hi * 8) * 2;
    bf16x8 b0 = *reinterpret_cast<const bf16x8*>((const char*)Ks + KSWZ(r32, cb));
    bf16x8 b1 = *reinterpret_cast<const bf16x8*>((const char*)Ks + KSWZ(32 + r32, cb));
    p0 = __builtin_amdgcn_mfma_f32_32x32x16_bf16(b0, qr[d0], p0, 0, 0, 0);
    p1 = __builtin_amdgcn_mfma_f32_32x32x16_bf16(b1, qr[d0], p1, 0, 0, 0); }
}
__device__ __forceinline__ int v_st(int k, int c) { const int kk = (k & ~0xC) | ((k & 4) << 1) | ((k & 8) >> 1); return ((kk >> 3) * 4 + (c >> 5)) * 512 + ((kk & 7) * 32 + (c & 31)) * 2; }
__device__ __forceinline__ int v_rd_base(int lane) { return ((lane & 3) << 3) | (((lane >> 2) & 3) << 6) | (((lane >> 4) & 1) << 5) | (((lane >> 5) & 1) << 8); }
constexpr int v_rd_off(int d0, int ks, int half) { return d0 * 512 + ks * 4096 + half * 2048; }
template <int OFF> __device__ __forceinline__ s16x4 tr_read(int vb) {
  s16x4 r; asm volatile("ds_read_b64_tr_b16 %0, %1 offset:%2" : "=&v"(r) : "v"(vb), "i"(OFF) : "memory"); return r;
}
template <int D0> __device__ __forceinline__ void pv_one(f32x16& od, int vb, bf16x8 pa0, bf16x8 pa1, bf16x8 pa2, bf16x8 pa3) {
  const s16x4 l0 = tr_read<v_rd_off(D0, 0, 0)>(vb), h0 = tr_read<v_rd_off(D0, 0, 1)>(vb), l1 = tr_read<v_rd_off(D0, 1, 0)>(vb), h1 = tr_read<v_rd_off(D0, 1, 1)>(vb);
  const s16x4 l2 = tr_read<v_rd_off(D0, 2, 0)>(vb), h2 = tr_read<v_rd_off(D0, 2, 1)>(vb), l3 = tr_read<v_rd_off(D0, 3, 0)>(vb), h3 = tr_read<v_rd_off(D0, 3, 1)>(vb);
  asm volatile("s_waitcnt lgkmcnt(0)" ::: "memory"); SBAR();
#define PK(L, H) (bf16x8){L[0], L[1], L[2], L[3], H[0], H[1], H[2], H[3]}
  od = __builtin_amdgcn_mfma_f32_32x32x16_bf16(pa0, PK(l0, h0), od, 0, 0, 0);
  od = __builtin_amdgcn_mfma_f32_32x32x16_bf16(pa1, PK(l1, h1), od, 0, 0, 0);
  od = __builtin_amdgcn_mfma_f32_32x32x16_bf16(pa2, PK(l2, h2), od, 0, 0, 0);
  od = __builtin_amdgcn_mfma_f32_32x32x16_bf16(pa3, PK(l3, h3), od, 0, 0, 0);
#undef PK
}
__device__ __forceinline__ void pv_d0(f32x16* o, int vb, bf16x8 pa0, bf16x8 pa1, bf16x8 pa2, bf16x8 pa3) {
  pv_one<0>(o[0], vb, pa0, pa1, pa2, pa3); pv_one<1>(o[1], vb, pa0, pa1, pa2, pa3); pv_one<2>(o[2], vb, pa0, pa1, pa2, pa3); pv_one<3>(o[3], vb, pa0, pa1, pa2, pa3);
}

struct ConvTask { const float* w; const float* wsh; unsigned char* wt; int gwave; float scale;
                  const float* wg; const float* wu; unsigned char* wgu; };
constexpr int CV_STEPS = 127, CV_GU_EXPERTS = 31;
template <bool WIN, int SDEPTH, bool F8, bool FIXM, bool QN = false, int kmask = -1, bool PP = false, bool WRES = false, bool CV = false>
__device__ __forceinline__ void attn_body(const bf16* __restrict__ Qb, const bf16* __restrict__ Kh, const unsigned char* __restrict__ Kh8, const bf16* __restrict__ Vh,
                                          unsigned char* __restrict__ Ob, float oscale, int seq, char* lds, const __attribute__((address_space(3))) float* tab, int relbase, float m0, float l0,
                                          const float* __restrict__ gq = nullptr, int qpos0 = 0, ConvTask cv = ConvTask{}) {
  int tid_ = threadIdx.x; asm volatile("" : "+v"(tid_));
  const int tid = tid_, wid = tid >> 6, lane = tid & 63, r32 = lane & 31, hi = lane >> 5;
  bf16* V_lds = (bf16*)lds; bf16* K_lds = (bf16*)(lds + 2 * SHM_V);
  float* ws = (float*)(lds + 2 * SHM_V + 2 * SHM_K) + wid * 64; float* li_l = ws; float* al_l = ws + 32;
  float m_reg = m0, l_reg = l0; f32x16 o[4]; bf16x8 qr[8];
  const bf16* Qw = Qb + (long)(wid * QBLK + r32) * LDQ + hi * 8;
  v8i_a q8[2];
  if constexpr (F8 && QN) {
    const bf16* Qr = Qb + (long)(wid * QBLK + r32) * LDQ + hi * 16;
    u32x4 raw[2][2][2];
#pragma unroll
    for (int s = 0; s < 2; ++s)
#pragma unroll
      for (int pt = 0; pt < 2; ++pt)
#pragma unroll
        for (int c = 0; c < 2; ++c) raw[s][pt][c] = *reinterpret_cast<const u32x4*>(Qr + 64 * s + 32 * pt + 8 * c);
#define QLO(w_) __uint_as_float((w_) << 16)
#define QHI(w_) __uint_as_float((w_) & 0xffff0000u)
    float ss = 0.f;
#pragma unroll
    for (int s = 0; s < 2; ++s)
#pragma unroll
      for (int pt = 0; pt < 2; ++pt)
#pragma unroll
        for (int c = 0; c < 2; ++c) { const u32x4 v = raw[s][pt][c];
          ss = fmaf(QLO(v.x), QLO(v.x), ss); ss = fmaf(QHI(v.x), QHI(v.x), ss); ss = fmaf(QLO(v.y), QLO(v.y), ss); ss = fmaf(QHI(v.y), QHI(v.y), ss);
          ss = fmaf(QLO(v.z), QLO(v.z), ss); ss = fmaf(QHI(v.z), QHI(v.z), ss); ss = fmaf(QLO(v.w), QLO(v.w), ss); ss = fmaf(QHI(v.w), QHI(v.w), ss); }
    { auto rr = __builtin_amdgcn_permlane32_swap(__float_as_uint(ss), __float_as_uint(ss), false, false); ss = __uint_as_float(rr[0]) + __uint_as_float(rr[1]); }
    const float rs = 1.0f / sqrtf(ss * (1.0f / D) + 1e-6f);
    constexpr float qsc = PP ? 8.0f * SCALE * LOG2E : 1.0f;
    const int tok = qpos0 + wid * QBLK + r32;
#pragma unroll
    for (int s = 0; s < 2; ++s) { int w[8]; const float pos = (float)(s == 0 ? (tok >> 6) : (tok & 63));
#pragma unroll
      for (int c = 0; c < 2; ++c) {
        const u32x4 va = raw[s][0][c], vb = raw[s][1][c];
        const float xa[8] = {QLO(va.x), QHI(va.x), QLO(va.y), QHI(va.y), QLO(va.z), QHI(va.z), QLO(va.w), QHI(va.w)}, xb[8] = {QLO(vb.x), QHI(vb.x), QLO(vb.y), QHI(vb.y), QLO(vb.z), QHI(vb.z), QLO(vb.w), QHI(vb.w)};
        float o1[8], o2[8];
#pragma unroll
        for (int u4 = 0; u4 < 2; ++u4) { const f32x4_a g1 = *reinterpret_cast<const f32x4_a*>(gq + 64 * s + 16 * hi + 8 * c + 4 * u4), g2 = *reinterpret_cast<const f32x4_a*>(gq + 64 * s + 32 + 16 * hi + 8 * c + 4 * u4);
#pragma unroll
          for (int u = 0; u < 4; ++u) { const int t = 4 * u4 + u; const float inv = __builtin_amdgcn_exp2f(-(float)(2 * (16 * hi + 8 * c + t)) * (1.0f / 64.0f) * 13.287712379549449f);
            const float rev = pos * inv * 0.15915494309189535f, fr = rev - floorf(rev); const float sn = __builtin_amdgcn_sinf(fr), cs = __builtin_amdgcn_cosf(fr);
            const float a = xa[t] * rs * g1[u], b = xb[t] * rs * g2[u]; o1[t] = (a * cs - b * sn) * qsc; o2[t] = (b * cs + a * sn) * qsc; } }
        int t0 = __builtin_amdgcn_cvt_pk_fp8_f32(o1[0], o1[1], 0, false); t0 = __builtin_amdgcn_cvt_pk_fp8_f32(o1[2], o1[3], t0, true); w[2 * c] = t0;
        t0 = __builtin_amdgcn_cvt_pk_fp8_f32(o1[4], o1[5], 0, false); t0 = __builtin_amdgcn_cvt_pk_fp8_f32(o1[6], o1[7], t0, true); w[2 * c + 1] = t0;
        t0 = __builtin_amdgcn_cvt_pk_fp8_f32(o2[0], o2[1], 0, false); t0 = __builtin_amdgcn_cvt_pk_fp8_f32(o2[2], o2[3], t0, true); w[4 + 2 * c] = t0;
        t0 = __builtin_amdgcn_cvt_pk_fp8_f32(o2[4], o2[5], 0, false); t0 = __builtin_amdgcn_cvt_pk_fp8_f32(o2[6], o2[7], t0, true); w[4 + 2 * c + 1] = t0; }
      q8[s] = (v8i_a){w[0], w[1], w[2], w[3], w[4], w[5], w[6], w[7]}; }
#undef QLO
#undef QHI
  } else if constexpr (F8) {
    const bf16* Qr = Qb + (long)(wid * QBLK + r32) * LDQ + hi * 32;
#pragma unroll
    for (int s = 0; s < 2; ++s) { int w[8];
#pragma unroll
      for (int c = 0; c < 4; ++c) { const u32x4 v = *reinterpret_cast<const u32x4*>(Qr + 64 * s + 8 * c);
        int t = __builtin_amdgcn_cvt_pk_fp8_f32(__uint_as_float(v.x << 16), __uint_as_float(v.x & 0xffff0000u), 0, false); t = __builtin_amdgcn_cvt_pk_fp8_f32(__uint_as_float(v.y << 16), __uint_as_float(v.y & 0xffff0000u), t, true); w[2 * c] = t;
        t = __builtin_amdgcn_cvt_pk_fp8_f32(__uint_as_float(v.z << 16), __uint_as_float(v.z & 0xffff0000u), 0, false); t = __builtin_amdgcn_cvt_pk_fp8_f32(__uint_as_float(v.w << 16), __uint_as_float(v.w & 0xffff0000u), t, true); w[2 * c + 1] = t; }
      q8[s] = (v8i_a){w[0], w[1], w[2], w[3], w[4], w[5], w[6], w[7]}; }
  } else {
#pragma unroll
    for (int d0 = 0; d0 < 8; ++d0) qr[d0] = *reinterpret_cast<const bf16x8*>(Qw + d0 * 16);
  }
#pragma unroll
  for (int d = 0; d < 4; ++d) { float z_; asm volatile("v_mov_b32 %0, 0" : "=v"(z_));
#pragma unroll
    for (int r = 0; r < 16; ++r) o[d][r] = z_; }
  const int sr = tid >> 4, sc = (tid & 15) * 8, vst0 = v_st(sr, sc), vst1 = v_st(32 + sr, sc);
  const int vb0 = (int)(uintptr_t)V_lds + v_rd_base(lane);
  const __attribute__((address_space(3))) float* tb0 = tab + (relbase - (wid * QBLK + r32) + 512 + 4 * hi);
  struct { bf16x8 vs0, vs1, ks0, ks1; } sr_[SDEPTH];
#define SLOAD(i, k0) do { sr_[i].vs0 = *reinterpret_cast<const bf16x8*>(&Vh[(long)(((k0) & kmask) + sr) * LDK + sc]); sr_[i].vs1 = *reinterpret_cast<const bf16x8*>(&Vh[(long)(((k0) & kmask) + 32 + sr) * LDK + sc]); \
    if constexpr (F8) { sr_[i].ks0 = *reinterpret_cast<const bf16x8*>(&Kh8[(long)(((k0) & kmask) + (tid >> 3)) * 256 + (tid & 7) * 16]); } \
    else { sr_[i].ks0 = *reinterpret_cast<const bf16x8*>(&Kh[(long)(((k0) & kmask) + sr) * LDK + sc]); sr_[i].ks1 = *reinterpret_cast<const bf16x8*>(&Kh[(long)(((k0) & kmask) + 32 + sr) * LDK + sc]); } } while (0)
#define SWRITE(b, i) do { *(bf16x8*)((char*)V_lds + (b) * SHM_V + vst0) = sr_[i].vs0;          \
    *(bf16x8*)((char*)V_lds + (b) * SHM_V + vst1) = sr_[i].vs1; int kc = sc * 2;               \
    if constexpr (F8) { *(bf16x8*)((char*)K_lds + (b) * SHM_K + KSWZ8(tid >> 3, (tid & 7) * 16)) = sr_[i].ks0; } \
    else { *(bf16x8*)((char*)K_lds + (b) * SHM_K + KSWZ(sr, kc)) = sr_[i].ks0;                       \
    *(bf16x8*)((char*)K_lds + (b) * SHM_K + KSWZ(32 + sr, kc)) = sr_[i].ks1; } } while (0)
#define SWAIT() do { if constexpr (SDEPTH == 2) asm volatile("s_waitcnt vmcnt(4)" ::: "memory"); else asm volatile("s_waitcnt vmcnt(0)" ::: "memory"); } while (0)
#define RESC(a) do { if (!FIXM && __any((a) < 1.f)) { if (hi == 0) al_l[r32] = (a); asm volatile("s_waitcnt lgkmcnt(0)" ::: "memory"); \
    for (int d = 0; d < 4; ++d) for (int r = 0; r < 16; ++r) o[d][r] *= al_l[crow(r, hi)]; } } while (0)
  f32x16 pA0, pA1, pB0, pB1; float mnA, mnB, alA, alB; bf16x8 pa0, pa1, pa2, pa3; const int NT = seq / KVBLK;
  if constexpr (WRES) {
    static_assert(!WRES || (WIN && !F8 && !FIXM && !PP), "window-resident path: the bf16 banded attention only");
    typedef __attribute__((address_space(3))) unsigned lds_u32;
    typedef __attribute__((address_space(3))) unsigned char lds_u8;
    constexpr int KST = 0, VST = 65536, TILEB = KVBLK * D * 2, TABO = 131072 + 512, SCRO = TABO + 4096;
    const int widu = __builtin_amdgcn_readfirstlane(wid);
    lds_u8* ldsb = (lds_u8*)(unsigned)(uintptr_t)lds;
    li_l = (float*)(lds + SCRO) + widu * 64; al_l = li_l + 32;
    __attribute__((address_space(3))) float* tabw = (__attribute__((address_space(3))) float*)(ldsb + TABO);
    unsigned kofs[2], vofs[2];
#pragma unroll
    for (int i = 0; i < 2; ++i) { const int row = 4 * (widu * 2 + i) + (lane >> 4), c = (lane & 15) ^ (row & 7); kofs[i] = (unsigned)((row * LDK + c * 8) * 2);
      const int blk = (widu * 2 + i) * 2 + (lane >> 5), kk = (blk >> 2) * 8 + ((lane & 31) >> 2), k = (kk & ~0xC) | ((kk & 4) << 1) | ((kk & 8) >> 1);
      vofs[i] = (unsigned)((k * LDK + (blk & 3) * 32 + 8 * (lane & 3)) * 2); }
#define WDMA(slot, tile) do { const unsigned char* kb_ = (const unsigned char*)(Kh + (long)(tile) * (KVBLK * LDK)); const unsigned char* vb_ = (const unsigned char*)(Vh + (long)(tile) * (KVBLK * LDK)); \
      asm volatile("" : "+s"(kb_), "+s"(vb_)); _Pragma("unroll") for (int i_ = 0; i_ < 2; ++i_) { \
        __builtin_amdgcn_global_load_lds((const unsigned*)(kb_ + kofs[i_]), (lds_u32*)(ldsb + KST + (slot) * TILEB + (widu * 2 + i_) * 1024), 16, 0, 0); \
        __builtin_amdgcn_global_load_lds((const unsigned*)(vb_ + vofs[i_]), (lds_u32*)(ldsb + VST + (slot) * TILEB + (widu * 2 + i_) * 1024), 16, 0, 0); } } while (0)
#pragma unroll
    for (int sl = 0; sl < 4; ++sl) if (sl < NT) WDMA(sl, sl);
    for (int e = tid; e < 1024; e += NW * 64) { const int rel = e - 512, n = rel < 0 ? -rel : rel; int b;
      if (n < 8) b = n; else if (n < 12) b = 8; else if (n < 16) b = 9; else if (n < 23) b = 10; else if (n < 32) b = 11; else if (n < 46) b = 12; else if (n < 64) b = 13; else if (n < 91) b = 14; else b = 15;
      tabw[e] = n <= 128 ? gq[((rel > 0 ? 16 : 0) + b) * 8] * (1.0f / SCALE) : -1e30f; }
    asm volatile("s_waitcnt vmcnt(0) lgkmcnt(0)" ::: "memory"); __syncthreads();
    const __attribute__((address_space(3))) float* tbw0 = tabw + (relbase - (wid * QBLK + r32) + 512 + 4 * hi);
    const int qlo = widu * QBLK, qhi = qlo + QBLK - 1;
#pragma unroll 1
    for (int st = 0; st < 2; ++st) {
#pragma unroll 1
      for (int jj = 0; jj < 4; ++jj) { const int j = st * 4 + jj; const int r0 = relbase + KVBLK * j;
        if (j < NT && r0 <= qhi + 128 && r0 + KVBLK - 1 >= qlo - 128) {
          qkt<WIN, F8>(pA0, pA1, (bf16*)(lds + KST + jj * TILEB), qr, q8, r32, hi, tbw0 + KVBLK * j);
          partialSM<FIXM>(pA0, pA1, m_reg, mnA, alA); finishSM(pA0, pA1, alA, l_reg, pa0, pa1, pa2, pa3); RESC(alA);
          pv_d0(o, (int)(uintptr_t)(lds + VST + jj * TILEB) + v_rd_base(lane), pa0, pa1, pa2, pa3); } }
      if (st == 0 && NT > 4) { __syncthreads();
#pragma unroll
        for (int sl = 0; sl < 4; ++sl) if (4 + sl < NT) WDMA(sl, 4 + sl);
        asm volatile("s_waitcnt vmcnt(0)" ::: "memory"); __syncthreads(); }
      else if (st == 0) break;
    }
#undef WDMA
  } else if constexpr (PP) {
    static_assert(!PP || (F8 && FIXM && !WIN), "ping-pong path: dense fp8 fixed-reference attention only");
    constexpr int NS = 4, KSLOT = KVBLK * D, VSLOT = KVBLK * D * 2, KRING = NS * VSLOT;
    typedef __attribute__((address_space(3))) unsigned lds_u32;
    const int widu = __builtin_amdgcn_readfirstlane(wid), grp = widu >> 2;
    li_l = (float*)(lds + KRING + NS * KSLOT) + widu * 64; al_l = li_l + 32;
    const __attribute__((address_space(3))) unsigned char* ldsb = (const __attribute__((address_space(3))) unsigned char*)(unsigned)(uintptr_t)lds;
    const int krow = widu * 8 + (lane >> 3);
    const unsigned kofs = (unsigned)(krow * 256 + (((lane & 7) ^ (krow & 7)) << 4));
    unsigned vofs[2];
#pragma unroll
    for (int i = 0; i < 2; ++i) { const int blk = (widu * 2 + i) * 2 + (lane >> 5), kk = (blk >> 2) * 8 + ((lane & 31) >> 2), k = (kk & ~0xC) | ((kk & 4) << 1) | ((kk & 8) >> 1);
      vofs[i] = (unsigned)((k * LDK + (blk & 3) * 32 + 8 * (lane & 3)) * 2); }
#define DMAK(t) do { const int t_ = (t) < NT ? (t) : NT - 1; const unsigned char* kb_ = Kh8 + (long)t_ * (KVBLK * 256); asm volatile("" : "+s"(kb_)); \
      __builtin_amdgcn_global_load_lds((const unsigned*)(kb_ + kofs), (lds_u32*)(ldsb + KRING + ((t) & (NS - 1)) * KSLOT + widu * 1024), 16, 0, 0); } while (0)
#define DMAV(t) do { const int t_ = (t) < NT ? (t) : NT - 1; const unsigned char* vb_ = (const unsigned char*)(Vh + (long)t_ * (KVBLK * LDK)); asm volatile("" : "+s"(vb_)); _Pragma("unroll") for (int i_ = 0; i_ < 2; ++i_) \
      __builtin_amdgcn_global_load_lds((const unsigned*)(vb_ + vofs[i_]), (lds_u32*)(ldsb + ((t) & (NS - 1)) * VSLOT + (widu * 2 + i_) * 1024), 16, 0, 0); } while (0)
#define PBAR() do { asm volatile("s_waitcnt lgkmcnt(0)" ::: "memory"); __builtin_amdgcn_s_barrier(); } while (0)
#define PEND() do { asm volatile("s_waitcnt vmcnt(%0)" :: "n"(CV ? 12 : 6) : "memory"); PBAR(); } while (0)
    const __attribute__((address_space(3))) unsigned char* const cvb = ldsb + (widu < 5 ? (KRING + NS * KSLOT + 2048) + widu * 6144 : 131072 + 512 + (widu - 5) * 6144);
#define CVDMA(s_, buf_) do { if constexpr (CV) { const int st_ = (s_) < CV_STEPS ? (s_) : CV_STEPS - 1; const float* src_; int pit_; \
      if (st_ < 65) { src_ = (st_ < 64 ? cv.w + (long)st_ * (512 * 2048) : cv.wsh) + (long)(16 * (cv.gwave >> 6)) * 2048 + 32 * (cv.gwave & 63); pit_ = 2048; } \
      else { const int m_ = st_ - 65; src_ = ((m_ & 1) ? cv.wu : cv.wg) + (long)(m_ >> 1) * (2048 * 512) + (long)(16 * (cv.gwave >> 4)) * 512 + 32 * (cv.gwave & 15); pit_ = 512; } \
      asm volatile("" : "+s"(src_), "+s"(pit_)); const unsigned lo_ = (unsigned)(((lane >> 3) * pit_ + 4 * (lane & 7)) * 4), st8_ = (unsigned)(8 * pit_ * 4); \
      _Pragma("unroll") for (int i_ = 0; i_ < 2; ++i_) __builtin_amdgcn_global_load_lds((const unsigned*)((const char*)src_ + lo_ + i_ * st8_), (lds_u32*)(cvb + (buf_) * 2048 + i_ * 1024), 16, 0, 0); } } while (0)
#define CVFIN(s_, buf_) do { if constexpr (CV) { const int st_ = (s_) < CV_STEPS ? (s_) : CV_STEPS - 1; \
      const __attribute__((address_space(3))) float* s2_ = (const __attribute__((address_space(3))) float*)(cvb + (buf_) * 2048) + (lane >> 5) * (8 * 32) + (lane & 31); \
      float v_[8]; _Pragma("unroll") for (int j_ = 0; j_ < 8; ++j_) v_[j_] = s2_[j_ * 32] * cv.scale; \
      int t_ = __builtin_amdgcn_cvt_pk_fp8_f32(v_[0], v_[1], 0, false); t_ = __builtin_amdgcn_cvt_pk_fp8_f32(v_[2], v_[3], t_, true); \
      int u_ = __builtin_amdgcn_cvt_pk_fp8_f32(v_[4], v_[5], 0, false); u_ = __builtin_amdgcn_cvt_pk_fp8_f32(v_[6], v_[7], u_, true); \
      typedef unsigned cv2u_ __attribute__((ext_vector_type(2))); unsigned char* d_; \
      if (st_ < 65) d_ = cv.wt + (long)st_ * (2048 * 512) + (long)(32 * (cv.gwave & 63) + (lane & 31)) * 512 + 16 * (cv.gwave >> 6) + 8 * (lane >> 5); \
      else { const int m_ = st_ - 65, n0_ = 32 * (cv.gwave & 15); d_ = cv.wgu + (long)(m_ >> 1) * (1024 * 2048) + (long)(256 * (n0_ >> 7) + 128 * (m_ & 1) + (n0_ & 127) + (lane & 31)) * 2048 + 16 * (cv.gwave >> 4) + 8 * (lane >> 5); } \
      *(cv2u_*)d_ = (cv2u_){(unsigned)t_, (unsigned)u_}; } } while (0)
#define KSL(t) ((bf16*)(lds + KRING + ((t) & (NS - 1)) * KSLOT))
#define VSL(t) (vb0 + ((t) & (NS - 1)) * VSLOT)
    DMAK(0); DMAV(0); DMAK(1); DMAV(1); DMAK(2); DMAK(3); DMAV(2);
    CVDMA(0, 0); CVDMA(1, 1); int cvi = 2, cvc = 0;
    asm volatile("s_waitcnt vmcnt(0)" ::: "memory"); PBAR();
    f32x16 cinit; { float nm_ = -m0 * (SCALE * LOG2E); asm volatile("" : "+v"(nm_));
#pragma unroll
      for (int r = 0; r < 16; ++r) cinit[r] = nm_; }
    qkt<WIN, F8, true>(pA0, pA1, KSL(0), qr, q8, r32, hi, tb0, &cinit); partialSM<FIXM, true>(pA0, pA1, m_reg, mnA, alA);
    PBAR();
    if (grp == 1) PBAR();
#pragma unroll 1
    for (int t = 1; t < NT; ++t) {
      SBAR(); CVDMA(t + 1, cvi); DMAK(t + 3); SBAR(); cvi = cvi == 2 ? 0 : cvi + 1;
      finishSM(pA0, pA1, alA, l_reg, pa0, pa1, pa2, pa3); SBAR();
      qkt<WIN, F8, true>(pA0, pA1, KSL(t), qr, q8, r32, hi, tb0, &cinit); SBAR();
      PEND();
      SBAR(); DMAV(t + 2); CVFIN(t - 1, cvc); cvc = cvc == 2 ? 0 : cvc + 1;
      pv_d0(o, VSL(t - 1), pa0, pa1, pa2, pa3); partialSM<FIXM, true>(pA0, pA1, m_reg, mnA, alA); SBAR();
      PEND();
    }
    if (grp == 0) PBAR();
    finishSM(pA0, pA1, alA, l_reg, pa0, pa1, pa2, pa3); SBAR();
    pv_d0(o, VSL(NT - 1), pa0, pa1, pa2, pa3);
    asm volatile("s_waitcnt vmcnt(0)" ::: "memory");
#undef DMAK
#undef DMAV
#undef PBAR
#undef PEND
#undef CVDMA
#undef CVFIN
#undef KSL
#undef VSL
  } else {
  constexpr int SE = 0, SO = SDEPTH - 1;
  SLOAD(SE, 0); asm volatile("s_waitcnt vmcnt(0)" ::: "memory"); SWRITE(0, SE); __syncthreads();
  qkt<WIN, F8>(pA0, pA1, K_lds, qr, q8, r32, hi, tb0); partialSM<FIXM>(pA0, pA1, m_reg, mnA, alA);
  SLOAD(SO, KVBLK); if constexpr (SDEPTH == 2) { if (2 < NT) SLOAD(SE, 2 * KVBLK); }
  SWAIT(); SWRITE(1, SO); __syncthreads();
  for (int j = 1; j + 1 < NT; j += 2) {
    SBAR(); qkt<WIN, F8>(pB0, pB1, (bf16*)((char*)K_lds + SHM_K), qr, q8, r32, hi, tb0 + 64 * j);
    finishSM(pA0, pA1, alA, l_reg, pa0, pa1, pa2, pa3); SBAR();
    SLOAD(SO, (j + SDEPTH) * KVBLK); SBAR();
    pv_d0(o, vb0, pa0, pa1, pa2, pa3); partialSM<FIXM>(pB0, pB1, m_reg, mnB, alB);
    __syncthreads(); SWAIT(); SWRITE(0, SE);
    RESC(alB); __syncthreads();
    SBAR(); qkt<WIN, F8>(pA0, pA1, K_lds, qr, q8, r32, hi, tb0 + 64 * (j + 1));
    finishSM(pB0, pB1, alB, l_reg, pa0, pa1, pa2, pa3); SBAR();
    if (SDEPTH == 1 || j + 3 < NT) SLOAD(SE, (j + 1 + SDEPTH) * KVBLK); SBAR();
    pv_d0(o, vb0 + (int)SHM_V, pa0, pa1, pa2, pa3); partialSM<FIXM>(pA0, pA1, m_reg, mnA, alA);
    __syncthreads(); SWAIT(); SWRITE(1, SO);
    RESC(alA); __syncthreads();
  }
  SBAR(); qkt<WIN, F8>(pB0, pB1, (bf16*)((char*)K_lds + SHM_K), qr, q8, r32, hi, tb0 + 64 * (NT - 1));
  finishSM(pA0, pA1, alA, l_reg, pa0, pa1, pa2, pa3); SBAR();
  pv_d0(o, vb0, pa0, pa1, pa2, pa3); partialSM<FIXM>(pB0, pB1, m_reg, mnB, alB);
  __syncthreads(); RESC(alB);
  finishSM(pB0, pB1, alB, l_reg, pa0, pa1, pa2, pa3); SBAR();
  pv_d0(o, vb0 + (int)SHM_V, pa0, pa1, pa2, pa3);
  }
  if (hi == 0) li_l[r32] = l_reg; asm volatile("s_waitcnt lgkmcnt(0)" ::: "memory");
  float rli[16];
#pragma unroll
  for (int r = 0; r < 16; ++r) rli[r] = __builtin_amdgcn_rcpf(li_l[crow(r, hi)]);
  unsigned char* Ow = Ob + (long)(wid * QBLK) * LDO;
#pragma unroll
  for (int r = 0; r < 16; ++r) { int orow = crow(r, hi); const float sc = rli[r] * oscale;
    for (int d0 = 0; d0 < 4; ++d0) Ow[(long)orow * LDO + d0 * 32 + r32] = (unsigned char)(__builtin_amdgcn_cvt_pk_fp8_f32(o[d0][r] * sc, 0.f, 0, false) & 0xff); }
  __syncthreads();
#undef SLOAD
#undef SWRITE
#undef SWAIT
#undef RESC
}
#undef KSWZ
#undef KSWZ8
#undef SBAR
}
constexpr int NWAVES = 8;
constexpr int SEQ = 8192, DM = 2048, HD = 128, NEXP = 64, TOPK = 8, FE = 512;
constexpr int INC = 7168;
constexpr int PLD = INC + PROJ_PAD;
constexpr int C_QA = 0, C_KA = 1024, C_VA = 1280, C_QB = 1536, C_KB = 2560, C_VB = 2816, C_GA = 3072, C_GB = 5120;
constexpr float LN_EPS = 1e-5f, RMS_EPS = 1e-6f;
constexpr float ALPHA = 1.189207115002721f;
constexpr float ROUTED_SCALE = 2.5f;
constexpr int LCAP = 8192;
constexpr int NEXP1 = NEXP + 1;

constexpr size_t MiB = 1u << 20;
constexpr size_t WS_CTL = 0, CTL_ZERO_BYTES = 32 * 1024;
constexpr size_t WS_WGU = 1 * MiB;
constexpr size_t WS_WINT = WS_WGU + 260 * MiB;
constexpr size_t WS_XBF = WS_WINT + 28 * MiB;
constexpr size_t WS_PROJ = WS_XBF + 32 * MiB;
constexpr size_t WS_OA = WS_PROJ + 116 * MiB;
constexpr size_t WS_OB = WS_OA + 16 * MiB;
constexpr size_t WS_MRG = WS_OB + 16 * MiB;
constexpr size_t WS_WAT = WS_MRG + 32 * MiB;
constexpr size_t WS_WBT = WS_WAT + 4 * MiB;
constexpr size_t WS_WOT = WS_WBT + 4 * MiB;
constexpr size_t WS_DEAD_END = WS_WOT + 8 * MiB;
constexpr size_t WS_Y = WS_WGU;
constexpr size_t WS_WD = WS_DEAD_END;
constexpr size_t WS_WR = WS_WD + 130 * MiB;
constexpr size_t WS_H32 = WS_WR + 1 * MiB;
constexpr size_t WS_HBF = WS_H32 + 64 * MiB;
constexpr size_t WS_HID = WS_HBF + 32 * MiB;
constexpr size_t WS_PRE = WS_HID + 88 * MiB;
constexpr size_t WS_LTOK = WS_PRE + 64 * MiB;
constexpr size_t WS_LW = WS_LTOK + 3 * MiB;
constexpr size_t WS_ROUTE = WS_LW + 3 * MiB;
constexpr size_t WS_HF8 = WS_H32;
constexpr size_t WS_KF8 = WS_H32 + 16 * MiB;
constexpr size_t WS_END = WS_ROUTE + 1 * MiB;
static_assert(WS_Y + 352 * MiB <= WS_WD, "Y overlay");
static_assert((size_t)SEQ * PLD * 2 <= 116 * MiB, "proj slot");
static_assert(WS_END <= 1024 * MiB, "d_ws map must fit 1 GiB");
constexpr int CW_TMO = 0;
constexpr int CW_CNT = 64, CNT_STRIDE = 32, CW_DFLAG = CW_CNT + CNT_STRIDE * 64 + 32;
constexpr int CW_BAR = 4096;

constexpr int RING_OFF = 0, RING_BYTES = 131072;
constexpr int LDSCTL_OFF = RING_BYTES;
constexpr int MISC_OFF = LDSCTL_OFF;
constexpr int IDXL_OFF = LDSCTL_OFF + 256;
constexpr int TST_OFF = IDXL_OFF + 1024 + 2048;
constexpr int LDS_BYTES = 163840;
static_assert(TST_OFF + 512 <= LDS_BYTES, "LDS map");

#define GAS __attribute__((address_space(1)))
#define LAS __attribute__((address_space(3)))
typedef unsigned short bf16;
typedef unsigned v4u __attribute__((ext_vector_type(4)));
typedef unsigned v2u __attribute__((ext_vector_type(2)));
typedef float f32x4 __attribute__((ext_vector_type(4)));
typedef short bf16x8 __attribute__((ext_vector_type(8)));
#define RLX_AGENT __ATOMIC_RELAXED, __HIP_MEMORY_SCOPE_AGENT
#define LDS_WAIT() asm volatile("s_waitcnt lgkmcnt(0)" ::: "memory")
#define VM_WAIT() asm volatile("s_waitcnt vmcnt(0)" ::: "memory")
__device__ __forceinline__ unsigned f2bf(float f) { unsigned u = __builtin_bit_cast(unsigned, f); return (u + 0x7fffu + ((u >> 16) & 1u)) >> 16; }
__device__ __forceinline__ unsigned pk2(float lo, float hi) { return f2bf(lo) | (f2bf(hi) << 16); }
__device__ __forceinline__ float bf2f(unsigned short h) { return __uint_as_float((unsigned)h << 16); }

#ifndef XB_L1_ACQ
#define XB_L1_ACQ 1
#endif
#ifndef XB_EARLY_WB
#define XB_EARLY_WB 0
#endif
#define XB_TMO      128
#define XB_XCNT(j)  (256  + 64 * (j))
#define XB_XSUB(j)  (1280 + 64 * (j))
#define XB_XGEN(j)  (2304 + 64 * (j))
#define XB_TOP      3328
#define XB_TOPGEN   3392
#define XCD_BAR_WORDS 3456
#define XB_SPIN_CAP (1u << 20)
static_assert((size_t)(CW_BAR + XCD_BAR_WORDS) * 4 <= CTL_ZERO_BYTES && (CW_DFLAG + 1) * 4 <= CTL_ZERO_BYTES && CW_DFLAG < CW_BAR, "every control word lies inside the per-call memset");
__device__ __forceinline__ unsigned xb_ld(unsigned* p)              { return __hip_atomic_load(p, __ATOMIC_RELAXED, __HIP_MEMORY_SCOPE_AGENT); }
__device__ __forceinline__ unsigned xb_add(unsigned* p, unsigned v) { return __hip_atomic_fetch_add(p, v, __ATOMIC_RELAXED, __HIP_MEMORY_SCOPE_AGENT); }
__device__ __forceinline__ unsigned xb_xcc_id() { return (unsigned)__builtin_amdgcn_s_getreg((3 << 11) | 20) & 0xFu; }
#define XB_SPIN(cond, bar) do { unsigned _sp = 0; while (cond) { __builtin_amdgcn_s_sleep(1); \
    if ((++_sp & 255u) == 0u) { if (xb_ld(&(bar)[XB_TMO])) break; if (_sp > XB_SPIN_CAP) { atomicAdd(&(bar)[XB_TMO], 1u); break; } } } } while (0)
struct XcdBarrier { unsigned* bar; unsigned x; volatile LAS unsigned* st; unsigned total; };
__device__ __forceinline__ XcdBarrier xcd_barrier_post(unsigned* bar, volatile LAS unsigned* st, unsigned total) {
    XcdBarrier b; b.bar = bar; b.x = xb_xcc_id(); b.st = st; b.total = total;
    if (threadIdx.x == 0) (void)xb_add(&bar[XB_XCNT(b.x)], 1u);
    return b;
}
__device__ __forceinline__ void xcd_barrier_complete(unsigned* bar, unsigned x, unsigned G, unsigned& nloc, unsigned& nx) {
    unsigned sum, cnt, mine, sp = 0u;
    for (;;) {
        sum = 0u; cnt = 0u; mine = 0u;
#pragma unroll
        for (unsigned j = 0; j < 16; ++j) { const unsigned c = xb_ld(&bar[XB_XCNT(j)]); sum += c; cnt += (c > 0u) ? 1u : 0u; mine = (j == x) ? c : mine; }
        if (sum == G) break;
        __builtin_amdgcn_s_sleep(1);
        if ((++sp & 255u) == 0u) { if (xb_ld(&bar[XB_TMO])) break; if (sp > XB_SPIN_CAP) { atomicAdd(&bar[XB_TMO], 1u); break; } }
    }
    nloc = mine > 0u ? mine : 1u; nx = cnt > 0u ? cnt : 1u;
}
__device__ __forceinline__ void xcd_barrier(const XcdBarrier& b) {
    asm volatile("s_waitcnt vmcnt(0)" ::: "memory");
    __syncthreads();
    if (threadIdx.x == 0) {
        unsigned* bar = b.bar;
        __builtin_amdgcn_s_waitcnt(0);
        unsigned nloc = b.st[0], nx = b.st[1];
        if (nloc == 0u) { xcd_barrier_complete(bar, b.x, b.total, nloc, nx); b.st[0] = nloc; b.st[1] = nx; }
        const unsigned old = xb_add(&bar[XB_XSUB(b.x)], 1u);
        const unsigned gen = old / nloc;
        if (old + 1u == (gen + 1u) * nloc) {
            __builtin_amdgcn_fence(__ATOMIC_RELEASE, "agent");
            asm volatile("s_waitcnt vmcnt(0)" ::: "memory");
            asm volatile("buffer_inv sc1" ::: "memory");
            const unsigned og = xb_add(&bar[XB_TOP], 1u);
            const unsigned tg = og / nx;
            if (og + 1u == (tg + 1u) * nx) {
#pragma unroll
                for (unsigned j = 0; j < 16; ++j) (void)xb_add(&bar[XB_XGEN(j)], 1u);
            } else XB_SPIN(xb_ld(&bar[XB_XGEN(b.x)]) == gen, bar);
            asm volatile("s_waitcnt vmcnt(0)" ::: "memory");
        } else {
            asm volatile("buffer_inv sc1" ::: "memory");
            XB_SPIN(xb_ld(&bar[XB_XGEN(b.x)]) == gen, bar);
            asm volatile("s_waitcnt vmcnt(0)" ::: "memory");
        }
    }
    __syncthreads();
}

template <class Pre>
__device__ __forceinline__ void xcd_barrier_pf(const XcdBarrier& b, Pre&& pre) {
    asm volatile("s_waitcnt vmcnt(0)" ::: "memory");
    __syncthreads();
    if (threadIdx.x >= 64) pre();
    unsigned gen = 0u; bool wait_own = false;
    if (threadIdx.x == 0) {
        unsigned* bar = b.bar;
        __builtin_amdgcn_s_waitcnt(0);
        unsigned nloc = b.st[0], nx = b.st[1];
        if (nloc == 0u) { xcd_barrier_complete(bar, b.x, b.total, nloc, nx); b.st[0] = nloc; b.st[1] = nx; }
        const unsigned old = xb_add(&bar[XB_XSUB(b.x)], 1u);
        gen = old / nloc; wait_own = true;
        if (old + 1u == (gen + 1u) * nloc) {
            __builtin_amdgcn_fence(__ATOMIC_RELEASE, "agent");
            asm volatile("s_waitcnt vmcnt(0)" ::: "memory");
            asm volatile("buffer_inv sc1" ::: "memory");
            const unsigned og = xb_add(&bar[XB_TOP], 1u);
            const unsigned tg = og / nx;
            if (og + 1u == (tg + 1u) * nx) { wait_own = false;
#pragma unroll
                for (unsigned j = 0; j < 16; ++j) (void)xb_add(&bar[XB_XGEN(j)], 1u); }
        } else {
            asm volatile("buffer_inv sc1" ::: "memory");
        }
    }
    if (threadIdx.x < 64) pre();
    if (threadIdx.x == 0) {
        if (wait_own) XB_SPIN(xb_ld(&b.bar[XB_XGEN(b.x)]) == gen, b.bar);
        asm volatile("s_waitcnt vmcnt(0)" ::: "memory");
    }
    __syncthreads();
}

__device__ __forceinline__ float wave_sum(float v) {
#pragma unroll
    for (int o = 1; o < 64; o <<= 1) v += __shfl_xor(v, o);
    return v;
}
__device__ __forceinline__ float sigmoidf_(float x) { return __builtin_amdgcn_rcpf(1.0f + __builtin_amdgcn_exp2f(-x * 1.4426950408889634f)); }

struct Args { const float* in[22]; float* out; unsigned char* ws; int ph_lo, ph_hi; };
struct Frame {
    LAS unsigned char* lds;
    volatile LAS unsigned* MISC;
    unsigned* ctl;
    int tid, lane, wave;
    int vcu, G;
    const float* in[22]; float* out; unsigned char* ws;
};

#ifndef G1_FP8
#define G1_FP8 1
#endif
#ifndef ATT_F8
#define ATT_F8 1
#endif
#ifndef P1_FP8
#define P1_FP8 1
#endif
#ifndef E2_ATTN_GU
#define E2_ATTN_GU 1
#endif
struct TItem { const float* W; unsigned char* WT; int K, N, k0, n0, drow0, f8; };
constexpr float W8SCALE = 32.0f, H8SCALE = 8.0f, OA_SCALE = 16.0f, OB_SCALE = 64.0f, MG_SCALE = 32.0f;
__device__ __forceinline__ void titem_issue(const TItem& it, LAS unsigned char* buf, int lane) {
#pragma unroll
    for (int g = 0; g < 8; ++g) { const int k = 8 * g + (lane >> 3), pos = lane & 7;
        __builtin_amdgcn_global_load_lds((const unsigned*)(it.W + (size_t)(it.k0 + k) * it.N + it.n0 + 4 * (pos ^ g)), (LAS unsigned*)(buf + g * 1024), 16, 0, 0); }
}
__device__ __forceinline__ void titem_finish(const TItem& it, const LAS float* buf, int lane) {
    const int c = lane & 7;
#pragma unroll
    for (int j = 0; j < 4; ++j) { const int nn = (lane >> 3) + 8 * j; const LAS float* s = buf + (8 * c) * 32 + (((nn >> 2) ^ c) << 2) + (nn & 3);
        const size_t eo = (size_t)(it.drow0 + nn) * it.K + it.k0 + 8 * c;
        if (it.f8) { v2u o; int t = __builtin_amdgcn_cvt_pk_fp8_f32(s[0 * 32] * W8SCALE, s[1 * 32] * W8SCALE, 0, false); t = __builtin_amdgcn_cvt_pk_fp8_f32(s[2 * 32] * W8SCALE, s[3 * 32] * W8SCALE, t, true); o.x = (unsigned)t;
            t = __builtin_amdgcn_cvt_pk_fp8_f32(s[4 * 32] * W8SCALE, s[5 * 32] * W8SCALE, 0, false); t = __builtin_amdgcn_cvt_pk_fp8_f32(s[6 * 32] * W8SCALE, s[7 * 32] * W8SCALE, t, true); o.y = (unsigned)t;
            __builtin_nontemporal_store(o, (GAS v2u*)(it.WT + eo)); }
        else { v4u o; o.x = pg8::cvt_pk_bf16(s[0 * 32], s[1 * 32]); o.y = pg8::cvt_pk_bf16(s[2 * 32], s[3 * 32]); o.z = pg8::cvt_pk_bf16(s[4 * 32], s[5 * 32]); o.w = pg8::cvt_pk_bf16(s[6 * 32], s[7 * 32]);
            __builtin_nontemporal_store(o, (GAS v4u*)(it.WT + 2 * eo)); } }
}
constexpr int I_IN = (DM / 64) * (INC / 32);
constexpr int I_BR = (1024 / 64) * (DM / 32);
constexpr int I_WO = (DM / 64) * (DM / 32);
constexpr int I_GU = (DM / 64) * (FE / 32);
constexpr int I_DN = (FE / 64) * (DM / 32);
constexpr int E1_SKIP = E2_ATTN_GU ? 31 : 0;
constexpr int NITEMS_E1 = 2 * I_BR + I_WO + (NEXP1 - E1_SKIP) * 2 * I_GU;
constexpr int NITEMS_E2 = NEXP1 * I_DN;
__device__ __forceinline__ void titem_plain(TItem& it, const float* W, int K, int N, void* WT, int item, int f8 = 0) {
    const int nblk = N / 32, kb = item / nblk, nb = item % nblk; it.W = W; it.WT = (unsigned char*)WT; it.K = K; it.N = N; it.k0 = 64 * kb; it.n0 = 32 * nb; it.drow0 = 32 * nb; it.f8 = f8;
}
template <int LIST>
__device__ __forceinline__ void titem_get(Frame& F, int r, TItem& it) {
    if constexpr (LIST == 0) { titem_plain(it, F.in[1], DM, INC, F.ws + WS_WINT, r, P1_FP8); }
    else if constexpr (LIST == 2) { const int e = r / I_DN; r -= e * I_DN;
        titem_plain(it, e < NEXP ? F.in[16] + (size_t)e * FE * DM : F.in[19], FE, DM, F.ws + WS_WD + (size_t)e * DM * FE, r, 1); }
    else {
        if (r < I_BR) { titem_plain(it, F.in[7], 1024, DM, F.ws + WS_WAT, r, 1); return; } r -= I_BR;
        if (r < I_BR) { titem_plain(it, F.in[8], 1024, DM, F.ws + WS_WBT, r, 1); return; } r -= I_BR;
        if (r < I_WO) { titem_plain(it, F.in[9], DM, DM, F.ws + WS_WOT, r, 1); return; } r -= I_WO;
        int e = r / (2 * I_GU); r -= e * (2 * I_GU); e += E1_SKIP;
        const int half = r >= I_GU ? 1 : 0; r -= half * I_GU;
        const float* w = e < NEXP ? (half ? F.in[15] : F.in[14]) + (size_t)e * DM * FE : (half ? F.in[18] : F.in[17]);
        const int nblk = FE / 32, kb = r / nblk, nb = r % nblk, n0 = 32 * nb;
        it.W = w; it.WT = F.ws + WS_WGU + (size_t)e * 1024 * DM * (G1_FP8 ? 1 : 2); it.f8 = G1_FP8; it.K = DM; it.N = FE; it.k0 = 64 * kb; it.n0 = n0; it.drow0 = 256 * (n0 >> 7) + 128 * half + (n0 & 127);
    }
}
#ifndef CONV_D
#define CONV_D 4
#endif
__device__ __forceinline__ void titem_load(const TItem& it, f32x4 (&r)[8], int lane) {
#pragma unroll
    for (int g = 0; g < 8; ++g) r[g] = __builtin_nontemporal_load((const GAS f32x4*)(it.W + (size_t)(it.k0 + 8 * g + (lane >> 3)) * it.N + it.n0 + 4 * (lane & 7)));
}
__device__ __forceinline__ void titem_store(const TItem& it, const f32x4 (&r)[8], LAS float* buf, int lane) {
#pragma unroll
    for (int g = 0; g < 8; ++g) *(LAS f32x4*)(buf + (8 * g + (lane >> 3)) * 32 + (((lane & 7) ^ g) << 2)) = r[g];
    titem_finish(it, buf, lane);
}
template <int LISTE>
__device__ __forceinline__ void convert_items(Frame& F, int first, int step, int last) {
    LAS float* buf = (LAS float*)(F.lds + RING_OFF + F.wave * 8192);
    if (first >= last) return;
    const int n_my = (last - first + step - 1) / step;
    f32x4 r[CONV_D][8]; TItem it;
#pragma unroll
    for (int d = 0; d < CONV_D; ++d) if (d < n_my) { titem_get<LISTE>(F, first + d * step, it); titem_load(it, r[d], F.lane); }
    for (int base = 0; base < n_my; base += CONV_D) {
#pragma unroll
        for (int d = 0; d < CONV_D; ++d) { const int idx = base + d;
            if (idx < n_my) { titem_get<LISTE>(F, first + idx * step, it); titem_store(it, r[d], buf, F.lane);
                if (idx + CONV_D < n_my) { titem_get<LISTE>(F, first + (idx + CONV_D) * step, it); titem_load(it, r[d], F.lane); } } }
    }
}
#ifndef CONV_Q
#define CONV_Q 200
#endif
#ifndef P1_NCG
#define P1_NCG 23
#endif
constexpr int NCONV = 32, NCOMP = 256 - NCONV, NCONV1 = 8 * (32 - P1_NCG), NCOMP1 = 8 * P1_NCG, E_X = (NCONV1 * NWAVES * CONV_Q < NITEMS_E1) ? NCONV1 * NWAVES * CONV_Q : NITEMS_E1;
#ifndef P1_QA
#define P1_QA 0
#endif
#ifndef P1_QB
#define P1_QB 0
#endif
constexpr int P1_TILES = (SEQ / 256) * (INC / 256), N5C = (P1_TILES % NCOMP1 == 0) ? NCOMP1 : P1_TILES % NCOMP1, N4C = NCOMP1 - N5C;
constexpr int E_Y = (E_X + N4C * NWAVES * P1_QA < NITEMS_E1) ? E_X + N4C * NWAVES * P1_QA : NITEMS_E1;
constexpr int E_SPLIT = (E_Y + N5C * NWAVES * P1_QB < NITEMS_E1) ? E_Y + N5C * NWAVES * P1_QB : NITEMS_E1;
#ifndef CONV_Q2
#define CONV_Q2 100
#endif
#ifndef P1_QE2
#define P1_QE2 0
#endif
constexpr int E2_A = (NCONV1 * NWAVES * P1_QE2 < NITEMS_E2) ? NCONV1 * NWAVES * P1_QE2 : NITEMS_E2;
constexpr int E2_SPLIT = (E2_A + 32 * NWAVES * CONV_Q2 < NITEMS_E2) ? E2_A + 32 * NWAVES * CONV_Q2 : NITEMS_E2;
#ifndef CONV_G1
#define CONV_G1 1
#endif
__device__ __forceinline__ void p0_prologue(Frame& F, bool compute_only) {
    const int gw = (compute_only ? (F.vcu >> 5) * P1_NCG + (F.vcu & 31) : F.vcu) * NWAVES + F.wave, NGW = (compute_only ? NCOMP1 : F.G) * NWAVES;
    convert_items<0>(F, gw, NGW, I_IN);
    { const int gt = gw * 64 + F.lane, NT = NGW * 64; const GAS f32x4* xs = (const GAS f32x4*)F.in[0]; GAS v4u* xo = (GAS v4u*)(F.ws + WS_XBF);
      for (int i = gt; i < SEQ * DM / 8; i += 4 * NT) {
          f32x4 a[4], b[4];
#pragma unroll
          for (int u = 0; u < 4; ++u) if (i + u * NT < SEQ * DM / 8) { a[u] = __builtin_nontemporal_load(xs + 2 * (i + u * NT)); b[u] = __builtin_nontemporal_load(xs + 2 * (i + u * NT) + 1); }
#pragma unroll
          for (int u = 0; u < 4; ++u) if (i + u * NT < SEQ * DM / 8) {
              if (P1_FP8) { v2u o; int t = __builtin_amdgcn_cvt_pk_fp8_f32(a[u].x, a[u].y, 0, false); t = __builtin_amdgcn_cvt_pk_fp8_f32(a[u].z, a[u].w, t, true); o.x = (unsigned)t;
                  t = __builtin_amdgcn_cvt_pk_fp8_f32(b[u].x, b[u].y, 0, false); t = __builtin_amdgcn_cvt_pk_fp8_f32(b[u].z, b[u].w, t, true); o.y = (unsigned)t; ((GAS v2u*)xo)[i + u * NT] = o; }
              else { v4u o; o.x = pg8::cvt_pk_bf16(a[u].x, a[u].y); o.y = pg8::cvt_pk_bf16(a[u].z, a[u].w); o.z = pg8::cvt_pk_bf16(b[u].x, b[u].y); o.w = pg8::cvt_pk_bf16(b[u].z, b[u].w); xo[i + u * NT] = o; } } } }
    { const int gt = gw * 64 + F.lane, NT = NGW * 64; bf16* wr = (bf16*)(F.ws + WS_WR);
      for (int i = gt; i < NEXP * DM; i += NT) {
          const int j_ = i & 7, ln = (i >> 3) & 63, nt_ = (i >> 9) & 3, ks = i >> 11, q_ = ln >> 4, t_ = ln & 15;
          const int k = ks * 32 + (j_ < 4 ? 4 * q_ + j_ : 16 + 4 * q_ + j_ - 4), e = 16 * nt_ + t_;
          const float w = F.in[12][(size_t)k * NEXP + e]; const unsigned h = f2bf(w); const float lo = w - __uint_as_float(h << 16);
          wr[i] = (bf16)h; wr[NEXP * DM + i] = (bf16)f2bf(lo); } }
    { const int gt = gw * 64 + F.lane, NT = NGW * 64; int* lt = (int*)(F.ws + WS_LTOK); float* lw = (float*)(F.ws + WS_LW);
      for (int i = gt; i < NEXP1 * LCAP; i += NT) { const bool sh = i >= NEXP * LCAP; lt[i] = sh ? i - NEXP * LCAP : 0; lw[i] = sh ? 1.0f : 0.0f; } }
}

#ifndef WT_STORES
#define WT_STORES 0
#endif
__device__ __forceinline__ void st_wt8(void* p, v2u w) {
    if (WT_STORES) __hip_atomic_store((unsigned long long*)p, ((unsigned long long)w.y << 32) | w.x, __ATOMIC_RELAXED, __HIP_MEMORY_SCOPE_AGENT);
    else *(v2u*)p = w;
}
__device__ __forceinline__ v4u pair16(v2u a, v2u b) {
    auto sx = __builtin_amdgcn_permlane16_swap(a.x, b.x, false, false);
    auto sy = __builtin_amdgcn_permlane16_swap(a.y, b.y, false, false);
    return (v4u){sx[0], sy[0], sx[1], sy[1]};
}
struct DenseOrder {
    const char* A; const char* B; int nM, nN, nwg, G, c; size_t tstep;
    __device__ __forceinline__ void init(const void* A_, const void* B_, int M, int N, int K, int G_, int c_) { A = (const char*)A_; B = (const char*)B_; nM = M / 256; nN = N / 256; nwg = nM * nN; G = G_; c = c_; tstep = (size_t)256 * K * (P1_FP8 ? 1 : 2); }
    __device__ __forceinline__ bool next(int i, pg8::Unit& u) const {
#ifdef P1_DOUBLE
        const long L = (long)(i >> 1) * G + c; if (L >= nwg) return false;
#else
        const long L = (long)i * G + c; if (L >= nwg) return false;
#endif
        int wgid = (int)L; { const int q = nwg / 8, r = nwg % 8, xcd = wgid % 8, off = wgid / 8; wgid = (xcd < r ? xcd * (q + 1) : r * (q + 1) + (xcd - r) * q) + off; }
        const int nig = 8 * nN, gid = wgid / nig, fm = gid * 8, gsz = (nM - fm) < 8 ? (nM - fm) : 8;
        const int pm = fm + ((wgid % nig) % gsz), pn = (wgid % nig) / gsz;
        u.A = A + (size_t)pm * tstep; u.B = B + (size_t)pn * tstep; u.idx = nullptr; u.wts = nullptr; u.r0 = pm * 256; u.c0 = pn * 256; u.aux = 0; u.kind = 0; return true;
    }
};
struct BranchOrder {
    const char *OA, *OB, *WA, *WB; int vcu;
    __device__ __forceinline__ bool next(int i, pg8::Unit& u) const {
#ifdef P3_DOUBLE
        if (i >= 4) return false; i &= 1;
#else
        if (i >= 2) return false;
#endif
        const int pm = vcu >> 3, pn = vcu & 7; const size_t ts = (size_t)256 * 1024;
        u.A = (i ? OB : OA) + (size_t)pm * ts; u.B = (i ? WB : WA) + (size_t)pn * ts; u.idx = nullptr; u.wts = nullptr; u.r0 = pm * 256; u.c0 = pn * 256; u.aux = 0; u.kind = i; return true;
    }
};
struct OneTileOrder {
    const char *A, *B; int vcu; size_t ts;
    __device__ __forceinline__ bool next(int i, pg8::Unit& u) const {
#ifdef P4_DOUBLE
        if (i >= 2) return false;
#else
        if (i >= 1) return false;
#endif
        const int pm = vcu >> 3, pn = vcu & 7;
        u.A = A + (size_t)pm * ts; u.B = B + (size_t)pn * ts; u.idx = nullptr; u.wts = nullptr; u.r0 = pm * 256; u.c0 = pn * 256; u.aux = 0; u.kind = 0; return true;
    }
};
template <int NPN>
struct MoeOrder {
    const LAS int* tst; const char* A; const char* B; const int* ltok; const float* lwt; int vcu, G; size_t arow, bexp, bpn;
    bool gather;
    int l0, lend, nheavy;
    const unsigned* flag; int wait_gmt, need;
    mutable int ec = 0;
    __device__ __forceinline__ bool next(int i, pg8::Unit& u) const {
        const int T = tst[NEXP1]; const int end = lend < 0 ? T * NPN : lend;
        int L;
#ifdef G2_DOUBLE
        if (NPN == 8) i >>= 1;
#endif
        if (nheavy > 0) { const int NL = G - nheavy; if (vcu >= NL) L = 2 * NL + i * G + vcu; else L = i < 2 ? i * NL + vcu : 2 * NL + (i - 2) * G + vcu; }
        else L = l0 + i * G + vcu;
        if (L >= end) return false;
        const int gmt = L / NPN, pn = L % NPN; int e = ec; if (tst[e] > gmt) e = 0;
        while (e < NEXP && tst[e + 1] <= gmt) ++e;
        ec = e;
        const int mt = gmt - tst[e];
        if (need > 0 && gmt >= wait_gmt) {
            unsigned spins = 0; while (__hip_atomic_load(flag, __ATOMIC_RELAXED, __HIP_MEMORY_SCOPE_AGENT) < (unsigned)need && ++spins < (1u << 22)) __builtin_amdgcn_s_sleep(2);
            __builtin_amdgcn_fence(__ATOMIC_ACQUIRE, "agent"); asm volatile("s_waitcnt vmcnt(0)" ::: "memory"); }
        u.A = gather ? A : A + (size_t)gmt * 256 * arow; u.B = B + (size_t)e * bexp + (size_t)pn * bpn; u.idx = ltok + e * LCAP + mt * 256; u.wts = lwt + e * LCAP + mt * 256;
        u.r0 = gmt * 256; u.c0 = pn * 256; u.aux = e * LCAP + mt * 256; u.kind = 0; return true;
    }
};

constexpr float GSCALE = 256.0f;
typedef float f32x2v __attribute__((ext_vector_type(2)));
struct EpiProj {
    static constexpr bool PERM = true; static constexpr int NST = 8;
    static constexpr int MSCALE = P1_FP8 ? 0x7a7a7a7a : 0x7f7f7f7f;
    bf16* O; const float* bgate;
    __device__ __forceinline__ bool operator()(const pg8::f32x4 (&acc)[2][2][4][2], const pg8::Unit& u, int wr, int wc, int fr, int fq, const LAS float* wl) const {
        const int row0 = u.r0 + wr * 64 + fr, col0 = u.c0 + wc * 32 + 8 * fq;
        constexpr float PS = 1.0f;
        static_assert(W8SCALE == 32.0f, "MSCALE");
        if (u.c0 >= C_GA) {
            f32x4 bb[2][2];
#pragma unroll
            for (int bj = 0; bj < 2; ++bj) { bb[bj][0] = *(const f32x4*)(bgate + col0 + bj * 128 - C_GA) * -1.4426950408889634f; bb[bj][1] = *(const f32x4*)(bgate + col0 + bj * 128 - C_GA + 4) * -1.4426950408889634f; }
            constexpr float KS = -1.4426950408889634f * PS, IG = 1.0f / GSCALE;
#define GSIG2(T_, A_, B_, J_, HI_) do { const f32x2v x_ = (f32x2v){(A_)[J_], (A_)[J_ + 1]} * KS + (f32x2v){(B_)[J_], (B_)[J_ + 1]}; \
                const f32x2v d_ = (f32x2v){__builtin_amdgcn_exp2f(x_[0]), __builtin_amdgcn_exp2f(x_[1])} * IG + IG; \
                T_ = __builtin_amdgcn_cvt_pk_fp8_f32(__builtin_amdgcn_rcpf(d_[0]), __builtin_amdgcn_rcpf(d_[1]), (HI_) ? T_ : 0, (HI_)); } while (0)
            const int odd = fq & 1; unsigned char* G = (unsigned char*)O + (size_t)C_GA * 2 + (col0 - 8 * odd - C_GA);
#pragma unroll
            for (int ai = 0; ai < 2; ++ai)
#pragma unroll
                for (int mp = 0; mp < 2; ++mp)
#pragma unroll
                    for (int bj = 0; bj < 2; ++bj) { v2u w[2];
#pragma unroll
                        for (int mm = 0; mm < 2; ++mm) { const int m = 2 * mp + mm; const f32x4 a0 = acc[ai][bj][m][0], a1 = acc[ai][bj][m][1]; const f32x4 c0 = bb[bj][0], c1 = bb[bj][1];
                            int t = 0; GSIG2(t, a0, c0, 0, false); GSIG2(t, a0, c0, 2, true); w[mm].x = (unsigned)t;
                            t = 0; GSIG2(t, a1, c1, 0, false); GSIG2(t, a1, c1, 2, true); w[mm].y = (unsigned)t; }
                        *(v4u*)(G + (size_t)(row0 + ai * 128 + (2 * mp + odd) * 16) * (PLD * 2) + bj * 128) = pair16(w[0], w[1]); }
#undef GSIG2
        } else {
#pragma unroll
            for (int ai = 0; ai < 2; ++ai)
#pragma unroll
                for (int m = 0; m < 4; ++m)
#pragma unroll
                    for (int bj = 0; bj < 2; ++bj) { const f32x4 v0 = acc[ai][bj][m][0] * PS, v1 = acc[ai][bj][m][1] * PS;
                        v4u w; w.x = pg8::cvt_pk_bf16(v0[0], v0[1]); w.y = pg8::cvt_pk_bf16(v0[2], v0[3]); w.z = pg8::cvt_pk_bf16(v1[0], v1[1]); w.w = pg8::cvt_pk_bf16(v1[2], v1[3]);
                        *(v4u*)(O + (size_t)(row0 + ai * 128 + m * 16) * PLD + col0 + bj * 128) = w; }
        }
        return false;
    }
};
struct EpiBranch {
    static constexpr bool PERM = true; static constexpr int NST = 0; static constexpr int MSCALE = 0x7f7f7f7f;
    const bf16* proj; unsigned char* O;
    __device__ __forceinline__ bool operator()(pg8::f32x4 (&acc)[2][2][4][2], const pg8::Unit& u, int wr, int wc, int fr, int fq, const LAS float* wl) const {
        const int row0 = u.r0 + wr * 64 + fr, col0 = u.c0 + wc * 32 + 8 * fq;
        const bool seg0 = u.kind == 0;
        v2u gbx[2][4][2], gax[2][4][2];
#pragma unroll
        for (int ai = 0; ai < 2; ++ai)
#pragma unroll
            for (int m = 0; m < 4; ++m)
#pragma unroll
                for (int bj = 0; bj < 2; ++bj) { const size_t r = (size_t)(row0 + ai * 128 + m * 16); const int c = col0 + bj * 128;
                    const unsigned char* gp = (const unsigned char*)proj + r * (PLD * 2) + (size_t)C_GA * 2 + c;
                    gbx[ai][m][bj] = *(const v2u*)(gp + (C_GB - C_GA)); gax[ai][m][bj] = seg0 ? *(const v2u*)gp : (v2u){0u, 0u}; }
        __builtin_amdgcn_sched_barrier(0);
#pragma unroll
        for (int ai = 0; ai < 2; ++ai) {
            v2u (&gb)[4][2] = gbx[ai]; v2u (&ga)[4][2] = gax[ai];
#pragma unroll
            for (int mp = 0; mp < 2; ++mp) {
                v2u wq[2][2];
#pragma unroll
                for (int mm = 0; mm < 2; ++mm)
#pragma unroll
                    for (int bj = 0; bj < 2; ++bj) { const int m = 2 * mp + mm;
                        const v2u gbv = gb[m][bj], gav = ga[m][bj];
                        const f32x2v g01 = __builtin_amdgcn_cvt_pk_f32_fp8((int)gbv.x, false), g23 = __builtin_amdgcn_cvt_pk_f32_fp8((int)gbv.x, true), g45 = __builtin_amdgcn_cvt_pk_f32_fp8((int)gbv.y, false), g67 = __builtin_amdgcn_cvt_pk_f32_fp8((int)gbv.y, true);
                        const f32x2v gp[4] = {g01, g23, g45, g67};
                        if (seg0) {
                            const f32x2v a01 = __builtin_amdgcn_cvt_pk_f32_fp8((int)gav.x, false), a23 = __builtin_amdgcn_cvt_pk_f32_fp8((int)gav.x, true), a45 = __builtin_amdgcn_cvt_pk_f32_fp8((int)gav.y, false), a67 = __builtin_amdgcn_cvt_pk_f32_fp8((int)gav.y, true);
                            const f32x2v ap[4] = {a01, a23, a45, a67};
#pragma unroll
                            for (int pq = 0; pq < 4; ++pq) { const f32x2v rg = {__builtin_amdgcn_rcpf(fmaxf(gp[pq][0], 1e-30f)), __builtin_amdgcn_rcpf(fmaxf(gp[pq][1], 1e-30f))};
                                const f32x2v f = (ap[pq] * (OB_SCALE / OA_SCALE)) * rg;
                                const f32x2v ac = (f32x2v){acc[ai][bj][m][pq >> 1][2 * (pq & 1)], acc[ai][bj][m][pq >> 1][2 * (pq & 1) + 1]} * f;
                                acc[ai][bj][m][pq >> 1][2 * (pq & 1)] = ac[0]; acc[ai][bj][m][pq >> 1][2 * (pq & 1) + 1] = ac[1]; }
                        } else {
                            constexpr float S1 = MG_SCALE / (OB_SCALE * W8SCALE * GSCALE);
                            int t2[2];
#pragma unroll
                            for (int hq = 0; hq < 2; ++hq) { const pg8::f32x4 vv = acc[ai][bj][m][hq];
                                const f32x2v p0 = ((f32x2v){vv[0], vv[1]} * gp[2 * hq]) * S1, p1 = ((f32x2v){vv[2], vv[3]} * gp[2 * hq + 1]) * S1;
                                int t = __builtin_amdgcn_cvt_pk_fp8_f32(p0[0], p0[1], 0, false); t2[hq] = __builtin_amdgcn_cvt_pk_fp8_f32(p1[0], p1[1], t, true); }
                            v2u w; w.x = (unsigned)t2[0]; w.y = (unsigned)t2[1];
                            wq[mm][bj] = w;
                        }
                    }
                if (!seg0) { const int odd = fq & 1;
#pragma unroll
                    for (int bj = 0; bj < 2; ++bj) *(v4u*)(O + (size_t)(row0 + ai * 128 + (2 * mp + odd) * 16) * DM + col0 - 8 * odd + bj * 128) = pair16(wq[0][bj], wq[1][bj]); }
            }
            __builtin_amdgcn_sched_barrier(0);
        }
        return seg0;
    }
};
struct EpiMix {
    static constexpr bool PERM = true; static constexpr int NST = 16; static constexpr int MSCALE = 0x75757575;
    bf16* O;
    __device__ __forceinline__ bool operator()(const pg8::f32x4 (&acc)[2][2][4][2], const pg8::Unit& u, int wr, int wc, int fr, int fq, const LAS float* wl) const {
        const int row0 = u.r0 + wr * 64 + fr, col0 = u.c0 + wc * 32 + 8 * fq;
#pragma unroll
        for (int ai = 0; ai < 2; ++ai)
#pragma unroll
            for (int m = 0; m < 4; ++m)
#pragma unroll
                for (int bj = 0; bj < 2; ++bj) { static_assert(MG_SCALE * W8SCALE == 1024.0f, "MSCALE"); const pg8::f32x4 v0 = acc[ai][bj][m][0], v1 = acc[ai][bj][m][1];
                    v4u w; w.x = pg8::cvt_pk_bf16(v0[0], v0[1]); w.y = pg8::cvt_pk_bf16(v0[2], v0[3]); w.z = pg8::cvt_pk_bf16(v1[0], v1[1]); w.w = pg8::cvt_pk_bf16(v1[2], v1[3]);
                    *(v4u*)(O + (size_t)(row0 + ai * 128 + m * 16) * DM + col0 + bj * 128) = w; }
        return false;
    }
};
struct EpiMoe1 {
    static constexpr bool PERM = true; static constexpr int NST = 4; static constexpr int MSCALE = 0x7f7f7f7f;
    unsigned char* H;
    __device__ __forceinline__ bool operator()(const pg8::f32x4 (&acc)[2][2][4][2], const pg8::Unit& u, int wr, int wc, int fr, int fq, const LAS float* wl) const {
        const int odd = fq & 1; const int row0 = u.r0 + wr * 64 + fr + odd * 16, col0 = (u.c0 >> 1) + wc * 32 + 8 * (fq - odd);
#pragma unroll
        for (int ai = 0; ai < 2; ++ai)
#pragma unroll
            for (int mp = 0; mp < 2; ++mp) { v2u w[2];
#pragma unroll
                for (int mm = 0; mm < 2; ++mm) { const int m = 2 * mp + mm; float h[8]; constexpr float CS = G1_FP8 ? 1.0f / W8SCALE : 1.0f;
                    const float wt = wl[wr * 64 + fr + ai * 128 + m * 16] * (H8SCALE * CS * CS);
#pragma unroll
                    for (int n = 0; n < 2; ++n)
#pragma unroll
                        for (int jp = 0; jp < 2; ++jp) {
                            const f32x2v ga = {acc[ai][0][m][n][2 * jp], acc[ai][0][m][n][2 * jp + 1]}, ua = {acc[ai][1][m][n][2 * jp], acc[ai][1][m][n][2 * jp + 1]};
                            const f32x2v ar = ga * (-1.4426950408889634f * CS);
                            const f32x2v d = (f32x2v){__builtin_amdgcn_exp2f(ar[0]), __builtin_amdgcn_exp2f(ar[1])} + 1.0f;
                            const f32x2v sg = {__builtin_amdgcn_rcpf(d[0]), __builtin_amdgcn_rcpf(d[1])};
                            const f32x2v pr = (ga * ua) * (sg * wt);
                            h[4 * n + 2 * jp] = __builtin_amdgcn_fmed3f(pr[0], -448.0f, 448.0f); h[4 * n + 2 * jp + 1] = __builtin_amdgcn_fmed3f(pr[1], -448.0f, 448.0f); }
                    int t = __builtin_amdgcn_cvt_pk_fp8_f32(h[0], h[1], 0, false); t = __builtin_amdgcn_cvt_pk_fp8_f32(h[2], h[3], t, true); w[mm].x = (unsigned)t;
                    t = __builtin_amdgcn_cvt_pk_fp8_f32(h[4], h[5], 0, false); t = __builtin_amdgcn_cvt_pk_fp8_f32(h[6], h[7], t, true); w[mm].y = (unsigned)t; }
                *(v4u*)(H + (size_t)(row0 + ai * 128 + mp * 32) * FE + col0) = pair16(w[0], w[1]); }
        return false;
    }
};
constexpr float YSCALE = 16.0f;
struct EpiMoe2 {
    static constexpr bool PERM = true; static constexpr int NST = 8; static constexpr int MSCALE = 0x7b7b7b7b;
    unsigned char* Y;
    __device__ __forceinline__ bool operator()(const pg8::f32x4 (&acc)[2][2][4][2], const pg8::Unit& u, int wr, int wc, int fr, int fq, const LAS float* wl) const {
        const int odd = fq & 1; const int lr0 = wr * 64 + fr + odd * 16, col0 = u.c0 + wc * 32 + 8 * (fq - odd);
#pragma unroll
        for (int ai = 0; ai < 2; ++ai)
#pragma unroll
            for (int mp = 0; mp < 2; ++mp) { const int lr = lr0 + ai * 128 + mp * 32;
#pragma unroll
                for (int bj = 0; bj < 2; ++bj) { v2u w[2];
#pragma unroll
                    for (int mm = 0; mm < 2; ++mm) { static_assert(YSCALE / (W8SCALE * H8SCALE) == 0.0625f, "MSCALE"); pg8::f32x4 v0 = acc[ai][bj][2 * mp + mm][0], v1 = acc[ai][bj][2 * mp + mm][1];
#pragma unroll
                        for (int j = 0; j < 4; ++j) { v0[j] = __builtin_amdgcn_fmed3f(v0[j], -448.0f, 448.0f); v1[j] = __builtin_amdgcn_fmed3f(v1[j], -448.0f, 448.0f); }
                        int t = __builtin_amdgcn_cvt_pk_fp8_f32(v0[0], v0[1], 0, false); t = __builtin_amdgcn_cvt_pk_fp8_f32(v0[2], v0[3], t, true); w[mm].x = (unsigned)t;
                        t = __builtin_amdgcn_cvt_pk_fp8_f32(v1[0], v1[1], 0, false); t = __builtin_amdgcn_cvt_pk_fp8_f32(v1[2], v1[3], t, true); w[mm].y = (unsigned)t; }
                    *(v4u*)(Y + (size_t)(u.r0 + lr) * DM + col0 + bj * 128) = pair16(w[0], w[1]); } }
        return false;
    }
};

__device__ __forceinline__ void p1b_qknorm(Frame& F) {
    const int gw = F.vcu * NWAVES + F.wave, NGW = F.G * NWAVES; const bf16* proj = (const bf16*)(F.ws + WS_PROJ);
    const int hf = F.lane >> 5, i = F.lane & 31;
    const float inv = __builtin_amdgcn_exp2f(-(float)(2 * i) * (1.0f / 64.0f) * 13.287712379549449f);
    const float gk0 = F.in[6][64 * hf + i], gk1 = F.in[6][64 * hf + 32 + i];
    for (int tok0 = gw; tok0 < SEQ; tok0 += 4 * NGW) {
        float x1[4][2], x2[4][2];
#pragma unroll
        for (int b = 0; b < 4; ++b) { const int tok = tok0 + b * NGW; const bf16* pq = proj + (size_t)(tok < SEQ ? tok : 0) * PLD + C_KB + 64 * hf + i;
#pragma unroll
            for (int hh = 0; hh < 2; ++hh) { x1[b][hh] = bf2f(pq[hh * HD]); x2[b][hh] = bf2f(pq[hh * HD + 32]); } }
        __builtin_amdgcn_sched_barrier(0);
#pragma unroll
        for (int b = 0; b < 4; ++b) { const int tok = tok0 + b * NGW;
            const float pos = (float)(hf == 0 ? (tok >> 6) : (tok & 63));
            const float rev = pos * inv * 0.15915494309189535f, fr = rev - floorf(rev);
            const float sn = __builtin_amdgcn_sinf(fr), cs = __builtin_amdgcn_cosf(fr);
#pragma unroll
            for (int hh = 0; hh < 2; ++hh) {
                const float ss = wave_sum(x1[b][hh] * x1[b][hh] + x2[b][hh] * x2[b][hh]);
                const float rs = 1.0f / sqrtf(ss * (1.0f / HD) + RMS_EPS);
                const float a = x1[b][hh] * rs * gk0, c = x2[b][hh] * rs * gk1;
                const float o1 = a * cs - c * sn, o2 = c * cs + a * sn;
                if (tok < SEQ) { unsigned char* kf = F.ws + WS_KF8 + (size_t)tok * 256 + hh * HD + 64 * hf + 32 * ((i >> 4) & 1) + (i & 15);
                    kf[0] = (unsigned char)(__builtin_amdgcn_cvt_pk_fp8_f32(o1, 0.f, 0, false) & 0xff); kf[16] = (unsigned char)(__builtin_amdgcn_cvt_pk_fp8_f32(o2, 0.f, 0, false) & 0xff); } } }
    }
}

struct KNormRegs { float x1[4][2], x2[4][2]; };
__device__ __forceinline__ void p1b_load(Frame& F, KNormRegs& R) {
    const int gw = F.vcu * NWAVES + F.wave, NGW = F.G * NWAVES; const bf16* proj = (const bf16*)(F.ws + WS_PROJ);
    const int hf = F.lane >> 5, i = F.lane & 31;
#pragma unroll
    for (int b = 0; b < 4; ++b) { const int tok = gw + b * NGW; const bf16* pq = proj + (size_t)(tok < SEQ ? tok : 0) * PLD + C_KB + 64 * hf + i;
#pragma unroll
        for (int hh = 0; hh < 2; ++hh) { R.x1[b][hh] = bf2f(pq[hh * HD]); R.x2[b][hh] = bf2f(pq[hh * HD + 32]); } }
}
__device__ __forceinline__ void p1b_finish(Frame& F, const KNormRegs& R) {
    const int gw = F.vcu * NWAVES + F.wave, NGW = F.G * NWAVES;
    const int lane = (int)__builtin_amdgcn_mbcnt_hi(~0u, __builtin_amdgcn_mbcnt_lo(~0u, 0u)), hf = lane >> 5, i = lane & 31;
    const float inv = __builtin_amdgcn_exp2f(-(float)(2 * i) * (1.0f / 64.0f) * 13.287712379549449f);
    const float gk0 = F.in[6][64 * hf + i], gk1 = F.in[6][64 * hf + 32 + i];
#pragma unroll
    for (int b = 0; b < 4; ++b) { const int tok = gw + b * NGW;
        const float pos = (float)(hf == 0 ? (tok >> 6) : (tok & 63));
        const float rev = pos * inv * 0.15915494309189535f, fr = rev - floorf(rev);
        const float sn = __builtin_amdgcn_sinf(fr), cs = __builtin_amdgcn_cosf(fr);
#pragma unroll
        for (int hh = 0; hh < 2; ++hh) {
            const float ss = wave_sum(R.x1[b][hh] * R.x1[b][hh] + R.x2[b][hh] * R.x2[b][hh]);
            const float rs = 1.0f / sqrtf(ss * (1.0f / HD) + RMS_EPS);
            const float a = R.x1[b][hh] * rs * gk0, c = R.x2[b][hh] * rs * gk1;
            const float o1 = a * cs - c * sn, o2 = c * cs + a * sn;
            if (tok < SEQ) { unsigned char* kf = F.ws + WS_KF8 + (size_t)tok * 256 + hh * HD + 64 * hf + 32 * ((i >> 4) & 1) + (i & 15);
                kf[0] = (unsigned char)(__builtin_amdgcn_cvt_pk_fp8_f32(o1, 0.f, 0, false) & 0xff); kf[16] = (unsigned char)(__builtin_amdgcn_cvt_pk_fp8_f32(o2, 0.f, 0, false) & 0xff); } } }
}

__device__ __forceinline__ int t5_bucket(int rel) {
    const int n = rel < 0 ? -rel : rel; int b;
    if (n < 8) b = n; else if (n < 12) b = 8; else if (n < 16) b = 9; else if (n < 23) b = 10; else if (n < 32) b = 11; else if (n < 46) b = 12; else if (n < 64) b = 13; else if (n < 91) b = 14; else b = 15;
    return (rel > 0 ? 16 : 0) + b;
}
#ifndef ATT_PP
#define ATT_PP 1
#endif
#ifndef E2_ATTN
#define E2_ATTN 1
#endif
#ifndef WIN_RES
#define WIN_RES 1
#endif
#ifndef PROBE_ATT_KMASK
#define PROBE_ATT_KMASK (-1)
#endif
__device__ __forceinline__ void p3_dense_attention(Frame& F) {
    using abf = attn::bf16;
    char* lds = (char*)F.lds;
    const abf* proj = (const abf*)(F.ws + WS_PROJ);
    float gqm = fmaxf(fabsf(F.in[5][F.lane]), fabsf(F.in[5][F.lane + 64])), gkm = fmaxf(fabsf(F.in[6][F.lane]), fabsf(F.in[6][F.lane + 64]));
#pragma unroll
    for (int o = 1; o < 64; o <<= 1) { gqm = fmaxf(gqm, __shfl_xor(gqm, o)); gkm = fmaxf(gkm, __shfl_xor(gkm, o)); }
    const float sbound = 1.15f * 128.0f * gqm * gkm;
    for (int un = F.vcu; un < 256; un += F.G) {
        const int h = un >> 5, ub = un & 31, kvh = h >> 2;
        attn::attn_body<false, 1, true, true, true, -1, ATT_PP != 0, false, E2_ATTN != 0>(proj + (size_t)(ub * 256) * PLD + C_QB + h * HD, proj + C_KB + kvh * HD, F.ws + WS_KF8 + kvh * HD, proj + C_VB + kvh * HD,
                               F.ws + WS_OB + (size_t)(ub * 256) * 1024 + h * HD, OB_SCALE, SEQ, lds, nullptr, 0, sbound, 0.f, F.in[5], ub * 256,
                               attn::ConvTask{F.in[16], F.in[19], F.ws + WS_WD, un * NWAVES + F.wave, W8SCALE, F.in[14], F.in[15], F.ws + WS_WGU});
#ifdef PROBE_ATT2
        attn::attn_body<false, 1, true, true, true, PROBE_ATT_KMASK>(proj + (size_t)(ub * 256) * PLD + C_QB + h * HD, proj + C_KB + kvh * HD, F.ws + WS_KF8 + kvh * HD, proj + C_VB + kvh * HD,
                               F.ws + WS_MRG + (size_t)(ub * 256) * 1024 + h * HD, OB_SCALE, SEQ, lds, nullptr, 0, sbound, 0.f, F.in[5], ub * 256);
#endif
    }
}
__device__ __forceinline__ void win_attention(Frame& F, int first, int step) {
    using abf = attn::bf16;
    char* lds = (char*)F.lds;
    const abf* proj = (const abf*)(F.ws + WS_PROJ);
    for (int un = first; un < 256; un += step) {
        const int h = un >> 5, ub = un & 31, kvh = h >> 2;
        const int q0 = ub * 256; int kf = q0 - 128, ke = q0 + 384; if (kf < 0) kf = 0; if (ke > SEQ) ke = SEQ;
        const float sinkl = F.in[3][h] * (1.0f / attn::SCALE);
#if WIN_RES
        attn::attn_body<true, 1, false, false, false, -1, false, true>(proj + (size_t)q0 * PLD + C_QA + h * HD, proj + (size_t)kf * PLD + C_KA + kvh * HD, nullptr, proj + (size_t)kf * PLD + C_VA + kvh * HD,
                              F.ws + WS_OA + (size_t)q0 * 1024 + h * HD, OA_SCALE, ke - kf, lds, nullptr, kf - q0, sinkl, 1.0f, F.in[4] + h, 0);
#else
        LAS float* tab = (LAS float*)(F.lds + attn::WIN_TAB);
        for (int e = F.tid; e < 1024; e += NWAVES * 64) { const int rel = e - 512; const int ar = rel < 0 ? -rel : rel;
            tab[e] = ar <= 128 ? F.in[4][t5_bucket(rel) * 8 + h] * (1.0f / attn::SCALE) : -1e30f; }
        __syncthreads();
        attn::attn_body<true, 1, false, false>(proj + (size_t)q0 * PLD + C_QA + h * HD, proj + (size_t)kf * PLD + C_KA + kvh * HD, nullptr, proj + (size_t)kf * PLD + C_VA + kvh * HD,
                              F.ws + WS_OA + (size_t)q0 * 1024 + h * HD, OA_SCALE, ke - kf, lds, tab, kf - q0, sinkl, 1.0f);
#endif
    }
}

#ifndef P9_PREF
#define P9_PREF 1
#endif
#ifndef KN_SPLIT
#define KN_SPLIT 1
#endif
#ifndef P6_FORM32
#define P6_FORM32 1
#endif
#ifndef P6_PREX
#define P6_PREX 1
#endif
#ifndef P6_PREG
#define P6_PREG 1
#endif
struct P6X { float __attribute__((ext_vector_type(4))) x[2][8][2]; };
template <int G0, int G1>
__device__ __forceinline__ void p6_load_x(Frame& F, P6X& X, int blk) {
    typedef float f32x4v __attribute__((ext_vector_type(4)));
    const int t = F.lane & 15, q = F.lane >> 4;
#pragma unroll
    for (int g = G0; g < G1; ++g) { const float* prow = F.in[0] + (size_t)(blk * 32 + g * 16 + t) * DM + F.wave * 256 + 4 * q;
#pragma unroll
        for (int s = 0; s < 8; ++s) { X.x[g][s][0] = *(const f32x4v*)(prow + 32 * s); X.x[g][s][1] = *(const f32x4v*)(prow + 32 * s + 16); } }
}
#define GAS __attribute__((address_space(1)))
__device__ __forceinline__ void p5_ln_router32(Frame& F, P6X& X, bool pre) {
    typedef float f32x4v __attribute__((ext_vector_type(4)));
    const bf16* mixb = (const bf16*)(F.ws + WS_PRE); bf16* hbf = (bf16*)(F.ws + WS_HBF);
    const bf16* wrh = (const bf16*)(F.ws + WS_WR);
    LAS float* red = (LAS float*)(F.lds);
    LAS float* part = (LAS float*)(F.lds + 4096);
    LAS int* cntl = (LAS int*)(F.lds + 4096 + 65536);
    LAS int* basel = cntl + 64;
    LAS int* rec_e = basel + 64;
    LAS int* rec_p = rec_e + 256;
    LAS float* rec_w = (LAS float*)(rec_p + 256);
    LAS float* gl = (LAS float*)(F.lds + 4096 + 65536 + 4096); LAS float* bl = gl + DM;
    const int w = F.wave;
    const float rb = F.in[13][F.lane];
    { const f32x4v gv = *(const f32x4v*)(F.in[10] + 4 * F.tid), bv = *(const f32x4v*)(F.in[11] + 4 * F.tid); *(LAS f32x4v*)(gl + 4 * F.tid) = gv; *(LAS f32x4v*)(bl + 4 * F.tid) = bv; }
    for (int blk = F.vcu; blk < SEQ / 32; blk += F.G) {
        int lane = F.lane; asm volatile("" : "+v"(lane));
        const int t = lane & 15, q = lane >> 4;
        if (F.tid < 64) cntl[F.tid] = 0;
        float mean[2], rstd[2];
        if (!pre || blk != F.vcu) p6_load_x<0, P6_PREG>(F, X, blk);
        f32x4v (&hv)[2][8][2] = X.x;
#pragma unroll
        for (int g = 0; g < 2; ++g) { v2u ma[8][2];
            if (g == 1 && P6_PREG < 2) p6_load_x<1, 2>(F, X, blk);
            { const bf16* mrow = mixb + (size_t)(blk * 32 + g * 16 + t) * DM + w * 256 + 4 * q;
#pragma unroll
              for (int s = 0; s < 8; ++s) { ma[s][0] = *(const v2u*)(mrow + 32 * s); ma[s][1] = *(const v2u*)(mrow + 32 * s + 16); } }
            __builtin_amdgcn_sched_barrier(0);
            float s1 = 0.f, s2 = 0.f;
#pragma unroll
            for (int s = 0; s < 8; ++s) { const v2u m0 = ma[s][0], m1 = ma[s][1];
                const f32x4v v0 = hv[g][s][0] * ALPHA + (f32x4v){pg8::bf_lo(m0.x), pg8::bf_hi(m0.x), pg8::bf_lo(m0.y), pg8::bf_hi(m0.y)}, v1 = hv[g][s][1] * ALPHA + (f32x4v){pg8::bf_lo(m1.x), pg8::bf_hi(m1.x), pg8::bf_lo(m1.y), pg8::bf_hi(m1.y)};
                hv[g][s][0] = v0; hv[g][s][1] = v1;
#pragma unroll
                for (int j = 0; j < 4; ++j) { s1 += v0[j] + v1[j]; s2 += v0[j] * v0[j] + v1[j] * v1[j]; } }
            __builtin_amdgcn_sched_barrier(0);
            s1 += __shfl_xor(s1, 16); s1 += __shfl_xor(s1, 32); s2 += __shfl_xor(s2, 16); s2 += __shfl_xor(s2, 32);
            if (q == 0) { red[(w * 32 + g * 16 + t) * 2] = s1; red[(w * 32 + g * 16 + t) * 2 + 1] = s2; } }
        __syncthreads();
#pragma unroll
        for (int g = 0; g < 2; ++g) { float m1 = 0.f, m2 = 0.f;
#pragma unroll
            for (int k = 0; k < 8; ++k) { m1 += red[(k * 32 + g * 16 + t) * 2]; m2 += red[(k * 32 + g * 16 + t) * 2 + 1]; }
            mean[g] = m1 * (1.0f / DM); const float var = m2 * (1.0f / DM) - mean[g] * mean[g]; rstd[g] = 1.0f / sqrtf(var + LN_EPS); }
        f32x4v acc[2][4] = {};
        const LAS float* gp = gl + w * 256 + 4 * q; const LAS float* bp = bl + w * 256 + 4 * q;
        const unsigned ro = (unsigned)((blk * 32 + t) * DM + w * 256 + 4 * q);
        GAS char* hb_ = (GAS char*)hbf; GAS char* hf_ = (GAS char*)(F.ws + WS_HF8); asm volatile("" : "+s"(hb_), "+s"(hf_));
        const unsigned lane8 = (unsigned)lane * 8u;
#pragma unroll
        for (int s = 0; s < 8; ++s) {
            bf16x8 Bh[4], Bl[4];
            { const GAS bf16* wuh_ = (const GAS bf16*)(wrh + (size_t)((w * 8 + s) * 2048)); const GAS bf16* wul_ = wuh_ + NEXP * DM; asm volatile("" : "+s"(wuh_), "+s"(wul_));
#pragma unroll
              for (int nt = 0; nt < 4; ++nt) { Bh[nt] = *(const GAS bf16x8*)(wuh_ + nt * 512 + lane8); Bl[nt] = *(const GAS bf16x8*)(wul_ + nt * 512 + lane8); } }
            __builtin_amdgcn_sched_barrier(0);
            const f32x4v g0 = *(const LAS f32x4v*)(gp + 32 * s), g1 = *(const LAS f32x4v*)(gp + 32 * s + 16), b0 = *(const LAS f32x4v*)(bp + 32 * s), b1 = *(const LAS f32x4v*)(bp + 32 * s + 16);
#pragma unroll
            for (int g = 0; g < 2; ++g) {
                const f32x4v y0 = (hv[g][s][0] - mean[g]) * rstd[g] * g0 + b0, y1 = (hv[g][s][1] - mean[g]) * rstd[g] * g1 + b1;
                v4u ah, al; ah.x = pg8::cvt_pk_bf16(y0[0], y0[1]); ah.y = pg8::cvt_pk_bf16(y0[2], y0[3]); ah.z = pg8::cvt_pk_bf16(y1[0], y1[1]); ah.w = pg8::cvt_pk_bf16(y1[2], y1[3]);
                al.x = pg8::cvt_pk_bf16(y0[0] - pg8::bf_lo(ah.x), y0[1] - pg8::bf_hi(ah.x)); al.y = pg8::cvt_pk_bf16(y0[2] - pg8::bf_lo(ah.y), y0[3] - pg8::bf_hi(ah.y));
                al.z = pg8::cvt_pk_bf16(y1[0] - pg8::bf_lo(ah.z), y1[1] - pg8::bf_hi(ah.z)); al.w = pg8::cvt_pk_bf16(y1[2] - pg8::bf_lo(ah.w), y1[3] - pg8::bf_hi(ah.w));
                { const unsigned ob = (ro + (unsigned)(g * 16 * DM + 32 * s)) * 2u; *(GAS v2u*)(hb_ + ob) = (v2u){ah.x, ah.y}; *(GAS v2u*)(hb_ + ob + 32) = (v2u){ah.z, ah.w}; }
                { int t0_ = __builtin_amdgcn_cvt_pk_fp8_f32(y0[0], y0[1], 0, false); t0_ = __builtin_amdgcn_cvt_pk_fp8_f32(y0[2], y0[3], t0_, true);
                  int t1_ = __builtin_amdgcn_cvt_pk_fp8_f32(y1[0], y1[1], 0, false); t1_ = __builtin_amdgcn_cvt_pk_fp8_f32(y1[2], y1[3], t1_, true);
                  const unsigned of = ro + (unsigned)(g * 16 * DM + 32 * s); *(GAS int*)(hf_ + of) = t0_; *(GAS int*)(hf_ + of + 16) = t1_; }
                const bf16x8 Ah = __builtin_bit_cast(bf16x8, ah), Al = __builtin_bit_cast(bf16x8, al);
#pragma unroll
                for (int nt = 0; nt < 4; ++nt) { acc[g][nt] = __builtin_amdgcn_mfma_f32_16x16x32_bf16(Ah, Bh[nt], acc[g][nt], 0, 0, 0);
                    acc[g][nt] = __builtin_amdgcn_mfma_f32_16x16x32_bf16(Al, Bh[nt], acc[g][nt], 0, 0, 0); acc[g][nt] = __builtin_amdgcn_mfma_f32_16x16x32_bf16(Ah, Bl[nt], acc[g][nt], 0, 0, 0); }
            }
            __builtin_amdgcn_sched_barrier(0);
        }
#pragma unroll
        for (int g = 0; g < 2; ++g)
#pragma unroll
            for (int nt = 0; nt < 4; ++nt)
#pragma unroll
                for (int r = 0; r < 4; ++r) part[(w * 32 + g * 16 + 4 * q + r) * 64 + 16 * nt + t] = acc[g][nt][r];
        __syncthreads();
#pragma unroll 4
        for (int i = 0; i < 4; ++i) {
            const int tl = w * 4 + i;
            float logit = 0.f;
#pragma unroll
            for (int k = 0; k < 8; ++k) logit += part[(k * 32 + tl) * 64 + lane];
            const float sc = 1.0f / (1.0f + expf(-logit));
            const float b = sc + rb;
            float mx = b; mx = fmaxf(mx, __shfl_xor(mx, 1)); mx = fmaxf(mx, __shfl_xor(mx, 2)); mx = fmaxf(mx, __shfl_xor(mx, 4));
            const unsigned long long bal = __ballot(b == mx); const unsigned gm = (unsigned)(bal >> (lane & ~7)) & 0xffu; const int first = __builtin_ctz(gm);
            float b2 = ((lane & 7) == first) ? -INFINITY : b; b2 = fmaxf(b2, __shfl_xor(b2, 1)); b2 = fmaxf(b2, __shfl_xor(b2, 2)); b2 = fmaxf(b2, __shfl_xor(b2, 4));
            const float gs = mx + b2; const int grp = lane >> 3; int gc = 0;
#pragma unroll
            for (int g3 = 0; g3 < 8; ++g3) { const float o = __uint_as_float(__builtin_amdgcn_readlane(__float_as_uint(gs), g3 * 8)); gc += (o > gs || (o == gs && g3 < grp)) ? 1 : 0; }
            const float mk = gc < 4 ? b : -INFINITY; int rank = 0;
#pragma unroll
            for (int j = 0; j < 64; ++j) { const float o = __uint_as_float(__builtin_amdgcn_readlane(__float_as_uint(mk), j)); rank += (o > mk || (o == mk && j < lane)) ? 1 : 0; }
            const bool sel = (gc < 4) && rank < 8;
            const float wsum = wave_sum(sel ? sc : 0.f);
            if (sel) { const int lp = atomicAdd((int*)(cntl + lane), 1); rec_e[tl * 8 + rank] = lane; rec_p[tl * 8 + rank] = lp; rec_w[tl * 8 + rank] = sc / wsum * ROUTED_SCALE; }
        }
        __syncthreads();
        int tx = F.tid; asm volatile("" : "+v"(tx));
        if (tx < 64) basel[tx] = (int)atomicAdd(F.ctl + CW_CNT + CNT_STRIDE * tx, (unsigned)cntl[tx]);
        __syncthreads();
        if (tx < 256) { const int tl = tx >> 3, e = rec_e[tx], pos = basel[e] + rec_p[tx]; const int token = blk * 32 + tl;
            ((int*)(F.ws + WS_LTOK))[e * LCAP + pos] = token; ((float*)(F.ws + WS_LW))[e * LCAP + pos] = rec_w[tx];
            int* rt = (int*)(F.ws + WS_ROUTE); rt[(token * 8 + (tx & 7)) * 2] = e; rt[(token * 8 + (tx & 7)) * 2 + 1] = pos; }
        __syncthreads();
    }
}

__device__ __forceinline__ void p5_ln_router(Frame& F, bool probe_rep = false) {
    typedef float f32x4v __attribute__((ext_vector_type(4)));
    const bf16* mixb = (const bf16*)(F.ws + WS_PRE); bf16* hbf = (bf16*)(F.ws + WS_HBF);
    const bf16* wrh = (const bf16*)(F.ws + WS_WR); const bf16* wrl = wrh + NEXP * DM;
    LAS float* red = (LAS float*)(F.lds);
    LAS float* part = (LAS float*)(F.lds + 4096);
    LAS int* cntl = (LAS int*)(F.lds + 4096 + 32768);
    LAS int* basel = cntl + 64;
    LAS int* rec_e = basel + 64;
    LAS int* rec_p = rec_e + 256;
    LAS float* rec_w = (LAS float*)(rec_p + 256);
    const int lane = F.lane, w = F.wave, gi = w >> 2, kq = w & 3, t = lane & 15, q = lane >> 4;
    for (int blk = F.vcu; blk < SEQ / 32; blk += F.G) {
        const int tok = blk * 32 + gi * 16 + t;
        if (F.tid < 64) cntl[F.tid] = 0;
        float s1 = 0.f, s2 = 0.f;
        const float* prow = F.in[0] + (size_t)tok * DM + kq * 512 + 4 * q; const bf16* mrow = mixb + (size_t)tok * DM + kq * 512 + 4 * q;
        f32x4v hv[16][2];
#pragma unroll
        for (int sg = 0; sg < 4; ++sg) {
            f32x4v xa[4][2]; v2u ma[4][2];
#pragma unroll
            for (int u = 0; u < 4; ++u) { const int s = 4 * sg + u; xa[u][0] = *(const f32x4v*)(prow + 32 * s); xa[u][1] = *(const f32x4v*)(prow + 32 * s + 16); ma[u][0] = *(const v2u*)(mrow + 32 * s); ma[u][1] = *(const v2u*)(mrow + 32 * s + 16); }
            __builtin_amdgcn_sched_barrier(0);
#pragma unroll
            for (int u = 0; u < 4; ++u) { const int s = 4 * sg + u; const v2u m0 = ma[u][0], m1 = ma[u][1];
                const f32x4v v0 = xa[u][0] * ALPHA + (f32x4v){pg8::bf_lo(m0.x), pg8::bf_hi(m0.x), pg8::bf_lo(m0.y), pg8::bf_hi(m0.y)}, v1 = xa[u][1] * ALPHA + (f32x4v){pg8::bf_lo(m1.x), pg8::bf_hi(m1.x), pg8::bf_lo(m1.y), pg8::bf_hi(m1.y)};
                hv[s][0] = v0; hv[s][1] = v1;
#pragma unroll
                for (int j = 0; j < 4; ++j) { s1 += v0[j] + v1[j]; s2 += v0[j] * v0[j] + v1[j] * v1[j]; } }
            __builtin_amdgcn_sched_barrier(0);
        }
        s1 += __shfl_xor(s1, 16); s1 += __shfl_xor(s1, 32); s2 += __shfl_xor(s2, 16); s2 += __shfl_xor(s2, 32);
        if (q == 0) { red[(w * 16 + t) * 2] = s1; red[(w * 16 + t) * 2 + 1] = s2; }
        __syncthreads();
        float m1 = 0.f, m2 = 0.f;
#pragma unroll
        for (int k = 0; k < 4; ++k) { m1 += red[((gi * 4 + k) * 16 + t) * 2]; m2 += red[((gi * 4 + k) * 16 + t) * 2 + 1]; }
        const float mean = m1 * (1.0f / DM); const float var = m2 * (1.0f / DM) - mean * mean; const float rstd = 1.0f / sqrtf(var + LN_EPS);
        f32x4v acc[4] = {};
        const float* gp = F.in[10] + kq * 512 + 4 * q; const float* bp = F.in[11] + kq * 512 + 4 * q;
        bf16* brow = hbf + (size_t)tok * DM + kq * 512 + 4 * q; unsigned char* frow = F.ws + WS_HF8 + (size_t)tok * DM + kq * 512 + 4 * q;
        struct P5Set { f32x4v g0, g1, b0, b1; bf16x8 Bh[4], Bl[4]; };
        P5Set A_; const unsigned lane8 = (unsigned)lane * 8u;
#define P5_LOAD(S, X) do { X.g0 = *(const f32x4v*)(gp + 32 * (S)); X.g1 = *(const f32x4v*)(gp + 32 * (S) + 16); X.b0 = *(const f32x4v*)(bp + 32 * (S)); X.b1 = *(const f32x4v*)(bp + 32 * (S) + 16); \
            { const bf16* wuh_ = wrh + (size_t)((kq * 16 + (S)) * 2048); const bf16* wul_ = wuh_ + NEXP * DM;     \
              asm volatile("" : "+s"(wuh_), "+s"(wul_));                                                         \
              _Pragma("unroll") for (int nt = 0; nt < 4; ++nt) { X.Bh[nt] = *(const bf16x8*)(wuh_ + nt * 512 + lane8); X.Bl[nt] = *(const bf16x8*)(wul_ + nt * 512 + lane8); } } } while (0)
#define P5_COMP(S, X) do { const f32x4v p0_ = hv[S][0], p1_ = hv[S][1]; \
            const f32x4v y0 = (p0_ - mean) * rstd * X.g0 + X.b0, y1 = (p1_ - mean) * rstd * X.g1 + X.b1; \
            v4u ah, al; ah.x = pg8::cvt_pk_bf16(y0[0], y0[1]); ah.y = pg8::cvt_pk_bf16(y0[2], y0[3]); ah.z = pg8::cvt_pk_bf16(y1[0], y1[1]); ah.w = pg8::cvt_pk_bf16(y1[2], y1[3]); \
            al.x = pg8::cvt_pk_bf16(y0[0] - pg8::bf_lo(ah.x), y0[1] - pg8::bf_hi(ah.x)); al.y = pg8::cvt_pk_bf16(y0[2] - pg8::bf_lo(ah.y), y0[3] - pg8::bf_hi(ah.y)); \
            al.z = pg8::cvt_pk_bf16(y1[0] - pg8::bf_lo(ah.z), y1[1] - pg8::bf_hi(ah.z)); al.w = pg8::cvt_pk_bf16(y1[2] - pg8::bf_lo(ah.w), y1[3] - pg8::bf_hi(ah.w)); \
            *(v2u*)(brow + 32 * (S)) = (v2u){ah.x, ah.y}; *(v2u*)(brow + 32 * (S) + 16) = (v2u){ah.z, ah.w}; \
            { int t0_ = __builtin_amdgcn_cvt_pk_fp8_f32(y0[0], y0[1], 0, false); t0_ = __builtin_amdgcn_cvt_pk_fp8_f32(y0[2], y0[3], t0_, true); \
              int t1_ = __builtin_amdgcn_cvt_pk_fp8_f32(y1[0], y1[1], 0, false); t1_ = __builtin_amdgcn_cvt_pk_fp8_f32(y1[2], y1[3], t1_, true); \
              *(int*)(frow + 32 * (S)) = t0_; *(int*)(frow + 32 * (S) + 16) = t1_; } \
            const bf16x8 Ah = __builtin_bit_cast(bf16x8, ah), Al = __builtin_bit_cast(bf16x8, al); \
            _Pragma("unroll") for (int nt = 0; nt < 4; ++nt) { acc[nt] = __builtin_amdgcn_mfma_f32_16x16x32_bf16(Ah, X.Bh[nt], acc[nt], 0, 0, 0); \
                acc[nt] = __builtin_amdgcn_mfma_f32_16x16x32_bf16(Al, X.Bh[nt], acc[nt], 0, 0, 0); acc[nt] = __builtin_amdgcn_mfma_f32_16x16x32_bf16(Ah, X.Bl[nt], acc[nt], 0, 0, 0); } } while (0)
#pragma unroll
        for (int s = 0; s < 16; ++s) {
            P5_LOAD(s, A_); __builtin_amdgcn_sched_barrier(0);
            P5_COMP(s, A_); __builtin_amdgcn_sched_barrier(0);
        }
#undef P5_LOAD
#undef P5_COMP
#pragma unroll
        for (int nt = 0; nt < 4; ++nt)
#pragma unroll
            for (int r = 0; r < 4; ++r) part[(w * 16 + 4 * q + r) * 64 + 16 * nt + t] = acc[nt][r];
        __syncthreads();
#ifdef PROBE_P5
        if (PROBE_P5 >= 2 && probe_rep) { __syncthreads(); continue; }
#endif
        const float rb = F.in[13][lane];
#pragma unroll 1
        for (int i = 0; i < 4; ++i) {
            const int tl = w * 4 + i, g2 = tl >> 4, tt = tl & 15;
            float logit = 0.f;
#pragma unroll
            for (int k = 0; k < 4; ++k) logit += part[((g2 * 4 + k) * 16 + tt) * 64 + lane];
            const float sc = 1.0f / (1.0f + expf(-logit));
            const float b = sc + rb;
            float mx = b; mx = fmaxf(mx, __shfl_xor(mx, 1)); mx = fmaxf(mx, __shfl_xor(mx, 2)); mx = fmaxf(mx, __shfl_xor(mx, 4));
            const unsigned long long bal = __ballot(b == mx); const unsigned gm = (unsigned)(bal >> (lane & ~7)) & 0xffu; const int first = __builtin_ctz(gm);
            float b2 = ((lane & 7) == first) ? -INFINITY : b; b2 = fmaxf(b2, __shfl_xor(b2, 1)); b2 = fmaxf(b2, __shfl_xor(b2, 2)); b2 = fmaxf(b2, __shfl_xor(b2, 4));
            const float gs = mx + b2; const int grp = lane >> 3; int gc = 0;
#pragma unroll
            for (int g3 = 0; g3 < 8; ++g3) { const float o = __uint_as_float(__builtin_amdgcn_readlane(__float_as_uint(gs), g3 * 8)); gc += (o > gs || (o == gs && g3 < grp)) ? 1 : 0; }
            const float mk = gc < 4 ? b : -INFINITY; int rank = 0;
#pragma unroll
            for (int j = 0; j < 64; ++j) { const float o = __uint_as_float(__builtin_amdgcn_readlane(__float_as_uint(mk), j)); rank += (o > mk || (o == mk && j < lane)) ? 1 : 0; }
            const bool sel = (gc < 4) && rank < 8;
            const float wsum = wave_sum(sel ? sc : 0.f);
            if (sel) { const int lp = atomicAdd((int*)(cntl + lane), 1); rec_e[tl * 8 + rank] = lane; rec_p[tl * 8 + rank] = lp; rec_w[tl * 8 + rank] = sc / wsum * ROUTED_SCALE; }
        }
        __syncthreads();
#ifdef PROBE_P5
        if (PROBE_P5 == 1 && probe_rep) { __syncthreads(); continue; }
#endif
        if (F.tid < 64) basel[F.tid] = (int)atomicAdd(F.ctl + CW_CNT + CNT_STRIDE * F.tid, (unsigned)cntl[F.tid]);
        __syncthreads();
        if (F.tid < 256) { const int tl = F.tid >> 3, e = rec_e[F.tid], pos = basel[e] + rec_p[F.tid]; const int token = blk * 32 + tl;
            ((int*)(F.ws + WS_LTOK))[e * LCAP + pos] = token; ((float*)(F.ws + WS_LW))[e * LCAP + pos] = rec_w[F.tid];
            int* rt = (int*)(F.ws + WS_ROUTE); rt[(token * 8 + (F.tid & 7)) * 2] = e; rt[(token * 8 + (F.tid & 7)) * 2 + 1] = pos; }
        __syncthreads();
    }
}

__device__ __forceinline__ void moe_build_tst(Frame& F) {
    LAS int* tst = (LAS int*)(F.lds + TST_OFF);
    static_assert(NEXP == 64 && NEXP1 == 65, "one count per lane of wave 0");
    int ln = (int)threadIdx.x; asm volatile("" : "+v"(ln));
    if (ln < 64) {
        const unsigned c = __hip_atomic_load(F.ctl + CW_CNT + CNT_STRIDE * ln, RLX_AGENT);
        const int tl = (int)((c + 255u) >> 8); int inc = tl;
#pragma unroll
        for (int o = 1; o < 64; o <<= 1) { const int n = __shfl_up(inc, o); if (ln >= o) inc += n; }
        tst[ln] = inc - tl;
        if (ln == 63) { tst[NEXP] = inc; tst[NEXP1] = inc + (SEQ + 255) / 256; } }
    __syncthreads();
}

struct P9Pre { unsigned rows[9]; v4u hv[4]; };
__device__ __forceinline__ void p9_prefetch(Frame& F, P9Pre& P) {
    const LAS int* tst = (const LAS int*)(F.lds + TST_OFF);
    const int gw = F.vcu * NWAVES + F.wave; const int lane = (int)__builtin_amdgcn_mbcnt_hi(~0u, __builtin_amdgcn_mbcnt_lo(~0u, 0u));
    const bf16* hbf = (const bf16*)(F.ws + WS_HBF); const int* rt = (const int*)(F.ws + WS_ROUTE);
#pragma unroll
    for (int k = 0; k < 8; ++k) { const int e = rt[(gw * 8 + k) * 2], pos = rt[(gw * 8 + k) * 2 + 1]; P.rows[k] = (unsigned)(tst[e] * 256 + pos) * (DM / 8); }
    P.rows[8] = (unsigned)(tst[NEXP] * 256 + gw) * (DM / 8);
#pragma unroll
    for (int c = 0; c < 4; ++c) P.hv[c] = __builtin_nontemporal_load((const v4u*)(hbf + (size_t)gw * DM + 512 * c + 8 * lane));
}
__device__ __forceinline__ void p9_combine(Frame& F, const P9Pre& P, bool pre) {
    const LAS int* tst = (const LAS int*)(F.lds + TST_OFF);
    const int gw = F.vcu * NWAVES + F.wave, NGW = F.G * NWAVES; const int lane = (int)__builtin_amdgcn_mbcnt_hi(~0u, __builtin_amdgcn_mbcnt_lo(~0u, 0u));
    const unsigned char* Y = (const unsigned char*)(F.ws + WS_Y); const bf16* hbf = (const bf16*)(F.ws + WS_HBF); const int* rt = (const int*)(F.ws + WS_ROUTE);
    unsigned rows[9];
#define P9_ROWS(dst, tok_) do { _Pragma("unroll") for (int k = 0; k < 8; ++k) { const int e = rt[((tok_) * 8 + k) * 2], pos = rt[((tok_) * 8 + k) * 2 + 1]; dst[k] = (unsigned)(tst[e] * 256 + pos) * (DM / 8); } \
        dst[8] = (unsigned)(tst[NEXP] * 256 + (tok_)) * (DM / 8); } while (0)
    if (pre) {
#pragma unroll
        for (int k = 0; k < 9; ++k) rows[k] = P.rows[k]; }
    else if (gw < SEQ) P9_ROWS(rows, gw);
    for (int tok = gw; tok < SEQ; tok += NGW) {
        float v[4][8]; float s1 = 0.f;
#pragma unroll
        for (int c = 0; c < 4; ++c) { const int col = 512 * c + 8 * lane;
            const v4u hv = (pre && tok == gw) ? P.hv[c] : __builtin_nontemporal_load((const v4u*)(hbf + (size_t)tok * DM + col));
            const f32x4 a = {pg8::bf_lo(hv.x), pg8::bf_hi(hv.x), pg8::bf_lo(hv.y), pg8::bf_hi(hv.y)}, b = {pg8::bf_lo(hv.z), pg8::bf_hi(hv.z), pg8::bf_lo(hv.w), pg8::bf_hi(hv.w)};
            float r[8] = {0.f, 0.f, 0.f, 0.f, 0.f, 0.f, 0.f, 0.f};
#pragma unroll
            for (int k = 0; k < 9; ++k) { const v2u y = __builtin_nontemporal_load((const v2u*)Y + (size_t)rows[k] + (col >> 3));
                const auto q0 = __builtin_amdgcn_cvt_pk_f32_fp8((int)y.x, false), q1 = __builtin_amdgcn_cvt_pk_f32_fp8((int)y.x, true), q2 = __builtin_amdgcn_cvt_pk_f32_fp8((int)y.y, false), q3 = __builtin_amdgcn_cvt_pk_f32_fp8((int)y.y, true);
                r[0] += q0[0]; r[1] += q0[1]; r[2] += q1[0]; r[3] += q1[1]; r[4] += q2[0]; r[5] += q2[1]; r[6] += q3[0]; r[7] += q3[1]; }
#pragma unroll
            for (int j = 0; j < 4; ++j) { v[c][j] = ALPHA * a[j] + r[j] * (1.0f / YSCALE); v[c][4 + j] = ALPHA * b[j] + r[4 + j] * (1.0f / YSCALE); }
#pragma unroll
            for (int j = 0; j < 8; ++j) s1 += v[c][j]; }
        if (tok + NGW < SEQ) P9_ROWS(rows, tok + NGW);
        const float mean = wave_sum(s1) * (1.0f / DM); float s2 = 0.f;
#pragma unroll
        for (int c = 0; c < 4; ++c)
#pragma unroll
            for (int j = 0; j < 8; ++j) { v[c][j] -= mean; s2 += v[c][j] * v[c][j]; }
        const float rstd = 1.0f / sqrtf(wave_sum(s2) * (1.0f / DM) + LN_EPS);
#pragma unroll
        for (int c = 0; c < 4; ++c) { const int col = 512 * c + 8 * lane;
            const f32x4 g0 = *(const f32x4*)(F.in[20] + col), g1 = *(const f32x4*)(F.in[20] + col + 4), b0 = *(const f32x4*)(F.in[21] + col), b1 = *(const f32x4*)(F.in[21] + col + 4);
            f32x4 o0, o1;
#pragma unroll
            for (int j = 0; j < 4; ++j) { o0[j] = v[c][j] * rstd * g0[j] + b0[j]; o1[j] = v[c][4 + j] * rstd * g1[j] + b1[j]; }
            __builtin_nontemporal_store(o0, (f32x4*)(F.out + (size_t)tok * DM + col)); __builtin_nontemporal_store(o1, (f32x4*)(F.out + (size_t)tok * DM + col + 4)); }
    }
#undef P9_ROWS
}

constexpr int NPHASES = 10;
#ifndef MK_ONE_LAUNCH
#define MK_ONE_LAUNCH 1
#endif
__global__ void __launch_bounds__(NWAVES * 64, 2) mega_fwd(Args args) {
    extern __shared__ __attribute__((aligned(16))) unsigned char lds[];
    Frame F;
    F.lds = (LAS unsigned char*)lds;
    F.MISC = (volatile LAS unsigned*)(F.lds + MISC_OFF);
    F.tid = threadIdx.x; F.lane = F.tid & 63; F.wave = __builtin_amdgcn_readfirstlane(F.tid >> 6);
    F.G = gridDim.x; { const int bx = blockIdx.x; F.vcu = (F.G % 8 == 0) ? (bx % 8) * (F.G / 8) + bx / 8 : bx; }
#pragma unroll
    for (int i = 0; i < 22; ++i) F.in[i] = args.in[i];
    F.out = args.out; F.ws = args.ws; F.ctl = (unsigned*)(args.ws + WS_CTL);
    for (int u = F.tid; u < (LDS_BYTES - LDSCTL_OFF) / 4; u += NWAVES * 64) ((LAS unsigned*)(F.lds + LDSCTL_OFF))[u] = 0u;
    __syncthreads();
    XcdBarrier bar; bar.bar = F.ctl + CW_BAR; bar.x = 0; bar.st = nullptr; bar.total = 0; XcdBarrier barB = bar;
    const bool conv1 = (F.G == 256) && (F.vcu & 31) >= P1_NCG;
    if (MK_ONE_LAUNCH) { bar = xcd_barrier_post(F.ctl + CW_BAR, F.MISC + 8, (unsigned)F.G); }
    const int lo = args.ph_lo, hi = args.ph_hi;
#ifndef PH_MASK
#define PH_MASK 0x3ff
#endif
#define IN(k) (((PH_MASK >> (k)) & 1) && lo <= (k) && (k) < hi)
#ifndef REP_MASK
#define REP_MASK 0
#endif
#define REP(k) for (int rep_ = 0; rep_ < 1 + ((REP_MASK >> (k)) & 1); ++rep_)
#ifndef BAR_REP
#define BAR_REP 1
#endif
#define SEAM(k) do { if (IN(k) && IN((k) + 1)) for (int br_ = 0; br_ < BAR_REP; ++br_) xcd_barrier(bar); } while (0)
    LAS int* idxl = (LAS int*)(F.lds + IDXL_OFF);
    const bool tst_needed = true;

    if (IN(0)) REP(0) { p0_prologue(F, false); } SEAM(0);
    if (IN(1)) REP(1) {
        const int grp = F.vcu >> 5, cin = F.vcu & 31;
        const bool conv = (F.G == 256) && cin >= P1_NCG;
        if (conv) { const int cw = (grp * (32 - P1_NCG) + (cin - P1_NCG)) * NWAVES + F.wave; convert_items<1>(F, cw, NCONV1 * NWAVES, E_X); if (!E2_ATTN) convert_items<2>(F, cw, NCONV1 * NWAVES, E2_A); }
        else {
            DenseOrder S; if (F.G == 256) S.init(F.ws + WS_XBF, F.ws + WS_WINT, SEQ, INC, DM, NCOMP1, cin * 8 + grp); else S.init(F.ws + WS_XBF, F.ws + WS_WINT, SEQ, INC, DM, F.G, (int)blockIdx.x);
            EpiProj E{(bf16*)(F.ws + WS_PROJ), F.in[2]};
            pg8::gemm_phase<EpiProj, DenseOrder, true, false, P1_FP8 != 0>(F.lds + RING_OFF, idxl, DM, S, E);
            if (F.G == 256 && E_SPLIT > E_X) { const int c = cin * 8 + grp;
                if (c >= N5C) convert_items<1>(F, E_X + (c - N5C) * NWAVES + F.wave, N4C * NWAVES, E_Y);
                else convert_items<1>(F, E_Y + c * NWAVES + F.wave, N5C * NWAVES, E_SPLIT); }
        }
    } SEAM(1);
    if (IN(2)) {
        constexpr bool all_win = E_SPLIT >= NITEMS_E1 && (E2_ATTN || (CONV_G1 ? E2_SPLIT : E2_A) >= NITEMS_E2);
        if (!(KN_SPLIT && all_win && F.G == 256)) p1b_qknorm(F);
        if (F.G == 256) {
            if (all_win) {
                KNormRegs kr; if (KN_SPLIT) p1b_load(F, kr);
                win_attention(F, F.vcu, 256);
                if (KN_SPLIT) p1b_finish(F, kr); }
            else if (F.vcu & 1) win_attention(F, F.vcu >> 1, 128);
            else { const int cw = (F.vcu >> 1) * NWAVES + F.wave;
                convert_items<1>(F, E_SPLIT + cw, 128 * NWAVES, NITEMS_E1); convert_items<2>(F, (CONV_G1 ? E2_SPLIT : E2_A) + cw, 128 * NWAVES, NITEMS_E2); }
        } else { win_attention(F, F.vcu, F.G); convert_items<1>(F, F.vcu * NWAVES + F.wave, F.G * NWAVES, NITEMS_E1); convert_items<2>(F, F.vcu * NWAVES + F.wave, F.G * NWAVES, NITEMS_E2); }
    } SEAM(2);
    if (IN(3)) REP(3) { p3_dense_attention(F); } SEAM(3);
    if (IN(4)) REP(4) {
        BranchOrder S{(const char*)(F.ws + WS_OA), (const char*)(F.ws + WS_OB), (const char*)(F.ws + WS_WAT), (const char*)(F.ws + WS_WBT), F.vcu};
        EpiBranch E{(const bf16*)(F.ws + WS_PROJ), F.ws + WS_MRG};
        if (F.vcu < 256) pg8::gemm_phase<EpiBranch, BranchOrder, false, false, true>(F.lds + RING_OFF, idxl, 1024, S, E);
    } SEAM(4);
    if (IN(5)) REP(5) {
        OneTileOrder S{(const char*)(F.ws + WS_MRG), (const char*)(F.ws + WS_WOT), F.vcu, (size_t)256 * DM};
        EpiMix E{(bf16*)(F.ws + WS_PRE)};
        if (F.vcu < 256) pg8::gemm_phase<EpiMix, OneTileOrder, false, false, true>(F.lds + RING_OFF, idxl, DM, S, E);
    }
    P6X px; const bool pre6 = P6_FORM32 && P6_PREX && IN(5) && IN(6) && F.vcu < SEQ / 32;
    if (IN(5) && IN(6)) xcd_barrier_pf(bar, [&]() { if (pre6) p6_load_x<0, P6_PREG>(F, px, F.vcu); });
    if (IN(6)) REP(6) { if (rep_) { xcd_barrier(bar);
#ifndef PROBE_P5
            if (blockIdx.x == 0 && F.tid < 64) __hip_atomic_store(F.ctl + CW_CNT + CNT_STRIDE * F.tid, 0u, RLX_AGENT);
#endif
            xcd_barrier(bar); } if (P6_FORM32) p5_ln_router32(F, px, pre6 && rep_ == 0); else p5_ln_router(F, rep_ != 0); } SEAM(6);
    if (IN(7) || IN(8) || IN(9)) { if (tst_needed) moe_build_tst(F); }
#ifndef DEFER_MAX
#define DEFER_MAX 64
#endif
    int n_defer = 0, u1_end = -1;
    if (IN(7) || IN(8)) { const int T_ = ((const LAS int*)(F.lds + TST_OFF))[NEXP1]; const int r_ = (4 * T_) % 256;
        if (F.G == 256 && !CONV_G1 && 4 * T_ > 256 && r_ > 0 && r_ <= DEFER_MAX && (lo <= 7 && 8 < hi)) { n_defer = r_; u1_end = 4 * T_ - r_; } }
    if (IN(7)) REP(7) {
        const bool split = CONV_G1 && F.G == 256, conv = split && ((F.vcu & 7) == 7);
        if (conv) { convert_items<2>(F, E2_A + (F.vcu >> 3) * NWAVES + F.wave, NCONV * NWAVES, E2_SPLIT); }
        else {
        MoeOrder<4> S{(const LAS int*)(F.lds + TST_OFF), (const char*)(F.ws + (G1_FP8 ? WS_HF8 : WS_HBF)), (const char*)(F.ws + WS_WGU), (const int*)(F.ws + WS_LTOK), (const float*)(F.ws + WS_LW), split ? F.vcu - (F.vcu >> 3) : F.vcu, split ? NCOMP : F.G, 0, (size_t)1024 * DM * (G1_FP8 ? 1 : 2), (size_t)256 * DM * (G1_FP8 ? 1 : 2), true,
                      0, u1_end, 0, nullptr, 0, 0};
        EpiMoe1 E{F.ws + WS_HID};
        pg8::gemm_phase<EpiMoe1, MoeOrder<4>, true, true, G1_FP8 != 0>(F.lds + RING_OFF, idxl, DM, S, E);
        }
    } SEAM(7);
    if (IN(8)) REP(8) {
        unsigned* dflag = F.ctl + CW_DFLAG;
        if (n_defer > 0 && F.vcu >= 256 - n_defer) {
            MoeOrder<4> S1{(const LAS int*)(F.lds + TST_OFF), (const char*)(F.ws + (G1_FP8 ? WS_HF8 : WS_HBF)), (const char*)(F.ws + WS_WGU), (const int*)(F.ws + WS_LTOK), (const float*)(F.ws + WS_LW), F.vcu - (256 - n_defer), 256, 0, (size_t)1024 * DM * (G1_FP8 ? 1 : 2), (size_t)256 * DM * (G1_FP8 ? 1 : 2), true,
                           u1_end, u1_end + n_defer, 0, nullptr, 0, 0};
            EpiMoe1 E1{F.ws + WS_HID};
            pg8::gemm_phase<EpiMoe1, MoeOrder<4>, true, true, G1_FP8 != 0>(F.lds + RING_OFF, idxl, DM, S1, E1);
            if (F.tid == 0) { __builtin_amdgcn_fence(__ATOMIC_RELEASE, "agent"); asm volatile("s_waitcnt vmcnt(0)" ::: "memory"); __hip_atomic_fetch_add(dflag, 1u, __ATOMIC_RELAXED, __HIP_MEMORY_SCOPE_AGENT); }
        }
        MoeOrder<8> S{(const LAS int*)(F.lds + TST_OFF), (const char*)(F.ws + WS_HID), (const char*)(F.ws + WS_WD), (const int*)(F.ws + WS_LTOK), (const float*)(F.ws + WS_LW), F.vcu, F.G, (size_t)FE, (size_t)DM * FE, (size_t)256 * FE, false,
                      0, -1, n_defer, dflag, n_defer > 0 ? u1_end / 4 : 0, n_defer};
#ifndef G2_ALIGN
#define G2_ALIGN true
#endif
        EpiMoe2 E{(unsigned char*)(F.ws + WS_Y)};
        pg8::gemm_phase<EpiMoe2, MoeOrder<8>, G2_ALIGN, false, true>(F.lds + RING_OFF, idxl, FE, S, E);
    }
    P9Pre pp9; const bool pre9 = P9_PREF && IN(8) && IN(9) && (F.vcu * NWAVES + F.wave) < SEQ;
    if (IN(8) && IN(9)) { if (P9_PREF) xcd_barrier_pf(bar, [&]() { if (pre9) p9_prefetch(F, pp9); }); else xcd_barrier(bar); }
    if (IN(9)) REP(9) { p9_combine(F, pp9, pre9 && rep_ == 0); }
#ifdef PROBE_T
    { const LAS int* tst_ = (const LAS int*)(F.lds + TST_OFF); if (tst_[NEXP1] > PROBE_T && blockIdx.x == 0 && F.tid == 0) F.out[0] = __builtin_nanf(""); }
#endif
#undef IN
#undef SEAM
}

extern "C" void kernel_launch(void* const* d_in, const int* in_sizes, int n_in, void* d_out, int out_size, void* d_ws, size_t ws_size, hipStream_t stream) {
    static int grid = 0;
    if (grid == 0) {
        if (n_in != 22 || out_size != SEQ * DM || ws_size < WS_END) { fprintf(stderr, "kernel_launch: unexpected shapes (n_in %d, out %d, ws %zu < %zu); nothing launched\n", n_in, out_size, ws_size, (size_t)WS_END); grid = -1; return; }
        int dev = 0, cus = 0, per_cu = 0;
        if (hipGetDevice(&dev) != hipSuccess || hipDeviceGetAttribute(&cus, hipDeviceAttributeMultiprocessorCount, dev) != hipSuccess) { grid = -1; return; }
        if (hipFuncSetAttribute((const void*)mega_fwd, hipFuncAttributeMaxDynamicSharedMemorySize, LDS_BYTES) != hipSuccess) { fprintf(stderr, "kernel_launch: hipFuncSetAttribute failed\n"); grid = -1; return; }
        if (hipOccupancyMaxActiveBlocksPerMultiprocessor(&per_cu, (const void*)mega_fwd, NWAVES * 64, LDS_BYTES) != hipSuccess || per_cu < 1) { fprintf(stderr, "kernel_launch: occupancy query says %d blocks per CU; nothing launched\n", per_cu); (void)hipGetLastError(); grid = -1; return; }
        grid = cus;
        if (grid > 256) grid = 256;
    }
    if (grid < 0) return;
    (void)hipMemsetAsync((char*)d_ws + WS_CTL, 0, CTL_ZERO_BYTES, stream);
    Args a{};
    for (int i = 0; i < 22; ++i) a.in[i] = (const float*)d_in[i];
    a.out = (float*)d_out; a.ws = (unsigned char*)d_ws;
#if MK_ONE_LAUNCH
    a.ph_lo = 0; a.ph_hi = NPHASES;
    hipLaunchKernelGGL(mega_fwd, dim3(grid), dim3(NWAVES * 64), LDS_BYTES, stream, a);
#else
    for (int p = 0; p < NPHASES; ++p) { a.ph_lo = p; a.ph_hi = p + 1; hipLaunchKernelGGL(mega_fwd, dim3(grid), dim3(NWAVES * 64), LDS_BYTES, stream, a); }
#endif
    const hipError_t le = hipPeekAtLastError();
    if (le != hipSuccess) fprintf(stderr, "kernel_launch: launch failed: %s\n", hipGetErrorName(le));
}
```
